# Optimizing an MI355X kernel written in HIP

```python
import math
import jax
import jax.numpy as jnp
from jax import lax
import numpy as np

D_MODEL = 1024
BATCH = 16
SEQ = 2048
DEPTH = 4

GRID_W = 64
CTX_LEN = 256
N_MIXERS = 4
MIX_DIFF, MIX_GMLP, MIX_NATTEN, MIX_FOURIER = 0, 1, 2, 3
CTX_READERS = (MIX_DIFF, MIX_NATTEN)
EPS = 1e-6
NEG_INF = -1e30
ROPE_BASE = 10000.0

DA_HEADS = 8
DA_HEAD_DIM = 64
DA_V_DIM = 2 * DA_HEAD_DIM
DA_WIDTH = DA_HEADS * DA_V_DIM
DA_Q_BLOCK = 128

GM_CHUNK = 128
GM_GROUPS = 8
GM_WIDTH = 2 * D_MODEL
GM_GROUP_DIM = GM_WIDTH // GM_GROUPS

NA_HEADS = 16
NA_HEAD_DIM = D_MODEL // NA_HEADS
NA_WIDTH = NA_HEADS * NA_HEAD_DIM
NA_WIN_R = 8
NA_WIN_C = 16
NA_COL_BLOCK = 16
NA_COL_BAND = 2 * NA_COL_BLOCK

FN_GROUPS = 4

N_EXPERTS = 16
EXPERT_DIM = D_MODEL
EC_CAPACITY_FACTOR = 2

kernel_name = 'hybrid_diffusion_trunk'


def rmsnorm(x, g):
    xf = x.astype(jnp.float32)
    y = xf * lax.rsqrt(jnp.mean(xf * xf, axis=-1, keepdims=True) + EPS)
    return (y * g.astype(jnp.float32)).astype(x.dtype)


def adaln_params(cond, w, b, n_mod):
    m = jax.nn.silu(cond) @ w[:, :n_mod * D_MODEL] + b[:n_mod * D_MODEL]
    return [t[:, None, :] for t in jnp.split(m, n_mod, axis=-1)]


def modulate(h, shift, scale):
    return h * (1.0 + scale) + shift


def axial_rope_angles(n_tok, dim):
    t = jnp.arange(n_tok, dtype=jnp.int32)
    n_freq = dim // 4
    inv = ROPE_BASE ** (-jnp.arange(n_freq, dtype=jnp.float32) / n_freq)
    rows = (t // GRID_W).astype(jnp.float32)
    cols = (t % GRID_W).astype(jnp.float32)
    return rows[:, None] * inv, cols[:, None] * inv


def rope_axis(x, ang):
    x1, x2 = jnp.split(x, 2, axis=-1)
    cos = jnp.cos(ang)[:, None, :].astype(x.dtype)
    sin = jnp.sin(ang)[:, None, :].astype(x.dtype)
    return jnp.concatenate([x1 * cos - x2 * sin, x1 * sin + x2 * cos], axis=-1)


def axial_rope(x, ang_r, ang_c):
    xr, xc = jnp.split(x, 2, axis=-1)
    return jnp.concatenate([rope_axis(xr, ang_r), rope_axis(xc, ang_c)], axis=-1)


def query_blocks(fn, q, block):
    b, n = q.shape[:2]
    qb = jnp.moveaxis(q.reshape((b, n // block, block) + q.shape[2:]), 1, 0)
    out = jnp.moveaxis(lax.map(fn, qb), 0, 1)
    return out.reshape((b, n) + out.shape[3:])


def dense_attention(q, k, v):
    s = jnp.einsum('bqhd,bkhd->bhqk', q, k).astype(jnp.float32) * (q.shape[-1] ** -0.5)
    p = jax.nn.softmax(s, axis=-1).astype(v.dtype)
    return jnp.einsum('bhqk,bkhd->bqhd', p, v)


def diff_project(h, w_in, with_q):
    b, n, _ = h.shape
    k, v = jnp.split(h @ w_in[:, DA_WIDTH:], 2, axis=-1)
    k = k.reshape(b, n, DA_HEADS, 2, DA_HEAD_DIM)
    v = v.reshape(b, n, DA_HEADS, DA_V_DIM)
    q = (h @ w_in[:, :DA_WIDTH]).reshape(b, n, DA_HEADS, 2, DA_HEAD_DIM) if with_q else None
    return q, k, v


def rope_heads(t, ang_r, ang_c):
    b, n = t.shape[:2]
    return axial_rope(t.reshape(b, n, -1, DA_HEAD_DIM), ang_r, ang_c).reshape(t.shape)


def diff_attend(q, k, v, lam):
    s = jnp.einsum('bqhjd,bkhjd->bhjqk', q, k).astype(jnp.float32) * (DA_HEAD_DIM ** -0.5)
    p = jax.nn.softmax(s, axis=-1)
    a = (p[:, :, 0] - lam * p[:, :, 1]).astype(v.dtype)
    return jnp.einsum('bhqk,bkhe->bqhe', a, v)


def diff_output(o, subln_g, lam_init, w_out):
    b, n = o.shape[:2]
    o = rmsnorm(o, subln_g) * (1.0 - lam_init)
    return o.reshape(b, n, DA_WIDTH) @ w_out


def diff_attention_mixer(hx, hc, w_in, lq1, lk1, lq2, lk2, subln_g, w_out, lam_init, ang_r, ang_c, ctx_out):
    q, k, v = diff_project(hx, w_in, True)
    q = rope_heads(q, ang_r, ang_c)
    k = rope_heads(k, ang_r, ang_c)
    qc, kc, vc = diff_project(hc, w_in, ctx_out)
    lam = (jnp.exp(jnp.sum(lq1.astype(jnp.float32) * lk1.astype(jnp.float32)))
           - jnp.exp(jnp.sum(lq2.astype(jnp.float32) * lk2.astype(jnp.float32))) + lam_init)
    k_all = jnp.concatenate([kc, k], axis=1)
    v_all = jnp.concatenate([vc, v], axis=1)
    o = query_blocks(lambda qb: diff_attend(qb, k_all, v_all, lam), q, DA_Q_BLOCK)
    y = diff_output(o, subln_g, lam_init, w_out)
    yc = diff_output(diff_attend(qc, kc, vc, lam), subln_g, lam_init, w_out) if ctx_out else None
    return y, yc


def chunk_gmlp(h, w_in, v_g, w_s, b_s, w_out):
    b, n, _ = h.shape
    u, v = jnp.split(jax.nn.gelu(h @ w_in), 2, axis=-1)
    v = rmsnorm(v, v_g)
    v = v.reshape(b, n // GM_CHUNK, GM_CHUNK, GM_GROUPS, GM_GROUP_DIM)
    sv = jnp.einsum('gpq,bcqge->bcpge', w_s, v) + jnp.swapaxes(b_s, 0, 1)[:, :, None]
    return (u * sv.reshape(b, n, GM_WIDTH)) @ w_out


def natten_latent(q, k, v, k_ctx, v_ctx, rpb):
    b, n, h, d = q.shape
    rows = n // GRID_W
    wr = min(NA_WIN_R, rows)
    n_cb = GRID_W // NA_COL_BLOCK
    qg = q.reshape(b, rows, GRID_W, h, d)
    kg = k.reshape(b, rows, GRID_W, h, d)
    vg = v.reshape(b, rows, GRID_W, h, d)
    band_start = np.clip(np.arange(n_cb) * NA_COL_BLOCK - NA_COL_BLOCK // 2, 0, GRID_W - NA_COL_BAND)
    band_cols = band_start[:, None] + np.arange(NA_COL_BAND)
    q_cols = np.arange(GRID_W).reshape(n_cb, NA_COL_BLOCK)
    win_c0 = np.clip(q_cols - NA_WIN_C // 2, 0, GRID_W - NA_WIN_C)
    kc_b = band_cols[:, None, :]
    col_ok = (kc_b >= win_c0[:, :, None]) & (kc_b < win_c0[:, :, None] + NA_WIN_C)
    dc_idx = np.clip(kc_b - q_cols[:, :, None] + NA_WIN_C - 1, 0, 2 * NA_WIN_C - 2)
    scale = d ** -0.5

    def one_row(r):
        r0 = jnp.clip(r - wr // 2, 0, rows - wr)
        kb = lax.dynamic_slice_in_dim(kg, r0, wr, axis=1)[:, :, band_cols]
        vb = lax.dynamic_slice_in_dim(vg, r0, wr, axis=1)[:, :, band_cols]
        qr = lax.dynamic_index_in_dim(qg, r, axis=1, keepdims=False).reshape(b, n_cb, NA_COL_BLOCK, h, d)
        dr = r0 + jnp.arange(wr) - r
        bias = rpb[:, dr + NA_WIN_R - 1][:, :, dc_idx]
        bias = jnp.transpose(bias, (0, 2, 3, 1, 4))
        s_loc = jnp.einsum('bjqhd,brjkhd->bhjqrk', qr, kb).astype(jnp.float32) * scale + bias
        s_loc = jnp.where(col_ok[:, :, None, :], s_loc, NEG_INF)
        s_ctx = jnp.einsum('bjqhd,bkhd->bhjqk', qr, k_ctx).astype(jnp.float32) * scale
        s = jnp.concatenate([s_loc.reshape(b, h, n_cb, NA_COL_BLOCK, wr * NA_COL_BAND), s_ctx], axis=-1)
        p = jax.nn.softmax(s, axis=-1).astype(v.dtype)
        p_loc = p[..., :wr * NA_COL_BAND].reshape(b, h, n_cb, NA_COL_BLOCK, wr, NA_COL_BAND)
        p_ctx = p[..., wr * NA_COL_BAND:]
        o = (jnp.einsum('bhjqrk,brjkhd->bjqhd', p_loc, vb)
             + jnp.einsum('bhjqk,bkhd->bjqhd', p_ctx, v_ctx))
        return o.reshape(b, GRID_W, h, d)

    out = lax.map(one_row, jnp.arange(rows))
    return jnp.moveaxis(out, 0, 1).reshape(b, n, h, d)


def natten_mixer(hx, hc, w_in, rpb, w_out, ctx_out):
    b, n, _ = hx.shape
    lc = hc.shape[1]
    q, k, v = [t.reshape(b, n, NA_HEADS, NA_HEAD_DIM) for t in jnp.split(hx @ w_in, 3, axis=-1)]
    kc, vc = [t.reshape(b, lc, NA_HEADS, NA_HEAD_DIM) for t in jnp.split(hc @ w_in[:, NA_WIDTH:], 2, axis=-1)]
    y = natten_latent(q, k, v, kc, vc, rpb).reshape(b, n, NA_WIDTH) @ w_out
    yc = None
    if ctx_out:
        qc = (hc @ w_in[:, :NA_WIDTH]).reshape(b, lc, NA_HEADS, NA_HEAD_DIM)
        yc = dense_attention(qc, kc, vc).reshape(b, lc, NA_WIDTH) @ w_out
    return y, yc


def fourier_mix(h, w_out):
    b, n, d = h.shape
    hg = h.astype(jnp.float32).reshape(b, n, FN_GROUPS, d // FN_GROUPS)
    f = jnp.real(jnp.fft.fftn(hg, axes=(1, 3), norm='ortho'))
    return f.reshape(b, n, d).astype(h.dtype) @ w_out


def expert_choice_moe(h, w_router, w_gate, w_up, w_down):
    b, n, d = h.shape
    cap = EC_CAPACITY_FACTOR * n // N_EXPERTS
    aff = jax.nn.softmax((h @ w_router).astype(jnp.float32), axis=-1)
    top_aff, top_idx = lax.top_k(jnp.swapaxes(aff, 1, 2), cap)
    idx = top_idx.reshape(b, N_EXPERTS * cap)
    bidx = jnp.arange(b)[:, None]
    xs = h[bidx, idx].reshape(b, N_EXPERTS, cap, d)
    hid = jax.nn.silu(jnp.einsum('becd,edf->becf', xs, w_gate)) * jnp.einsum('becd,edf->becf', xs, w_up)
    ys = jnp.einsum('becf,efd->becd', hid, w_down) * top_aff[..., None].astype(h.dtype)
    return jnp.zeros_like(h).at[bidx, idx].add(ys.reshape(b, N_EXPERTS * cap, d))


def setup_inputs(seed: int = 0) -> dict:
    key = jax.random.key(seed)
    keys = iter(jax.random.split(key, 40))

    def nrm(shape, scale):
        return jax.random.normal(next(keys), shape, jnp.float32) * scale

    def gain(shape):
        return 1.0 + nrm(shape, 0.02)

    n_a, n_b, n_c, n_d = [len(range(kind, DEPTH, N_MIXERS)) for kind in range(N_MIXERS)]
    d = D_MODEL
    return {
        'x': nrm((BATCH, SEQ, d), 1.0),
        'c': nrm((BATCH, d), 1.0),
        'ctx': nrm((BATCH, CTX_LEN, d), 1.0),
        'c_ctx': nrm((d,), 1.0),
        'ada_w': nrm((DEPTH, d, 6 * d), 0.5 * d ** -0.5),
        'ada_b': nrm((DEPTH, 6 * d), 0.01),
        'mixer_norm_g': gain((DEPTH, d)),
        'moe_norm_g': gain((DEPTH, d)),
        'router_w': nrm((DEPTH, d, N_EXPERTS), d ** -0.5),
        'moe_w_gate': nrm((DEPTH, N_EXPERTS, d, EXPERT_DIM), d ** -0.5),
        'moe_w_up': nrm((DEPTH, N_EXPERTS, d, EXPERT_DIM), d ** -0.5),
        'moe_w_down': nrm((DEPTH, N_EXPERTS, EXPERT_DIM, d), EXPERT_DIM ** -0.5),
        'da_w_in': nrm((n_a, d, 3 * DA_WIDTH), d ** -0.5),
        'da_lambda_q1': nrm((n_a, DA_HEAD_DIM), 0.1),
        'da_lambda_k1': nrm((n_a, DA_HEAD_DIM), 0.1),
        'da_lambda_q2': nrm((n_a, DA_HEAD_DIM), 0.1),
        'da_lambda_k2': nrm((n_a, DA_HEAD_DIM), 0.1),
        'da_subln_g': gain((n_a, DA_V_DIM)),
        'da_w_out': nrm((n_a, DA_WIDTH, d), DA_WIDTH ** -0.5),
        'gm_w_in': nrm((n_b, d, 2 * GM_WIDTH), d ** -0.5),
        'gm_v_g': gain((n_b, GM_WIDTH)),
        'gm_w_s': nrm((n_b, GM_GROUPS, GM_CHUNK, GM_CHUNK), GM_CHUNK ** -0.5),
        'gm_b_s': 1.0 + nrm((n_b, GM_GROUPS, GM_CHUNK), 0.02),
        'gm_w_out': nrm((n_b, GM_WIDTH, d), GM_WIDTH ** -0.5),
        'na_w_in': nrm((n_c, d, 3 * NA_WIDTH), d ** -0.5),
        'na_rpb': nrm((n_c, NA_HEADS, 2 * NA_WIN_R - 1, 2 * NA_WIN_C - 1), 0.1),
        'na_w_out': nrm((n_c, NA_WIDTH, d), NA_WIDTH ** -0.5),
        'fn_w_out': nrm((n_d, d, d), d ** -0.5),
        'final_norm_g': gain((d,)),
    }


def reference(x, c, ctx, c_ctx, ada_w, ada_b, mixer_norm_g, moe_norm_g, router_w,
              moe_w_gate, moe_w_up, moe_w_down,
              da_w_in, da_lambda_q1, da_lambda_k1, da_lambda_q2, da_lambda_k2, da_subln_g, da_w_out,
              gm_w_in, gm_v_g, gm_w_s, gm_b_s, gm_w_out,
              na_w_in, na_rpb, na_w_out, fn_w_out, final_norm_g):
    n_tok = x.shape[1]
    ang_r, ang_c = axial_rope_angles(n_tok, DA_HEAD_DIM)
    readers = [i for i in range(DEPTH) if i % N_MIXERS in CTX_READERS]
    last_reader = max(readers) if readers else -1
    for i in range(DEPTH):
        kind, j = i % N_MIXERS, i // N_MIXERS
        need_ctx = i <= last_reader
        update_ctx = i < last_reader
        sh1, sc1, g1, sh2, sc2, g2 = adaln_params(c, ada_w[i], ada_b[i], 6)
        hx = modulate(rmsnorm(x, mixer_norm_g[i]), sh1, sc1)
        hc = None
        if need_ctx:
            cmod = adaln_params(c_ctx[None, :], ada_w[i], ada_b[i], 6 if update_ctx else 3)
            hc = modulate(rmsnorm(ctx, mixer_norm_g[i]), cmod[0], cmod[1])
        if kind == MIX_DIFF:
            lam_init = 0.8 - 0.6 * math.exp(-0.3 * i)
            y, yc = diff_attention_mixer(hx, hc, da_w_in[j], da_lambda_q1[j], da_lambda_k1[j],
                                         da_lambda_q2[j], da_lambda_k2[j], da_subln_g[j], da_w_out[j],
                                         lam_init, ang_r, ang_c, update_ctx)
        elif kind == MIX_GMLP:
            y = chunk_gmlp(hx, gm_w_in[j], gm_v_g[j], gm_w_s[j], gm_b_s[j], gm_w_out[j])
            yc = chunk_gmlp(hc, gm_w_in[j], gm_v_g[j], gm_w_s[j], gm_b_s[j], gm_w_out[j]) if update_ctx else None
        elif kind == MIX_NATTEN:
            y, yc = natten_mixer(hx, hc, na_w_in[j], na_rpb[j], na_w_out[j], update_ctx)
        else:
            y = fourier_mix(hx, fn_w_out[j])
            yc = fourier_mix(hc, fn_w_out[j]) if update_ctx else None
        x = x + g1 * y
        hx = modulate(rmsnorm(x, moe_norm_g[i]), sh2, sc2)
        x = x + g2 * expert_choice_moe(hx, router_w[i], moe_w_gate[i], moe_w_up[i], moe_w_down[i])
        if update_ctx:
            ctx = ctx + cmod[2] * yc
            hc = modulate(rmsnorm(ctx, moe_norm_g[i]), cmod[3], cmod[4])
            ctx = ctx + cmod[5] * expert_choice_moe(hc, router_w[i], moe_w_gate[i], moe_w_up[i], moe_w_down[i])
    return rmsnorm(x, final_norm_g)
```

```cpp
#include <hip/hip_runtime.h>
#include <cstdio>
#include <cstdint>

#define LAS __attribute__((address_space(3)))
#define GAS __attribute__((address_space(1)))
typedef unsigned short bf16_t;
typedef short bf16x8 __attribute__((ext_vector_type(8)));
typedef short s16x4 __attribute__((ext_vector_type(4)));
typedef float f32x4 __attribute__((ext_vector_type(4)));
typedef float f32x2 __attribute__((ext_vector_type(2)));
typedef float f32x16 __attribute__((ext_vector_type(16)));
typedef unsigned u32x4 __attribute__((ext_vector_type(4)));
typedef unsigned u32x2 __attribute__((ext_vector_type(2)));

constexpr int D = 1024, NB = 16, SEQ = 2048, NLAT = NB * SEQ, CTXL = 256, NCTX = NB * CTXL, MALL = NLAT + NCTX;
constexpr int NE = 16, CAP = 256, CAPC = 32, KVL = CTXL + SEQ;
constexpr int MODW = 6 * D, MODR = 17;
constexpr float EPS = 1e-6f;
constexpr int NWAVES = 8, NTHREADS = 512;

constexpr size_t MiB = (size_t)1 << 20;
constexpr size_t WS_CTL = 0, CTL_BYTES = 1 * MiB;
constexpr size_t WS_MOD = 1 * MiB;
constexpr size_t WS_ROPE = 3 * MiB;
constexpr size_t WS_CS = 3 * MiB + 65536;
constexpr size_t WS_AFF = 4 * MiB;
constexpr size_t WS_SLOTROW = 7 * MiB;
constexpr size_t WS_SLOTAFF = 7 * MiB + 524288;
constexpr size_t WS_TOKSLOT = 8 * MiB;
constexpr size_t WS_TOKSLOTC = 10 * MiB;
constexpr size_t WS_SUMSQ = 21 * MiB;
constexpr size_t WS_DP = 12 * MiB;
constexpr size_t WS_WQKV0 = 28 * MiB, WS_WO0 = 34 * MiB, WS_WGIN = 36 * MiB, WS_WGOUT = 44 * MiB, WS_WQKV2 = 48 * MiB, WS_WO2 = 54 * MiB, WS_WFO = 56 * MiB;
constexpr size_t WS_WGU = 58 * MiB;
constexpr size_t WS_WD = 122 * MiB;
constexpr size_t WS_X = 154 * MiB;
constexpr size_t WS_CTX = 282 * MiB;
constexpr size_t WS_HX = 298 * MiB;
constexpr size_t WS_RA = 370 * MiB;
constexpr size_t WS_RB = 658 * MiB;
constexpr size_t WS_W2 = 946 * MiB;
constexpr size_t WS_END = 1042 * MiB;
constexpr size_t WGU_OF(int layer) { return layer == 3 ? WS_WGU + 32 * MiB : ((layer & 1) ? WS_W2 : WS_WGU); }
constexpr size_t WD_OF(int layer) { return layer == 3 ? WS_WD + 16 * MiB : ((layer & 1) ? WS_W2 + 64 * MiB : WS_WD); }
constexpr size_t RA_HID = WS_RA, RA_YS = WS_RA + 144 * MiB, RA_APP = WS_RA;
constexpr size_t RB_Q = WS_RB, RB_K = WS_RB + 72 * MiB, RB_V = WS_RB + 144 * MiB, RB_O = WS_RB + 216 * MiB;
constexpr size_t RB_U = WS_RB, RB_VT = WS_RB + 144 * MiB;
constexpr size_t RB_PQ = WS_RB, RB_F = WS_RB + 128 * MiB;

constexpr int LDS_RING = 131072;
constexpr int LDS_MISC = LDS_RING;
constexpr int LDS_BYTES = 147456;

#define LDS_WAIT() asm volatile("s_waitcnt lgkmcnt(0)" ::: "memory")
#define VM_WAIT() asm volatile("s_waitcnt vmcnt(0)" ::: "memory")
__device__ __forceinline__ unsigned cvt_pk_bf16(float lo, float hi) { unsigned r; asm volatile("v_cvt_pk_bf16_f32 %0, %1, %2" : "=v"(r) : "v"(lo), "v"(hi)); return r; }
__device__ __forceinline__ float bf_lo(unsigned w) { return __uint_as_float(w << 16); }
__device__ __forceinline__ float bf_hi(unsigned w) { return __uint_as_float(w & 0xffff0000u); }
__device__ __forceinline__ float wave_sum(float v) {
#pragma unroll
    for (int o = 1; o < 64; o <<= 1) v += __shfl_xor(v, o);
    return v;
}
__device__ __forceinline__ float fast_rcp(float x) { return __builtin_amdgcn_rcpf(x); }
__device__ __forceinline__ float silu_f(float x) { return x * fast_rcp(1.0f + __builtin_amdgcn_exp2f(-1.4426950408889634f * x)); }
__device__ __forceinline__ float gelu_tanh_f(float x) {
    const float y2 = 1.5957691216057308f * (x + 0.044715f * x * x * x);
    return x - x * fast_rcp(1.0f + __builtin_amdgcn_exp2f(1.4426950408889634f * y2));
}

__device__ __forceinline__ f32x4 gelu_tanh4(const f32x4 x) {
    constexpr float cp = -1.5957691216057308f * 1.4426950408889634f, ca = 0.044715f * cp;
    const f32x4 t = __builtin_elementwise_fma(x * x, (f32x4){ca, ca, ca, ca}, (f32x4){cp, cp, cp, cp}) * x; f32x4 e, r;
#pragma unroll
    for (int j = 0; j < 4; ++j) e[j] = __builtin_amdgcn_exp2f(t[j]);
    f32x2 dl = (f32x2){e[0], e[1]}, dh = (f32x2){e[2], e[3]};
#if defined(__HIP_DEVICE_COMPILE__)
    asm("v_pk_add_f32 %0, %1, 1.0 op_sel_hi:[1,0]" : "=v"(dl) : "v"(dl));
    asm("v_pk_add_f32 %0, %1, 1.0 op_sel_hi:[1,0]" : "=v"(dh) : "v"(dh));
#endif
    r[0] = __builtin_amdgcn_rcpf(dl[0]); r[1] = __builtin_amdgcn_rcpf(dl[1]); r[2] = __builtin_amdgcn_rcpf(dh[0]); r[3] = __builtin_amdgcn_rcpf(dh[1]);
    return x * r;
}

#define XB_TMO      128
#define XB_XCNT(j)  (256  + 64 * (j))
#define XB_XSUB(j)  (1280 + 64 * (j))
#define XB_XGEN(j)  (2304 + 64 * (j))
#define XB_TOP      3328
#define XB_TOPGEN   3392
#define XCD_BAR_WORDS 3456
#define XB_SPIN_CAP (1u << 18)
__device__ __forceinline__ unsigned xb_ld(unsigned* p)              { return __hip_atomic_load(p, __ATOMIC_RELAXED, __HIP_MEMORY_SCOPE_AGENT); }
__device__ __forceinline__ unsigned xb_add(unsigned* p, unsigned v) { return __hip_atomic_fetch_add(p, v, __ATOMIC_RELAXED, __HIP_MEMORY_SCOPE_AGENT); }
__device__ __forceinline__ unsigned xb_xcc_id() { return (unsigned)__builtin_amdgcn_s_getreg((3 << 11) | 20) & 0xFu; }
#define XB_SPIN(cond, bar) do { unsigned _sp = 0; while (cond) { __builtin_amdgcn_s_sleep(1); \
    if ((++_sp & 255u) == 0u) { if (xb_ld(&(bar)[XB_TMO])) break; if (_sp > XB_SPIN_CAP) { atomicAdd(&(bar)[XB_TMO], 1u); break; } } } } while (0)
struct XcdBarrier { unsigned* bar; unsigned x; volatile LAS unsigned* st; };
__device__ __forceinline__ XcdBarrier xcd_barrier_post(unsigned* bar, volatile LAS unsigned* st) {
    XcdBarrier b; b.bar = bar; b.x = xb_xcc_id(); b.st = st;
    if (threadIdx.x == 0) (void)xb_add(&bar[XB_XCNT(b.x)], 1u);
    return b;
}
__device__ __forceinline__ void xcd_barrier_complete(unsigned* bar, unsigned x, unsigned& nloc, unsigned& nx) {
    const unsigned G = gridDim.x * gridDim.y * gridDim.z;
    unsigned sum, cnt, mine, sp = 0u;
    for (;;) {
        sum = 0u; cnt = 0u; mine = 0u;
#pragma unroll
        for (unsigned j = 0; j < 16; ++j) { const unsigned c = xb_ld(&bar[XB_XCNT(j)]); sum += c; cnt += (c > 0u) ? 1u : 0u; mine = (j == x) ? c : mine; }
        if (sum == G) break;
        __builtin_amdgcn_s_sleep(1);
        if ((++sp & 255u) == 0u) { if (xb_ld(&bar[XB_TMO])) break; if (sp > XB_SPIN_CAP) { atomicAdd(&bar[XB_TMO], 1u); break; } }
    }
    nloc = mine > 0u ? mine : 1u; nx = cnt > 0u ? cnt : 1u;
}
__device__ __forceinline__ void xcd_barrier(const XcdBarrier& b) {
    asm volatile("s_waitcnt vmcnt(0)" ::: "memory");
    __syncthreads();
    if (threadIdx.x == 0) {
        unsigned* bar = b.bar;
        __builtin_amdgcn_s_waitcnt(0);
        unsigned nloc = b.st[0], nx = b.st[1];
        if (nloc == 0u) { xcd_barrier_complete(bar, b.x, nloc, nx); b.st[0] = nloc; b.st[1] = nx; }
        const unsigned old = xb_add(&bar[XB_XSUB(b.x)], 1u);
        const unsigned gen = old / nloc;
        if (old + 1u == (gen + 1u) * nloc) {
            __builtin_amdgcn_fence(__ATOMIC_RELEASE, "agent");
            asm volatile("s_waitcnt vmcnt(0)" ::: "memory");
            const unsigned og = xb_add(&bar[XB_TOP], 1u);
            const unsigned tg = og / nx;
            if (og + 1u == (tg + 1u) * nx) xb_add(&bar[XB_TOPGEN], 1u);
            else XB_SPIN(xb_ld(&bar[XB_TOPGEN]) == tg, bar);
            __builtin_amdgcn_fence(__ATOMIC_ACQUIRE, "agent");
            xb_add(&bar[XB_XGEN(b.x)], 1u);
            asm volatile("s_waitcnt vmcnt(0)" ::: "memory");
        } else {
            XB_SPIN(xb_ld(&bar[XB_XGEN(b.x)]) == gen, bar);
            __builtin_amdgcn_fence(__ATOMIC_ACQUIRE, "agent");
            asm volatile("s_waitcnt vmcnt(0)" ::: "memory");
        }
    }
    __syncthreads();
}

namespace gm {
constexpr int BM = 256, BK = 64, HALF = 128, HTB = HALF * BK * 2, STAGE_BYTES = 8 * HTB;
__device__ __forceinline__ int lds_byte(int r, int c) { const int st = (r >> 4) * 2 + (c >> 5), rr = r & 15, cc = c & 31, ob = rr * 64 + cc * 2; return st * 1024 + (ob ^ (((ob >> 9) & 1) << 5)); }
__device__ __forceinline__ void stage_rc(int b, int& R, int& C) { const int st = b / 1024, sb = b % 1024, swz = sb ^ (((sb >> 9) & 1) << 5); R = (st >> 1) * 16 + swz / 64; C = (st & 1) * 32 + (swz % 64) / 2; }
__device__ __forceinline__ int perm32(int rho) { const int n = rho >> 4, i = rho & 15; return 8 * (i >> 2) + 4 * n + (i & 3); }
struct Unit { int pm, pn, z; };
__device__ __forceinline__ int xcd_remap(int L, int nwg) { const int q = nwg / 8, r = nwg % 8, xcd = L % 8, off = L / 8; return (xcd < r ? xcd * (q + 1) : r * (q + 1) + (xcd - r) * q) + off; }
__device__ __forceinline__ void tile_of(int w, int nM, int nN, int& pm, int& pn) { const int nig = 8 * nN, gid = w / nig, fm = gid * 8, gsz = (nM - fm) < 8 ? (nM - fm) : 8; pm = fm + ((w % nig) % gsz); pn = (w % nig) / gsz; }

typedef f32x4 Acc[2][2][4][2];
#ifdef MK_F8_UNSCALED
constexpr int F8_ONE = 0;
#else
constexpr int F8_ONE = 0x7f7f7f7f;
#endif
constexpr float F8_SX = 8.0f, F8_SW = 64.0f, F8_SH = 4.0f;
__device__ __forceinline__ unsigned pk4_fp8(float a, float b, float c, float d) {
    int w = 0;
    w = __builtin_amdgcn_cvt_pk_fp8_f32(__builtin_amdgcn_fmed3f(a, -440.f, 440.f), __builtin_amdgcn_fmed3f(b, -440.f, 440.f), w, false);
    w = __builtin_amdgcn_cvt_pk_fp8_f32(__builtin_amdgcn_fmed3f(c, -440.f, 440.f), __builtin_amdgcn_fmed3f(d, -440.f, 440.f), w, true);
    return (unsigned)w;
}
typedef int i32x4_t __attribute__((ext_vector_type(4)));
typedef int i32x8_t __attribute__((ext_vector_type(8)));
__device__ __forceinline__ void mfma_f8(f32x4& c, const i32x8_t a, const i32x8_t b) {
#if !defined(__HIP_DEVICE_COMPILE__)
    (void)c; (void)a; (void)b;
#elif defined(MK_F8_UNSCALED)
    asm volatile("v_mfma_f32_16x16x128_f8f6f4 %0, %1, %2, %0" : "+v"(c) : "v"(a), "v"(b));
#else
    const int one = F8_ONE; asm volatile("v_mfma_scale_f32_16x16x128_f8f6f4 %0, %1, %2, %0, %3, %3 op_sel_hi:[0,0,0]" : "+v"(c) : "v"(a), "v"(b), "v"(one));
#endif
}
template <class P, class = void> struct is_f8 { static constexpr bool value = false; };
template <class P> struct is_f8<P, decltype((void)P::F8)> { static constexpr bool value = P::F8; };

template <class P>
__device__ __forceinline__ void gemm_phase(LAS unsigned char* lds, const P& p, int cu = -1) {
    int tid = threadIdx.x; asm volatile("" : "+v"(tid));
    const int wid = __builtin_amdgcn_readfirstlane(tid >> 6), lane = tid & 63, wr = wid >> 2, wc = wid & 3, fr = lane & 15, fq = lane >> 4;
    int K = p.K(); asm volatile("" : "+s"(K));
    const int nt = K / BK;
    const unsigned lda = p.lda(), ldb = p.ldb();
    const int G = gridDim.x, c = cu < 0 ? (int)blockIdx.x : cu, nwg = p.nunits();
    if (c >= nwg) return;
    unsigned voffA[2], voffB[2], cA2[2]; int RA[2];
#pragma unroll
    for (int i = 0; i < 2; ++i) { int R, C; stage_rc(tid * 16 + i * 8192, R, C); const int Rb = P::PERM ? ((R & ~31) + perm32(R & 31)) : R;
        RA[i] = R; cA2[i] = (unsigned)C * 2u; voffA[i] = (unsigned)R * lda + (unsigned)C * 2u; voffB[i] = (unsigned)Rb * ldb + (unsigned)C * 2u; }
    const size_t hstepA = (size_t)HALF * lda, hstepB = (size_t)HALF * ldb;
    const unsigned ldsw = (unsigned)wid * 1024u;
    const int aoff = lds_byte(wr * 64 + fr, fq * 8), boff = lds_byte(wc * 32 + fr, fq * 8);
    struct Src { const char* a; const char* b; unsigned ga[2][2]; };
    const char* araw = P::GATHER ? p.araw() : nullptr;
#define GM_GLDS(gp, lp) __builtin_amdgcn_global_load_lds((const unsigned*)(gp), (LAS unsigned*)(lp), 16, 0, 0)
#define GM_SA(b, h) (((b) * 2 + (h)) * HTB)
#define GM_SB(b, h) ((4 + (b) * 2 + (h)) * HTB)
#define GM_STAGE_B(bufoff, ptr) do { GM_GLDS((ptr) + voffB[0], lds + (bufoff) + ldsw); GM_GLDS((ptr) + voffB[1], lds + (bufoff) + ldsw + 8192); } while (0)
#define GM_STAGE_A(bufoff, S, h, koff) do { if constexpr (P::GATHER) { GM_GLDS(araw + (S).ga[h][0] + (koff), lds + (bufoff) + ldsw); GM_GLDS(araw + (S).ga[h][1] + (koff), lds + (bufoff) + ldsw + 8192); } \
        else if constexpr (P::AZERO) { const size_t ko_ = (size_t)(koff); const char* ab_ = ((ko_ >= 256) == ((h) == 1)) ? (S).a + (size_t)(h) * hstepA + (ko_ & 255) : p.zero_base(); \
            GM_GLDS(ab_ + voffA[0], lds + (bufoff) + ldsw); GM_GLDS(ab_ + voffA[1], lds + (bufoff) + ldsw + 8192); } \
        else { GM_GLDS((S).a + (size_t)(h) * hstepA + (koff) + voffA[0], lds + (bufoff) + ldsw); GM_GLDS((S).a + (size_t)(h) * hstepA + (koff) + voffA[1], lds + (bufoff) + ldsw + 8192); } } while (0)
#define GM_LDA(dst, b, h) do { _Pragma("unroll") for (int m = 0; m < 4; ++m) _Pragma("unroll") for (int k = 0; k < 2; ++k) dst[m][k] = *(const LAS bf16x8*)(lds + GM_SA(b, h) + aoff + m * 2048 + k * 1024); } while (0)
#define GM_LDB(dst, b, h) do { _Pragma("unroll") for (int n = 0; n < 2; ++n) _Pragma("unroll") for (int k = 0; k < 2; ++k) dst[n][k] = *(const LAS bf16x8*)(lds + GM_SB(b, h) + boff + n * 2048 + k * 1024); } while (0)
#define GM_CAT8(X) __builtin_shufflevector(__builtin_bit_cast(i32x4_t, X[0]), __builtin_bit_cast(i32x4_t, X[1]), 0, 1, 2, 3, 4, 5, 6, 7)
#define GM_MMA(ai, bj, At, Bt) do { __builtin_amdgcn_s_setprio(1); _Pragma("unroll") for (int m = 0; m < 4; ++m) _Pragma("unroll") for (int n = 0; n < 2; ++n) { \
        if constexpr (is_f8<P>::value) mfma_f8(acc[ai][bj][m][n], GM_CAT8(Bt[n]), GM_CAT8(At[m])); \
        else { _Pragma("unroll") for (int k = 0; k < 2; ++k) acc[ai][bj][m][n] = __builtin_amdgcn_mfma_f32_16x16x32_bf16(Bt[n][k], At[m][k], acc[ai][bj][m][n], 0, 0, 0); } } __builtin_amdgcn_s_setprio(0); } while (0)
#define GM_WAIT_V(n) asm volatile("s_waitcnt vmcnt(" #n ")" ::: "memory")
#define GM_WAIT_L(n) asm volatile("s_waitcnt lgkmcnt(" #n ")" ::: "memory")
#define GM_BAR __builtin_amdgcn_s_barrier()
#define GM_SCHED __builtin_amdgcn_sched_barrier(0)
#define GM_LOAD_SRC(S, u) do { (S).a = p.abase(u); (S).b = p.bbase(u); if constexpr (P::GATHER) { const int* _ix = p.gidx(u); _Pragma("unroll") for (int _h = 0; _h < 2; ++_h) _Pragma("unroll") for (int _i = 0; _i < 2; ++_i) \
        (S).ga[_h][_i] = (unsigned)_ix[_h * HALF + RA[_i]]; } } while (0)
#define GM_ADOPT(D, S) do { (D).a = (S).a; (D).b = (S).b; if constexpr (P::GATHER) { _Pragma("unroll") for (int _h = 0; _h < 2; ++_h) _Pragma("unroll") for (int _i = 0; _i < 2; ++_i) (D).ga[_h][_i] = (S).ga[_h][_i] * lda + cA2[_i]; } } while (0)
    Unit cur, nxt, nx2; int ui = 0;
    p.unit(xcd_remap(c, nwg), cur);
    Src cs, ns, fs;
    GM_LOAD_SRC(fs, cur); GM_ADOPT(cs, fs);
    bool has_next = ((long)G + c) < (long)nwg;
    if (has_next) { p.unit(xcd_remap(G + c, nwg), nxt); GM_LOAD_SRC(ns, nxt); } else { nxt = cur; ns = fs; }
    Acc acc;
#pragma unroll
    for (int a = 0; a < 2; ++a)
#pragma unroll
        for (int b = 0; b < 2; ++b)
#pragma unroll
            for (int m = 0; m < 4; ++m)
#pragma unroll
                for (int n = 0; n < 2; ++n) acc[a][b][m][n] = (f32x4){0.f, 0.f, 0.f, 0.f};
    bf16x8 At[4][2], B0[2][2], B1[2][2];
    GM_STAGE_B(GM_SB(0, 0), cs.b); GM_STAGE_B(GM_SB(0, 1), cs.b + hstepB); GM_STAGE_A(GM_SA(0, 0), cs, 0, 0); GM_STAGE_A(GM_SA(0, 1), cs, 1, 0);
    if (wr == 1) GM_BAR;
    GM_WAIT_V(2); GM_BAR;
    GM_STAGE_B(GM_SB(1, 0), cs.b + 128); GM_STAGE_A(GM_SA(1, 0), cs, 0, 128); GM_STAGE_B(GM_SB(1, 1), cs.b + hstepB + 128);
    GM_WAIT_V(6); GM_BAR;
    for (;;) {
#pragma clang loop unroll(disable)
        for (int t = 0; t < nt; t += 2) {
            const bool last = (t == nt - 2);
            GM_LDB(B0, 0, 0); GM_LDB(B1, 0, 1); GM_SCHED; GM_LDA(At, 0, 0); GM_STAGE_A(GM_SA(1, 1), cs, 1, (size_t)(t + 1) * 128);
            GM_WAIT_V(8); GM_WAIT_L(0); GM_BAR; GM_MMA(0, 0, At, B0); GM_MMA(0, 1, At, B1); GM_BAR; GM_SCHED;
            size_t kb;
            if (last) {
                if constexpr (P::GATHER) { asm volatile("" : "+v"(ns.ga[0][0]), "+v"(ns.ga[0][1]), "+v"(ns.ga[1][0]), "+v"(ns.ga[1][1])); }
                GM_ADOPT(cs, ns); kb = 0; } else kb = (size_t)(t + 2) * 128;
            GM_LDA(At, 0, 1); GM_STAGE_B(GM_SB(0, 0), cs.b + kb); GM_STAGE_B(GM_SB(0, 1), cs.b + hstepB + kb); GM_STAGE_A(GM_SA(0, 0), cs, 0, kb);
            GM_WAIT_V(8); GM_WAIT_L(0); GM_BAR; GM_MMA(1, 0, At, B0); GM_MMA(1, 1, At, B1); GM_BAR; GM_SCHED;
            GM_LDB(B0, 1, 0); GM_LDB(B1, 1, 1); GM_SCHED; GM_LDA(At, 1, 0); GM_STAGE_A(GM_SA(0, 1), cs, 1, kb);
            GM_WAIT_V(8); GM_WAIT_L(0); GM_BAR; GM_MMA(0, 0, At, B0); GM_MMA(0, 1, At, B1); GM_BAR; GM_SCHED;
            GM_LDA(At, 1, 1); GM_STAGE_B(GM_SB(1, 0), cs.b + kb + 128); GM_STAGE_B(GM_SB(1, 1), cs.b + hstepB + kb + 128); GM_STAGE_A(GM_SA(1, 0), cs, 0, kb + 128);
            GM_WAIT_V(8); GM_WAIT_L(0); GM_BAR; GM_MMA(1, 0, At, B0); GM_MMA(1, 1, At, B1); GM_BAR; GM_SCHED;
        }
        bool has_nx2 = false;
        if (has_next) { const long L2 = (long)(ui + 2) * G + c; has_nx2 = L2 < (long)nwg; if (has_nx2) { p.unit(xcd_remap((int)L2, nwg), nx2); GM_LOAD_SRC(ns, nx2); } }
        if constexpr (is_f8<P>::value) asm volatile("s_nop 7\n\ts_nop 7\n\ts_nop 7" ::: "memory");
        if (wr == 0) GM_BAR;
        { int t2 = threadIdx.x; asm volatile("" : "+v"(t2));
          const int w2 = __builtin_amdgcn_readfirstlane(t2 >> 6), l2 = t2 & 63; p.epi(acc, cur, w2 >> 2, w2 & 3, l2 & 15, l2 >> 4); }
        if (!has_next) break;
#pragma unroll
        for (int a = 0; a < 2; ++a)
#pragma unroll
            for (int b = 0; b < 2; ++b)
#pragma unroll
                for (int m = 0; m < 4; ++m)
#pragma unroll
                    for (int n = 0; n < 2; ++n) acc[a][b][m][n] = (f32x4){0.f, 0.f, 0.f, 0.f};
        cur = nxt; nxt = nx2; has_next = has_nx2; ++ui;
        if (wr == 1) GM_BAR;
    }
    GM_WAIT_V(0);
    GM_BAR;
#undef GM_GLDS
#undef GM_SA
#undef GM_SB
#undef GM_STAGE_A
#undef GM_STAGE_B
#undef GM_LDA
#undef GM_LDB
#undef GM_MMA
#undef GM_CAT8
#undef GM_WAIT_V
#undef GM_WAIT_L
#undef GM_BAR
#undef GM_SCHED
#undef GM_LOAD_SRC
}
}

namespace gm {
constexpr int ES = 4608;
__device__ __forceinline__ size_t kv_row0(int pm) { return pm < 128 ? (size_t)(pm >> 3) * KVL + CTXL + (size_t)(pm & 7) * 256 : (size_t)(pm - 128) * KVL; }
__device__ __forceinline__ u32x4 pack8(const f32x4 a, const f32x4 b) { u32x4 w; w.x = cvt_pk_bf16(a[0], a[1]); w.y = cvt_pk_bf16(a[2], a[3]); w.z = cvt_pk_bf16(b[0], b[1]); w.w = cvt_pk_bf16(b[2], b[3]); return w; }
#define GM_NOGATHER static constexpr bool AZERO = false; __device__ __forceinline__ const char* zero_base() const { return nullptr; } __device__ __forceinline__ const char* araw() const { return nullptr; } __device__ __forceinline__ const int* gidx(const Unit&) const { return nullptr; }
#define GM_DEV __device__ __forceinline__

struct P_QKV0 {
    static constexpr bool PERM = false, GATHER = false;
    const char* A; const char* B; bf16_t* q; bf16_t* k; bf16_t* v; const float* ropeC; const float* ropeS;
    GM_DEV int K() const { return 1024; } GM_DEV unsigned lda() const { return 2048; } GM_DEV unsigned ldb() const { return 2048; }
    GM_DEV int nunits() const { return 144 * 12; }
    GM_DEV void unit(int w, Unit& u) const { u.z = 0; tile_of(w, 144, 12, u.pm, u.pn); }
    GM_DEV const char* abase(const Unit& u) const { return A + (size_t)u.pm * 256 * 2048; }
    GM_DEV const char* bbase(const Unit& u) const { return B + (size_t)u.pn * 256 * 2048; }
    GM_NOGATHER
    GM_DEV void rope_store(Acc& acc, bf16_t* dst, const Unit& u, bool is_ctx, int wr, int wc, int fr, int fq) const {
        constexpr size_t rstride = 128, cstride = (size_t)KVL * 128;
        const int par = wc & 1;
#pragma unroll
        for (int ai = 0; ai < 2; ++ai)
#pragma unroll
            for (int m = 0; m < 4; ++m) { const int rl = ai * 128 + wr * 64 + m * 16 + fr;
                f32x4 c4 = (f32x4){1.f, 1.f, 1.f, 1.f}, s4 = (f32x4){0.f, 0.f, 0.f, 0.f};
                if (!is_ctx) { const int t = (u.pm & 7) * 256 + rl, pos = par ? (t & 63) : (t >> 6); c4 = *(const f32x4*)(ropeC + pos * 16 + 4 * fq); s4 = *(const f32x4*)(ropeS + pos * 16 + 4 * fq); }
#pragma unroll
                for (int bj = 0; bj < 2; ++bj) { const f32x4 x1 = acc[ai][bj][m][0], x2 = acc[ai][bj][m][1];
                    *(u32x4*)(dst + (size_t)rl * rstride + (size_t)bj * cstride) = pack8(x1 * c4 - x2 * s4, x1 * s4 + x2 * c4); }
                __builtin_amdgcn_sched_barrier(0); }
    }
    GM_DEV void epi(Acc& acc, const Unit& u, int wr, int wc, int fr, int fq) const {
        const int sect = u.pn >> 2, colt = (u.pn & 3) * 256; const bool is_ctx = u.pm >= 128;
        const int b = u.pm < 128 ? (u.pm >> 3) : (u.pm - 128); const size_t key0 = u.pm < 128 ? (size_t)CTXL + (size_t)(u.pm & 7) * 256 : 0;
        if (sect < 2) {
            bf16_t* d0 = q + (size_t)sect * (size_t)(k - q) + (((size_t)b * 8 + (colt >> 7)) * KVL + key0) * 128;
            rope_store(acc, d0 + wc * 32 + 8 * fq, u, is_ctx, wr, wc, fr, fq);
        } else {
            bf16_t* dst = v + (((size_t)b * 8 + (colt >> 7)) * KVL + key0) * 128 + wc * 32 + 4 * fq;
#pragma unroll
            for (int ai = 0; ai < 2; ++ai)
#pragma unroll
                for (int m = 0; m < 4; ++m) { const int rl = ai * 128 + wr * 64 + m * 16 + fr;
#pragma unroll
                    for (int bj = 0; bj < 2; ++bj)
#pragma unroll
                        for (int n = 0; n < 2; ++n) { const f32x4 x = acc[ai][bj][m][n]; u32x2 w; w.x = cvt_pk_bf16(x[0], x[1]); w.y = cvt_pk_bf16(x[2], x[3]);
                            *(u32x2*)(dst + (size_t)bj * KVL * 128 + (size_t)rl * 128 + 16 * n) = w; } }
        }
    }
};
struct P_QKV2 {
    static constexpr bool PERM = true, GATHER = false;
    const char* A; const char* B; bf16_t* q; bf16_t* k; bf16_t* v;
    GM_DEV int K() const { return 1024; } GM_DEV unsigned lda() const { return 2048; } GM_DEV unsigned ldb() const { return 2048; }
    GM_DEV int nunits() const { return 144 * 12; }
    GM_DEV void unit(int w, Unit& u) const { u.z = 0; tile_of(w, 144, 12, u.pm, u.pn); }
    GM_DEV const char* abase(const Unit& u) const { return A + (size_t)u.pm * 256 * 2048; }
    GM_DEV const char* bbase(const Unit& u) const { return B + (size_t)u.pn * 256 * 2048; }
    GM_NOGATHER
    GM_DEV void epi(Acc& acc, const Unit& u, int wr, int wc, int fr, int fq) const {
        const int sect = u.pn >> 2, colt = (u.pn & 3) * 256; const bool is_ctx = u.pm >= 128;
        if (sect == 0 && is_ctx) return;
        bf16_t* dst = sect == 0 ? q + (size_t)u.pm * 256 * 1024 : (sect == 1 ? k : v) + kv_row0(u.pm) * 1024;
#pragma unroll
        for (int ai = 0; ai < 2; ++ai)
#pragma unroll
            for (int m = 0; m < 4; ++m) { const int rl = ai * 128 + wr * 64 + m * 16 + fr;
#pragma unroll
                for (int bj = 0; bj < 2; ++bj) *(u32x4*)(dst + (size_t)rl * 1024 + colt + bj * 128 + wc * 32 + 8 * fq) = pack8(acc[ai][bj][m][0], acc[ai][bj][m][1]); }
    }
};
struct P_OUT {
    static constexpr bool PERM = true, GATHER = false;
    const char* A; const char* B; unsigned lda_; int K_, nM;
    bf16_t* xb_; bf16_t* cb_; const float* gate;
    GM_DEV int K() const { return K_; } GM_DEV unsigned lda() const { return lda_; } GM_DEV unsigned ldb() const { return (unsigned)K_ * 2u; }
    GM_DEV int nunits() const { return nM * 4; }
    GM_DEV void unit(int w, Unit& u) const { u.z = 0; tile_of(w, nM, 4, u.pm, u.pn); }
    GM_DEV const char* abase(const Unit& u) const { return A + (size_t)u.pm * 256 * lda_; }
    GM_DEV const char* bbase(const Unit& u) const { return B + (size_t)u.pn * 256 * (size_t)K_ * 2; }
    GM_NOGATHER
    GM_DEV void epi(Acc& acc, const Unit& u, int wr, int wc, int fr, int fq) const {
        const bool is_ctx = u.pm >= 128;
        const size_t t0 = is_ctx ? (size_t)(u.pm - 128) * 256 * 1024 : (size_t)u.pm * 256 * 1024;
        bf16_t* xs = (is_ctx ? cb_ : xb_) + t0;
        const int col0 = u.pn * 256 + wc * 32 + 8 * fq;
        const float* g = gate + (size_t)(is_ctx ? 16 : (u.pm >> 3)) * MODW + col0;
        f32x4 gv[2][2];
#pragma unroll
        for (int bj = 0; bj < 2; ++bj)
#pragma unroll
            for (int n = 0; n < 2; ++n) gv[bj][n] = *(const f32x4*)(g + bj * 128 + 4 * n);
        u32x4 xh[2][2];
#define PO_LOAD(slot, off_) do { _Pragma("unroll") for (int bj = 0; bj < 2; ++bj) xh[slot][bj] = *(const u32x4*)(xs + (off_) + bj * 128); } while (0)
        PO_LOAD(0, (size_t)(wr * 64 + fr) * 1024 + col0);
#pragma unroll
        for (int q = 0; q < 8; ++q) { const int ai = q >> 2, m = q & 3; const size_t off = (size_t)(ai * 128 + wr * 64 + m * 16 + fr) * 1024 + col0;
            if (q + 1 < 8) { const size_t off2 = (size_t)(((q + 1) >> 2) * 128 + wr * 64 + ((q + 1) & 3) * 16 + fr) * 1024 + col0; PO_LOAD((q + 1) & 1, off2); }
#pragma unroll
            for (int bj = 0; bj < 2; ++bj) { const u32x4 w = xh[q & 1][bj];
                const f32x4 x0 = (f32x4){bf_lo(w.x), bf_hi(w.x), bf_lo(w.y), bf_hi(w.y)}, x1 = (f32x4){bf_lo(w.z), bf_hi(w.z), bf_lo(w.w), bf_hi(w.w)};
                *(u32x4*)(xs + off + bj * 128) = pack8(x0 + gv[bj][0] * acc[ai][bj][m][0], x1 + gv[bj][1] * acc[ai][bj][m][1]); } }
#undef PO_LOAD
    }
};
struct P_GU {
    static constexpr bool PERM = true, GATHER = true, AZERO = false, F8 = true;
    GM_DEV const char* zero_base() const { return nullptr; }
    const char* hx; const char* W; unsigned char* hid; const int* slot_row; int nM;
    GM_DEV int K() const { return 512; } GM_DEV unsigned lda() const { return 1024; } GM_DEV unsigned ldb() const { return 1024; }
    GM_DEV int nunits() const { return NE * nM * 8; }
    GM_DEV void unit(int w, Unit& u) const { const int per = nM * 8; u.z = w / per; tile_of(w - u.z * per, nM, 8, u.pm, u.pn); }
    GM_DEV const char* abase(const Unit&) const { return hx; }
    GM_DEV const char* bbase(const Unit& u) const { return W + ((size_t)u.z * 2048 + (size_t)u.pn * 256) * 1024; }
    GM_DEV const char* araw() const { return hx; }
    GM_DEV const int* gidx(const Unit& u) const { return slot_row + u.z * ES + u.pm * 256; }
    GM_DEV void epi(Acc& acc, const Unit& u, int wr, int wc, int fr, int fq) const {
        unsigned char* dst = hid + ((size_t)u.z * ES + (size_t)u.pm * 256) * 1024 + u.pn * 128 + wc * 32 + 8 * fq;
        constexpr float ds = 1.0f / (F8_SX * F8_SW), c1 = -1.4426950408889634f * ds, kk = 1.0f / (F8_SH * ds * ds);
#pragma unroll
        for (int ai = 0; ai < 2; ++ai)
#pragma unroll
            for (int m = 0; m < 4; ++m) { const int rl = ai * 128 + wr * 64 + m * 16 + fr; f32x4 h[2];
#pragma unroll
                for (int n = 0; n < 2; ++n) { const f32x4 ag = acc[ai][0][m][n], au = acc[ai][1][m][n]; const f32x4 t = ag * c1; f32x4 e;
#pragma unroll
                    for (int j = 0; j < 4; ++j) e[j] = __builtin_amdgcn_exp2f(t[j]);
                    const f32x4 d = __builtin_elementwise_fma(e, (f32x4){kk, kk, kk, kk}, (f32x4){kk, kk, kk, kk}); f32x4 r;
#pragma unroll
                    for (int j = 0; j < 4; ++j) r[j] = __builtin_amdgcn_rcpf(d[j]);
                    h[n] = (ag * au) * r; }
                u32x2 w; w.x = pk4_fp8(h[0][0], h[0][1], h[0][2], h[0][3]); w.y = pk4_fp8(h[1][0], h[1][1], h[1][2], h[1][3]);
                *(u32x2*)(dst + (size_t)rl * 1024) = w; }
    }
};
struct P_DOWN {
    static constexpr bool PERM = true, GATHER = false, F8 = true;
    const char* hid; const char* W; bf16_t* ys; const float* slot_aff; int nM;
    GM_DEV int K() const { return 512; } GM_DEV unsigned lda() const { return 1024; } GM_DEV unsigned ldb() const { return 1024; }
    GM_DEV int nunits() const { return NE * nM * 4; }
    GM_DEV void unit(int w, Unit& u) const { const int per = nM * 4; u.z = w / per; tile_of(w - u.z * per, nM, 4, u.pm, u.pn); }
    GM_DEV const char* abase(const Unit& u) const { return hid + ((size_t)u.z * ES + (size_t)u.pm * 256) * 1024; }
    GM_DEV const char* bbase(const Unit& u) const { return W + ((size_t)u.z * 1024 + (size_t)u.pn * 256) * 1024; }
    GM_NOGATHER
    GM_DEV void epi(Acc& acc, const Unit& u, int wr, int wc, int fr, int fq) const {
        const size_t r0 = (size_t)u.z * ES + (size_t)u.pm * 256;
        unsigned char* dst8 = (unsigned char*)ys + r0 * 1024 + u.pn * 256 + wc * 32 + 8 * fq;
        float af[2][4];
#pragma unroll
        for (int ai = 0; ai < 2; ++ai)
#pragma unroll
            for (int m = 0; m < 4; ++m) af[ai][m] = slot_aff[r0 + ai * 128 + wr * 64 + m * 16 + fr];
#pragma unroll
        for (int ai = 0; ai < 2; ++ai)
#pragma unroll
            for (int m = 0; m < 4; ++m) { const int rl = ai * 128 + wr * 64 + m * 16 + fr; const float a = af[ai][m];
#pragma unroll
                for (int bj = 0; bj < 2; ++bj) { const f32x4 y0 = acc[ai][bj][m][0] * (a * (32.0f / (F8_SH * F8_SW))), y1 = acc[ai][bj][m][1] * (a * (32.0f / (F8_SH * F8_SW)));
                    int w0 = 0, w1 = 0;
                    w0 = __builtin_amdgcn_cvt_pk_fp8_f32(__builtin_amdgcn_fmed3f(y0[0], -440.f, 440.f), __builtin_amdgcn_fmed3f(y0[1], -440.f, 440.f), w0, false);
                    w0 = __builtin_amdgcn_cvt_pk_fp8_f32(__builtin_amdgcn_fmed3f(y0[2], -440.f, 440.f), __builtin_amdgcn_fmed3f(y0[3], -440.f, 440.f), w0, true);
                    w1 = __builtin_amdgcn_cvt_pk_fp8_f32(__builtin_amdgcn_fmed3f(y1[0], -440.f, 440.f), __builtin_amdgcn_fmed3f(y1[1], -440.f, 440.f), w1, false);
                    w1 = __builtin_amdgcn_cvt_pk_fp8_f32(__builtin_amdgcn_fmed3f(y1[2], -440.f, 440.f), __builtin_amdgcn_fmed3f(y1[3], -440.f, 440.f), w1, true);
                    u32x2 w; w.x = (unsigned)w0; w.y = (unsigned)w1; *(u32x2*)(dst8 + (size_t)rl * 1024 + bj * 128) = w; } }
    }
};
struct P_GMU {
    static constexpr bool PERM = true, GATHER = false;
    const char* hx; const char* W; bf16_t* u_out;
    GM_DEV int K() const { return 1024; } GM_DEV unsigned lda() const { return 2048; } GM_DEV unsigned ldb() const { return 2048; }
    GM_DEV int nunits() const { return 1152; }
    GM_DEV void unit(int w, Unit& u) const { u.z = 0; tile_of(w, 144, 8, u.pm, u.pn); }
    GM_DEV const char* abase(const Unit& u) const { return hx + (size_t)u.pm * 256 * 2048; }
    GM_DEV const char* bbase(const Unit& u) const { return W + (size_t)u.pn * 256 * 2048; }
    GM_NOGATHER
    GM_DEV void epi(Acc& acc, const Unit& u, int wr, int wc, int fr, int fq) const {
        bf16_t* dst = u_out + (size_t)u.pm * 256 * 2048 + u.pn * 256 + wc * 32 + 8 * fq;
#pragma unroll
        for (int ai = 0; ai < 2; ++ai)
#pragma unroll
            for (int m = 0; m < 4; ++m) { const int rl = ai * 128 + wr * 64 + m * 16 + fr;
#pragma unroll
                for (int bj = 0; bj < 2; ++bj) { const f32x4 g0 = gelu_tanh4(acc[ai][bj][m][0]), g1 = gelu_tanh4(acc[ai][bj][m][1]);
                    *(u32x4*)(dst + (size_t)rl * 2048 + bj * 128) = pack8(g0, g1); }
                __builtin_amdgcn_sched_barrier(0); }
    }
};
struct P_GMV {
    static constexpr bool PERM = true, GATHER = false;
    const char* hx; const char* W; bf16_t* vT; float* sumsq;
    GM_DEV int K() const { return 1024; } GM_DEV unsigned lda() const { return 2048; } GM_DEV unsigned ldb() const { return 2048; }
    GM_DEV int nunits() const { return 1152; }
    GM_DEV void unit(int w, Unit& u) const { u.z = 0; tile_of(w, 8, 144, u.pm, u.pn); }
    GM_DEV const char* abase(const Unit& u) const { return W + (size_t)(2048 + u.pm * 256) * 2048; }
    GM_DEV const char* bbase(const Unit& u) const { return hx + (size_t)u.pn * 256 * 2048; }
    GM_NOGATHER
    GM_DEV void epi(Acc& acc, const Unit& u, int wr, int wc, int fr, int fq) const {
        const bool is_ctx = u.pn >= 128; const int b = is_ctx ? u.pn - 128 : (u.pn >> 3);
        const int tok0 = is_ctx ? 0 : CTXL + (u.pn & 7) * 256, grow0 = is_ctx ? NLAT + b * CTXL : b * SEQ + (u.pn & 7) * 256;
        bf16_t* dst = vT + ((size_t)b * 2048 + (size_t)u.pm * 256) * KVL + tok0 + wc * 32 + 8 * fq;
#pragma unroll
        for (int bj = 0; bj < 2; ++bj) {
            f32x4 s0 = (f32x4){0.f, 0.f, 0.f, 0.f}, s1 = (f32x4){0.f, 0.f, 0.f, 0.f};
#pragma unroll
            for (int ai = 0; ai < 2; ++ai)
#pragma unroll
                for (int m = 0; m < 4; ++m) { const int rl = ai * 128 + wr * 64 + m * 16 + fr; const f32x4 g0 = gelu_tanh4(acc[ai][bj][m][0]), g1 = gelu_tanh4(acc[ai][bj][m][1]);
                    *(u32x4*)(dst + (size_t)rl * KVL + bj * 128) = pack8(g0, g1); s0 += g0 * g0; s1 += g1 * g1;
                    __builtin_amdgcn_sched_barrier(0); }
#pragma unroll
            for (int j = 0; j < 4; ++j) { float a = s0[j], c = s1[j];
                a += __shfl_xor(a, 1); a += __shfl_xor(a, 2); a += __shfl_xor(a, 4); a += __shfl_xor(a, 8);
                c += __shfl_xor(c, 1); c += __shfl_xor(c, 2); c += __shfl_xor(c, 4); c += __shfl_xor(c, 8);
                if (fr == 0) { float* pp = sumsq + (size_t)(grow0 + bj * 128 + wc * 32 + 8 * fq + j) * 16 + u.pm * 2 + wr; pp[0] = a; pp[64] = c; } }
        }
    }
};
struct P_SPAT {
    static constexpr bool PERM = true, GATHER = false, AZERO = true;
    const char* App; const char* vT; bf16_t* u_io; const float* v_g; const float* b_s; const char* zeros;
    GM_DEV const char* zero_base() const { return zeros; } GM_DEV const char* araw() const { return nullptr; } GM_DEV const int* gidx(const Unit&) const { return nullptr; }
    GM_DEV int K() const { return 256; } GM_DEV unsigned lda() const { return 256; } GM_DEV unsigned ldb() const { return KVL * 2; }
    GM_DEV int nunits() const { return NB * 9 * 8; }
    GM_DEV void unit(int w, Unit& u) const { u.z = w; u.pm = 0; u.pn = 0; }
    GM_DEV const char* abase(const Unit& u) const { return App + (size_t)u.z * 65536; }
    GM_DEV const char* bbase(const Unit& u) const { const int g = u.z & 7, bc = u.z >> 3, b = bc / 9, cp = bc - b * 9; return vT + (((size_t)b * 2048 + (size_t)g * 256) * KVL + (size_t)cp * 256) * 2; }
    GM_DEV void epi(Acc& acc, const Unit& u, int wr, int wc, int fr, int fq) const {
        const int g = u.z & 7, bc = u.z >> 3, b = bc / 9, cp = bc - b * 9;
        const size_t trow0 = cp == 0 ? (size_t)NLAT + (size_t)b * CTXL : (size_t)b * SEQ + (size_t)(cp - 1) * 256;
        const int ch0 = g * 256 + wc * 32 + 8 * fq;
        f32x4 vg[2][2];
#pragma unroll
        for (int bj = 0; bj < 2; ++bj)
#pragma unroll
            for (int n = 0; n < 2; ++n) vg[bj][n] = *(const f32x4*)(v_g + ch0 + bj * 128 + 4 * n);
        float bsv[8];
#pragma unroll
        for (int q = 0; q < 8; ++q) bsv[q] = b_s[g * 128 + (((q >> 2) * 128 + wr * 64 + (q & 3) * 16 + fr) & 127)];
        u32x4 ub[2][2];
#pragma unroll
        for (int bj = 0; bj < 2; ++bj) ub[0][bj] = *(const u32x4*)(u_io + (trow0 + wr * 64 + fr) * 2048 + ch0 + bj * 128);
#pragma unroll
        for (int q = 0; q < 8; ++q) { const int ai = q >> 2, m = q & 3, rl = ai * 128 + wr * 64 + m * 16 + fr; const float bs = bsv[q];
            bf16_t* up = u_io + (trow0 + rl) * 2048 + ch0;
            if (q + 1 < 8) { const int rl2 = ((q + 1) >> 2) * 128 + wr * 64 + ((q + 1) & 3) * 16 + fr;
#pragma unroll
                for (int bj = 0; bj < 2; ++bj) ub[(q + 1) & 1][bj] = *(const u32x4*)(u_io + (trow0 + rl2) * 2048 + ch0 + bj * 128); }
#pragma unroll
            for (int bj = 0; bj < 2; ++bj) { const u32x4 uw = ub[q & 1][bj];
                const f32x4 u0 = (f32x4){bf_lo(uw.x), bf_hi(uw.x), bf_lo(uw.y), bf_hi(uw.y)}, u1 = (f32x4){bf_lo(uw.z), bf_hi(uw.z), bf_lo(uw.w), bf_hi(uw.w)};
                *(u32x4*)(up + bj * 128) = pack8(u0 * (acc[ai][bj][m][0] * vg[bj][0] + bs), u1 * (acc[ai][bj][m][1] * vg[bj][1] + bs)); } }
    }
};
constexpr int PQ_LD = 2176;
struct P_CDFT {
    static constexpr bool PERM = true, GATHER = false;
    const char* CS; const char* hx; bf16_t* PQt;
    GM_DEV int K() const { return 256; } GM_DEV unsigned lda() const { return 512; } GM_DEV unsigned ldb() const { return 2048; }
    GM_DEV int nunits() const { return 4 * NB * 9; }
    GM_DEV void unit(int w, Unit& u) const { u.z = w / (NB * 9); const int r = w - u.z * (NB * 9); u.pn = r; const int tt = r % 9; u.pm = (tt >= 4 && tt < 8) ? 1 : 0; }
    GM_DEV const char* abase(const Unit& u) const { return CS + (size_t)u.pm * 256 * 512; }
    GM_DEV const char* bbase(const Unit& u) const { return hx + (size_t)u.pn * 256 * 2048 + (size_t)u.z * 512; }
    GM_NOGATHER
    GM_DEV void epi(Acc& acc, const Unit& u, int wr, int wc, int fr, int fq) const {
        const int b = u.pn / 9, tt = u.pn - b * 9;
        bf16_t* dst = PQt + ((size_t)b * 1024 + (size_t)u.z * 256) * PQ_LD + tt * 256 + wc * 32 + 8 * fq;
#pragma unroll
        for (int ai = 0; ai < 2; ++ai)
#pragma unroll
            for (int m = 0; m < 4; ++m) { const int rl = ai * 128 + wr * 64 + m * 16 + fr;
#pragma unroll
                for (int bj = 0; bj < 2; ++bj) { if (tt == 8 && bj == 1) continue;
                    *(u32x4*)(dst + (size_t)rl * PQ_LD + bj * 128) = pack8(acc[ai][bj][m][0] * 0.0625f, acc[ai][bj][m][1] * 0.0625f); } }
    }
};
struct P_PDFT {
    static constexpr bool PERM = true, GATHER = false;
    const char* DP; const char* PQt; bf16_t* f;
    GM_DEV int K() const { return PQ_LD; } GM_DEV unsigned lda() const { return PQ_LD * 2; } GM_DEV unsigned ldb() const { return PQ_LD * 2; }
    GM_DEV int nunits() const { return 512; }
    GM_DEV void unit(int w, Unit& u) const { u.z = w >> 5; tile_of(w & 31, 8, 4, u.pm, u.pn); }
    GM_DEV const char* abase(const Unit& u) const { return DP + (size_t)u.pm * 256 * (PQ_LD * 2); }
    GM_DEV const char* bbase(const Unit& u) const { return PQt + ((size_t)u.z * 1024 + (size_t)u.pn * 256) * (PQ_LD * 2); }
    GM_NOGATHER
    GM_DEV void epi(Acc& acc, const Unit& u, int wr, int wc, int fr, int fq) const {
        bf16_t* dst = f + ((size_t)u.z * 2048 + (size_t)u.pm * 256) * 1024 + u.pn * 256 + wc * 32 + 8 * fq; const float sc = 0.022097086912079608f;
#pragma unroll
        for (int ai = 0; ai < 2; ++ai)
#pragma unroll
            for (int m = 0; m < 4; ++m) { const int rl = ai * 128 + wr * 64 + m * 16 + fr;
#pragma unroll
                for (int bj = 0; bj < 2; ++bj) *(u32x4*)(dst + (size_t)rl * 1024 + bj * 128) = pack8(acc[ai][bj][m][0] * sc, acc[ai][bj][m][1] * sc); }
    }
};
}

namespace at {
constexpr float SCALE = 0.125f;
constexpr float THR = 8.f;
#define AT_SBAR() __builtin_amdgcn_sched_barrier(0)
#define AT_KSWZ(row, colB) ((row) * 256 + ((colB) ^ (((row) & 7) << 4)))
#define AT_KSWZ64(row, colB) ((row) * 128 + ((colB) ^ ((((row) >> 1) & 7) << 4)))
__device__ __forceinline__ int crow(int r, int hi) { return (r & 3) + 8 * (r >> 2) + 4 * hi; }
__device__ __forceinline__ void partialSM(f32x16& p0, f32x16& p1, float& m_reg, float& mn, float& alpha) {
    constexpr float C = SCALE * 1.4426950408889634f;
    float pmax = p0[0];
#pragma unroll
    for (int r = 1; r < 16; ++r) pmax = fmaxf(pmax, p0[r]);
#pragma unroll
    for (int r = 0; r < 16; ++r) pmax = fmaxf(pmax, p1[r]);
    { auto rr = __builtin_amdgcn_permlane32_swap(__float_as_uint(pmax), __float_as_uint(pmax), false, false);
      pmax = fmaxf(__uint_as_float(rr[0]), __uint_as_float(rr[1])); }
    if (__builtin_expect(__all(pmax - m_reg <= THR / SCALE), 1)) { mn = m_reg; alpha = 1.f; }
    else { mn = fmaxf(m_reg, pmax); alpha = __builtin_amdgcn_exp2f((m_reg - mn) * C); m_reg = mn; }
    const float mnC = -mn * C;
#pragma unroll
    for (int r = 0; r < 16; ++r) p0[r] = fmaf(p0[r], C, mnC);
#pragma unroll
    for (int r = 0; r < 16; ++r) p1[r] = fmaf(p1[r], C, mnC);
#pragma unroll
    for (int r = 0; r < 16; ++r) p0[r] = __builtin_amdgcn_exp2f(p0[r]);
}
#define AT_PK4(P, BASE, OUT) do { unsigned a0 = cvt_pk_bf16(P[BASE + 0], P[BASE + 1]), a1 = cvt_pk_bf16(P[BASE + 2], P[BASE + 3]);   \
    unsigned b0 = cvt_pk_bf16(P[BASE + 4], P[BASE + 5]), b1 = cvt_pk_bf16(P[BASE + 6], P[BASE + 7]);                              \
    auto r0 = __builtin_amdgcn_permlane32_swap(a0, b0, false, false); auto r1 = __builtin_amdgcn_permlane32_swap(a1, b1, false, false); \
    u32x4 w = {r0[0], r1[0], r0[1], r1[1]}; OUT = *reinterpret_cast<bf16x8*>(&w); } while (0)
__device__ __forceinline__ void finishSM(f32x16& p0, f32x16& p1, float alpha, float& l_reg, bf16x8& pa0, bf16x8& pa1, bf16x8& pa2, bf16x8& pa3) {
#pragma unroll
    for (int r = 0; r < 16; ++r) p1[r] = __builtin_amdgcn_exp2f(p1[r]);
    float ps = 0;
#pragma unroll
    for (int r = 0; r < 16; ++r) ps += p0[r];
#pragma unroll
    for (int r = 0; r < 16; ++r) ps += p1[r];
    { auto rr = __builtin_amdgcn_permlane32_swap(__float_as_uint(ps), __float_as_uint(ps), false, false);
      ps = __uint_as_float(rr[0]) + __uint_as_float(rr[1]); }
    l_reg = l_reg * alpha + ps;
    AT_PK4(p0, 0, pa0); AT_PK4(p0, 8, pa1); AT_PK4(p1, 0, pa2); AT_PK4(p1, 8, pa3);
}
__device__ __forceinline__ void qkt64(f32x16& p0, f32x16& p1, const LAS char* Ks, const bf16x8* qr, int r32, int hi, int cb0) {
    p0 = f32x16{}; p1 = f32x16{};
    bf16x8 k0[4], k1[4];
#pragma unroll
    for (int d0 = 0; d0 < 4; ++d0) { const int cb = cb0 + (d0 * 16 + hi * 8) * 2;
        k0[d0] = *reinterpret_cast<const LAS bf16x8*>(Ks + AT_KSWZ(r32, cb)); k1[d0] = *reinterpret_cast<const LAS bf16x8*>(Ks + AT_KSWZ(32 + r32, cb)); }
    __builtin_amdgcn_sched_barrier(0);
#pragma unroll
    for (int d0 = 0; d0 < 4; ++d0) { p0 = __builtin_amdgcn_mfma_f32_32x32x16_bf16(k0[d0], qr[d0], p0, 0, 0, 0); p1 = __builtin_amdgcn_mfma_f32_32x32x16_bf16(k1[d0], qr[d0], p1, 0, 0, 0); }
}
template <int NCB> __device__ __forceinline__ int v_st(int k, int c) { const int kk = (k & ~0xC) | ((k & 4) << 1) | ((k & 8) >> 1); return ((kk >> 3) * NCB + (c >> 5)) * 512 + ((kk & 7) * 32 + (c & 31)) * 2; }
__device__ __forceinline__ int v_rd_base(int lane) { return ((lane & 3) << 3) | (((lane >> 2) & 3) << 6) | (((lane >> 4) & 1) << 5) | (((lane >> 5) & 1) << 8); }
template <int NCB> constexpr int v_rd_off(int d0, int ks, int half) { return d0 * 512 + ks * (NCB * 1024) + half * (NCB * 512); }
template <int OFF> __device__ __forceinline__ s16x4 tr_read(int vb) {
    return __builtin_amdgcn_ds_read_tr16_b64_v4i16((LAS s16x4*)(uintptr_t)(unsigned)(vb + OFF));
}
template <int NCB, int D0> __device__ __forceinline__ void pv_one(f32x16& od, int vb, bf16x8 pa0, bf16x8 pa1, bf16x8 pa2, bf16x8 pa3) {
    const s16x4 l0 = tr_read<v_rd_off<NCB>(D0, 0, 0)>(vb), h0 = tr_read<v_rd_off<NCB>(D0, 0, 1)>(vb), l1 = tr_read<v_rd_off<NCB>(D0, 1, 0)>(vb), h1 = tr_read<v_rd_off<NCB>(D0, 1, 1)>(vb);
    const s16x4 l2 = tr_read<v_rd_off<NCB>(D0, 2, 0)>(vb), h2 = tr_read<v_rd_off<NCB>(D0, 2, 1)>(vb), l3 = tr_read<v_rd_off<NCB>(D0, 3, 0)>(vb), h3 = tr_read<v_rd_off<NCB>(D0, 3, 1)>(vb);
#define AT_PK(L, H) (bf16x8){L[0], L[1], L[2], L[3], H[0], H[1], H[2], H[3]}
    od = __builtin_amdgcn_mfma_f32_32x32x16_bf16(pa0, AT_PK(l0, h0), od, 0, 0, 0);
    od = __builtin_amdgcn_mfma_f32_32x32x16_bf16(pa1, AT_PK(l1, h1), od, 0, 0, 0);
    od = __builtin_amdgcn_mfma_f32_32x32x16_bf16(pa2, AT_PK(l2, h2), od, 0, 0, 0);
    od = __builtin_amdgcn_mfma_f32_32x32x16_bf16(pa3, AT_PK(l3, h3), od, 0, 0, 0);
#undef AT_PK
}

template <int NCB, int D0>
__device__ __forceinline__ void pv_pair(f32x16& o0, f32x16& o1, int vb, bf16x8 pa0, bf16x8 pa1, bf16x8 pa2, bf16x8 pa3) {
    s16x4 l[2][4], h[2][4];
    l[0][0] = tr_read<v_rd_off<NCB>(D0, 0, 0)>(vb); h[0][0] = tr_read<v_rd_off<NCB>(D0, 0, 1)>(vb); l[0][1] = tr_read<v_rd_off<NCB>(D0, 1, 0)>(vb); h[0][1] = tr_read<v_rd_off<NCB>(D0, 1, 1)>(vb);
    l[0][2] = tr_read<v_rd_off<NCB>(D0, 2, 0)>(vb); h[0][2] = tr_read<v_rd_off<NCB>(D0, 2, 1)>(vb); l[0][3] = tr_read<v_rd_off<NCB>(D0, 3, 0)>(vb); h[0][3] = tr_read<v_rd_off<NCB>(D0, 3, 1)>(vb);
    l[1][0] = tr_read<v_rd_off<NCB>(D0 + 1, 0, 0)>(vb); h[1][0] = tr_read<v_rd_off<NCB>(D0 + 1, 0, 1)>(vb); l[1][1] = tr_read<v_rd_off<NCB>(D0 + 1, 1, 0)>(vb); h[1][1] = tr_read<v_rd_off<NCB>(D0 + 1, 1, 1)>(vb);
    l[1][2] = tr_read<v_rd_off<NCB>(D0 + 1, 2, 0)>(vb); h[1][2] = tr_read<v_rd_off<NCB>(D0 + 1, 2, 1)>(vb); l[1][3] = tr_read<v_rd_off<NCB>(D0 + 1, 3, 0)>(vb); h[1][3] = tr_read<v_rd_off<NCB>(D0 + 1, 3, 1)>(vb);
    __builtin_amdgcn_sched_barrier(0);
#define AT_PK(L, H) (bf16x8){L[0], L[1], L[2], L[3], H[0], H[1], H[2], H[3]}
    o0 = __builtin_amdgcn_mfma_f32_32x32x16_bf16(pa0, AT_PK(l[0][0], h[0][0]), o0, 0, 0, 0); o1 = __builtin_amdgcn_mfma_f32_32x32x16_bf16(pa0, AT_PK(l[1][0], h[1][0]), o1, 0, 0, 0);
    o0 = __builtin_amdgcn_mfma_f32_32x32x16_bf16(pa1, AT_PK(l[0][1], h[0][1]), o0, 0, 0, 0); o1 = __builtin_amdgcn_mfma_f32_32x32x16_bf16(pa1, AT_PK(l[1][1], h[1][1]), o1, 0, 0, 0);
    o0 = __builtin_amdgcn_mfma_f32_32x32x16_bf16(pa2, AT_PK(l[0][2], h[0][2]), o0, 0, 0, 0); o1 = __builtin_amdgcn_mfma_f32_32x32x16_bf16(pa2, AT_PK(l[1][2], h[1][2]), o1, 0, 0, 0);
    o0 = __builtin_amdgcn_mfma_f32_32x32x16_bf16(pa3, AT_PK(l[0][3], h[0][3]), o0, 0, 0, 0); o1 = __builtin_amdgcn_mfma_f32_32x32x16_bf16(pa3, AT_PK(l[1][3], h[1][3]), o1, 0, 0, 0);
#undef AT_PK
    __builtin_amdgcn_sched_barrier(0);
}
__device__ __forceinline__ void pv_batch2(f32x16& o0, f32x16& o1, int vb, bf16x8 pa0, bf16x8 pa1, bf16x8 pa2, bf16x8 pa3) { pv_pair<2, 0>(o0, o1, vb, pa0, pa1, pa2, pa3); }

constexpr int DA_LDS_V = 0, DA_LDS_K = 32768, DA_LDS_WS = 69632, DA_XPITCH = 132;
template <int VARIANT = 0>
__device__ __forceinline__ void diff_attn_unit(const bf16_t* __restrict__ Qb, const bf16_t* __restrict__ Kh, const bf16_t* __restrict__ Vh, bf16_t* __restrict__ Ob,
                                               int seq, float lam, float oscale, const float* __restrict__ subg, LAS char* lds) {
    constexpr int LDK = 128, SHM_V = 16384, SHM_K = 16384, KVBLK = 64;
    constexpr float C = SCALE * 1.4426950408889634f;
    int tid = threadIdx.x; asm volatile("" : "+v"(tid));
    const int wid = __builtin_amdgcn_readfirstlane(tid >> 6), lane = tid & 63, r32 = lane & 31, hi = lane >> 5, jh = wid >> 2, wq = wid & 3;
    LAS char* V_lds = lds + DA_LDS_V; LAS char* K_lds = lds + DA_LDS_K;
    LAS float* ws = (LAS float*)(lds + DA_LDS_WS) + wid * 64; LAS float* li_l = ws; LAS float* al_l = ws + 32;
    float m_reg = -1e30f, l_reg = 0.f, alpha = 1.f; f32x16 o[4] = {}; bf16x8 qr[4];
    const bf16_t* Qw = Qb + (size_t)(wq * 32 + r32) * 128 + jh * 64 + hi * 8;
#pragma unroll
    for (int d0 = 0; d0 < 4; ++d0) qr[d0] = *reinterpret_cast<const bf16x8*>(Qw + d0 * 16);
    const int cb0 = jh * 128;
    const int sr = tid >> 4, sc = (tid & 15) * 8, vst0 = v_st<4>(sr, sc), vst1 = v_st<4>(32 + sr, sc), kst0 = AT_KSWZ(sr, sc * 2), kst1 = AT_KSWZ(32 + sr, sc * 2);
    const int vb0 = (int)(uintptr_t)V_lds + v_rd_base(lane);
    const int NT = seq / KVBLK;
    bf16x8 ek0[2], ek1[2], ev0[2], ev1[2];
#define DA_ELOAD(s, ev) do { const int kt_ = (ev) + 1; \
        if (kt_ < NT) { ek0[s] = *reinterpret_cast<const bf16x8*>(&Kh[(size_t)(kt_ * KVBLK + sr) * LDK + sc]); ek1[s] = *reinterpret_cast<const bf16x8*>(&Kh[(size_t)(kt_ * KVBLK + 32 + sr) * LDK + sc]); } \
        ev0[s] = *reinterpret_cast<const bf16x8*>(&Vh[(size_t)((ev) * KVBLK + sr) * LDK + sc]); ev1[s] = *reinterpret_cast<const bf16x8*>(&Vh[(size_t)((ev) * KVBLK + 32 + sr) * LDK + sc]); } while (0)
#define DA_EWRITE(s, ev) do { const int kt_ = (ev) + 1; \
        if (kt_ < NT) { *(LAS bf16x8*)(K_lds + (kt_ & 1) * SHM_K + kst0) = ek0[s]; *(LAS bf16x8*)(K_lds + (kt_ & 1) * SHM_K + kst1) = ek1[s]; } \
        *(LAS bf16x8*)(V_lds + ((ev) & 1) * SHM_V + vst0) = ev0[s]; *(LAS bf16x8*)(V_lds + ((ev) & 1) * SHM_V + vst1) = ev1[s]; } while (0)
#define DA_CONSUME(s) asm volatile("" :: "v"(ek0[s]), "v"(ek1[s]), "v"(ev0[s]), "v"(ev1[s]))
#define DA_STAGE(i) do { if ((i) & 1) { if (VARIANT == 4) DA_CONSUME(1); else DA_EWRITE(1, i); if ((i) + 2 < NT) DA_ELOAD(1, (i) + 2); } else { if (VARIANT == 4) DA_CONSUME(0); else DA_EWRITE(0, i); if ((i) + 2 < NT) DA_ELOAD(0, (i) + 2); } } while (0)
#define DA_RESC(a) do { if (__any((a) < 1.f)) { if (hi == 0) al_l[r32] = (a); asm volatile("s_waitcnt lgkmcnt(0)" ::: "memory"); \
    _Pragma("unroll") for (int d = 0; d < 4; ++d) _Pragma("unroll") for (int r = 0; r < 16; ++r) o[d][r] *= al_l[crow(r, hi)]; } } while (0)
#define DA_PV(vb) do { pv_pair<4, 0>(o[0], o[1], vb, pa0, pa1, pa2, pa3); pv_pair<4, 2>(o[2], o[3], vb, pa0, pa1, pa2, pa3); } while (0)
    f32x16 p0, p1; bf16x8 pa0, pa1, pa2, pa3;
    { const bf16x8 a0 = *reinterpret_cast<const bf16x8*>(&Kh[(size_t)sr * LDK + sc]), a1 = *reinterpret_cast<const bf16x8*>(&Kh[(size_t)(32 + sr) * LDK + sc]);
      *(LAS bf16x8*)(K_lds + kst0) = a0; *(LAS bf16x8*)(K_lds + kst1) = a1; }
    DA_ELOAD(0, 0); if (1 < NT) DA_ELOAD(1, 1);
    __syncthreads();
    if (jh == 1) __syncthreads();
    for (int i = 0; i < NT; ++i) {
        if (VARIANT != 1) { if (jh == 1) DA_STAGE(i); }
        if (i > 0 && VARIANT != 3) { DA_RESC(alpha); const int vb = vb0 + ((i - 1) & 1) * SHM_V; DA_PV(vb); }
        qkt64(p0, p1, K_lds + (i & 1) * SHM_K, qr, r32, hi, cb0);
        __syncthreads();
        if (VARIANT != 1) { if (jh == 0) DA_STAGE(i); }
        { float pmax = p0[0];
#pragma unroll
          for (int r = 1; r < 16; ++r) pmax = fmaxf(pmax, p0[r]);
#pragma unroll
          for (int r = 0; r < 16; ++r) pmax = fmaxf(pmax, p1[r]);
          { auto rr = __builtin_amdgcn_permlane32_swap(__float_as_uint(pmax), __float_as_uint(pmax), false, false); pmax = fmaxf(__uint_as_float(rr[0]), __uint_as_float(rr[1])); }
          float mn;
          if (__builtin_expect(__all(pmax - m_reg <= THR / SCALE), 1)) { mn = m_reg; alpha = 1.f; }
          else { mn = fmaxf(m_reg, pmax); alpha = __builtin_amdgcn_exp2f((m_reg - mn) * C); m_reg = mn; }
          const float mnC = -mn * C; float ps = 0.f;
#pragma unroll
          for (int r = 0; r < 16; ++r) { if (VARIANT == 2) { p0[r] = fmaf(p0[r], C, mnC); p1[r] = fmaf(p1[r], C, mnC); } else { p0[r] = __builtin_amdgcn_exp2f(fmaf(p0[r], C, mnC)); p1[r] = __builtin_amdgcn_exp2f(fmaf(p1[r], C, mnC)); } }
#pragma unroll
          for (int r = 0; r < 16; ++r) ps += p0[r] + p1[r];
          { auto rr = __builtin_amdgcn_permlane32_swap(__float_as_uint(ps), __float_as_uint(ps), false, false); ps = __uint_as_float(rr[0]) + __uint_as_float(rr[1]); }
          l_reg = l_reg * alpha + ps;
          AT_PK4(p0, 0, pa0); AT_PK4(p0, 8, pa1); AT_PK4(p1, 0, pa2); AT_PK4(p1, 8, pa3); }
        __syncthreads();
    }
    { DA_RESC(alpha); const int vb = vb0 + ((NT - 1) & 1) * SHM_V; DA_PV(vb); }
    if (jh == 0) __syncthreads();
    if (hi == 0) li_l[r32] = l_reg; asm volatile("s_waitcnt lgkmcnt(0)" ::: "memory");
    float rli[16];
#pragma unroll
    for (int r = 0; r < 16; ++r) rli[r] = __builtin_amdgcn_rcpf(li_l[crow(r, hi)]);
    __syncthreads();
    LAS float* X = (LAS float*)lds;
    if (jh == 1) {
#pragma unroll
        for (int r = 0; r < 16; ++r)
#pragma unroll
            for (int d0 = 0; d0 < 4; ++d0) X[(wq * 32 + crow(r, hi)) * DA_XPITCH + d0 * 32 + r32] = o[d0][r] * rli[r];
    }
    __syncthreads();
    if (jh == 0) {
#pragma unroll
        for (int r = 0; r < 16; ++r)
#pragma unroll
            for (int d0 = 0; d0 < 4; ++d0) { const int ix = (wq * 32 + crow(r, hi)) * DA_XPITCH + d0 * 32 + r32; X[ix] = o[d0][r] * rli[r] - lam * X[ix]; }
    }
    __syncthreads();
    { const int row = tid >> 2, qd = tid & 3; const LAS f32x4* xr = (const LAS f32x4*)(X + row * DA_XPITCH + qd * 32);
      f32x4 v[8]; float ss = 0.f;
#pragma unroll
      for (int i = 0; i < 8; ++i) { v[i] = xr[i]; ss += (v[i][0] * v[i][0] + v[i][1] * v[i][1]) + (v[i][2] * v[i][2] + v[i][3] * v[i][3]); }
      ss += __shfl_xor(ss, 1); ss += __shfl_xor(ss, 2);
      const float rs = __builtin_amdgcn_rsqf(ss * (1.f / 128.f) + EPS) * oscale;
      const f32x4* gp = (const f32x4*)(subg + qd * 32); f32x4 gq[8];
#pragma unroll
      for (int i = 0; i < 8; ++i) gq[i] = gp[i];
      bf16_t* op = Ob + (size_t)row * 1024 + qd * 32;
#pragma unroll
      for (int i = 0; i < 4; ++i) { const f32x4 a = v[2 * i] * rs * gq[2 * i], b = v[2 * i + 1] * rs * gq[2 * i + 1]; *(u32x4*)(op + 8 * i) = gm::pack8(a, b); } }
    __syncthreads();
#undef DA_ELOAD
#undef DA_EWRITE
#undef DA_STAGE
#undef DA_RESC
#undef DA_PV
}

constexpr int DD_LDS_K = 0, DD_LDS_V = 65536, DD_LDS_WS = 131072 + 256;
__device__ __forceinline__ void diff_attn_unit_dma(const bf16_t* __restrict__ Qb, const bf16_t* __restrict__ Kh, const bf16_t* __restrict__ Vh, bf16_t* __restrict__ Ob,
                                                   int seq, float lam, float oscale, const float* __restrict__ subg, LAS char* lds) {
    constexpr int LDK = 128, SLOT = 16384, KVBLK = 64;
    constexpr float C = SCALE * 1.4426950408889634f;
    int tid = threadIdx.x; asm volatile("" : "+v"(tid));
    const int wid = __builtin_amdgcn_readfirstlane(tid >> 6), lane = tid & 63, r32 = lane & 31, hi = lane >> 5, jh = wid >> 2, wq = wid & 3;
    LAS char* K_lds = lds + DD_LDS_K; LAS char* V_lds = lds + DD_LDS_V;
    LAS float* ws = (LAS float*)(lds + DD_LDS_WS) + wid * 64; LAS float* li_l = ws; LAS float* al_l = ws + 32;
    float m_reg = -1e30f, l_reg = 0.f, alpha = 1.f; f32x16 o[4] = {}; bf16x8 qr[4];
    const bf16_t* Qw = Qb + (size_t)(wq * 32 + r32) * 128 + jh * 64 + hi * 8;
#pragma unroll
    for (int d0 = 0; d0 < 4; ++d0) qr[d0] = *reinterpret_cast<const bf16x8*>(Qw + d0 * 16);
    const int cb0 = jh * 128;
    const int vb0 = (int)(uintptr_t)V_lds + v_rd_base(lane);
    const int NT = seq / KVBLK;
    unsigned koff[2], voff[2]; unsigned pbase[2];
#pragma unroll
    for (int j = 0; j < 2; ++j) { const int piece = j * 8 + wid; pbase[j] = (unsigned)piece * 1024u;
        const int krow = piece * 4 + (lane >> 4), kcolB = ((lane & 15) * 16) ^ ((krow & 7) << 4); koff[j] = (unsigned)(krow * LDK + (kcolB >> 1));
        const int sub = piece * 2 + (lane >> 5), kk = (sub >> 2) * 8 + ((lane & 31) >> 2), vk = (kk & ~0xC) | ((kk & 4) << 1) | ((kk & 8) >> 1), vc = (sub & 3) * 32 + (lane & 3) * 8; voff[j] = (unsigned)(vk * LDK + vc); }
#define DD_DMA(gp, lp) __builtin_amdgcn_global_load_lds((const unsigned*)(gp), (LAS unsigned*)(lp), 16, 0, 0)
#define DD_KTILE(t, slot) do { const bf16_t* g_ = Kh + (size_t)(t) * KVBLK * LDK; DD_DMA(g_ + koff[0], K_lds + (slot) * SLOT + pbase[0]); DD_DMA(g_ + koff[1], K_lds + (slot) * SLOT + pbase[1]); } while (0)
#define DD_VTILE(t, slot) do { const bf16_t* g_ = Vh + (size_t)(t) * KVBLK * LDK; DD_DMA(g_ + voff[0], V_lds + (slot) * SLOT + pbase[0]); DD_DMA(g_ + voff[1], V_lds + (slot) * SLOT + pbase[1]); } while (0)
#define DD_STAGE(e) do { asm volatile("s_waitcnt vmcnt(4)" ::: "memory"); const int kt_ = (e) + 3 < NT ? (e) + 3 : 0, vt_ = (e) + 2 < NT ? (e) + 2 : 0; DD_KTILE(kt_, ((e) + 3) & 3); DD_VTILE(vt_, ((e) + 2) & 3); } while (0)
#define DD_BAR() do { asm volatile("s_waitcnt lgkmcnt(0)" ::: "memory"); __builtin_amdgcn_s_barrier(); asm volatile("" ::: "memory"); } while (0)
#define DD_RESC(a) do { if (__any((a) < 1.f)) { if (hi == 0) al_l[r32] = (a); asm volatile("s_waitcnt lgkmcnt(0)" ::: "memory"); \
    _Pragma("unroll") for (int d = 0; d < 4; ++d) _Pragma("unroll") for (int r = 0; r < 16; ++r) o[d][r] *= al_l[crow(r, hi)]; } } while (0)
#define DD_PV(vb) do { pv_pair<4, 0>(o[0], o[1], vb, pa0, pa1, pa2, pa3); pv_pair<4, 2>(o[2], o[3], vb, pa0, pa1, pa2, pa3); } while (0)
    f32x16 p0, p1; bf16x8 pa0, pa1, pa2, pa3;
    DD_KTILE(0, 0); DD_KTILE(1, 1); DD_KTILE(2, 2); DD_VTILE(0, 0); DD_VTILE(1, 1);
    asm volatile("s_waitcnt vmcnt(0)" ::: "memory");
    asm volatile("" : "+v"(qr[0]), "+v"(qr[1]), "+v"(qr[2]), "+v"(qr[3]));
    DD_BAR();
    if (jh == 1) DD_BAR();
    for (int i = 0; i < NT; ++i) {
        if (jh == 1) DD_STAGE(i);
        if (i > 0) { DD_RESC(alpha); const int vb = vb0 + ((i - 1) & 3) * SLOT; DD_PV(vb); }
        qkt64(p0, p1, K_lds + (i & 3) * SLOT, qr, r32, hi, cb0);
        DD_BAR();
        if (jh == 0) DD_STAGE(i);
        { float pmax = p0[0];
#pragma unroll
          for (int r = 1; r < 16; ++r) pmax = fmaxf(pmax, p0[r]);
#pragma unroll
          for (int r = 0; r < 16; ++r) pmax = fmaxf(pmax, p1[r]);
          { auto rr = __builtin_amdgcn_permlane32_swap(__float_as_uint(pmax), __float_as_uint(pmax), false, false); pmax = fmaxf(__uint_as_float(rr[0]), __uint_as_float(rr[1])); }
          float mn;
          if (__builtin_expect(__all(pmax - m_reg <= THR / SCALE), 1)) { mn = m_reg; alpha = 1.f; }
          else { mn = fmaxf(m_reg, pmax); alpha = __builtin_amdgcn_exp2f((m_reg - mn) * C); m_reg = mn; }
          const float mnC = -mn * C; float ps = 0.f;
#pragma unroll
          for (int r = 0; r < 16; ++r) { p0[r] = __builtin_amdgcn_exp2f(fmaf(p0[r], C, mnC)); p1[r] = __builtin_amdgcn_exp2f(fmaf(p1[r], C, mnC)); }
#pragma unroll
          for (int r = 0; r < 16; ++r) ps += p0[r] + p1[r];
          { auto rr = __builtin_amdgcn_permlane32_swap(__float_as_uint(ps), __float_as_uint(ps), false, false); ps = __uint_as_float(rr[0]) + __uint_as_float(rr[1]); }
          l_reg = l_reg * alpha + ps;
          AT_PK4(p0, 0, pa0); AT_PK4(p0, 8, pa1); AT_PK4(p1, 0, pa2); AT_PK4(p1, 8, pa3); }
        DD_BAR();
    }
    { DD_RESC(alpha); const int vb = vb0 + ((NT - 1) & 3) * SLOT; DD_PV(vb); }
    asm volatile("s_waitcnt vmcnt(0)" ::: "memory");
    if (jh == 0) DD_BAR();
    if (hi == 0) li_l[r32] = l_reg; asm volatile("s_waitcnt lgkmcnt(0)" ::: "memory");
    float rli[16];
#pragma unroll
    for (int r = 0; r < 16; ++r) rli[r] = __builtin_amdgcn_rcpf(li_l[crow(r, hi)]);
    DD_BAR();
    LAS float* X = (LAS float*)lds;
    if (jh == 1) {
#pragma unroll
        for (int r = 0; r < 16; ++r)
#pragma unroll
            for (int d0 = 0; d0 < 4; ++d0) X[(wq * 32 + crow(r, hi)) * DA_XPITCH + d0 * 32 + r32] = o[d0][r] * rli[r];
    }
    DD_BAR();
    if (jh == 0) {
#pragma unroll
        for (int r = 0; r < 16; ++r)
#pragma unroll
            for (int d0 = 0; d0 < 4; ++d0) { const int ix = (wq * 32 + crow(r, hi)) * DA_XPITCH + d0 * 32 + r32; X[ix] = o[d0][r] * rli[r] - lam * X[ix]; }
    }
    DD_BAR();
    { const int row = tid >> 2, qd = tid & 3; const LAS f32x4* xr = (const LAS f32x4*)(X + row * DA_XPITCH + qd * 32);
      f32x4 v[8]; float ss = 0.f;
#pragma unroll
      for (int i = 0; i < 8; ++i) { v[i] = xr[i]; ss += (v[i][0] * v[i][0] + v[i][1] * v[i][1]) + (v[i][2] * v[i][2] + v[i][3] * v[i][3]); }
      ss += __shfl_xor(ss, 1); ss += __shfl_xor(ss, 2);
      const float rs = __builtin_amdgcn_rsqf(ss * (1.f / 128.f) + EPS) * oscale;
      const f32x4* gp = (const f32x4*)(subg + qd * 32); f32x4 gq[8];
#pragma unroll
      for (int i = 0; i < 8; ++i) gq[i] = gp[i];
      bf16_t* op = Ob + (size_t)row * 1024 + qd * 32;
#pragma unroll
      for (int i = 0; i < 4; ++i) { const f32x4 a = v[2 * i] * rs * gq[2 * i], b = v[2 * i + 1] * rs * gq[2 * i + 1]; *(u32x4*)(op + 8 * i) = gm::pack8(a, b); } }
    asm volatile("s_waitcnt vmcnt(0)" ::: "memory");
    DD_BAR();
#undef DD_DMA
#undef DD_KTILE
#undef DD_VTILE
#undef DD_STAGE
#undef DD_BAR
#undef DD_RESC
#undef DD_PV
}

constexpr int NA_LDS_K = 0, NA_LDS_V = 24576, NA_LDS_RPB = 49152, NA_LDS_WS = 53248;
__device__ __forceinline__ void natten_unit(const bf16_t* __restrict__ qbuf, const bf16_t* __restrict__ kbuf, const bf16_t* __restrict__ vbuf, bf16_t* __restrict__ obuf,
                                            const float* __restrict__ rpb, int b, int h, int R4, LAS char* lds) {
    constexpr float L2E = 1.4426950408889634f;
    int tid = threadIdx.x; asm volatile("" : "+v"(tid));
    const int wid = __builtin_amdgcn_readfirstlane(tid >> 6), lane = tid & 63, r32 = lane & 31, hi = lane >> 5;
    const int qrow = R4 * 4 + (wid >> 1), qc0 = (wid & 1) * 32, qc = qc0 + r32;
    const int r0q = min(max(qrow - 4, 0), 24), wc0 = min(max(qc - 8, 0), 48);
    const int lo = min(max(R4 * 4 - 4, 0), 24), hir = min(max(R4 * 4 - 1, 0), 24) + 7, nloc = hir - lo + 1, T = nloc + 4;
    LAS char* K_lds = lds + NA_LDS_K; LAS char* V_lds = lds + NA_LDS_V; LAS float* rp = (LAS float*)(lds + NA_LDS_RPB);
    LAS float* ws = (LAS float*)(lds + NA_LDS_WS) + wid * 64; LAS float* li_l = ws; LAS float* al_l = ws + 32;
    for (int i = tid; i < 465; i += NTHREADS) rp[i] = rpb[h * 465 + i];
    const size_t qtok = (size_t)b * SEQ + qrow * 64 + qc;
    bf16x8 qr[4];
#pragma unroll
    for (int d0 = 0; d0 < 4; ++d0) qr[d0] = *reinterpret_cast<const bf16x8*>(qbuf + qtok * 1024 + h * 64 + d0 * 16 + hi * 8);
    const bf16_t* Kb = kbuf + (size_t)b * KVL * 1024 + h * 64; const bf16_t* Vb = vbuf + (size_t)b * KVL * 1024 + h * 64;
    const int srow = tid >> 3, sch = tid & 7;
    const int kst = AT_KSWZ64(srow, sch * 16), vst = v_st<2>(srow, sch * 8);
    const int vb0 = (int)(uintptr_t)V_lds + v_rd_base(lane);
    float m_reg = -1e30f, l_reg = 0.f; f32x16 o[2] = {};
    bf16x8 kreg[3], vreg[3];
#define NA_KROW(ti) ((ti) < nloc ? CTXL + (lo + (ti)) * 64 : ((ti) - nloc) * 64)
#define NA_LOAD(s, ti) do { if ((ti) < T) { const int kr0_ = NA_KROW(ti); kreg[s] = *reinterpret_cast<const bf16x8*>(Kb + (size_t)(kr0_ + srow) * 1024 + sch * 8); vreg[s] = *reinterpret_cast<const bf16x8*>(Vb + (size_t)(kr0_ + srow) * 1024 + sch * 8); } } while (0)
#define NA_WRITE(s) do { *(LAS bf16x8*)(K_lds + (s) * 8192 + kst) = kreg[s]; *(LAS bf16x8*)(V_lds + (s) * 8192 + vst) = vreg[s]; } while (0)
    NA_LOAD(0, 0); NA_LOAD(1, 1); NA_LOAD(2, 2);
    NA_WRITE(0); NA_LOAD(0, 3);
    __syncthreads();
#define NA_STEP(ti, S0, S1) do { \
        const bool local = (ti) < nloc; const int kr = lo + (ti); \
        const bool active = !local || (kr >= r0q && kr < r0q + 8); \
        if (active) { \
            f32x16 p0 = {}, p1 = {}; \
            const LAS char* Ks = K_lds + (S0) * 8192; \
              \
            { bf16x8 kf0[4], kf1[4]; \
              _Pragma("unroll") for (int d0 = 0; d0 < 4; ++d0) { const int cb = (d0 * 16 + hi * 8) * 2; \
                kf0[d0] = *reinterpret_cast<const LAS bf16x8*>(Ks + AT_KSWZ64(r32, cb)); kf1[d0] = *reinterpret_cast<const LAS bf16x8*>(Ks + AT_KSWZ64(32 + r32, cb)); } \
              __builtin_amdgcn_sched_barrier(0); \
              _Pragma("unroll") for (int d0 = 0; d0 < 4; ++d0) { \
                p0 = __builtin_amdgcn_mfma_f32_32x32x16_bf16(kf0[d0], qr[d0], p0, 0, 0, 0); \
                p1 = __builtin_amdgcn_mfma_f32_32x32x16_bf16(kf1[d0], qr[d0], p1, 0, 0, 0); } } \
            if (local) { float bb0[16], bb1[16];                                 \
                const LAS float* rb = rp + (kr - qrow + 7) * 31 + 15 - qc; \
                _Pragma("unroll") for (int r = 0; r < 16; ++r) { const int kc = crow(r, hi); bb0[r] = rb[kc]; bb1[r] = rb[kc + 32]; } \
                __builtin_amdgcn_sched_barrier(0); \
                _Pragma("unroll") for (int r = 0; r < 16; ++r) { const int kc = crow(r, hi); \
                    p0[r] = (kc >= wc0 && kc < wc0 + 16) ? fmaf(p0[r], SCALE, bb0[r]) : -1e30f; \
                    p1[r] = (kc + 32 >= wc0 && kc + 32 < wc0 + 16) ? fmaf(p1[r], SCALE, bb1[r]) : -1e30f; } \
            } else { \
                _Pragma("unroll") for (int r = 0; r < 16; ++r) { p0[r] *= SCALE; p1[r] *= SCALE; } \
            } \
            float pmax = p0[0]; \
            _Pragma("unroll") for (int r = 1; r < 16; ++r) pmax = fmaxf(pmax, p0[r]); \
            _Pragma("unroll") for (int r = 0; r < 16; ++r) pmax = fmaxf(pmax, p1[r]); \
            { auto rr = __builtin_amdgcn_permlane32_swap(__float_as_uint(pmax), __float_as_uint(pmax), false, false); pmax = fmaxf(__uint_as_float(rr[0]), __uint_as_float(rr[1])); } \
            const float mn = fmaxf(m_reg, pmax), alpha = __builtin_amdgcn_exp2f((m_reg - mn) * L2E); m_reg = mn; \
            float ps = 0.f; \
            _Pragma("unroll") for (int r = 0; r < 16; ++r) { p0[r] = __builtin_amdgcn_exp2f((p0[r] - mn) * L2E); p1[r] = __builtin_amdgcn_exp2f((p1[r] - mn) * L2E); ps += p0[r] + p1[r]; } \
            { auto rr = __builtin_amdgcn_permlane32_swap(__float_as_uint(ps), __float_as_uint(ps), false, false); ps = __uint_as_float(rr[0]) + __uint_as_float(rr[1]); } \
            l_reg = l_reg * alpha + ps; \
            if (__any(alpha < 1.f)) { if (hi == 0) al_l[r32] = alpha; asm volatile("s_waitcnt lgkmcnt(0)" ::: "memory"); \
                _Pragma("unroll") for (int d = 0; d < 2; ++d) _Pragma("unroll") for (int r = 0; r < 16; ++r) o[d][r] *= al_l[crow(r, hi)]; } \
            bf16x8 pa0, pa1, pa2, pa3; \
            AT_PK4(p0, 0, pa0); AT_PK4(p0, 8, pa1); AT_PK4(p1, 0, pa2); AT_PK4(p1, 8, pa3); \
            const int vb = vb0 + (S0) * 8192; \
            pv_batch2(o[0], o[1], vb, pa0, pa1, pa2, pa3); \
        } \
        if ((ti) + 1 < T) { NA_WRITE(S1); NA_LOAD(S1, (ti) + 4); } \
        __syncthreads(); } while (0)
    for (int t3 = 0; t3 < T; t3 += 3) { NA_STEP(t3, 0, 1); NA_STEP(t3 + 1, 1, 2); NA_STEP(t3 + 2, 2, 0); }
    if (hi == 0) li_l[r32] = l_reg; asm volatile("s_waitcnt lgkmcnt(0)" ::: "memory");
    LAS bf16_t* ost = (LAS bf16_t*)(lds + NA_LDS_K) + wid * (32 * 72);
#pragma unroll
    for (int r = 0; r < 16; ++r) { const int orow = crow(r, hi); const float rl = __builtin_amdgcn_rcpf(li_l[orow]);
#pragma unroll
        for (int d0 = 0; d0 < 2; ++d0) { const unsigned w = cvt_pk_bf16(o[d0][r] * rl, 0.f); ost[orow * 72 + d0 * 32 + r32] = (bf16_t)(w & 0xffffu); } }
    asm volatile("s_waitcnt lgkmcnt(0)" ::: "memory");
    { bf16_t* op = obuf + ((size_t)b * SEQ + qrow * 64 + qc0) * 1024 + h * 64;
#pragma unroll
      for (int t = 0; t < 4; ++t) { const int ch = lane + 64 * t, orow = ch >> 3, c8 = (ch & 7) * 8;
          *(u32x4*)(op + (size_t)orow * 1024 + c8) = *(const LAS u32x4*)(ost + orow * 72 + c8); } }
    __syncthreads();
#undef NA_KROW
#undef NA_LOAD
#undef NA_WRITE
#undef NA_STEP
}
}

struct Params { const float* in[29]; float* out; unsigned char* ws; int ph_lo, ph_hi, li, pad; };
enum { I_X = 0, I_C, I_CTX, I_CCTX, I_ADAW, I_ADAB, I_MNG, I_MOEG, I_ROUTER, I_WGATE, I_WUP, I_WDOWN, I_DAWIN, I_LQ1, I_LK1, I_LQ2, I_LK2, I_SUBLN, I_DAWOUT,
       I_GMWIN, I_GMVG, I_GMWS, I_GMBS, I_GMWOUT, I_NAWIN, I_NARPB, I_NAWOUT, I_FNWOUT, I_FINALG };
struct Frame {
    LAS unsigned char* lds; const float* in[29]; unsigned char* ws; float* out;
    int tid, lane, wave, G, bid;
    template <class T> __device__ __forceinline__ T* W(size_t off) const { return (T*)(ws + off); }
};

struct TItem { const float* src; bf16_t* dst; int ldw, K, f8; };
__device__ __forceinline__ void titem_load(const TItem& t, int lane, float (&r)[32]) {
#pragma unroll
    for (int i = 0; i < 32; ++i) r[i] = t.src[(size_t)(2 * i + (lane >> 5)) * t.ldw + (lane & 31)];
}
__device__ __forceinline__ void titem_finish(const TItem& t, int lane, const float (&r)[32], LAS float* scr) {
#pragma unroll
    for (int i = 0; i < 32; ++i) scr[(2 * i + (lane >> 5)) * 33 + (lane & 31)] = r[i];
    LDS_WAIT(); asm volatile("" ::: "memory");
    if (t.f8) { const int c4 = lane & 3; unsigned char* d8 = (unsigned char*)t.dst;
#pragma unroll
        for (int j = 0; j < 2; ++j) { const int n = (lane >> 2) + 16 * j; const LAS float* s = scr + (16 * c4) * 33 + n; u32x4 o;
            o.x = gm::pk4_fp8(s[0 * 33] * gm::F8_SW, s[1 * 33] * gm::F8_SW, s[2 * 33] * gm::F8_SW, s[3 * 33] * gm::F8_SW); o.y = gm::pk4_fp8(s[4 * 33] * gm::F8_SW, s[5 * 33] * gm::F8_SW, s[6 * 33] * gm::F8_SW, s[7 * 33] * gm::F8_SW);
            o.z = gm::pk4_fp8(s[8 * 33] * gm::F8_SW, s[9 * 33] * gm::F8_SW, s[10 * 33] * gm::F8_SW, s[11 * 33] * gm::F8_SW); o.w = gm::pk4_fp8(s[12 * 33] * gm::F8_SW, s[13 * 33] * gm::F8_SW, s[14 * 33] * gm::F8_SW, s[15 * 33] * gm::F8_SW);
            *(u32x4*)(d8 + (size_t)n * t.K + 16 * c4) = o; }
        LDS_WAIT(); asm volatile("" ::: "memory"); return; }
    const int c = lane & 7;
#pragma unroll
    for (int j = 0; j < 4; ++j) { const int n = (lane >> 3) + 8 * j; const LAS float* s = scr + (8 * c) * 33 + n;
        u32x4 o; o.x = cvt_pk_bf16(s[0 * 33], s[1 * 33]); o.y = cvt_pk_bf16(s[2 * 33], s[3 * 33]); o.z = cvt_pk_bf16(s[4 * 33], s[5 * 33]); o.w = cvt_pk_bf16(s[6 * 33], s[7 * 33]);
        *(u32x4*)(t.dst + (size_t)n * t.K + 8 * c) = o; }
    LDS_WAIT(); asm volatile("" ::: "memory");
}
__device__ __forceinline__ TItem titem_make(const float* W, int ldw, int K, bf16_t* WT, int k0, int n0, int drow0) { TItem t; t.src = W + (size_t)k0 * ldw + n0; t.dst = WT + (size_t)drow0 * K + k0; t.ldw = ldw; t.K = K; t.f8 = 0; return t; }
__device__ __forceinline__ TItem titem_make8(const float* W, int ldw, int K, unsigned char* WT, int k0, int n0, int drow0) { TItem t; t.src = W + (size_t)k0 * ldw + n0; t.dst = (bf16_t*)(WT + (size_t)drow0 * K + k0); t.ldw = ldw; t.K = K; t.f8 = 1; return t; }
__device__ __forceinline__ TItem titem_plain(const float* W, int K, int N, bf16_t* WT, int item) { const int nblk = N / 32, kb = item / nblk, nb = item - kb * nblk; return titem_make(W, N, K, WT, 64 * kb, 32 * nb, 32 * nb); }
__device__ __forceinline__ TItem titem_moe(const Frame& F, int layer, int item) {
    const int kind = item / 8192, r = item - kind * 8192, e = r >> 9, it = r & 511, kb = it >> 5, nb = it & 31;
    const size_t eoff = ((size_t)layer * NE + e) * (size_t)(D * D);
    if (kind < 2) { const float* W = (kind == 0 ? F.in[I_WGATE] : F.in[I_WUP]) + eoff; unsigned char* WT = F.W<unsigned char>(WGU_OF(layer)) + (size_t)e * 2048 * 1024;
        const int n0 = 32 * nb; return titem_make8(W, D, D, WT, 64 * kb, n0, 256 * (n0 >> 7) + 128 * kind + (n0 & 127)); }
    const float* W = F.in[I_WDOWN] + eoff; unsigned char* WT = F.W<unsigned char>(WD_OF(layer)) + (size_t)e * 1024 * 1024; return titem_make8(W, D, D, WT, 64 * kb, 32 * nb, 32 * nb);
}
constexpr int MIX_J0 = 16 * 96, MIX_J1 = 16 * 32, MIX_J2 = 16 * 128, MIX_J3 = 32 * 32, MIX_J4 = 16 * 96, MIX_J5 = 16 * 32, MIX_J6 = 16 * 32, MIX_NJ = MIX_J0 + MIX_J1 + MIX_J2 + MIX_J3 + MIX_J4 + MIX_J5 + MIX_J6;
__device__ __forceinline__ TItem titem_mixer(const Frame& F, int it) { int r = it;
    if (r < MIX_J0) return titem_plain(F.in[I_DAWIN], 1024, 3072, F.W<bf16_t>(WS_WQKV0), r); r -= MIX_J0;
    if (r < MIX_J1) return titem_plain(F.in[I_DAWOUT], 1024, 1024, F.W<bf16_t>(WS_WO0), r); r -= MIX_J1;
    if (r < MIX_J2) return titem_plain(F.in[I_GMWIN], 1024, 4096, F.W<bf16_t>(WS_WGIN), r); r -= MIX_J2;
    if (r < MIX_J3) return titem_plain(F.in[I_GMWOUT], 2048, 1024, F.W<bf16_t>(WS_WGOUT), r); r -= MIX_J3;
    if (r < MIX_J4) return titem_plain(F.in[I_NAWIN], 1024, 3072, F.W<bf16_t>(WS_WQKV2), r); r -= MIX_J4;
    if (r < MIX_J5) return titem_plain(F.in[I_NAWOUT], 1024, 1024, F.W<bf16_t>(WS_WO2), r); r -= MIX_J5;
    return titem_plain(F.in[I_FNWOUT], 1024, 1024, F.W<bf16_t>(WS_WFO), r);
}
__device__ __forceinline__ void weights_range(const Frame& F, int layer, int n_mix, int i0, int i1, int gw, int nw) {
    LAS float* scr = (LAS float*)F.lds + F.wave * 2112;
    int it = i0 + gw; if (it >= i1) return;
    TItem cur = it < n_mix ? titem_mixer(F, it) : titem_moe(F, layer, it - n_mix); float ra[32], rb[32];
    titem_load(cur, F.lane, ra);
    for (;;) { const int nx = it + nw; const bool more = nx < i1; TItem nxt = cur;
        if (more) { nxt = nx < n_mix ? titem_mixer(F, nx) : titem_moe(F, layer, nx - n_mix); titem_load(nxt, F.lane, rb); }
        titem_finish(cur, F.lane, ra, scr);
        if (!more) break;
#pragma unroll
        for (int i = 0; i < 32; ++i) ra[i] = rb[i];
        cur = nxt; it = nx; }
}
__device__ __forceinline__ void moe_weights_phase(const Frame& F, int layer, int i0 = 0) { weights_range(F, layer, 0, i0, 24576, F.bid * NWAVES + F.wave, F.G * NWAVES); __syncthreads(); }
__device__ __forceinline__ void moe_weights_tail(const Frame& F, int layer, int i0, int per, int rank) {
    if (rank < 0) return;
    const int b0 = i0 + rank * per; weights_range(F, layer, 0, b0, b0 + per < 24576 ? b0 + per : 24576, F.wave, NWAVES); __syncthreads();
}
__device__ __forceinline__ void p0_prologue(const Frame& F, bool tails) {
    weights_range(F, 0, MIX_NJ, 0, tails ? MIX_NJ : MIX_NJ + 24576, F.bid * NWAVES + F.wave, F.G * NWAVES);
    const int gt = F.bid * NTHREADS + F.tid, NGT = F.G * NTHREADS;
    for (int i = gt; i < 1024; i += NGT) { const int pos = i >> 4, f = i & 15; const float inv = powf(10000.f, -(float)f / 16.f), ang = (float)pos * inv;
        F.W<float>(WS_ROPE)[i] = cosf(ang); F.W<float>(WS_ROPE + 4096)[i] = sinf(ang); }
    for (int i = gt; i < 512 * 256 / 8; i += NGT) { const int m = i >> 5, j0 = (i & 31) * 8; const int mm = m & 255; float v[8];
#pragma unroll
        for (int t = 0; t < 8; ++t) { const float x = (float)((mm * (j0 + t)) & 255) * (1.f / 128.f); v[t] = m < 256 ? cospif(x) : sinpif(x); }
        u32x4 w; w.x = cvt_pk_bf16(v[0], v[1]); w.y = cvt_pk_bf16(v[2], v[3]); w.z = cvt_pk_bf16(v[4], v[5]); w.w = cvt_pk_bf16(v[6], v[7]);
        *(u32x4*)(F.W<bf16_t>(WS_CS) + (size_t)i * 8) = w; }
    for (int i = gt; i < 2048 * 272; i += NGT) { const int k = i / 272, n0 = (i - k * 272) * 8; float v[8];
#pragma unroll
        for (int t = 0; t < 8; ++t) { const int np = n0 + t; const float x = (float)((k * (np & 1023)) & 2047) * (1.f / 1024.f);
            v[t] = np < 1024 ? cospif(x) : (np < 2048 ? -sinpif(x) : (np == 2048 ? ((k & 1) ? -1.f : 1.f) : 0.f)); }
        u32x4 w; w.x = cvt_pk_bf16(v[0], v[1]); w.y = cvt_pk_bf16(v[2], v[3]); w.z = cvt_pk_bf16(v[4], v[5]); w.w = cvt_pk_bf16(v[6], v[7]);
        *(u32x4*)(F.W<bf16_t>(WS_DP) + (size_t)i * 8) = w; }
    LAS float* sc = (LAS float*)F.lds;
    LAS float* part = (LAS float*)(F.lds + 73728);
    __syncthreads();
    { float cx[34];
#pragma unroll
      for (int q = 0; q < 34; ++q) { const int i = F.tid + NTHREADS * q, r = i >> 10, k = i & 1023; cx[q] = r < 16 ? F.in[I_C][r * 1024 + k] : F.in[I_CCTX][k]; }
#pragma unroll
      for (int q = 0; q < 34; ++q) sc[F.tid + NTHREADS * q] = cx[q] / (1.f + expf(-cx[q])); }
    __syncthreads();
    for (int item = F.bid; item < 4 * 192; item += F.G) { const int l = item / 192, c0 = (item - l * 192) * 32, cs = F.tid & 31, ks = F.tid >> 5;
        const float* wp = F.in[I_ADAW] + ((size_t)l * 1024 + (size_t)ks * 64) * MODW + c0 + cs;
        float a[17];
#pragma unroll
        for (int r = 0; r < 17; ++r) a[r] = 0.f;
        for (int k0 = 0; k0 < 64; k0 += 32) { float w[32];
#pragma unroll
            for (int kk = 0; kk < 32; ++kk) w[kk] = wp[(size_t)(k0 + kk) * MODW];
#pragma unroll
            for (int kk = 0; kk < 32; ++kk) {
#pragma unroll
                for (int r = 0; r < 17; ++r) a[r] = fmaf(sc[r * 1024 + ks * 64 + k0 + kk], w[kk], a[r]);
                __builtin_amdgcn_sched_barrier(0); } }
#pragma unroll
        for (int r = 0; r < 17; ++r) part[(ks * 17 + r) * 32 + cs] = a[r];
        __syncthreads();
        for (int i = F.tid; i < 17 * 32; i += NTHREADS) { const int r = i >> 5, cc = i & 31; float s = F.in[I_ADAB][l * MODW + c0 + cc];
#pragma unroll
            for (int q = 0; q < 16; ++q) s += part[(q * 17 + r) * 32 + cc];
            F.W<float>(WS_MOD)[((size_t)l * MODR + r) * MODW + c0 + cc] = s; }
        __syncthreads(); }
}

template <int CTRL> __device__ __forceinline__ float dpp_f(float x) { return __uint_as_float((unsigned)__builtin_amdgcn_mov_dpp((int)__float_as_uint(x), CTRL, 0xf, 0xf, true)); }
constexpr int DPP_X1 = 0xB1, DPP_X2 = 0x4E, DPP_ROR4 = 0x124, DPP_ROR8 = 0x128, DPP_ROR12 = 0x12C;
__device__ __forceinline__ float swap16_sum(float a, float b) { auto rr = __builtin_amdgcn_permlane16_swap(__float_as_uint(a), __float_as_uint(b), false, false); return __uint_as_float(rr[0]) + __uint_as_float(rr[1]); }
__device__ __forceinline__ float swap32_sum(float a, float b) { auto rr = __builtin_amdgcn_permlane32_swap(__float_as_uint(a), __float_as_uint(b), false, false); return __uint_as_float(rr[0]) + __uint_as_float(rr[1]); }
__device__ __forceinline__ float swap16_max(float a) { auto rr = __builtin_amdgcn_permlane16_swap(__float_as_uint(a), __float_as_uint(a), false, false); return fmaxf(__uint_as_float(rr[0]), __uint_as_float(rr[1])); }
__device__ __forceinline__ float swap32_max(float a) { auto rr = __builtin_amdgcn_permlane32_swap(__float_as_uint(a), __float_as_uint(a), false, false); return fmaxf(__uint_as_float(rr[0]), __uint_as_float(rr[1])); }
__device__ __forceinline__ float wave_sum64(float x) {
    x += dpp_f<DPP_ROR8>(x); x += dpp_f<DPP_ROR4>(x); x += dpp_f<DPP_X2>(x); x += dpp_f<DPP_X1>(x); x = swap16_sum(x, x); return swap32_sum(x, x);
}
template <int O> __device__ __forceinline__ float lane_xor(float x, int lane, bool x4a) {
    if (O == 1) return dpp_f<DPP_X1>(x);
    if (O == 2) return dpp_f<DPP_X2>(x);
    if (O == 4) { const float a = dpp_f<DPP_ROR4>(x), b = dpp_f<DPP_ROR12>(x); return x4a ? a : b; }
    if (O == 8) return dpp_f<DPP_ROR8>(x);
    if (O == 16) { auto rr = __builtin_amdgcn_permlane16_swap(__float_as_uint(x), __float_as_uint(x), false, false); return __uint_as_float((lane & 16) ? rr[0] : rr[1]); }
    auto rr = __builtin_amdgcn_permlane32_swap(__float_as_uint(x), __float_as_uint(x), false, false); return __uint_as_float((lane & 32) ? rr[0] : rr[1]);
}
struct NormArgs {
    const float* xsrc; float* xdst; const float* csrc; float* cdst;
    int do_lat, do_ctx, xbf, xcopy;
    const float* gain; const float* shift; const float* scale;
    bf16_t* hx;
    const bf16_t* ys; const int* tokslot; const int* tokslotc; const float* g2;
    int ctx_comb;
    const float* wrouter; float* aff;
    float* out;
};
constexpr int WRT_PITCH = 1028;
constexpr size_t WS_ZROW = WS_CTL + 768 * 1024;
struct NormVec { f32x4 g[4], sh[4], g2[4]; int mr; };
template <bool COMBINE, bool FINAL, bool ROUTER = false>
__device__ __forceinline__ void normvec_load(const NormArgs& A, int mr, int lane, NormVec& nv) {
    nv.mr = mr;
#pragma unroll
    for (int j = 0; j < 4; ++j) { nv.g[j] = ((const f32x4*)A.gain)[lane + 64 * j];
        if (!FINAL) { nv.sh[j] = ((const f32x4*)(A.shift + (size_t)mr * MODW))[lane + 64 * j]; const f32x4 sc = ((const f32x4*)(A.scale + (size_t)mr * MODW))[lane + 64 * j];
            nv.g[j] = nv.g[j] * (sc + 1.0f);
            if (ROUTER) { nv.g[j] = nv.g[j] * gm::F8_SX; nv.sh[j] = nv.sh[j] * gm::F8_SX; } }
        if (COMBINE) nv.g2[j] = ((const f32x4*)(A.g2 + (size_t)mr * MODW))[lane + 64 * j]; }
}
template <int R>
__device__ __forceinline__ void norm_load(const NormArgs& A, int row0, int rstep, int lane, f32x4 (&v)[R][4]) {
#pragma unroll
    for (int r = 0; r < R; ++r) { const int row = row0 + r * rstep;
        if (A.xbf) { const bf16_t* src = row >= NLAT ? (const bf16_t*)A.csrc + (size_t)(row - NLAT) * D : (const bf16_t*)A.xsrc + (size_t)row * D;
#pragma unroll
            for (int j = 0; j < 4; ++j) { const u32x2 w = ((const u32x2*)src)[lane + 64 * j]; v[r][j] = (f32x4){bf_lo(w.x), bf_hi(w.x), bf_lo(w.y), bf_hi(w.y)}; } }
        else { const float* src = row >= NLAT ? A.csrc + (size_t)(row - NLAT) * D : A.xsrc + (size_t)row * D;
#pragma unroll
            for (int j = 0; j < 4; ++j) v[r][j] = ((const f32x4*)src)[lane + 64 * j]; } }
}
template <bool COMBINE, bool ROUTER, bool FINAL, int R>
__device__ __forceinline__ void norm_rows(const NormArgs& A, const NormVec& nv, int row0, int rstep, int lane, const LAS float* wrT, const bf16_t* zrow, f32x4 (&v)[R][4], int hxfold = -1) {
    int row[R], b[R], mr[R]; bool ic[R];
#pragma unroll
    for (int r = 0; r < R; ++r) { row[r] = row0 + r * rstep; ic[r] = row[r] >= NLAT; b[r] = ic[r] ? (row[r] - NLAT) >> 8 : row[r] >> 11; mr[r] = ic[r] ? 16 : b[r]; }
    if (!COMBINE && !FINAL && A.xcopy) {
#pragma unroll
        for (int r = 0; r < R; ++r) { bf16_t* dst = ic[r] ? (bf16_t*)A.cdst + (size_t)(row[r] - NLAT) * D : (bf16_t*)A.xdst + (size_t)row[r] * D;
#pragma unroll
            for (int j = 0; j < 4; ++j) { u32x2 w; w.x = cvt_pk_bf16(v[r][j][0], v[r][j][1]); w.y = cvt_pk_bf16(v[r][j][2], v[r][j][3]); ((u32x2*)dst)[lane + 64 * j] = w; } } }
    if (COMBINE) {
        int myslot[R]; unsigned msk[R]; int tmax = 0;
#pragma unroll
        for (int r = 0; r < R; ++r) { myslot[r] = -1;
            if (lane < 16 && (!ic[r] || A.ctx_comb)) myslot[r] = ic[r] ? A.tokslotc[(b[r] * 16 + lane) * CTXL + ((row[r] - NLAT) & 255)] : A.tokslot[(b[r] * 16 + lane) * SEQ + (row[r] & 2047)]; }
#pragma unroll
        for (int r = 0; r < R; ++r) { msk[r] = (unsigned)__ballot(myslot[r] >= 0) & 0xffffu; const int c = __builtin_popcount(msk[r]); tmax = c > tmax ? c : tmax; }
        f32x4 a[R][4];
#pragma unroll
        for (int r = 0; r < R; ++r)
#pragma unroll
            for (int j = 0; j < 4; ++j) a[r][j] = (f32x4){0.f, 0.f, 0.f, 0.f};
        for (int t = 0; t < tmax; ++t) {
            unsigned w[R][4];
#pragma unroll
            for (int r = 0; r < R; ++r) { const unsigned m = msk[r]; const bool ok = m != 0u; const int e = ok ? __builtin_ctz(m) : 0; msk[r] = m & (m - 1u);
                const int sl = __builtin_amdgcn_readlane(myslot[r], e);
                const unsigned char* yr = ok ? (const unsigned char*)A.ys + ((size_t)e * gm::ES + (ic[r] ? 4096 + b[r] * CAPC : b[r] * CAP) + sl) * D : (const unsigned char*)zrow;
#pragma unroll
                for (int j = 0; j < 4; ++j) w[r][j] = ((const unsigned*)yr)[lane + 64 * j]; }
#pragma unroll
            for (int r = 0; r < R; ++r)
#pragma unroll
                for (int j = 0; j < 4; ++j) { const f32x2 lo = __builtin_amdgcn_cvt_pk_f32_fp8((int)w[r][j], false), hi2 = __builtin_amdgcn_cvt_pk_f32_fp8((int)w[r][j], true);
                    a[r][j] += (f32x4){lo[0], lo[1], hi2[0], hi2[1]}; }
        }
#pragma unroll
        for (int r = 0; r < R; ++r) { if (ic[r] && !A.ctx_comb) continue;
#pragma unroll
            for (int j = 0; j < 4; ++j) v[r][j] += nv.g2[j] * (a[r][j] * 0.03125f);
            if (!FINAL) { bf16_t* dst = ic[r] ? (bf16_t*)A.cdst + (size_t)(row[r] - NLAT) * D : (bf16_t*)A.xdst + (size_t)row[r] * D;
#pragma unroll
                for (int j = 0; j < 4; ++j) { u32x2 w; w.x = cvt_pk_bf16(v[r][j][0], v[r][j][1]); w.y = cvt_pk_bf16(v[r][j][2], v[r][j][3]); ((u32x2*)dst)[lane + 64 * j] = w; } } }
    }
    float ss[R];
#pragma unroll
    for (int r = 0; r < R; ++r) { ss[r] = 0.f;
#pragma unroll
        for (int j = 0; j < 4; ++j) ss[r] += (v[r][j][0] * v[r][j][0] + v[r][j][1] * v[r][j][1]) + (v[r][j][2] * v[r][j][2] + v[r][j][3] * v[r][j][3]); }
#pragma unroll
    for (int r = 0; r < R; ++r) ss[r] = wave_sum64(ss[r]);
    if (FINAL) {
#pragma unroll
        for (int r = 0; r < R; ++r) { const float rstd = __builtin_amdgcn_rsqf(ss[r] * (1.f / D) + EPS);
#pragma unroll
            for (int j = 0; j < 4; ++j) ((f32x4*)(A.out + (size_t)row[r] * D))[lane + 64 * j] = v[r][j] * rstd * nv.g[j]; }
        return;
    }
#pragma unroll
    for (int r = 0; r < R; ++r) { const float rstd = __builtin_amdgcn_rsqf(ss[r] * (1.f / D) + EPS);
#pragma unroll
        for (int j = 0; j < 4; ++j) { v[r][j] = v[r][j] * rstd * nv.g[j] + nv.sh[j];
            if (ROUTER) ((unsigned*)((unsigned char*)A.hx + (size_t)row[r] * D))[lane + 64 * j] = gm::pk4_fp8(v[r][j][0], v[r][j][1], v[r][j][2], v[r][j][3]);
            else if (hxfold < 0) { u32x2 w; w.x = cvt_pk_bf16(v[r][j][0], v[r][j][1]); w.y = cvt_pk_bf16(v[r][j][2], v[r][j][3]); ((u32x2*)(A.hx + (size_t)row[r] * D))[lane + 64 * j] = w; } } }
    if (hxfold >= 0) {
#pragma unroll
        for (int j = 0; j < 4; ++j) { const f32x4 a = R == 2 ? v[0][j] + v[R - 1][j] : v[0][j];
            u32x2 w; w.x = cvt_pk_bf16(a[0], a[1]); w.y = cvt_pk_bf16(a[2], a[3]); ((u32x2*)(A.hx + (size_t)hxfold * D))[lane + 64 * j] = w;
            if (R == 2) { const f32x4 d = v[0][j] - v[1][j]; u32x2 w2; w2.x = cvt_pk_bf16(d[0], d[1]); w2.y = cvt_pk_bf16(d[2], d[3]); ((u32x2*)(A.hx + (size_t)(hxfold + 1024) * D))[lane + 64 * j] = w2; } } }
    if (ROUTER) {
        float t1[R]; float lgs[R][16];
        f32x4 wb[2][4];
#define RT_LOAD(buf, e) do { _Pragma("unroll") for (int j = 0; j < 4; ++j) wb[buf][j] = *(const LAS f32x4*)(wrT + (e) * WRT_PITCH + 4 * lane + 256 * j); } while (0)
        RT_LOAD(0, 0);
#pragma unroll
        for (int e = 0; e < 16; ++e) {
            if (e + 1 < 16) RT_LOAD((e + 1) & 1, e + 1);
            __builtin_amdgcn_sched_barrier(0);
            f32x2 s_[R];
#pragma unroll
            for (int r = 0; r < R; ++r) s_[r] = (f32x2){0.f, 0.f};
#pragma unroll
            for (int j = 0; j < 4; ++j) { const f32x4 w = wb[e & 1][j]; const f32x2 wlo = (f32x2){w[0], w[1]}, whi = (f32x2){w[2], w[3]};
#pragma unroll
                for (int r = 0; r < R; ++r) { s_[r] = __builtin_elementwise_fma((f32x2){v[r][j][0], v[r][j][1]}, wlo, s_[r]); s_[r] = __builtin_elementwise_fma((f32x2){v[r][j][2], v[r][j][3]}, whi, s_[r]); } }
#pragma unroll
            for (int r = 0; r < R; ++r) lgs[r][e] = s_[r][0] + s_[r][1];
            __builtin_amdgcn_sched_barrier(0);
        }
#undef RT_LOAD
        const bool x4a = __builtin_amdgcn_mov_dpp(lane, DPP_ROR4, 0xf, 0xf, true) == (lane ^ 4);
#pragma unroll
        for (int r = 0; r < R; ++r) {
            float lg[16];
#pragma unroll
            for (int e = 0; e < 16; ++e) lg[e] = lgs[r][e];
            float t8[8], t4[4], t2[2];
#pragma unroll
            for (int k = 0; k < 8; ++k) t8[k] = swap32_sum(lg[k], lg[k + 8]);
#pragma unroll
            for (int k = 0; k < 4; ++k) t4[k] = swap16_sum(t8[k], t8[k + 4]);
            { const bool up = (lane & 8) != 0;
#pragma unroll
              for (int k = 0; k < 2; ++k) { const float keep = up ? t4[k + 2] : t4[k], send = up ? t4[k] : t4[k + 2]; t2[k] = keep + lane_xor<8>(send, lane, x4a); } }
            { const bool up = (lane & 4) != 0; const float keep = up ? t2[1] : t2[0], send = up ? t2[0] : t2[1]; t1[r] = keep + lane_xor<4>(send, lane, x4a); }
        }
#pragma unroll
        for (int r = 0; r < R; ++r) { t1[r] += lane_xor<2>(t1[r], lane, x4a); }
#pragma unroll
        for (int r = 0; r < R; ++r) { t1[r] += lane_xor<1>(t1[r], lane, x4a); }
        float mx[R], ex[R], sm[R];
#pragma unroll
        for (int r = 0; r < R; ++r) { float m = t1[r]; m = fmaxf(m, dpp_f<DPP_ROR8>(m)); m = fmaxf(m, dpp_f<DPP_ROR4>(m)); m = swap16_max(m); mx[r] = swap32_max(m); }
#pragma unroll
        for (int r = 0; r < R; ++r) { ex[r] = __builtin_amdgcn_exp2f((t1[r] - mx[r]) * 1.4426950408889634f); sm[r] = ex[r]; }
#pragma unroll
        for (int r = 0; r < R; ++r) { float q = sm[r]; q += dpp_f<DPP_ROR8>(q); q += dpp_f<DPP_ROR4>(q); q = swap16_sum(q, q); sm[r] = swap32_sum(q, q); }
#pragma unroll
        for (int r = 0; r < R; ++r) if ((lane & 3) == 0) A.aff[(size_t)row[r] * 16 + (lane >> 2)] = ex[r] * __builtin_amdgcn_rcpf(sm[r]);
    }
}
template <bool COMBINE, bool ROUTER, bool FINAL>
__device__ __forceinline__ void norm_phase(const Frame& F, const NormArgs& A) {
    constexpr int R = 2;
    LAS float* wrT = (LAS float*)F.lds;
    if (ROUTER) {
        float tmp[32];
#pragma unroll
        for (int k = 0; k < 32; ++k) tmp[k] = A.wrouter[F.tid + NTHREADS * k];
#pragma unroll
        for (int k = 0; k < 32; ++k) { const int i = F.tid + NTHREADS * k; wrT[(i & 15) * WRT_PITCH + (i >> 4)] = tmp[k] * (1.0f / gm::F8_SX); }
        __syncthreads(); }
    const bf16_t* zrow = (const bf16_t*)(F.ws + WS_ZROW);
    const int gw = F.bid * NWAVES + F.wave, NGW = F.G * NWAVES;
    NormVec nv; nv.mr = -1;
    for (int part = 0; part < 2; ++part) {
        if (part == 0 ? !A.do_lat : !A.do_ctx) continue;
        const int base = part == 0 ? 0 : NLAT, n = part == 0 ? NLAT : NCTX, rpw = (n + NGW - 1) / NGW;
        int row = base + gw * rpw; const int rend = (row + rpw < base + n) ? row + rpw : base + n;
        f32x4 va[R][4], vb[R][4];
        const auto same = [&](int r) { return r + 1 < rend && (part == 1 ? ((r - NLAT) >> 8) == ((r + 1 - NLAT) >> 8) : (r >> 11) == ((r + 1) >> 11)); };
        if (row < rend && same(row)) norm_load<R>(A, row, 1, F.lane, va);
        while (row < rend) {
            const int mr = part == 1 ? 16 : (row >> 11);
            if (mr != nv.mr) normvec_load<COMBINE, FINAL, ROUTER>(A, mr, F.lane, nv);
            if (same(row)) { const int nx = row + R; const bool more = nx < rend && same(nx);
                if (more) norm_load<R>(A, nx, 1, F.lane, vb);
                norm_rows<COMBINE, ROUTER, FINAL, R>(A, nv, row, 1, F.lane, wrT, zrow, va);
                if (more) {
#pragma unroll
                    for (int r = 0; r < R; ++r)
#pragma unroll
                        for (int j = 0; j < 4; ++j) va[r][j] = vb[r][j]; }
                else if (nx < rend && !more) {   }
                row = nx; }
            else { f32x4 v1[1][4]; norm_load<1>(A, row, 1, F.lane, v1); norm_rows<COMBINE, ROUTER, FINAL, 1>(A, nv, row, 1, F.lane, wrT, zrow, v1); row += 1;
                if (row < rend && same(row)) norm_load<R>(A, row, 1, F.lane, va); }
        }
    }
    __syncthreads();
}

constexpr int HF_ROWS = 2304;
template <bool COMBINE>
__device__ __forceinline__ void norm_fold_phase(const Frame& F, const NormArgs& A) {
    const bf16_t* zrow = (const bf16_t*)(F.ws + WS_ZROW);
    const int gw = F.bid * NWAVES + F.wave, NGW = F.G * NWAVES;
    constexpr int NPAIR = NB * 1023;
    NormVec nv; nv.mr = -1;
    { const int ipw = (NPAIR + NGW - 1) / NGW; int it = gw * ipw; const int iend = (it + ipw < NPAIR) ? it + ipw : NPAIR; f32x4 va[2][4], vb[2][4];
      if (it < iend) { const int b = it / 1023, n = 1 + it - b * 1023; norm_load<2>(A, b * SEQ + n, SEQ - 2 * n, F.lane, va); }
      for (; it < iend; ++it) { const int b = it / 1023, n = 1 + it - b * 1023; const int nx = it + 1; const bool more = nx < iend;
          if (b != nv.mr) normvec_load<COMBINE, false>(A, b, F.lane, nv);
          if (more) { const int b2 = nx / 1023, n2 = 1 + nx - b2 * 1023; norm_load<2>(A, b2 * SEQ + n2, SEQ - 2 * n2, F.lane, vb); }
          norm_rows<COMBINE, false, false, 2>(A, nv, b * SEQ + n, SEQ - 2 * n, F.lane, nullptr, zrow, va, b * HF_ROWS + n);
          if (more) {
#pragma unroll
              for (int r = 0; r < 2; ++r)
#pragma unroll
                  for (int j = 0; j < 4; ++j) va[r][j] = vb[r][j]; } } }
    for (int it = gw; it < 2 * NB; it += NGW) { const int b = it >> 1, hi = it & 1; f32x4 v1[1][4];
        if (b != nv.mr) normvec_load<COMBINE, false>(A, b, F.lane, nv);
        norm_load<1>(A, b * SEQ + hi * 1024, 0, F.lane, v1); norm_rows<COMBINE, false, false, 1>(A, nv, b * SEQ + hi * 1024, 0, F.lane, nullptr, zrow, v1, b * HF_ROWS + hi * 2048); }
    for (int it = gw; it < NB * 256; it += NGW) { const int b = it >> 8, q = it & 255; const int r = q == 0 ? 1024 : 2048 + q;
        u32x2 z; z.x = 0u; z.y = 0u;
#pragma unroll
        for (int j = 0; j < 4; ++j) ((u32x2*)(A.hx + ((size_t)b * HF_ROWS + r) * D))[F.lane + 64 * j] = z; }
    __syncthreads();
}

template <int NV, int NTOK, int CAPN>
__device__ __forceinline__ void select_unit(const Frame& F, const float* aff_base  , int* tokslot_out  , int* slot_row_out, float* slot_aff_out, int row_base) {
    LAS int* cnt = (LAS int*)F.lds;
    LAS int* tg = cnt + 64; LAS int* te = tg + NV * 8;
    unsigned v[NV]; bool ok[NV];
#pragma unroll
    for (int k = 0; k < NV; ++k) { const int n = F.tid + NTHREADS * k; ok[k] = n < NTOK; v[k] = ok[k] ? __float_as_uint(aff_base[(size_t)n * 16]) : 0u; }
    unsigned T = 0u;
    for (int bit = 29; bit >= 0; --bit) { const unsigned cand = T | (1u << bit); int cw = 0;
#pragma unroll
        for (int k = 0; k < NV; ++k) cw += __builtin_popcountll(__ballot(ok[k] && v[k] >= cand));
        LAS int* cb = cnt + (bit & 1) * 8;
        if (F.lane == 0) cb[F.wave] = cw;
        __syncthreads();
        int tot = 0;
#pragma unroll
        for (int w = 0; w < 8; ++w) tot += cb[w];
        if (tot >= CAPN) T = cand; }
    int pg[NV], pe[NV]; bool isg[NV], ise[NV];
#pragma unroll
    for (int k = 0; k < NV; ++k) { isg[k] = ok[k] && v[k] > T; ise[k] = ok[k] && v[k] == T;
        const unsigned long long mg = __ballot(isg[k]), me = __ballot(ise[k]); const unsigned long long below = (1ull << F.lane) - 1ull;
        pg[k] = __builtin_popcountll(mg & below); pe[k] = __builtin_popcountll(me & below);
        if (F.lane == 0) { tg[k * 8 + F.wave] = __builtin_popcountll(mg); te[k * 8 + F.wave] = __builtin_popcountll(me); } }
    __syncthreads();
    LAS int* xg = te + NV * 8; LAS int* xe = xg + NV * 8 + 1;
    if (F.tid == 0) { int ag = 0, ae = 0; for (int i = 0; i < NV * 8; ++i) { xg[i] = ag; xe[i] = ae; ag += tg[i]; ae += te[i]; } xg[NV * 8] = ag; }
    __syncthreads();
    const int totg = xg[NV * 8];
#pragma unroll
    for (int k = 0; k < NV; ++k) { const int og = xg[k * 8 + F.wave], oe = xe[k * 8 + F.wave];
        const int n = F.tid + NTHREADS * k;
        if (ok[k]) { int slot = -1;
            if (isg[k]) slot = og + pg[k];
            else if (ise[k]) { const int rk = oe + pe[k]; if (totg + rk < CAPN) slot = totg + rk; }
            tokslot_out[n] = slot;
            if (slot >= 0) { slot_row_out[slot] = row_base + n; slot_aff_out[slot] = __uint_as_float(v[k]); } } }
    __syncthreads();
}
__device__ __forceinline__ void topk_phase(const Frame& F, bool do_ctx) {
    const float* aff = F.W<float>(WS_AFF); int* slot_row = F.W<int>(WS_SLOTROW); float* slot_aff = F.W<float>(WS_SLOTAFF); int* tokslot = F.W<int>(WS_TOKSLOT); int* tokslotc = F.W<int>(WS_TOKSLOTC);
    const int nunits = do_ctx ? 512 : 256;
    for (int u = F.bid; u < nunits; u += F.G) {
        if (u < 256) { const int b = u >> 4, e = u & 15;
            select_unit<4, SEQ, CAP>(F, aff + (size_t)b * SEQ * 16 + e, tokslot + (b * 16 + e) * SEQ, slot_row + e * gm::ES + b * CAP, slot_aff + e * gm::ES + b * CAP, b * SEQ); }
        else { const int b = (u - 256) >> 4, e = u & 15;
            select_unit<1, CTXL, CAPC>(F, aff + ((size_t)NLAT + (size_t)b * CTXL) * 16 + e, tokslotc + (b * 16 + e) * CTXL, slot_row + e * gm::ES + 4096 + b * CAPC, slot_aff + e * gm::ES + 4096 + b * CAPC, NLAT + b * CTXL); }
    }
}

__device__ __forceinline__ void gm_prep_phase(const Frame& F) {
    const float* ws_ = F.in[I_GMWS]; const float* sumsq = F.W<float>(WS_SUMSQ); bf16_t* App = F.W<bf16_t>(RA_APP);
    LAS float* rs = (LAS float*)F.lds;
    for (int item = F.bid; item < NB * 9 * 2; item += F.G) { const int gq = item & 1, bc = item >> 1, b = bc / 9, cp = bc - b * 9;
        const size_t trow0 = cp == 0 ? (size_t)NLAT + (size_t)b * CTXL : (size_t)b * SEQ + (size_t)(cp - 1) * 256;
        if (F.tid < 256) { const f32x4* pa = (const f32x4*)(sumsq + (trow0 + F.tid) * 16); const f32x4 a0 = pa[0], a1 = pa[1], a2 = pa[2], a3 = pa[3];
            const float sm = (((a0[0] + a0[1]) + (a0[2] + a0[3])) + ((a1[0] + a1[1]) + (a1[2] + a1[3]))) + (((a2[0] + a2[1]) + (a2[2] + a2[3])) + ((a3[0] + a3[1]) + (a3[2] + a3[3])));
            rs[F.tid] = __builtin_amdgcn_rsqf(sm * (1.f / 2048.f) + EPS); }
        __syncthreads();
        constexpr int U = 4;
        for (int i0 = F.tid; i0 < 4 * 4096; i0 += U * NTHREADS) {
            f32x4 w0[U], w1[U];
#pragma unroll
            for (int q = 0; q < U; ++q) { const int i = i0 + q * NTHREADS; const int g = gq * 4 + (i >> 12), r = (i >> 4) & 255, k0 = (i & 15) * 8;
                const float* wp = ws_ + ((size_t)g * 128 + (r & 127)) * 128 + k0; w0[q] = *(const f32x4*)wp; w1[q] = *(const f32x4*)(wp + 4); }
#pragma unroll
            for (int q = 0; q < U; ++q) { const int i = i0 + q * NTHREADS; const int g = gq * 4 + (i >> 12), r = (i >> 4) & 255, k0 = (i & 15) * 8, tk = (r >> 7) * 128 + k0;
                const f32x4 r0 = *(const LAS f32x4*)(rs + tk), r1 = *(const LAS f32x4*)(rs + tk + 4);
                *(u32x4*)(App + ((size_t)(bc * 8 + g) * 4096 + (i & 4095)) * 8) = gm::pack8(w0[q] * r0, w1[q] * r1); }
        }
        __syncthreads();
    }
}

enum { PH_PRO = 0,
       PH_L0_N1, PH_L0_QKV, PH_L0_ATT, PH_L0_OUT, PH_L0_N2, PH_L0_TOPK, PH_L0_GU, PH_L0_DOWN,
       PH_L1_N1, PH_L1_GMIN, PH_L1_PREP, PH_L1_SPAT, PH_L1_OUT, PH_L1_N2, PH_L1_TOPK, PH_L1_GU, PH_L1_DOWN,
       PH_L2_N1, PH_L2_QKV, PH_L2_ATT, PH_L2_OUT, PH_L2_N2, PH_L2_TOPK, PH_L2_GU, PH_L2_DOWN,
       PH_L3_N1, PH_L3_CDFT, PH_L3_PDFT, PH_L3_OUT, PH_L3_N2, PH_L3_TOPK, PH_L3_GU, PH_L3_DOWN,
       PH_FINAL, NPHASES };

__device__ __forceinline__ const float* modp(const Frame& F, int layer, int j) { return F.W<float>(WS_MOD) + (size_t)layer * MODR * MODW + (size_t)j * D; }

template <bool COMBINE>
__device__ __forceinline__ void norm1_phase(const Frame& F, int layer, bool do_ctx, bool ctx_comb) {
    NormArgs A{};
    A.xsrc = COMBINE ? F.W<float>(WS_X) : F.in[I_X]; A.xdst = F.W<float>(WS_X); A.csrc = COMBINE ? F.W<float>(WS_CTX) : F.in[I_CTX]; A.cdst = F.W<float>(WS_CTX);
    A.do_lat = 1; A.do_ctx = do_ctx ? 1 : 0; A.xbf = COMBINE ? 1 : 0; A.xcopy = COMBINE ? 0 : 1;
    A.gain = F.in[I_MNG] + layer * D; A.shift = modp(F, layer, 0); A.scale = modp(F, layer, 1); A.hx = F.W<bf16_t>(WS_HX);
    A.ys = F.W<bf16_t>(RA_YS); A.tokslot = F.W<int>(WS_TOKSLOT); A.tokslotc = F.W<int>(WS_TOKSLOTC); A.g2 = modp(F, layer > 0 ? layer - 1 : 0, 5); A.ctx_comb = ctx_comb ? 1 : 0;
    norm_phase<COMBINE, false, false>(F, A);
}
__device__ __forceinline__ void norm2_phase(const Frame& F, int layer, bool do_ctx) {
    NormArgs A{};
    A.xsrc = F.W<float>(WS_X); A.csrc = F.W<float>(WS_CTX); A.do_lat = 1; A.do_ctx = do_ctx ? 1 : 0; A.xbf = 1;
    A.gain = F.in[I_MOEG] + layer * D; A.shift = modp(F, layer, 3); A.scale = modp(F, layer, 4); A.hx = F.W<bf16_t>(WS_HX);
    A.wrouter = F.in[I_ROUTER] + (size_t)layer * D * NE; A.aff = F.W<float>(WS_AFF);
    norm_phase<false, true, false>(F, A);
}
__device__ __forceinline__ void out_phase(const Frame& F, int layer, const char* A, unsigned lda, int K, size_t wofs, int nM) {
    gm::P_OUT p; p.A = A; p.B = (const char*)(F.ws + wofs); p.lda_ = lda; p.K_ = K; p.nM = nM;
    p.xb_ = F.W<bf16_t>(WS_X); p.cb_ = F.W<bf16_t>(WS_CTX); p.gate = modp(F, layer, 2);
    gm::gemm_phase(F.lds, p);
}
__device__ __forceinline__ void gu_phase(const Frame& F, int layer, bool with_ctx) {
    gm::P_GU p; p.hx = (const char*)(F.ws + WS_HX); p.W = (const char*)(F.ws + WGU_OF(layer)); p.hid = F.W<unsigned char>(RA_HID); p.slot_row = F.W<int>(WS_SLOTROW); p.nM = with_ctx ? 18 : 16;
    gm::gemm_phase(F.lds, p);
}
__device__ __forceinline__ void down_phase(const Frame& F, int layer, bool with_ctx) {
    gm::P_DOWN p; p.hid = (const char*)(F.ws + RA_HID); p.W = (const char*)(F.ws + WD_OF(layer)); p.ys = F.W<bf16_t>(RA_YS); p.slot_aff = F.W<float>(WS_SLOTAFF); p.nM = with_ctx ? 18 : 16;
    gm::gemm_phase(F.lds, p);
}

__global__ void __launch_bounds__(NTHREADS, 2) fwd(Params P) {
    extern __shared__ __attribute__((aligned(16))) unsigned char lds_raw[];
    Frame F;
    F.lds = (LAS unsigned char*)lds_raw; F.ws = P.ws; F.out = P.out;
#pragma unroll
    for (int i = 0; i < 29; ++i) F.in[i] = P.in[i];
    F.tid = threadIdx.x; F.lane = F.tid & 63; F.wave = __builtin_amdgcn_readfirstlane(F.tid >> 6); F.G = gridDim.x; F.bid = blockIdx.x;
    volatile LAS unsigned* MISC = (volatile LAS unsigned*)(F.lds + LDS_MISC);
    if (F.tid < 64) MISC[F.tid] = 0u;
    __syncthreads();
    const int lo = P.ph_lo, hi = P.ph_hi;
    const bool tails = (gridDim.x == 256);
    XcdBarrier bar = xcd_barrier_post((unsigned*)(F.ws + WS_CTL) + 1024 + (size_t)P.li * XCD_BAR_WORDS, MISC);
#ifdef MK_ONLY_PHASE
#define IN(k) ((k) == MK_ONLY_PHASE && lo <= (k) && (k) < hi)
#else
#define IN(k) (lo <= (k) && (k) < hi)
#endif
#define SEAM(k) do { if (IN(k) && IN((k) + 1)) xcd_barrier(bar); } while (0)
#define REFRESH() do { int tz_ = threadIdx.x; asm volatile("" : "+v"(tz_)); F.tid = tz_; F.lane = tz_ & 63; F.wave = __builtin_amdgcn_readfirstlane(tz_ >> 6); } while (0)

    if (IN(PH_PRO)) { REFRESH(); p0_prologue(F, tails); } SEAM(PH_PRO);

    if (IN(PH_L0_N1)) { REFRESH(); norm1_phase<false>(F, 0, true, false); } SEAM(PH_L0_N1);
    if (IN(PH_L0_QKV)) { REFRESH();
        gm::P_QKV0 p; p.A = (const char*)(F.ws + WS_HX); p.B = (const char*)(F.ws + WS_WQKV0); p.q = F.W<bf16_t>(RB_Q); p.k = F.W<bf16_t>(RB_K); p.v = F.W<bf16_t>(RB_V);
        p.ropeC = F.W<float>(WS_ROPE); p.ropeS = F.W<float>(WS_ROPE + 4096);
        gm::gemm_phase(F.lds, p);
        if (tails) moe_weights_tail(F, 1, 0, 48, F.bid - 192);
    } SEAM(PH_L0_QKV);
    if (IN(PH_L0_ATT)) { REFRESH();
        float lam;
        { const float a = F.in[I_LQ1][F.lane] * F.in[I_LK1][F.lane], b = F.in[I_LQ2][F.lane] * F.in[I_LK2][F.lane]; lam = expf(wave_sum(a)) - expf(wave_sum(b)) + 0.2f; }
        const bf16_t* q = F.W<bf16_t>(RB_Q); const bf16_t* k = F.W<bf16_t>(RB_K); const bf16_t* v = F.W<bf16_t>(RB_V); bf16_t* o = F.W<bf16_t>(RB_O);
        if (tails && ((F.bid >> 3) & 3) == 0) { const int rank = (F.bid >> 5) * 8 + (F.bid & 7);
            weights_range(F, 0, 0, rank * 384, rank * 384 + 384, F.wave, NWAVES);
            weights_range(F, 1, 0, 18432 + rank * 96, 18432 + rank * 96 + 96, F.wave, NWAVES);
            weights_range(F, 3, 0, 3072 + rank * 336, 3072 + rank * 336 + 336, F.wave, NWAVES);
            __syncthreads(); }
        { unsigned* qcnt = (unsigned*)(F.ws + WS_CTL) + 160000; volatile LAS unsigned* qslot = (volatile LAS unsigned*)(F.lds + LDS_MISC) + 8;
          const int myx = (int)(xb_xcc_id() & 7u);
          for (int s8 = 0; s8 < 8; ++s8) { const int x = (myx + s8) & 7;
            for (;;) {
                if (F.tid == 0) *qslot = __hip_atomic_fetch_add(qcnt + x * 64, 1u, __ATOMIC_RELAXED, __HIP_MEMORY_SCOPE_AGENT);
                __syncthreads();
                const int kq = (int)*qslot;
                if (kq >= 288) { __syncthreads(); break; }
                if (kq < 256) { const int bh = x + 8 * (kq >> 4), qb = kq & 15, b = bh >> 3, h = bh & 7; const size_t row0 = (size_t)b * SEQ + qb * 128;
                    at::diff_attn_unit_dma(q + (((size_t)b * 8 + h) * KVL + CTXL + qb * 128) * 128, k + ((size_t)b * 8 + h) * KVL * 128, v + ((size_t)b * 8 + h) * KVL * 128, o + row0 * D + h * 128, KVL, lam, 0.8f, F.in[I_SUBLN], (LAS char*)F.lds); }
                else { const int kk = kq - 256, bh = x + 8 * (kk >> 1), qb = kk & 1, b = bh >> 3, h = bh & 7; const size_t row0 = (size_t)NLAT + (size_t)b * CTXL + qb * 128;
                    at::diff_attn_unit_dma(q + (((size_t)b * 8 + h) * KVL + qb * 128) * 128, k + ((size_t)b * 8 + h) * KVL * 128, v + ((size_t)b * 8 + h) * KVL * 128, o + row0 * D + h * 128, CTXL, lam, 0.8f, F.in[I_SUBLN], (LAS char*)F.lds); }
            } } }
#ifdef MK_PROBE_ATT
        { bf16_t* od = F.W<bf16_t>(RA_HID);
          for (int u = F.bid; u < 2048 + 256; u += F.G) {
            if (u < 2048) { const int b = u >> 7, h = (u >> 4) & 7, qb = u & 15; const size_t row0 = (size_t)b * SEQ + qb * 128;
                at::diff_attn_unit<MK_PROBE_ATT>(q + (((size_t)b * 8 + h) * KVL + CTXL + qb * 128) * 128, k + ((size_t)b * 8 + h) * KVL * 128, v + ((size_t)b * 8 + h) * KVL * 128, od + row0 * D + h * 128, KVL, lam, 0.8f, F.in[I_SUBLN], (LAS char*)F.lds); }
            else { const int uu = u - 2048, b = uu >> 4, h = (uu >> 1) & 7, qb = uu & 1; const size_t row0 = (size_t)NLAT + (size_t)b * CTXL + qb * 128;
                at::diff_attn_unit<MK_PROBE_ATT>(q + (((size_t)b * 8 + h) * KVL + qb * 128) * 128, k + ((size_t)b * 8 + h) * KVL * 128, v + ((size_t)b * 8 + h) * KVL * 128, od + row0 * D + h * 128, CTXL, lam, 0.8f, F.in[I_SUBLN], (LAS char*)F.lds); }
          } }
#endif
    } SEAM(PH_L0_ATT);
    if (IN(PH_L0_OUT)) { REFRESH(); out_phase(F, 0, (const char*)(F.ws + RB_O), 2048, 1024, WS_WO0, 144); if (tails) moe_weights_tail(F, 1, 3072, 48, F.bid - 64); } SEAM(PH_L0_OUT);
    if (IN(PH_L0_N2)) { REFRESH(); norm2_phase(F, 0, true); } SEAM(PH_L0_N2);
    if (IN(PH_L0_TOPK)) { REFRESH(); topk_phase(F, true); } SEAM(PH_L0_TOPK);
    if (IN(PH_L0_GU)) { REFRESH(); gu_phase(F, 0, true); } SEAM(PH_L0_GU);
    if (IN(PH_L0_DOWN)) { REFRESH(); down_phase(F, 0, true); if (tails) moe_weights_tail(F, 1, 12288, 48, F.bid - 128); } SEAM(PH_L0_DOWN);

    if (IN(PH_L1_N1)) { REFRESH();
        norm1_phase<true>(F, 1, true, true);
        if (!tails) moe_weights_phase(F, 1, 0);
    } SEAM(PH_L1_N1);
    if (IN(PH_L1_GMIN)) { REFRESH();
        { gm::P_GMU p; p.hx = (const char*)(F.ws + WS_HX); p.W = (const char*)(F.ws + WS_WGIN); p.u_out = F.W<bf16_t>(RB_U); gm::gemm_phase(F.lds, p); }
        { gm::P_GMV p; p.hx = (const char*)(F.ws + WS_HX); p.W = (const char*)(F.ws + WS_WGIN); p.vT = F.W<bf16_t>(RB_VT); p.sumsq = F.W<float>(WS_SUMSQ); gm::gemm_phase(F.lds, p, F.G - 1 - F.bid); }
    } SEAM(PH_L1_GMIN);
    if (IN(PH_L1_PREP)) { REFRESH(); gm_prep_phase(F); } SEAM(PH_L1_PREP);
    if (IN(PH_L1_SPAT)) { REFRESH();
        gm::P_SPAT p; p.App = (const char*)(F.ws + RA_APP); p.vT = (const char*)(F.ws + RB_VT); p.u_io = F.W<bf16_t>(RB_U); p.v_g = F.in[I_GMVG]; p.b_s = F.in[I_GMBS]; p.zeros = (const char*)(F.ws + WS_CTL + 800 * 1024);
        gm::gemm_phase(F.lds, p);
    } SEAM(PH_L1_SPAT);
    if (IN(PH_L1_OUT)) { REFRESH(); out_phase(F, 1, (const char*)(F.ws + RB_U), 4096, 2048, WS_WGOUT, 144); if (tails) moe_weights_tail(F, 2, 0, 96, F.bid - 64); } SEAM(PH_L1_OUT);
    if (IN(PH_L1_N2)) { REFRESH(); norm2_phase(F, 1, true); } SEAM(PH_L1_N2);
    if (IN(PH_L1_TOPK)) { REFRESH(); topk_phase(F, true); } SEAM(PH_L1_TOPK);
    if (IN(PH_L1_GU)) { REFRESH(); gu_phase(F, 1, true); } SEAM(PH_L1_GU);
    if (IN(PH_L1_DOWN)) { REFRESH(); down_phase(F, 1, true); if (tails) moe_weights_tail(F, 2, 18432, 48, F.bid - 128); } SEAM(PH_L1_DOWN);

    if (IN(PH_L2_N1)) { REFRESH(); norm1_phase<true>(F, 2, true, true); if (!tails) moe_weights_phase(F, 2); } SEAM(PH_L2_N1);
    if (IN(PH_L2_QKV)) { REFRESH();
        gm::P_QKV2 p; p.A = (const char*)(F.ws + WS_HX); p.B = (const char*)(F.ws + WS_WQKV2); p.q = F.W<bf16_t>(RB_Q); p.k = F.W<bf16_t>(RB_K); p.v = F.W<bf16_t>(RB_V);
        gm::gemm_phase(F.lds, p);
        if (tails) moe_weights_tail(F, 3, 0, 48, F.bid - 192);
    } SEAM(PH_L2_QKV);
    if (IN(PH_L2_ATT)) { REFRESH();
        for (int u = F.bid; u < 2048; u += F.G) { const int b = u >> 7, h = (u >> 3) & 15, R4 = u & 7;
            at::natten_unit(F.W<bf16_t>(RB_Q), F.W<bf16_t>(RB_K), F.W<bf16_t>(RB_V), F.W<bf16_t>(RB_O), F.in[I_NARPB], b, h, R4, (LAS char*)F.lds); }
    } SEAM(PH_L2_ATT);
    if (IN(PH_L2_OUT)) { REFRESH(); out_phase(F, 2, (const char*)(F.ws + RB_O), 2048, 1024, WS_WO2, 128); } SEAM(PH_L2_OUT);
    if (IN(PH_L2_N2)) { REFRESH(); norm2_phase(F, 2, false); } SEAM(PH_L2_N2);
    if (IN(PH_L2_TOPK)) { REFRESH(); topk_phase(F, false); } SEAM(PH_L2_TOPK);
    if (IN(PH_L2_GU)) { REFRESH(); gu_phase(F, 2, false); } SEAM(PH_L2_GU);
    if (IN(PH_L2_DOWN)) { REFRESH(); down_phase(F, 2, false); } SEAM(PH_L2_DOWN);

    if (IN(PH_L3_N1)) { REFRESH();
        NormArgs A{};
        A.xsrc = F.W<float>(WS_X); A.xdst = F.W<float>(WS_X); A.csrc = F.W<float>(WS_CTX); A.cdst = F.W<float>(WS_CTX); A.do_lat = 1; A.do_ctx = 0; A.xbf = 1;
        A.gain = F.in[I_MNG] + 3 * D; A.shift = modp(F, 3, 0); A.scale = modp(F, 3, 1); A.hx = F.W<bf16_t>(WS_HX);
        A.ys = F.W<bf16_t>(RA_YS); A.tokslot = F.W<int>(WS_TOKSLOT); A.tokslotc = F.W<int>(WS_TOKSLOTC); A.g2 = modp(F, 2, 5); A.ctx_comb = 0;
        norm_fold_phase<true>(F, A);
        if (!tails) moe_weights_phase(F, 3, 0); } SEAM(PH_L3_N1);
    if (IN(PH_L3_CDFT)) { REFRESH();
        gm::P_CDFT p; p.CS = (const char*)(F.ws + WS_CS); p.hx = (const char*)(F.ws + WS_HX); p.PQt = F.W<bf16_t>(RB_PQ);
        gm::gemm_phase(F.lds, p);
    } SEAM(PH_L3_CDFT);
    if (IN(PH_L3_PDFT)) { REFRESH();
        gm::P_PDFT p; p.DP = (const char*)(F.ws + WS_DP); p.PQt = (const char*)(F.ws + RB_PQ); p.f = F.W<bf16_t>(RB_F);
        gm::gemm_phase(F.lds, p);
    } SEAM(PH_L3_PDFT);
    if (IN(PH_L3_OUT)) { REFRESH(); out_phase(F, 3, (const char*)(F.ws + RB_F), 2048, 1024, WS_WFO, 128); } SEAM(PH_L3_OUT);
    if (IN(PH_L3_N2)) { REFRESH(); norm2_phase(F, 3, false); } SEAM(PH_L3_N2);
    if (IN(PH_L3_TOPK)) { REFRESH(); topk_phase(F, false); } SEAM(PH_L3_TOPK);
    if (IN(PH_L3_GU)) { REFRESH(); gu_phase(F, 3, false); } SEAM(PH_L3_GU);
    if (IN(PH_L3_DOWN)) { REFRESH(); down_phase(F, 3, false); } SEAM(PH_L3_DOWN);

    if (IN(PH_FINAL)) { REFRESH();
        NormArgs A{};
        A.xsrc = F.W<float>(WS_X); A.do_lat = 1; A.do_ctx = 0; A.xbf = 1; A.gain = F.in[I_FINALG];
        A.ys = F.W<bf16_t>(RA_YS); A.tokslot = F.W<int>(WS_TOKSLOT); A.tokslotc = F.W<int>(WS_TOKSLOTC); A.g2 = modp(F, 3, 5); A.out = F.out;
        norm_phase<true, false, true>(F, A);
    }
#undef IN
#undef SEAM
}

extern "C" void kernel_launch(void* const* d_in, const int* in_sizes, int n_in, void* d_out, int out_size, void* d_ws, size_t ws_size, hipStream_t stream) {
    static int grid = 0;
    if (grid == 0) {
        if (n_in != 29 || in_sizes[0] != NLAT * D || out_size != NLAT * D || ws_size < WS_END) {
            fprintf(stderr, "kernel_launch: shape mismatch: n_in %d in0 %d out %d ws %zu (need >= %zu)\n", n_in, n_in > 0 ? in_sizes[0] : -1, out_size, ws_size, (size_t)WS_END); grid = -1; return; }
        int dev = 0, cus = 0, per_cu = 0;
        if (hipGetDevice(&dev) != hipSuccess || hipDeviceGetAttribute(&cus, hipDeviceAttributeMultiprocessorCount, dev) != hipSuccess) { grid = -1; return; }
        if (hipFuncSetAttribute((const void*)fwd, hipFuncAttributeMaxDynamicSharedMemorySize, LDS_BYTES) != hipSuccess) { fprintf(stderr, "kernel_launch: hipFuncSetAttribute failed\n"); grid = -1; return; }
        if (hipOccupancyMaxActiveBlocksPerMultiprocessor(&per_cu, (const void*)fwd, NTHREADS, LDS_BYTES) != hipSuccess || per_cu < 1) { fprintf(stderr, "kernel_launch: occupancy query says %d\n", per_cu); (void)hipGetLastError(); per_cu = 1; }
        grid = cus;
    }
    if (grid < 0) return;
    (void)hipMemsetAsync((char*)d_ws + WS_CTL, 0, CTL_BYTES, stream);
    Params p{};
    for (int i = 0; i < 29; ++i) p.in[i] = (const float*)d_in[i];
    p.out = (float*)d_out; p.ws = (unsigned char*)d_ws;
#ifndef MK_RANGES
#define MK_RANGES 0, NPHASES
#endif
    static const int ranges[] = { MK_RANGES };
    for (unsigned r = 0; r + 1 < sizeof(ranges) / sizeof(ranges[0]); r += 2) { p.ph_lo = ranges[r]; p.ph_hi = ranges[r + 1]; p.li = (int)(r / 2); hipLaunchKernelGGL(fwd, dim3(grid), dim3(NTHREADS), LDS_BYTES, stream, p); }
    const hipError_t le = hipPeekAtLastError();
    if (le != hipSuccess) fprintf(stderr, "kernel_launch: launch failed: %s\n", hipGetErrorName(le));
}
```

```cpp
#include <hip/hip_runtime.h>
#include <cstdio>
#include <cstdint>

#define LAS __attribute__((address_space(3)))
#define GAS __attribute__((address_space(1)))
typedef unsigned short bf16_t;
typedef short bf16x8 __attribute__((ext_vector_type(8)));
typedef short s16x4 __attribute__((ext_vector_type(4)));
typedef float f32x4 __attribute__((ext_vector_type(4)));
typedef float f32x2 __attribute__((ext_vector_type(2)));
typedef float f32x16 __attribute__((ext_vector_type(16)));
typedef unsigned u32x4 __attribute__((ext_vector_type(4)));
typedef unsigned u32x2 __attribute__((ext_vector_type(2)));

constexpr int D = 1024, NB = 16, SEQ = 2048, NLAT = NB * SEQ, CTXL = 256, NCTX = NB * CTXL, MALL = NLAT + NCTX;
constexpr int NE = 16, CAP = 256, CAPC = 32, KVL = CTXL + SEQ;
constexpr int MODW = 6 * D, MODR = 17;
constexpr float EPS = 1e-6f;
constexpr int NWAVES = 8, NTHREADS = 512;

constexpr size_t MiB = (size_t)1 << 20;
constexpr size_t WS_CTL = 0, CTL_BYTES = 1 * MiB;
constexpr size_t WS_MOD = 1 * MiB;
constexpr size_t WS_ROPE = 3 * MiB;
constexpr size_t WS_CS = 3 * MiB + 65536;
constexpr size_t WS_AFF = 4 * MiB;
constexpr size_t WS_SLOTROW = 7 * MiB;
constexpr size_t WS_SLOTAFF = 7 * MiB + 524288;
constexpr size_t WS_TOKSLOT = 8 * MiB;
constexpr size_t WS_TOKSLOTC = 10 * MiB;
constexpr size_t WS_SUMSQ = 21 * MiB;
constexpr size_t WS_DP = 12 * MiB;
constexpr size_t WS_WQKV0 = 28 * MiB, WS_WO0 = 34 * MiB, WS_WGIN = 36 * MiB, WS_WGOUT = 44 * MiB, WS_WQKV2 = 48 * MiB, WS_WO2 = 54 * MiB, WS_WFO = 56 * MiB;
constexpr size_t WS_WGU = 58 * MiB;
constexpr size_t WS_WD = 122 * MiB;
constexpr size_t WS_X = 154 * MiB;
constexpr size_t WS_CTX = 282 * MiB;
constexpr size_t WS_HX = 298 * MiB;
constexpr size_t WS_RA = 370 * MiB;
constexpr size_t WS_RB = 658 * MiB;
constexpr size_t WS_W2 = 946 * MiB;
constexpr size_t WS_END = 1042 * MiB;
constexpr size_t WGU_OF(int layer) { return layer == 3 ? WS_WGU + 32 * MiB : ((layer & 1) ? WS_W2 : WS_WGU); }
constexpr size_t WD_OF(int layer) { return layer == 3 ? WS_WD + 16 * MiB : ((layer & 1) ? WS_W2 + 64 * MiB : WS_WD); }
constexpr size_t RA_HID = WS_RA, RA_YS = WS_RA + 144 * MiB, RA_APP = WS_RA;
constexpr size_t RB_Q = WS_RB, RB_K = WS_RB + 72 * MiB, RB_V = WS_RB + 144 * MiB, RB_O = WS_RB + 216 * MiB;
constexpr size_t RB_U = WS_RB, RB_VT = WS_RB + 144 * MiB;
constexpr size_t RB_PQ = WS_RB, RB_F = WS_RB + 128 * MiB;

constexpr int LDS_RING = 131072;
constexpr int LDS_MISC = LDS_RING;
constexpr int LDS_BYTES = 147456;

#define LDS_WAIT() asm volatile("s_waitcnt lgkmcnt(0)" ::: "memory")
#define VM_WAIT() asm volatile("s_waitcnt vmcnt(0)" ::: "memory")
__device__ __forceinline__ unsigned cvt_pk_bf16(float lo, float hi) { unsigned r; asm volatile("v_cvt_pk_bf16_f32 %0, %1, %2" : "=v"(r) : "v"(lo), "v"(hi)); return r; }
__device__ __forceinline__ float bf_lo(unsigned w) { return __uint_as_float(w << 16); }
__device__ __forceinline__ float bf_hi(unsigned w) { return __uint_as_float(w & 0xffff0000u); }
__device__ __forceinline__ float wave_sum(float v) {
#pragma unroll
    for (int o = 1; o < 64; o <<= 1) v += __shfl_xor(v, o);
    return v;
}
__device__ __forceinline__ float fast_rcp(float x) { return __builtin_amdgcn_rcpf(x); }
__device__ __forceinline__ float silu_f(float x) { return x * fast_rcp(1.0f + __builtin_amdgcn_exp2f(-1.4426950408889634f * x)); }
__device__ __forceinline__ float gelu_tanh_f(float x) {
    const float y2 = 1.5957691216057308f * (x + 0.044715f * x * x * x);
    return x - x * fast_rcp(1.0f + __builtin_amdgcn_exp2f(1.4426950408889634f * y2));
}

__device__ __forceinline__ f32x4 gelu_tanh4(const f32x4 x) {
    constexpr float cp = -1.5957691216057308f * 1.4426950408889634f, ca = 0.044715f * cp;
    const f32x4 t = __builtin_elementwise_fma(x * x, (f32x4){ca, ca, ca, ca}, (f32x4){cp, cp, cp, cp}) * x; f32x4 e, r;
#pragma unroll
    for (int j = 0; j < 4; ++j) e[j] = __builtin_amdgcn_exp2f(t[j]);
    f32x2 dl = (f32x2){e[0], e[1]}, dh = (f32x2){e[2], e[3]};
#if defined(__HIP_DEVICE_COMPILE__)
    asm("v_pk_add_f32 %0, %1, 1.0 op_sel_hi:[1,0]" : "=v"(dl) : "v"(dl));
    asm("v_pk_add_f32 %0, %1, 1.0 op_sel_hi:[1,0]" : "=v"(dh) : "v"(dh));
#endif
    r[0] = __builtin_amdgcn_rcpf(dl[0]); r[1] = __builtin_amdgcn_rcpf(dl[1]); r[2] = __builtin_amdgcn_rcpf(dh[0]); r[3] = __builtin_amdgcn_rcpf(dh[1]);
    return x * r;
}

#define XB_TMO      128
#define XB_XCNT(j)  (256  + 64 * (j))
#define XB_XSUB(j)  (1280 + 64 * (j))
#define XB_XGEN(j)  (2304 + 64 * (j))
#define XB_TOP      3328
#define XB_TOPGEN   3392
#define XCD_BAR_WORDS 3456
#define XB_SPIN_CAP (1u << 18)
__device__ __forceinline__ unsigned xb_ld(unsigned* p)              { return __hip_atomic_load(p, __ATOMIC_RELAXED, __HIP_MEMORY_SCOPE_AGENT); }
__device__ __forceinline__ unsigned xb_add(unsigned* p, unsigned v) { return __hip_atomic_fetch_add(p, v, __ATOMIC_RELAXED, __HIP_MEMORY_SCOPE_AGENT); }
__device__ __forceinline__ unsigned xb_xcc_id() { return (unsigned)__builtin_amdgcn_s_getreg((3 << 11) | 20) & 0xFu; }
#define XB_SPIN(cond, bar) do { unsigned _sp = 0; while (cond) { __builtin_amdgcn_s_sleep(1); \
    if ((++_sp & 255u) == 0u) { if (xb_ld(&(bar)[XB_TMO])) break; if (_sp > XB_SPIN_CAP) { atomicAdd(&(bar)[XB_TMO], 1u); break; } } } } while (0)
struct XcdBarrier { unsigned* bar; unsigned x; volatile LAS unsigned* st; };
__device__ __forceinline__ XcdBarrier xcd_barrier_post(unsigned* bar, volatile LAS unsigned* st) {
    XcdBarrier b; b.bar = bar; b.x = xb_xcc_id(); b.st = st;
    if (threadIdx.x == 0) (void)xb_add(&bar[XB_XCNT(b.x)], 1u);
    return b;
}
__device__ __forceinline__ void xcd_barrier_complete(unsigned* bar, unsigned x, unsigned& nloc, unsigned& nx) {
    const unsigned G = gridDim.x * gridDim.y * gridDim.z;
    unsigned sum, cnt, mine, sp = 0u;
    for (;;) {
        sum = 0u; cnt = 0u; mine = 0u;
#pragma unroll
        for (unsigned j = 0; j < 16; ++j) { const unsigned c = xb_ld(&bar[XB_XCNT(j)]); sum += c; cnt += (c > 0u) ? 1u : 0u; mine = (j == x) ? c : mine; }
        if (sum == G) break;
        __builtin_amdgcn_s_sleep(1);
        if ((++sp & 255u) == 0u) { if (xb_ld(&bar[XB_TMO])) break; if (sp > XB_SPIN_CAP) { atomicAdd(&bar[XB_TMO], 1u); break; } }
    }
    nloc = mine > 0u ? mine : 1u; nx = cnt > 0u ? cnt : 1u;
}
__device__ __forceinline__ void xcd_barrier(const XcdBarrier& b) {
    asm volatile("s_waitcnt vmcnt(0)" ::: "memory");
    __syncthreads();
    if (threadIdx.x == 0) {
        unsigned* bar = b.bar;
        __builtin_amdgcn_s_waitcnt(0);
        unsigned nloc = b.st[0], nx = b.st[1];
        if (nloc == 0u) { xcd_barrier_complete(bar, b.x, nloc, nx); b.st[0] = nloc; b.st[1] = nx; }
        const unsigned old = xb_add(&bar[XB_XSUB(b.x)], 1u);
        const unsigned gen = old / nloc;
        if (old + 1u == (gen + 1u) * nloc) {
            __builtin_amdgcn_fence(__ATOMIC_RELEASE, "agent");
            asm volatile("s_waitcnt vmcnt(0)" ::: "memory");
            const unsigned og = xb_add(&bar[XB_TOP], 1u);
            const unsigned tg = og / nx;
            if (og + 1u == (tg + 1u) * nx) xb_add(&bar[XB_TOPGEN], 1u);
            else XB_SPIN(xb_ld(&bar[XB_TOPGEN]) == tg, bar);
            __builtin_amdgcn_fence(__ATOMIC_ACQUIRE, "agent");
            xb_add(&bar[XB_XGEN(b.x)], 1u);
            asm volatile("s_waitcnt vmcnt(0)" ::: "memory");
        } else {
            XB_SPIN(xb_ld(&bar[XB_XGEN(b.x)]) == gen, bar);
            __builtin_amdgcn_fence(__ATOMIC_ACQUIRE, "agent");
            asm volatile("s_waitcnt vmcnt(0)" ::: "memory");
        }
    }
    __syncthreads();
}

namespace gm {
constexpr int BM = 256, BK = 64, HALF = 128, HTB = HALF * BK * 2, STAGE_BYTES = 8 * HTB;
__device__ __forceinline__ int lds_byte(int r, int c) { const int st = (r >> 4) * 2 + (c >> 5), rr = r & 15, cc = c & 31, ob = rr * 64 + cc * 2; return st * 1024 + (ob ^ (((ob >> 9) & 1) << 5)); }
__device__ __forceinline__ void stage_rc(int b, int& R, int& C) { const int st = b / 1024, sb = b % 1024, swz = sb ^ (((sb >> 9) & 1) << 5); R = (st >> 1) * 16 + swz / 64; C = (st & 1) * 32 + (swz % 64) / 2; }
__device__ __forceinline__ int perm32(int rho) { const int n = rho >> 4, i = rho & 15; return 8 * (i >> 2) + 4 * n + (i & 3); }
struct Unit { int pm, pn, z; };
__device__ __forceinline__ int xcd_remap(int L, int nwg) { const int q = nwg / 8, r = nwg % 8, xcd = L % 8, off = L / 8; return (xcd < r ? xcd * (q + 1) : r * (q + 1) + (xcd - r) * q) + off; }
__device__ __forceinline__ void tile_of(int w, int nM, int nN, int& pm, int& pn) { const int nig = 8 * nN, gid = w / nig, fm = gid * 8, gsz = (nM - fm) < 8 ? (nM - fm) : 8; pm = fm + ((w % nig) % gsz); pn = (w % nig) / gsz; }

typedef f32x4 Acc[2][2][4][2];
#ifdef MK_F8_UNSCALED
constexpr int F8_ONE = 0;
#else
constexpr int F8_ONE = 0x7f7f7f7f;
#endif
constexpr float F8_SX = 8.0f, F8_SW = 64.0f, F8_SH = 4.0f;
__device__ __forceinline__ unsigned pk4_fp8(float a, float b, float c, float d) {
    int w = 0;
    w = __builtin_amdgcn_cvt_pk_fp8_f32(__builtin_amdgcn_fmed3f(a, -440.f, 440.f), __builtin_amdgcn_fmed3f(b, -440.f, 440.f), w, false);
    w = __builtin_amdgcn_cvt_pk_fp8_f32(__builtin_amdgcn_fmed3f(c, -440.f, 440.f), __builtin_amdgcn_fmed3f(d, -440.f, 440.f), w, true);
    return (unsigned)w;
}
typedef int i32x4_t __attribute__((ext_vector_type(4)));
typedef int i32x8_t __attribute__((ext_vector_type(8)));
__device__ __forceinline__ void mfma_f8(f32x4& c, const i32x8_t a, const i32x8_t b) {
#if !defined(__HIP_DEVICE_COMPILE__)
    (void)c; (void)a; (void)b;
#elif defined(MK_F8_UNSCALED)
    asm volatile("v_mfma_f32_16x16x128_f8f6f4 %0, %1, %2, %0" : "+v"(c) : "v"(a), "v"(b));
#else
    const int one = F8_ONE; asm volatile("v_mfma_scale_f32_16x16x128_f8f6f4 %0, %1, %2, %0, %3, %3 op_sel_hi:[0,0,0]" : "+v"(c) : "v"(a), "v"(b), "v"(one));
#endif
}
template <class P, class = void> struct is_f8 { static constexpr bool value = false; };
template <class P> struct is_f8<P, decltype((void)P::F8)> { static constexpr bool value = P::F8; };

template <class P>
__device__ __forceinline__ void gemm_phase(LAS unsigned char* lds, const P& p, int cu = -1) {
    int tid = threadIdx.x; asm volatile("" : "+v"(tid));
    const int wid = __builtin_amdgcn_readfirstlane(tid >> 6), lane = tid & 63, wr = wid >> 2, wc = wid & 3, fr = lane & 15, fq = lane >> 4;
    int K = p.K(); asm volatile("" : "+s"(K));
    const int nt = K / BK;
    const unsigned lda = p.lda(), ldb = p.ldb();
    const int G = gridDim.x, c = cu < 0 ? (int)blockIdx.x : cu, nwg = p.nunits();
    if (c >= nwg) return;
    unsigned voffA[2], voffB[2], cA2[2]; int RA[2];
#pragma unroll
    for (int i = 0; i < 2; ++i) { int R, C; stage_rc(tid * 16 + i * 8192, R, C); const int Rb = P::PERM ? ((R & ~31) + perm32(R & 31)) : R;
        RA[i] = R; cA2[i] = (unsigned)C * 2u; voffA[i] = (unsigned)R * lda + (unsigned)C * 2u; voffB[i] = (unsigned)Rb * ldb + (unsigned)C * 2u; }
    const size_t hstepA = (size_t)HALF * lda, hstepB = (size_t)HALF * ldb;
    const unsigned ldsw = (unsigned)wid * 1024u;
    const int aoff = lds_byte(wr * 64 + fr, fq * 8), boff = lds_byte(wc * 32 + fr, fq * 8);
    struct Src { const char* a; const char* b; unsigned ga[2][2]; };
    const char* araw = P::GATHER ? p.araw() : nullptr;
#define GM_GLDS(gp, lp) __builtin_amdgcn_global_load_lds((const unsigned*)(gp), (LAS unsigned*)(lp), 16, 0, 0)
#define GM_SA(b, h) (((b) * 2 + (h)) * HTB)
#define GM_SB(b, h) ((4 + (b) * 2 + (h)) * HTB)
#define GM_STAGE_B(bufoff, ptr) do { GM_GLDS((ptr) + voffB[0], lds + (bufoff) + ldsw); GM_GLDS((ptr) + voffB[1], lds + (bufoff) + ldsw + 8192); } while (0)
#define GM_STAGE_A(bufoff, S, h, koff) do { if constexpr (P::GATHER) { GM_GLDS(araw + (S).ga[h][0] + (koff), lds + (bufoff) + ldsw); GM_GLDS(araw + (S).ga[h][1] + (koff), lds + (bufoff) + ldsw + 8192); } \
        else if constexpr (P::AZERO) { const size_t ko_ = (size_t)(koff); const char* ab_ = ((ko_ >= 256) == ((h) == 1)) ? (S).a + (size_t)(h) * hstepA + (ko_ & 255) : p.zero_base(); \
            GM_GLDS(ab_ + voffA[0], lds + (bufoff) + ldsw); GM_GLDS(ab_ + voffA[1], lds + (bufoff) + ldsw + 8192); } \
        else { GM_GLDS((S).a + (size_t)(h) * hstepA + (koff) + voffA[0], lds + (bufoff) + ldsw); GM_GLDS((S).a + (size_t)(h) * hstepA + (koff) + voffA[1], lds + (bufoff) + ldsw + 8192); } } while (0)
#define GM_LDA(dst, b, h) do { _Pragma("unroll") for (int m = 0; m < 4; ++m) _Pragma("unroll") for (int k = 0; k < 2; ++k) dst[m][k] = *(const LAS bf16x8*)(lds + GM_SA(b, h) + aoff + m * 2048 + k * 1024); } while (0)
#define GM_LDB(dst, b, h) do { _Pragma("unroll") for (int n = 0; n < 2; ++n) _Pragma("unroll") for (int k = 0; k < 2; ++k) dst[n][k] = *(const LAS bf16x8*)(lds + GM_SB(b, h) + boff + n * 2048 + k * 1024); } while (0)
#define GM_CAT8(X) __builtin_shufflevector(__builtin_bit_cast(i32x4_t, X[0]), __builtin_bit_cast(i32x4_t, X[1]), 0, 1, 2, 3, 4, 5, 6, 7)
#define GM_MMA(ai, bj, At, Bt) do { __builtin_amdgcn_s_setprio(1); _Pragma("unroll") for (int m = 0; m < 4; ++m) _Pragma("unroll") for (int n = 0; n < 2; ++n) { \
        if constexpr (is_f8<P>::value) mfma_f8(acc[ai][bj][m][n], GM_CAT8(Bt[n]), GM_CAT8(At[m])); \
        else { _Pragma("unroll") for (int k = 0; k < 2; ++k) acc[ai][bj][m][n] = __builtin_amdgcn_mfma_f32_16x16x32_bf16(Bt[n][k], At[m][k], acc[ai][bj][m][n], 0, 0, 0); } } __builtin_amdgcn_s_setprio(0); } while (0)
#define GM_WAIT_V(n) asm volatile("s_waitcnt vmcnt(" #n ")" ::: "memory")
#define GM_WAIT_L(n) asm volatile("s_waitcnt lgkmcnt(" #n ")" ::: "memory")
#define GM_BAR __builtin_amdgcn_s_barrier()
#define GM_SCHED __builtin_amdgcn_sched_barrier(0)
#define GM_LOAD_SRC(S, u) do { (S).a = p.abase(u); (S).b = p.bbase(u); if constexpr (P::GATHER) { const int* _ix = p.gidx(u); _Pragma("unroll") for (int _h = 0; _h < 2; ++_h) _Pragma("unroll") for (int _i = 0; _i < 2; ++_i) \
        (S).ga[_h][_i] = (unsigned)_ix[_h * HALF + RA[_i]]; } } while (0)
#define GM_ADOPT(D, S) do { (D).a = (S).a; (D).b = (S).b; if constexpr (P::GATHER) { _Pragma("unroll") for (int _h = 0; _h < 2; ++_h) _Pragma("unroll") for (int _i = 0; _i < 2; ++_i) (D).ga[_h][_i] = (S).ga[_h][_i] * lda + cA2[_i]; } } while (0)
    Unit cur, nxt, nx2; int ui = 0;
    p.unit(xcd_remap(c, nwg), cur);
    Src cs, ns, fs;
    GM_LOAD_SRC(fs, cur); GM_ADOPT(cs, fs);
    bool has_next = ((long)G + c) < (long)nwg;
    if (has_next) { p.unit(xcd_remap(G + c, nwg), nxt); GM_LOAD_SRC(ns, nxt); } else { nxt = cur; ns = fs; }
    Acc acc;
#pragma unroll
    for (int a = 0; a < 2; ++a)
#pragma unroll
        for (int b = 0; b < 2; ++b)
#pragma unroll
            for (int m = 0; m < 4; ++m)
#pragma unroll
                for (int n = 0; n < 2; ++n) acc[a][b][m][n] = (f32x4){0.f, 0.f, 0.f, 0.f};
    bf16x8 At[4][2], B0[2][2], B1[2][2];
    GM_STAGE_B(GM_SB(0, 0), cs.b); GM_STAGE_B(GM_SB(0, 1), cs.b + hstepB); GM_STAGE_A(GM_SA(0, 0), cs, 0, 0); GM_STAGE_A(GM_SA(0, 1), cs, 1, 0);
    if (wr == 1) GM_BAR;
    GM_WAIT_V(2); GM_BAR;
    GM_STAGE_B(GM_SB(1, 0), cs.b + 128); GM_STAGE_A(GM_SA(1, 0), cs, 0, 128); GM_STAGE_B(GM_SB(1, 1), cs.b + hstepB + 128);
    GM_WAIT_V(6); GM_BAR;
    for (;;) {
#pragma clang loop unroll(disable)
        for (int t = 0; t < nt; t += 2) {
            const bool last = (t == nt - 2);
            GM_LDB(B0, 0, 0); GM_LDB(B1, 0, 1); GM_SCHED; GM_LDA(At, 0, 0); GM_STAGE_A(GM_SA(1, 1), cs, 1, (size_t)(t + 1) * 128);
            GM_WAIT_V(8); GM_WAIT_L(0); GM_BAR; GM_MMA(0, 0, At, B0); GM_MMA(0, 1, At, B1); GM_BAR; GM_SCHED;
            size_t kb;
            if (last) {
                if constexpr (P::GATHER) { asm volatile("" : "+v"(ns.ga[0][0]), "+v"(ns.ga[0][1]), "+v"(ns.ga[1][0]), "+v"(ns.ga[1][1])); }
                GM_ADOPT(cs, ns); kb = 0; } else kb = (size_t)(t + 2) * 128;
            GM_LDA(At, 0, 1); GM_STAGE_B(GM_SB(0, 0), cs.b + kb); GM_STAGE_B(GM_SB(0, 1), cs.b + hstepB + kb); GM_STAGE_A(GM_SA(0, 0), cs, 0, kb);
            GM_WAIT_V(8); GM_WAIT_L(0); GM_BAR; GM_MMA(1, 0, At, B0); GM_MMA(1, 1, At, B1); GM_BAR; GM_SCHED;
            GM_LDB(B0, 1, 0); GM_LDB(B1, 1, 1); GM_SCHED; GM_LDA(At, 1, 0); GM_STAGE_A(GM_SA(0, 1), cs, 1, kb);
            GM_WAIT_V(8); GM_WAIT_L(0); GM_BAR; GM_MMA(0, 0, At, B0); GM_MMA(0, 1, At, B1); GM_BAR; GM_SCHED;
            GM_LDA(At, 1, 1); GM_STAGE_B(GM_SB(1, 0), cs.b + kb + 128); GM_STAGE_B(GM_SB(1, 1), cs.b + hstepB + kb + 128); GM_STAGE_A(GM_SA(1, 0), cs, 0, kb + 128);
            GM_WAIT_V(8); GM_WAIT_L(0); GM_BAR; GM_MMA(1, 0, At, B0); GM_MMA(1, 1, At, B1); GM_BAR; GM_SCHED;
        }
        bool has_nx2 = false;
        if (has_next) { const long L2 = (long)(ui + 2) * G + c; has_nx2 = L2 < (long)nwg; if (has_nx2) { p.unit(xcd_remap((int)L2, nwg), nx2); GM_LOAD_SRC(ns, nx2); } }
        if constexpr (is_f8<P>::value) asm volatile("s_nop 7\n\ts_nop 7\n\ts_nop 7" ::: "memory");
        if (wr == 0) GM_BAR;
        { int t2 = threadIdx.x; asm volatile("" : "+v"(t2));
          const int w2 = __builtin_amdgcn_readfirstlane(t2 >> 6), l2 = t2 & 63; p.epi(acc, cur, w2 >> 2, w2 & 3, l2 & 15, l2 >> 4); }
        if (!has_next) break;
#pragma unroll
        for (int a = 0; a < 2; ++a)
#pragma unroll
            for (int b = 0; b < 2; ++b)
#pragma unroll
                for (int m = 0; m < 4; ++m)
#pragma unroll
                    for (int n = 0; n < 2; ++n) acc[a][b][m][n] = (f32x4){0.f, 0.f, 0.f, 0.f};
        cur = nxt; nxt = nx2; has_next = has_nx2; ++ui;
        if (wr == 1) GM_BAR;
    }
    GM_WAIT_V(0);
    GM_BAR;
#undef GM_GLDS
#undef GM_SA
#undef GM_SB
#undef GM_STAGE_A
#undef GM_STAGE_B
#undef GM_LDA
#undef GM_LDB
#undef GM_MMA
#undef GM_CAT8
#undef GM_WAIT_V
#undef GM_WAIT_L
#undef GM_BAR
#undef GM_SCHED
#undef GM_LOAD_SRC
}
}

namespace gm {
constexpr int ES = 4608;
__device__ __forceinline__ size_t kv_row0(int pm) { return pm < 128 ? (size_t)(pm >> 3) * KVL + CTXL + (size_t)(pm & 7) * 256 : (size_t)(pm - 128) * KVL; }
__device__ __forceinline__ u32x4 pack8(const f32x4 a, const f32x4 b) { u32x4 w; w.x = cvt_pk_bf16(a[0], a[1]); w.y = cvt_pk_bf16(a[2], a[3]); w.z = cvt_pk_bf16(b[0], b[1]); w.w = cvt_pk_bf16(b[2], b[3]); return w; }
#define GM_NOGATHER static constexpr bool AZERO = false; __device__ __forceinline__ const char* zero_base() const { return nullptr; } __device__ __forceinline__ const char* araw() const { return nullptr; } __device__ __forceinline__ const int* gidx(const Unit&) const { return nullptr; }
#define GM_DEV __device__ __forceinline__

struct P_QKV0 {
    static constexpr bool PERM = false, GATHER = false;
    const char* A; const char* B; bf16_t* q; bf16_t* k; bf16_t* v; const float* ropeC; const float* ropeS;
    GM_DEV int K() const { return 1024; } GM_DEV unsigned lda() const { return 2048; } GM_DEV unsigned ldb() const { return 2048; }
    GM_DEV int nunits() const { return 144 * 12; }
    GM_DEV void unit(int w, Unit& u) const { u.z = 0; tile_of(w, 144, 12, u.pm, u.pn); }
    GM_DEV const char* abase(const Unit& u) const { return A + (size_t)u.pm * 256 * 2048; }
    GM_DEV const char* bbase(const Unit& u) const { return B + (size_t)u.pn * 256 * 2048; }
    GM_NOGATHER
    GM_DEV void rope_store(Acc& acc, bf16_t* dst, const Unit& u, bool is_ctx, int wr, int wc, int fr, int fq) const {
        constexpr size_t rstride = 128, cstride = (size_t)KVL * 128;
        const int par = wc & 1;
#pragma unroll
        for (int ai = 0; ai < 2; ++ai)
#pragma unroll
            for (int m = 0; m < 4; ++m) { const int rl = ai * 128 + wr * 64 + m * 16 + fr;
                f32x4 c4 = (f32x4){1.f, 1.f, 1.f, 1.f}, s4 = (f32x4){0.f, 0.f, 0.f, 0.f};
                if (!is_ctx) { const int t = (u.pm & 7) * 256 + rl, pos = par ? (t & 63) : (t >> 6); c4 = *(const f32x4*)(ropeC + pos * 16 + 4 * fq); s4 = *(const f32x4*)(ropeS + pos * 16 + 4 * fq); }
#pragma unroll
                for (int bj = 0; bj < 2; ++bj) { const f32x4 x1 = acc[ai][bj][m][0], x2 = acc[ai][bj][m][1];
                    *(u32x4*)(dst + (size_t)rl * rstride + (size_t)bj * cstride) = pack8(x1 * c4 - x2 * s4, x1 * s4 + x2 * c4); }
                __builtin_amdgcn_sched_barrier(0); }
    }
    GM_DEV void epi(Acc& acc, const Unit& u, int wr, int wc, int fr, int fq) const {
        const int sect = u.pn >> 2, colt = (u.pn & 3) * 256; const bool is_ctx = u.pm >= 128;
        const int b = u.pm < 128 ? (u.pm >> 3) : (u.pm - 128); const size_t key0 = u.pm < 128 ? (size_t)CTXL + (size_t)(u.pm & 7) * 256 : 0;
        if (sect < 2) {
            bf16_t* d0 = q + (size_t)sect * (size_t)(k - q) + (((size_t)b * 8 + (colt >> 7)) * KVL + key0) * 128;
            rope_store(acc, d0 + wc * 32 + 8 * fq, u, is_ctx, wr, wc, fr, fq);
        } else {
            bf16_t* dst = v + (((size_t)b * 8 + (colt >> 7)) * KVL + key0) * 128 + wc * 32 + 4 * fq;
#pragma unroll
            for (int ai = 0; ai < 2; ++ai)
#pragma unroll
                for (int m = 0; m < 4; ++m) { const int rl = ai * 128 + wr * 64 + m * 16 + fr;
#pragma unroll
                    for (int bj = 0; bj < 2; ++bj)
#pragma unroll
                        for (int n = 0; n < 2; ++n) { const f32x4 x = acc[ai][bj][m][n]; u32x2 w; w.x = cvt_pk_bf16(x[0], x[1]); w.y = cvt_pk_bf16(x[2], x[3]);
                            *(u32x2*)(dst + (size_t)bj * KVL * 128 + (size_t)rl * 128 + 16 * n) = w; } }
        }
    }
};
struct P_QKV2 {
    static constexpr bool PERM = true, GATHER = false;
    const char* A; const char* B; bf16_t* q; bf16_t* k; bf16_t* v;
    GM_DEV int K() const { return 1024; } GM_DEV unsigned lda() const { return 2048; } GM_DEV unsigned ldb() const { return 2048; }
    GM_DEV int nunits() const { return 144 * 12; }
    GM_DEV void unit(int w, Unit& u) const { u.z = 0; tile_of(w, 144, 12, u.pm, u.pn); }
    GM_DEV const char* abase(const Unit& u) const { return A + (size_t)u.pm * 256 * 2048; }
    GM_DEV const char* bbase(const Unit& u) const { return B + (size_t)u.pn * 256 * 2048; }
    GM_NOGATHER
    GM_DEV void epi(Acc& acc, const Unit& u, int wr, int wc, int fr, int fq) const {
        const int sect = u.pn >> 2, colt = (u.pn & 3) * 256; const bool is_ctx = u.pm >= 128;
        if (sect == 0 && is_ctx) return;
        bf16_t* dst = sect == 0 ? q + (size_t)u.pm * 256 * 1024 : (sect == 1 ? k : v) + kv_row0(u.pm) * 1024;
#pragma unroll
        for (int ai = 0; ai < 2; ++ai)
#pragma unroll
            for (int m = 0; m < 4; ++m) { const int rl = ai * 128 + wr * 64 + m * 16 + fr;
#pragma unroll
                for (int bj = 0; bj < 2; ++bj) *(u32x4*)(dst + (size_t)rl * 1024 + colt + bj * 128 + wc * 32 + 8 * fq) = pack8(acc[ai][bj][m][0], acc[ai][bj][m][1]); }
    }
};
struct P_OUT {
    static constexpr bool PERM = true, GATHER = false;
    const char* A; const char* B; unsigned lda_; int K_, nM;
    bf16_t* xb_; bf16_t* cb_; const float* gate;
    GM_DEV int K() const { return K_; } GM_DEV unsigned lda() const { return lda_; } GM_DEV unsigned ldb() const { return (unsigned)K_ * 2u; }
    GM_DEV int nunits() const { return nM * 4; }
    GM_DEV void unit(int w, Unit& u) const { u.z = 0; tile_of(w, nM, 4, u.pm, u.pn); }
    GM_DEV const char* abase(const Unit& u) const { return A + (size_t)u.pm * 256 * lda_; }
    GM_DEV const char* bbase(const Unit& u) const { return B + (size_t)u.pn * 256 * (size_t)K_ * 2; }
    GM_NOGATHER
    GM_DEV void epi(Acc& acc, const Unit& u, int wr, int wc, int fr, int fq) const {
        const bool is_ctx = u.pm >= 128;
        const size_t t0 = is_ctx ? (size_t)(u.pm - 128) * 256 * 1024 : (size_t)u.pm * 256 * 1024;
        bf16_t* xs = (is_ctx ? cb_ : xb_) + t0;
        const int col0 = u.pn * 256 + wc * 32 + 8 * fq;
        const float* g = gate + (size_t)(is_ctx ? 16 : (u.pm >> 3)) * MODW + col0;
        f32x4 gv[2][2];
#pragma unroll
        for (int bj = 0; bj < 2; ++bj)
#pragma unroll
            for (int n = 0; n < 2; ++n) gv[bj][n] = *(const f32x4*)(g + bj * 128 + 4 * n);
        u32x4 xh[2][2];
#define PO_LOAD(slot, off_) do { _Pragma("unroll") for (int bj = 0; bj < 2; ++bj) xh[slot][bj] = *(const u32x4*)(xs + (off_) + bj * 128); } while (0)
        PO_LOAD(0, (size_t)(wr * 64 + fr) * 1024 + col0);
#pragma unroll
        for (int q = 0; q < 8; ++q) { const int ai = q >> 2, m = q & 3; const size_t off = (size_t)(ai * 128 + wr * 64 + m * 16 + fr) * 1024 + col0;
            if (q + 1 < 8) { const size_t off2 = (size_t)(((q + 1) >> 2) * 128 + wr * 64 + ((q + 1) & 3) * 16 + fr) * 1024 + col0; PO_LOAD((q + 1) & 1, off2); }
#pragma unroll
            for (int bj = 0; bj < 2; ++bj) { const u32x4 w = xh[q & 1][bj];
                const f32x4 x0 = (f32x4){bf_lo(w.x), bf_hi(w.x), bf_lo(w.y), bf_hi(w.y)}, x1 = (f32x4){bf_lo(w.z), bf_hi(w.z), bf_lo(w.w), bf_hi(w.w)};
                *(u32x4*)(xs + off + bj * 128) = pack8(x0 + gv[bj][0] * acc[ai][bj][m][0], x1 + gv[bj][1] * acc[ai][bj][m][1]); } }
#undef PO_LOAD
    }
};
struct P_GU {
    static constexpr bool PERM = true, GATHER = true, AZERO = false, F8 = true;
    GM_DEV const char* zero_base() const { return nullptr; }
    const char* hx; const char* W; unsigned char* hid; const int* slot_row; int nM;
    GM_DEV int K() const { return 512; } GM_DEV unsigned lda() const { return 1024; } GM_DEV unsigned ldb() const { return 1024; }
    GM_DEV int nunits() const { return NE * nM * 8; }
    GM_DEV void unit(int w, Unit& u) const { const int per = nM * 8; u.z = w / per; tile_of(w - u.z * per, nM, 8, u.pm, u.pn); }
    GM_DEV const char* abase(const Unit&) const { return hx; }
    GM_DEV const char* bbase(const Unit& u) const { return W + ((size_t)u.z * 2048 + (size_t)u.pn * 256) * 1024; }
    GM_DEV const char* araw() const { return hx; }
    GM_DEV const int* gidx(const Unit& u) const { return slot_row + u.z * ES + u.pm * 256; }
    GM_DEV void epi(Acc& acc, const Unit& u, int wr, int wc, int fr, int fq) const {
        unsigned char* dst = hid + ((size_t)u.z * ES + (size_t)u.pm * 256) * 1024 + u.pn * 128 + wc * 32 + 8 * fq;
        constexpr float ds = 1.0f / (F8_SX * F8_SW), c1 = -1.4426950408889634f * ds, kk = 1.0f / (F8_SH * ds * ds);
#pragma unroll
        for (int ai = 0; ai < 2; ++ai)
#pragma unroll
            for (int m = 0; m < 4; ++m) { const int rl = ai * 128 + wr * 64 + m * 16 + fr; f32x4 h[2];
#pragma unroll
                for (int n = 0; n < 2; ++n) { const f32x4 ag = acc[ai][0][m][n], au = acc[ai][1][m][n]; const f32x4 t = ag * c1; f32x4 e;
#pragma unroll
                    for (int j = 0; j < 4; ++j) e[j] = __builtin_amdgcn_exp2f(t[j]);
                    const f32x4 d = __builtin_elementwise_fma(e, (f32x4){kk, kk, kk, kk}, (f32x4){kk, kk, kk, kk}); f32x4 r;
#pragma unroll
                    for (int j = 0; j < 4; ++j) r[j] = __builtin_amdgcn_rcpf(d[j]);
                    h[n] = (ag * au) * r; }
                u32x2 w; w.x = pk4_fp8(h[0][0], h[0][1], h[0][2], h[0][3]); w.y = pk4_fp8(h[1][0], h[1][1], h[1][2], h[1][3]);
                *(u32x2*)(dst + (size_t)rl * 1024) = w; }
    }
};
struct P_DOWN {
    static constexpr bool PERM = true, GATHER = false, F8 = true;
    const char* hid; const char* W; bf16_t* ys; const float* slot_aff; int nM;
    GM_DEV int K() const { return 512; } GM_DEV unsigned lda() const { return 1024; } GM_DEV unsigned ldb() const { return 1024; }
    GM_DEV int nunits() const { return NE * nM * 4; }
    GM_DEV void unit(int w, Unit& u) const { const int per = nM * 4; u.z = w / per; tile_of(w - u.z * per, nM, 4, u.pm, u.pn); }
    GM_DEV const char* abase(const Unit& u) const { return hid + ((size_t)u.z * ES + (size_t)u.pm * 256) * 1024; }
    GM_DEV const char* bbase(const Unit& u) const { return W + ((size_t)u.z * 1024 + (size_t)u.pn * 256) * 1024; }
    GM_NOGATHER
    GM_DEV void epi(Acc& acc, const Unit& u, int wr, int wc, int fr, int fq) const {
        const size_t r0 = (size_t)u.z * ES + (size_t)u.pm * 256;
        unsigned char* dst8 = (unsigned char*)ys + r0 * 1024 + u.pn * 256 + wc * 32 + 8 * fq;
        float af[2][4];
#pragma unroll
        for (int ai = 0; ai < 2; ++ai)
#pragma unroll
            for (int m = 0; m < 4; ++m) af[ai][m] = slot_aff[r0 + ai * 128 + wr * 64 + m * 16 + fr];
#pragma unroll
        for (int ai = 0; ai < 2; ++ai)
#pragma unroll
            for (int m = 0; m < 4; ++m) { const int rl = ai * 128 + wr * 64 + m * 16 + fr; const float a = af[ai][m];
#pragma unroll
                for (int bj = 0; bj < 2; ++bj) { const f32x4 y0 = acc[ai][bj][m][0] * (a * (32.0f / (F8_SH * F8_SW))), y1 = acc[ai][bj][m][1] * (a * (32.0f / (F8_SH * F8_SW)));
                    int w0 = 0, w1 = 0;
                    w0 = __builtin_amdgcn_cvt_pk_fp8_f32(__builtin_amdgcn_fmed3f(y0[0], -440.f, 440.f), __builtin_amdgcn_fmed3f(y0[1], -440.f, 440.f), w0, false);
                    w0 = __builtin_amdgcn_cvt_pk_fp8_f32(__builtin_amdgcn_fmed3f(y0[2], -440.f, 440.f), __builtin_amdgcn_fmed3f(y0[3], -440.f, 440.f), w0, true);
                    w1 = __builtin_amdgcn_cvt_pk_fp8_f32(__builtin_amdgcn_fmed3f(y1[0], -440.f, 440.f), __builtin_amdgcn_fmed3f(y1[1], -440.f, 440.f), w1, false);
                    w1 = __builtin_amdgcn_cvt_pk_fp8_f32(__builtin_amdgcn_fmed3f(y1[2], -440.f, 440.f), __builtin_amdgcn_fmed3f(y1[3], -440.f, 440.f), w1, true);
                    u32x2 w; w.x = (unsigned)w0; w.y = (unsigned)w1; *(u32x2*)(dst8 + (size_t)rl * 1024 + bj * 128) = w; } }
    }
};
struct P_GMU {
    static constexpr bool PERM = true, GATHER = false;
    const char* hx; const char* W; bf16_t* u_out;
    GM_DEV int K() const { return 1024; } GM_DEV unsigned lda() const { return 2048; } GM_DEV unsigned ldb() const { return 2048; }
    GM_DEV int nunits() const { return 1152; }
    GM_DEV void unit(int w, Unit& u) const { u.z = 0; tile_of(w, 144, 8, u.pm, u.pn); }
    GM_DEV const char* abase(const Unit& u) const { return hx + (size_t)u.pm * 256 * 2048; }
    GM_DEV const char* bbase(const Unit& u) const { return W + (size_t)u.pn * 256 * 2048; }
    GM_NOGATHER
    GM_DEV void epi(Acc& acc, const Unit& u, int wr, int wc, int fr, int fq) const {
        bf16_t* dst = u_out + (size_t)u.pm * 256 * 2048 + u.pn * 256 + wc * 32 + 8 * fq;
#pragma unroll
        for (int ai = 0; ai < 2; ++ai)
#pragma unroll
            for (int m = 0; m < 4; ++m) { const int rl = ai * 128 + wr * 64 + m * 16 + fr;
#pragma unroll
                for (int bj = 0; bj < 2; ++bj) { const f32x4 g0 = gelu_tanh4(acc[ai][bj][m][0]), g1 = gelu_tanh4(acc[ai][bj][m][1]);
                    *(u32x4*)(dst + (size_t)rl * 2048 + bj * 128) = pack8(g0, g1); }
                __builtin_amdgcn_sched_barrier(0); }
    }
};
struct P_GMV {
    static constexpr bool PERM = true, GATHER = false;
    const char* hx; const char* W; bf16_t* vT; float* sumsq;
    GM_DEV int K() const { return 1024; } GM_DEV unsigned lda() const { return 2048; } GM_DEV unsigned ldb() const { return 2048; }
    GM_DEV int nunits() const { return 1152; }
    GM_DEV void unit(int w, Unit& u) const { u.z = 0; tile_of(w, 8, 144, u.pm, u.pn); }
    GM_DEV const char* abase(const Unit& u) const { return W + (size_t)(2048 + u.pm * 256) * 2048; }
    GM_DEV const char* bbase(const Unit& u) const { return hx + (size_t)u.pn * 256 * 2048; }
    GM_NOGATHER
    GM_DEV void epi(Acc& acc, const Unit& u, int wr, int wc, int fr, int fq) const {
        const bool is_ctx = u.pn >= 128; const int b = is_ctx ? u.pn - 128 : (u.pn >> 3);
        const int tok0 = is_ctx ? 0 : CTXL + (u.pn & 7) * 256, grow0 = is_ctx ? NLAT + b * CTXL : b * SEQ + (u.pn & 7) * 256;
        bf16_t* dst = vT + ((size_t)b * 2048 + (size_t)u.pm * 256) * KVL + tok0 + wc * 32 + 8 * fq;
#pragma unroll
        for (int bj = 0; bj < 2; ++bj) {
            f32x4 s0 = (f32x4){0.f, 0.f, 0.f, 0.f}, s1 = (f32x4){0.f, 0.f, 0.f, 0.f};
#pragma unroll
            for (int ai = 0; ai < 2; ++ai)
#pragma unroll
                for (int m = 0; m < 4; ++m) { const int rl = ai * 128 + wr * 64 + m * 16 + fr; const f32x4 g0 = gelu_tanh4(acc[ai][bj][m][0]), g1 = gelu_tanh4(acc[ai][bj][m][1]);
                    *(u32x4*)(dst + (size_t)rl * KVL + bj * 128) = pack8(g0, g1); s0 += g0 * g0; s1 += g1 * g1;
                    __builtin_amdgcn_sched_barrier(0); }
#pragma unroll
            for (int j = 0; j < 4; ++j) { float a = s0[j], c = s1[j];
                a += __shfl_xor(a, 1); a += __shfl_xor(a, 2); a += __shfl_xor(a, 4); a += __shfl_xor(a, 8);
                c += __shfl_xor(c, 1); c += __shfl_xor(c, 2); c += __shfl_xor(c, 4); c += __shfl_xor(c, 8);
                if (fr == 0) { float* pp = sumsq + (size_t)(grow0 + bj * 128 + wc * 32 + 8 * fq + j) * 16 + u.pm * 2 + wr; pp[0] = a; pp[64] = c; } }
        }
    }
};
struct P_SPAT {
    static constexpr bool PERM = true, GATHER = false, AZERO = true;
    const char* App; const char* vT; bf16_t* u_io; const float* v_g; const float* b_s; const char* zeros;
    GM_DEV const char* zero_base() const { return zeros; } GM_DEV const char* araw() const { return nullptr; } GM_DEV const int* gidx(const Unit&) const { return nullptr; }
    GM_DEV int K() const { return 256; } GM_DEV unsigned lda() const { return 256; } GM_DEV unsigned ldb() const { return KVL * 2; }
    GM_DEV int nunits() const { return NB * 9 * 8; }
    GM_DEV void unit(int w, Unit& u) const { u.z = w; u.pm = 0; u.pn = 0; }
    GM_DEV const char* abase(const Unit& u) const { return App + (size_t)u.z * 65536; }
    GM_DEV const char* bbase(const Unit& u) const { const int g = u.z & 7, bc = u.z >> 3, b = bc / 9, cp = bc - b * 9; return vT + (((size_t)b * 2048 + (size_t)g * 256) * KVL + (size_t)cp * 256) * 2; }
    GM_DEV void epi(Acc& acc, const Unit& u, int wr, int wc, int fr, int fq) const {
        const int g = u.z & 7, bc = u.z >> 3, b = bc / 9, cp = bc - b * 9;
        const size_t trow0 = cp == 0 ? (size_t)NLAT + (size_t)b * CTXL : (size_t)b * SEQ + (size_t)(cp - 1) * 256;
        const int ch0 = g * 256 + wc * 32 + 8 * fq;
        f32x4 vg[2][2];
#pragma unroll
        for (int bj = 0; bj < 2; ++bj)
#pragma unroll
            for (int n = 0; n < 2; ++n) vg[bj][n] = *(const f32x4*)(v_g + ch0 + bj * 128 + 4 * n);
        float bsv[8];
#pragma unroll
        for (int q = 0; q < 8; ++q) bsv[q] = b_s[g * 128 + (((q >> 2) * 128 + wr * 64 + (q & 3) * 16 + fr) & 127)];
        u32x4 ub[2][2];
#pragma unroll
        for (int bj = 0; bj < 2; ++bj) ub[0][bj] = *(const u32x4*)(u_io + (trow0 + wr * 64 + fr) * 2048 + ch0 + bj * 128);
#pragma unroll
        for (int q = 0; q < 8; ++q) { const int ai = q >> 2, m = q & 3, rl = ai * 128 + wr * 64 + m * 16 + fr; const float bs = bsv[q];
            bf16_t* up = u_io + (trow0 + rl) * 2048 + ch0;
            if (q + 1 < 8) { const int rl2 = ((q + 1) >> 2) * 128 + wr * 64 + ((q + 1) & 3) * 16 + fr;
#pragma unroll
                for (int bj = 0; bj < 2; ++bj) ub[(q + 1) & 1][bj] = *(const u32x4*)(u_io + (trow0 + rl2) * 2048 + ch0 + bj * 128); }
#pragma unroll
            for (int bj = 0; bj < 2; ++bj) { const u32x4 uw = ub[q & 1][bj];
                const f32x4 u0 = (f32x4){bf_lo(uw.x), bf_hi(uw.x), bf_lo(uw.y), bf_hi(uw.y)}, u1 = (f32x4){bf_lo(uw.z), bf_hi(uw.z), bf_lo(uw.w), bf_hi(uw.w)};
                *(u32x4*)(up + bj * 128) = pack8(u0 * (acc[ai][bj][m][0] * vg[bj][0] + bs), u1 * (acc[ai][bj][m][1] * vg[bj][1] + bs)); } }
    }
};
constexpr int PQ_LD = 2176;
struct P_CDFT {
    static constexpr bool PERM = true, GATHER = false;
    const char* CS; const char* hx; bf16_t* PQt;
    GM_DEV int K() const { return 256; } GM_DEV unsigned lda() const { return 512; } GM_DEV unsigned ldb() const { return 2048; }
    GM_DEV int nunits() const { return 4 * NB * 9; }
    GM_DEV void unit(int w, Unit& u) const { u.z = w / (NB * 9); const int r = w - u.z * (NB * 9); u.pn = r; const int tt = r % 9; u.pm = (tt >= 4 && tt < 8) ? 1 : 0; }
    GM_DEV const char* abase(const Unit& u) const { return CS + (size_t)u.pm * 256 * 512; }
    GM_DEV const char* bbase(const Unit& u) const { return hx + (size_t)u.pn * 256 * 2048 + (size_t)u.z * 512; }
    GM_NOGATHER
    GM_DEV void epi(Acc& acc, const Unit& u, int wr, int wc, int fr, int fq) const {
        const int b = u.pn / 9, tt = u.pn - b * 9;
        bf16_t* dst = PQt + ((size_t)b * 1024 + (size_t)u.z * 256) * PQ_LD + tt * 256 + wc * 32 + 8 * fq;
#pragma unroll
        for (int ai = 0; ai < 2; ++ai)
#pragma unroll
            for (int m = 0; m < 4; ++m) { const int rl = ai * 128 + wr * 64 + m * 16 + fr;
#pragma unroll
                for (int bj = 0; bj < 2; ++bj) { if (tt == 8 && bj == 1) continue;
                    *(u32x4*)(dst + (size_t)rl * PQ_LD + bj * 128) = pack8(acc[ai][bj][m][0] * 0.0625f, acc[ai][bj][m][1] * 0.0625f); } }
    }
};
struct P_PDFT {
    static constexpr bool PERM = true, GATHER = false;
    const char* DP; const char* PQt; bf16_t* f;
    GM_DEV int K() const { return PQ_LD; } GM_DEV unsigned lda() const { return PQ_LD * 2; } GM_DEV unsigned ldb() const { return PQ_LD * 2; }
    GM_DEV int nunits() const { return 512; }
    GM_DEV void unit(int w, Unit& u) const { u.z = w >> 5; tile_of(w & 31, 8, 4, u.pm, u.pn); }
    GM_DEV const char* abase(const Unit& u) const { return DP + (size_t)u.pm * 256 * (PQ_LD * 2); }
    GM_DEV const char* bbase(const Unit& u) const { return PQt + ((size_t)u.z * 1024 + (size_t)u.pn * 256) * (PQ_LD * 2); }
    GM_NOGATHER
    GM_DEV void epi(Acc& acc, const Unit& u, int wr, int wc, int fr, int fq) const {
        bf16_t* dst = f + ((size_t)u.z * 2048 + (size_t)u.pm * 256) * 1024 + u.pn * 256 + wc * 32 + 8 * fq; const float sc = 0.022097086912079608f;
#pragma unroll
        for (int ai = 0; ai < 2; ++ai)
#pragma unroll
            for (int m = 0; m < 4; ++m) { const int rl = ai * 128 + wr * 64 + m * 16 + fr;
#pragma unroll
                for (int bj = 0; bj < 2; ++bj) *(u32x4*)(dst + (size_t)rl * 1024 + bj * 128) = pack8(acc[ai][bj][m][0] * sc, acc[ai][bj][m][1] * sc); }
    }
};
}

namespace at {
constexpr float SCALE = 0.125f;
constexpr float THR = 8.f;
#define AT_SBAR() __builtin_amdgcn_sched_barrier(0)
#define AT_KSWZ(row, colB) ((row) * 256 + ((colB) ^ (((row) & 7) << 4)))
#define AT_KSWZ64(row, colB) ((row) * 128 + ((colB) ^ ((((row) >> 1) & 7) << 4)))
__device__ __forceinline__ int crow(int r, int hi) { return (r & 3) + 8 * (r >> 2) + 4 * hi; }
__device__ __forceinline__ void partialSM(f32x16& p0, f32x16& p1, float& m_reg, float& mn, float& alpha) {
    constexpr float C = SCALE * 1.4426950408889634f;
    float pmax = p0[0];
#pragma unroll
    for (int r = 1; r < 16; ++r) pmax = fmaxf(pmax, p0[r]);
#pragma unroll
    for (int r = 0; r < 16; ++r) pmax = fmaxf(pmax, p1[r]);
    { auto rr = __builtin_amdgcn_permlane32_swap(__float_as_uint(pmax), __float_as_uint(pmax), false, false);
      pmax = fmaxf(__uint_as_float(rr[0]), __uint_as_float(rr[1])); }
    if (__builtin_expect(__all(pmax - m_reg <= THR / SCALE), 1)) { mn = m_reg; alpha = 1.f; }
    else { mn = fmaxf(m_reg, pmax); alpha = __builtin_amdgcn_exp2f((m_reg - mn) * C); m_reg = mn; }
    const float mnC = -mn * C;
#pragma unroll
    for (int r = 0; r < 16; ++r) p0[r] = fmaf(p0[r], C, mnC);
#pragma unroll
    for (int r = 0; r < 16; ++r) p1[r] = fmaf(p1[r], C, mnC);
#pragma unroll
    for (int r = 0; r < 16; ++r) p0[r] = __builtin_amdgcn_exp2f(p0[r]);
}
#define AT_PK4(P, BASE, OUT) do { unsigned a0 = cvt_pk_bf16(P[BASE + 0], P[BASE + 1]), a1 = cvt_pk_bf16(P[BASE + 2], P[BASE + 3]);   \
    unsigned b0 = cvt_pk_bf16(P[BASE + 4], P[BASE + 5]), b1 = cvt_pk_bf16(P[BASE + 6], P[BASE + 7]);                              \
    auto r0 = __builtin_amdgcn_permlane32_swap(a0, b0, false, false); auto r1 = __builtin_amdgcn_permlane32_swap(a1, b1, false, false); \
    u32x4 w = {r0[0], r1[0], r0[1], r1[1]}; OUT = *reinterpret_cast<bf16x8*>(&w); } while (0)
__device__ __forceinline__ void finishSM(f32x16& p0, f32x16& p1, float alpha, float& l_reg, bf16x8& pa0, bf16x8& pa1, bf16x8& pa2, bf16x8& pa3) {
#pragma unroll
    for (int r = 0; r < 16; ++r) p1[r] = __builtin_amdgcn_exp2f(p1[r]);
    float ps = 0;
#pragma unroll
    for (int r = 0; r < 16; ++r) ps += p0[r];
#pragma unroll
    for (int r = 0; r < 16; ++r) ps += p1[r];
    { auto rr = __builtin_amdgcn_permlane32_swap(__float_as_uint(ps), __float_as_uint(ps), false, false);
      ps = __uint_as_float(rr[0]) + __uint_as_float(rr[1]); }
    l_reg = l_reg * alpha + ps;
    AT_PK4(p0, 0, pa0); AT_PK4(p0, 8, pa1); AT_PK4(p1, 0, pa2); AT_PK4(p1, 8, pa3);
}
__device__ __forceinline__ void qkt64(f32x16& p0, f32x16& p1, const LAS char* Ks, const bf16x8* qr, int r32, int hi, int cb0) {
    p0 = f32x16{}; p1 = f32x16{};
    bf16x8 k0[4], k1[4];
#pragma unroll
    for (int d0 = 0; d0 < 4; ++d0) { const int cb = cb0 + (d0 * 16 + hi * 8) * 2;
        k0[d0] = *reinterpret_cast<const LAS bf16x8*>(Ks + AT_KSWZ(r32, cb)); k1[d0] = *reinterpret_cast<const LAS bf16x8*>(Ks + AT_KSWZ(32 + r32, cb)); }
    __builtin_amdgcn_sched_barrier(0);
#pragma unroll
    for (int d0 = 0; d0 < 4; ++d0) { p0 = __builtin_amdgcn_mfma_f32_32x32x16_bf16(k0[d0], qr[d0], p0, 0, 0, 0); p1 = __builtin_amdgcn_mfma_f32_32x32x16_bf16(k1[d0], qr[d0], p1, 0, 0, 0); }
}
template <int NCB> __device__ __forceinline__ int v_st(int k, int c) { const int kk = (k & ~0xC) | ((k & 4) << 1) | ((k & 8) >> 1); return ((kk >> 3) * NCB + (c >> 5)) * 512 + ((kk & 7) * 32 + (c & 31)) * 2; }
__device__ __forceinline__ int v_rd_base(int lane) { return ((lane & 3) << 3) | (((lane >> 2) & 3) << 6) | (((lane >> 4) & 1) << 5) | (((lane >> 5) & 1) << 8); }
template <int NCB> constexpr int v_rd_off(int d0, int ks, int half) { return d0 * 512 + ks * (NCB * 1024) + half * (NCB * 512); }
template <int OFF> __device__ __forceinline__ s16x4 tr_read(int vb) {
    return __builtin_amdgcn_ds_read_tr16_b64_v4i16((LAS s16x4*)(uintptr_t)(unsigned)(vb + OFF));
}
template <int NCB, int D0> __device__ __forceinline__ void pv_one(f32x16& od, int vb, bf16x8 pa0, bf16x8 pa1, bf16x8 pa2, bf16x8 pa3) {
    const s16x4 l0 = tr_read<v_rd_off<NCB>(D0, 0, 0)>(vb), h0 = tr_read<v_rd_off<NCB>(D0, 0, 1)>(vb), l1 = tr_read<v_rd_off<NCB>(D0, 1, 0)>(vb), h1 = tr_read<v_rd_off<NCB>(D0, 1, 1)>(vb);
    const s16x4 l2 = tr_read<v_rd_off<NCB>(D0, 2, 0)>(vb), h2 = tr_read<v_rd_off<NCB>(D0, 2, 1)>(vb), l3 = tr_read<v_rd_off<NCB>(D0, 3, 0)>(vb), h3 = tr_read<v_rd_off<NCB>(D0, 3, 1)>(vb);
#define AT_PK(L, H) (bf16x8){L[0], L[1], L[2], L[3], H[0], H[1], H[2], H[3]}
    od = __builtin_amdgcn_mfma_f32_32x32x16_bf16(pa0, AT_PK(l0, h0), od, 0, 0, 0);
    od = __builtin_amdgcn_mfma_f32_32x32x16_bf16(pa1, AT_PK(l1, h1), od, 0, 0, 0);
    od = __builtin_amdgcn_mfma_f32_32x32x16_bf16(pa2, AT_PK(l2, h2), od, 0, 0, 0);
    od = __builtin_amdgcn_mfma_f32_32x32x16_bf16(pa3, AT_PK(l3, h3), od, 0, 0, 0);
#undef AT_PK
}

template <int NCB, int D0>
__device__ __forceinline__ void pv_pair(f32x16& o0, f32x16& o1, int vb, bf16x8 pa0, bf16x8 pa1, bf16x8 pa2, bf16x8 pa3) {
    s16x4 l[2][4], h[2][4];
    l[0][0] = tr_read<v_rd_off<NCB>(D0, 0, 0)>(vb); h[0][0] = tr_read<v_rd_off<NCB>(D0, 0, 1)>(vb); l[0][1] = tr_read<v_rd_off<NCB>(D0, 1, 0)>(vb); h[0][1] = tr_read<v_rd_off<NCB>(D0, 1, 1)>(vb);
    l[0][2] = tr_read<v_rd_off<NCB>(D0, 2, 0)>(vb); h[0][2] = tr_read<v_rd_off<NCB>(D0, 2, 1)>(vb); l[0][3] = tr_read<v_rd_off<NCB>(D0, 3, 0)>(vb); h[0][3] = tr_read<v_rd_off<NCB>(D0, 3, 1)>(vb);
    l[1][0] = tr_read<v_rd_off<NCB>(D0 + 1, 0, 0)>(vb); h[1][0] = tr_read<v_rd_off<NCB>(D0 + 1, 0, 1)>(vb); l[1][1] = tr_read<v_rd_off<NCB>(D0 + 1, 1, 0)>(vb); h[1][1] = tr_read<v_rd_off<NCB>(D0 + 1, 1, 1)>(vb);
    l[1][2] = tr_read<v_rd_off<NCB>(D0 + 1, 2, 0)>(vb); h[1][2] = tr_read<v_rd_off<NCB>(D0 + 1, 2, 1)>(vb); l[1][3] = tr_read<v_rd_off<NCB>(D0 + 1, 3, 0)>(vb); h[1][3] = tr_read<v_rd_off<NCB>(D0 + 1, 3, 1)>(vb);
    __builtin_amdgcn_sched_barrier(0);
#define AT_PK(L, H) (bf16x8){L[0], L[1], L[2], L[3], H[0], H[1], H[2], H[3]}
    o0 = __builtin_amdgcn_mfma_f32_32x32x16_bf16(pa0, AT_PK(l[0][0], h[0][0]), o0, 0, 0, 0); o1 = __builtin_amdgcn_mfma_f32_32x32x16_bf16(pa0, AT_PK(l[1][0], h[1][0]), o1, 0, 0, 0);
    o0 = __builtin_amdgcn_mfma_f32_32x32x16_bf16(pa1, AT_PK(l[0][1], h[0][1]), o0, 0, 0, 0); o1 = __builtin_amdgcn_mfma_f32_32x32x16_bf16(pa1, AT_PK(l[1][1], h[1][1]), o1, 0, 0, 0);
    o0 = __builtin_amdgcn_mfma_f32_32x32x16_bf16(pa2, AT_PK(l[0][2], h[0][2]), o0, 0, 0, 0); o1 = __builtin_amdgcn_mfma_f32_32x32x16_bf16(pa2, AT_PK(l[1][2], h[1][2]), o1, 0, 0, 0);
    o0 = __builtin_amdgcn_mfma_f32_32x32x16_bf16(pa3, AT_PK(l[0][3], h[0][3]), o0, 0, 0, 0); o1 = __builtin_amdgcn_mfma_f32_32x32x16_bf16(pa3, AT_PK(l[1][3], h[1][3]), o1, 0, 0, 0);
#undef AT_PK
    __builtin_amdgcn_sched_barrier(0);
}
__device__ __forceinline__ void pv_batch2(f32x16& o0, f32x16& o1, int vb, bf16x8 pa0, bf16x8 pa1, bf16x8 pa2, bf16x8 pa3) { pv_pair<2, 0>(o0, o1, vb, pa0, pa1, pa2, pa3); }

constexpr int DA_LDS_V = 0, DA_LDS_K = 32768, DA_LDS_WS = 69632, DA_XPITCH = 132;
template <int VARIANT = 0>
__device__ __forceinline__ void diff_attn_unit(const bf16_t* __restrict__ Qb, const bf16_t* __restrict__ Kh, const bf16_t* __restrict__ Vh, bf16_t* __restrict__ Ob,
                                               int seq, float lam, float oscale, const float* __restrict__ subg, LAS char* lds) {
    constexpr int LDK = 128, SHM_V = 16384, SHM_K = 16384, KVBLK = 64;
    constexpr float C = SCALE * 1.4426950408889634f;
    int tid = threadIdx.x; asm volatile("" : "+v"(tid));
    const int wid = __builtin_amdgcn_readfirstlane(tid >> 6), lane = tid & 63, r32 = lane & 31, hi = lane >> 5, jh = wid >> 2, wq = wid & 3;
    LAS char* V_lds = lds + DA_LDS_V; LAS char* K_lds = lds + DA_LDS_K;
    LAS float* ws = (LAS float*)(lds + DA_LDS_WS) + wid * 64; LAS float* li_l = ws; LAS float* al_l = ws + 32;
    float m_reg = -1e30f, l_reg = 0.f, alpha = 1.f; f32x16 o[4] = {}; bf16x8 qr[4];
    const bf16_t* Qw = Qb + (size_t)(wq * 32 + r32) * 128 + jh * 64 + hi * 8;
#pragma unroll
    for (int d0 = 0; d0 < 4; ++d0) qr[d0] = *reinterpret_cast<const bf16x8*>(Qw + d0 * 16);
    const int cb0 = jh * 128;
    const int sr = tid >> 4, sc = (tid & 15) * 8, vst0 = v_st<4>(sr, sc), vst1 = v_st<4>(32 + sr, sc), kst0 = AT_KSWZ(sr, sc * 2), kst1 = AT_KSWZ(32 + sr, sc * 2);
    const int vb0 = (int)(uintptr_t)V_lds + v_rd_base(lane);
    const int NT = seq / KVBLK;
    bf16x8 ek0[2], ek1[2], ev0[2], ev1[2];
#define DA_ELOAD(s, ev) do { const int kt_ = (ev) + 1; \
        if (kt_ < NT) { ek0[s] = *reinterpret_cast<const bf16x8*>(&Kh[(size_t)(kt_ * KVBLK + sr) * LDK + sc]); ek1[s] = *reinterpret_cast<const bf16x8*>(&Kh[(size_t)(kt_ * KVBLK + 32 + sr) * LDK + sc]); } \
        ev0[s] = *reinterpret_cast<const bf16x8*>(&Vh[(size_t)((ev) * KVBLK + sr) * LDK + sc]); ev1[s] = *reinterpret_cast<const bf16x8*>(&Vh[(size_t)((ev) * KVBLK + 32 + sr) * LDK + sc]); } while (0)
#define DA_EWRITE(s, ev) do { const int kt_ = (ev) + 1; \
        if (kt_ < NT) { *(LAS bf16x8*)(K_lds + (kt_ & 1) * SHM_K + kst0) = ek0[s]; *(LAS bf16x8*)(K_lds + (kt_ & 1) * SHM_K + kst1) = ek1[s]; } \
        *(LAS bf16x8*)(V_lds + ((ev) & 1) * SHM_V + vst0) = ev0[s]; *(LAS bf16x8*)(V_lds + ((ev) & 1) * SHM_V + vst1) = ev1[s]; } while (0)
#define DA_CONSUME(s) asm volatile("" :: "v"(ek0[s]), "v"(ek1[s]), "v"(ev0[s]), "v"(ev1[s]))
#define DA_STAGE(i) do { if ((i) & 1) { if (VARIANT == 4) DA_CONSUME(1); else DA_EWRITE(1, i); if ((i) + 2 < NT) DA_ELOAD(1, (i) + 2); } else { if (VARIANT == 4) DA_CONSUME(0); else DA_EWRITE(0, i); if ((i) + 2 < NT) DA_ELOAD(0, (i) + 2); } } while (0)
#define DA_RESC(a) do { if (__any((a) < 1.f)) { if (hi == 0) al_l[r32] = (a); asm volatile("s_waitcnt lgkmcnt(0)" ::: "memory"); \
    _Pragma("unroll") for (int d = 0; d < 4; ++d) _Pragma("unroll") for (int r = 0; r < 16; ++r) o[d][r] *= al_l[crow(r, hi)]; } } while (0)
#define DA_PV(vb) do { pv_pair<4, 0>(o[0], o[1], vb, pa0, pa1, pa2, pa3); pv_pair<4, 2>(o[2], o[3], vb, pa0, pa1, pa2, pa3); } while (0)
    f32x16 p0, p1; bf16x8 pa0, pa1, pa2, pa3;
    { const bf16x8 a0 = *reinterpret_cast<const bf16x8*>(&Kh[(size_t)sr * LDK + sc]), a1 = *reinterpret_cast<const bf16x8*>(&Kh[(size_t)(32 + sr) * LDK + sc]);
      *(LAS bf16x8*)(K_lds + kst0) = a0; *(LAS bf16x8*)(K_lds + kst1) = a1; }
    DA_ELOAD(0, 0); if (1 < NT) DA_ELOAD(1, 1);
    __syncthreads();
    if (jh == 1) __syncthreads();
    for (int i = 0; i < NT; ++i) {
        if (VARIANT != 1) { if (jh == 1) DA_STAGE(i); }
        if (i > 0 && VARIANT != 3) { DA_RESC(alpha); const int vb = vb0 + ((i - 1) & 1) * SHM_V; DA_PV(vb); }
        qkt64(p0, p1, K_lds + (i & 1) * SHM_K, qr, r32, hi, cb0);
        __syncthreads();
        if (VARIANT != 1) { if (jh == 0) DA_STAGE(i); }
        { float pmax = p0[0];
#pragma unroll
          for (int r = 1; r < 16; ++r) pmax = fmaxf(pmax, p0[r]);
#pragma unroll
          for (int r = 0; r < 16; ++r) pmax = fmaxf(pmax, p1[r]);
          { auto rr = __builtin_amdgcn_permlane32_swap(__float_as_uint(pmax), __float_as_uint(pmax), false, false); pmax = fmaxf(__uint_as_float(rr[0]), __uint_as_float(rr[1])); }
          float mn;
          if (__builtin_expect(__all(pmax - m_reg <= THR / SCALE), 1)) { mn = m_reg; alpha = 1.f; }
          else { mn = fmaxf(m_reg, pmax); alpha = __builtin_amdgcn_exp2f((m_reg - mn) * C); m_reg = mn; }
          const float mnC = -mn * C; float ps = 0.f;
#pragma unroll
          for (int r = 0; r < 16; ++r) { if (VARIANT == 2) { p0[r] = fmaf(p0[r], C, mnC); p1[r] = fmaf(p1[r], C, mnC); } else { p0[r] = __builtin_amdgcn_exp2f(fmaf(p0[r], C, mnC)); p1[r] = __builtin_amdgcn_exp2f(fmaf(p1[r], C, mnC)); } }
#pragma unroll
          for (int r = 0; r < 16; ++r) ps += p0[r] + p1[r];
          { auto rr = __builtin_amdgcn_permlane32_swap(__float_as_uint(ps), __float_as_uint(ps), false, false); ps = __uint_as_float(rr[0]) + __uint_as_float(rr[1]); }
          l_reg = l_reg * alpha + ps;
          AT_PK4(p0, 0, pa0); AT_PK4(p0, 8, pa1); AT_PK4(p1, 0, pa2); AT_PK4(p1, 8, pa3); }
        __syncthreads();
    }
    { DA_RESC(alpha); const int vb = vb0 + ((NT - 1) & 1) * SHM_V; DA_PV(vb); }
    if (jh == 0) __syncthreads();
    if (hi == 0) li_l[r32] = l_reg; asm volatile("s_waitcnt lgkmcnt(0)" ::: "memory");
    float rli[16];
#pragma unroll
    for (int r = 0; r < 16; ++r) rli[r] = __builtin_amdgcn_rcpf(li_l[crow(r, hi)]);
    __syncthreads();
    LAS float* X = (LAS float*)lds;
    if (jh == 1) {
#pragma unroll
        for (int r = 0; r < 16; ++r)
#pragma unroll
            for (int d0 = 0; d0 < 4; ++d0) X[(wq * 32 + crow(r, hi)) * DA_XPITCH + d0 * 32 + r32] = o[d0][r] * rli[r];
    }
    __syncthreads();
    if (jh == 0) {
#pragma unroll
        for (int r = 0; r < 16; ++r)
#pragma unroll
            for (int d0 = 0; d0 < 4; ++d0) { const int ix = (wq * 32 + crow(r, hi)) * DA_XPITCH + d0 * 32 + r32; X[ix] = o[d0][r] * rli[r] - lam * X[ix]; }
    }
    __syncthreads();
    { const int row = tid >> 2, qd = tid & 3; const LAS f32x4* xr = (const LAS f32x4*)(X + row * DA_XPITCH + qd * 32);
      f32x4 v[8]; float ss = 0.f;
#pragma unroll
      for (int i = 0; i < 8; ++i) { v[i] = xr[i]; ss += (v[i][0] * v[i][0] + v[i][1] * v[i][1]) + (v[i][2] * v[i][2] + v[i][3] * v[i][3]); }
      ss += __shfl_xor(ss, 1); ss += __shfl_xor(ss, 2);
      const float rs = __builtin_amdgcn_rsqf(ss * (1.f / 128.f) + EPS) * oscale;
      const f32x4* gp = (const f32x4*)(subg + qd * 32); f32x4 gq[8];
#pragma unroll
      for (int i = 0; i < 8; ++i) gq[i] = gp[i];
      bf16_t* op = Ob + (size_t)row * 1024 + qd * 32;
#pragma unroll
      for (int i = 0; i < 4; ++i) { const f32x4 a = v[2 * i] * rs * gq[2 * i], b = v[2 * i + 1] * rs * gq[2 * i + 1]; *(u32x4*)(op + 8 * i) = gm::pack8(a, b); } }
    __syncthreads();
#undef DA_ELOAD
#undef DA_EWRITE
#undef DA_STAGE
#undef DA_RESC
#undef DA_PV
}

constexpr int DD_LDS_K = 0, DD_LDS_V = 65536, DD_LDS_WS = 131072 + 256;
__device__ __forceinline__ void diff_attn_unit_dma(const bf16_t* __restrict__ Qb, const bf16_t* __restrict__ Kh, const bf16_t* __restrict__ Vh, bf16_t* __restrict__ Ob,
                                                   int seq, float lam, float oscale, const float* __restrict__ subg, LAS char* lds) {
    constexpr int LDK = 128, SLOT = 16384, KVBLK = 64;
    constexpr float C = SCALE * 1.4426950408889634f;
    int tid = threadIdx.x; asm volatile("" : "+v"(tid));
    const int wid = __builtin_amdgcn_readfirstlane(tid >> 6), lane = tid & 63, r32 = lane & 31, hi = lane >> 5, jh = wid >> 2, wq = wid & 3;
    LAS char* K_lds = lds + DD_LDS_K; LAS char* V_lds = lds + DD_LDS_V;
    LAS float* ws = (LAS float*)(lds + DD_LDS_WS) + wid * 64; LAS float* li_l = ws; LAS float* al_l = ws + 32;
    float m_reg = -1e30f, l_reg = 0.f, alpha = 1.f; f32x16 o[4] = {}; bf16x8 qr[4];
    const bf16_t* Qw = Qb + (size_t)(wq * 32 + r32) * 128 + jh * 64 + hi * 8;
#pragma unroll
    for (int d0 = 0; d0 < 4; ++d0) qr[d0] = *reinterpret_cast<const bf16x8*>(Qw + d0 * 16);
    const int cb0 = jh * 128;
    const int vb0 = (int)(uintptr_t)V_lds + v_rd_base(lane);
    const int NT = seq / KVBLK;
    unsigned koff[2], voff[2]; unsigned pbase[2];
#pragma unroll
    for (int j = 0; j < 2; ++j) { const int piece = j * 8 + wid; pbase[j] = (unsigned)piece * 1024u;
        const int krow = piece * 4 + (lane >> 4), kcolB = ((lane & 15) * 16) ^ ((krow & 7) << 4); koff[j] = (unsigned)(krow * LDK + (kcolB >> 1));
        const int sub = piece * 2 + (lane >> 5), kk = (sub >> 2) * 8 + ((lane & 31) >> 2), vk = (kk & ~0xC) | ((kk & 4) << 1) | ((kk & 8) >> 1), vc = (sub & 3) * 32 + (lane & 3) * 8; voff[j] = (unsigned)(vk * LDK + vc); }
#define DD_DMA(gp, lp) __builtin_amdgcn_global_load_lds((const unsigned*)(gp), (LAS unsigned*)(lp), 16, 0, 0)
#define DD_KTILE(t, slot) do { const bf16_t* g_ = Kh + (size_t)(t) * KVBLK * LDK; DD_DMA(g_ + koff[0], K_lds + (slot) * SLOT + pbase[0]); DD_DMA(g_ + koff[1], K_lds + (slot) * SLOT + pbase[1]); } while (0)
#define DD_VTILE(t, slot) do { const bf16_t* g_ = Vh + (size_t)(t) * KVBLK * LDK; DD_DMA(g_ + voff[0], V_lds + (slot) * SLOT + pbase[0]); DD_DMA(g_ + voff[1], V_lds + (slot) * SLOT + pbase[1]); } while (0)
#define DD_STAGE(e) do { asm volatile("s_waitcnt vmcnt(4)" ::: "memory"); const int kt_ = (e) + 3 < NT ? (e) + 3 : 0, vt_ = (e) + 2 < NT ? (e) + 2 : 0; DD_KTILE(kt_, ((e) + 3) & 3); DD_VTILE(vt_, ((e) + 2) & 3); } while (0)
#define DD_BAR() do { asm volatile("s_waitcnt lgkmcnt(0)" ::: "memory"); __builtin_amdgcn_s_barrier(); asm volatile("" ::: "memory"); } while (0)
#define DD_RESC(a) do { if (__any((a) < 1.f)) { if (hi == 0) al_l[r32] = (a); asm volatile("s_waitcnt lgkmcnt(0)" ::: "memory"); \
    _Pragma("unroll") for (int d = 0; d < 4; ++d) _Pragma("unroll") for (int r = 0; r < 16; ++r) o[d][r] *= al_l[crow(r, hi)]; } } while (0)
#define DD_PV(vb) do { pv_pair<4, 0>(o[0], o[1], vb, pa0, pa1, pa2, pa3); pv_pair<4, 2>(o[2], o[3], vb, pa0, pa1, pa2, pa3); } while (0)
    f32x16 p0, p1; bf16x8 pa0, pa1, pa2, pa3;
    DD_KTILE(0, 0); DD_KTILE(1, 1); DD_KTILE(2, 2); DD_VTILE(0, 0); DD_VTILE(1, 1);
    asm volatile("s_waitcnt vmcnt(0)" ::: "memory");
    asm volatile("" : "+v"(qr[0]), "+v"(qr[1]), "+v"(qr[2]), "+v"(qr[3]));
    DD_BAR();
    if (jh == 1) DD_BAR();
    for (int i = 0; i < NT; ++i) {
        if (jh == 1) DD_STAGE(i);
        if (i > 0) { DD_RESC(alpha); const int vb = vb0 + ((i - 1) & 3) * SLOT; DD_PV(vb); }
        qkt64(p0, p1, K_lds + (i & 3) * SLOT, qr, r32, hi, cb0);
        DD_BAR();
        if (jh == 0) DD_STAGE(i);
        { float pmax = p0[0];
#pragma unroll
          for (int r = 1; r < 16; ++r) pmax = fmaxf(pmax, p0[r]);
#pragma unroll
          for (int r = 0; r < 16; ++r) pmax = fmaxf(pmax, p1[r]);
          { auto rr = __builtin_amdgcn_permlane32_swap(__float_as_uint(pmax), __float_as_uint(pmax), false, false); pmax = fmaxf(__uint_as_float(rr[0]), __uint_as_float(rr[1])); }
          float mn;
          if (__builtin_expect(__all(pmax - m_reg <= THR / SCALE), 1)) { mn = m_reg; alpha = 1.f; }
          else { mn = fmaxf(m_reg, pmax); alpha = __builtin_amdgcn_exp2f((m_reg - mn) * C); m_reg = mn; }
          const float mnC = -mn * C; float ps = 0.f;
#pragma unroll
          for (int r = 0; r < 16; ++r) { p0[r] = __builtin_amdgcn_exp2f(fmaf(p0[r], C, mnC)); p1[r] = __builtin_amdgcn_exp2f(fmaf(p1[r], C, mnC)); }
#pragma unroll
          for (int r = 0; r < 16; ++r) ps += p0[r] + p1[r];
          { auto rr = __builtin_amdgcn_permlane32_swap(__float_as_uint(ps), __float_as_uint(ps), false, false); ps = __uint_as_float(rr[0]) + __uint_as_float(rr[1]); }
          l_reg = l_reg * alpha + ps;
          AT_PK4(p0, 0, pa0); AT_PK4(p0, 8, pa1); AT_PK4(p1, 0, pa2); AT_PK4(p1, 8, pa3); }
        DD_BAR();
    }
    { DD_RESC(alpha); const int vb = vb0 + ((NT - 1) & 3) * SLOT; DD_PV(vb); }
    asm volatile("s_waitcnt vmcnt(0)" ::: "memory");
    if (jh == 0) DD_BAR();
    if (hi == 0) li_l[r32] = l_reg; asm volatile("s_waitcnt lgkmcnt(0)" ::: "memory");
    float rli[16];
#pragma unroll
    for (int r = 0; r < 16; ++r) rli[r] = __builtin_amdgcn_rcpf(li_l[crow(r, hi)]);
    DD_BAR();
    LAS float* X = (LAS float*)lds;
    if (jh == 1) {
#pragma unroll
        for (int r = 0; r < 16; ++r)
#pragma unroll
            for (int d0 = 0; d0 < 4; ++d0) X[(wq * 32 + crow(r, hi)) * DA_XPITCH + d0 * 32 + r32] = o[d0][r] * rli[r];
    }
    DD_BAR();
    if (jh == 0) {
#pragma unroll
        for (int r = 0; r < 16; ++r)
#pragma unroll
            for (int d0 = 0; d0 < 4; ++d0) { const int ix = (wq * 32 + crow(r, hi)) * DA_XPITCH + d0 * 32 + r32; X[ix] = o[d0][r] * rli[r] - lam * X[ix]; }
    }
    DD_BAR();
    { const int row = tid >> 2, qd = tid & 3; const LAS f32x4* xr = (const LAS f32x4*)(X + row * DA_XPITCH + qd * 32);
      f32x4 v[8]; float ss = 0.f;
#pragma unroll
      for (int i = 0; i < 8; ++i) { v[i] = xr[i]; ss += (v[i][0] * v[i][0] + v[i][1] * v[i][1]) + (v[i][2] * v[i][2] + v[i][3] * v[i][3]); }
      ss += __shfl_xor(ss, 1); ss += __shfl_xor(ss, 2);
      const float rs = __builtin_amdgcn_rsqf(ss * (1.f / 128.f) + EPS) * oscale;
      const f32x4* gp = (const f32x4*)(subg + qd * 32); f32x4 gq[8];
#pragma unroll
      for (int i = 0; i < 8; ++i) gq[i] = gp[i];
      bf16_t* op = Ob + (size_t)row * 1024 + qd * 32;
#pragma unroll
      for (int i = 0; i < 4; ++i) { const f32x4 a = v[2 * i] * rs * gq[2 * i], b = v[2 * i + 1] * rs * gq[2 * i + 1]; *(u32x4*)(op + 8 * i) = gm::pack8(a, b); } }
    asm volatile("s_waitcnt vmcnt(0)" ::: "memory");
    DD_BAR();
#undef DD_DMA
#undef DD_KTILE
#undef DD_VTILE
#undef DD_STAGE
#undef DD_BAR
#undef DD_RESC
#undef DD_PV
}

constexpr int NA_LDS_K = 0, NA_LDS_V = 24576, NA_LDS_RPB = 49152, NA_LDS_WS = 53248;
__device__ __forceinline__ void natten_unit(const bf16_t* __restrict__ qbuf, const bf16_t* __restrict__ kbuf, const bf16_t* __restrict__ vbuf, bf16_t* __restrict__ obuf,
                                            const float* __restrict__ rpb, int b, int h, int R4, LAS char* lds) {
    constexpr float L2E = 1.4426950408889634f, SC2 = SCALE * L2E;
    int tid = threadIdx.x; asm volatile("" : "+v"(tid));
    const int wid = __builtin_amdgcn_readfirstlane(tid >> 6), lane = tid & 63, r32 = lane & 31, hi = lane >> 5;
    const int qrow = R4 * 4 + (wid >> 1), qc0 = (wid & 1) * 32, qc = qc0 + r32;
    const int r0q = min(max(qrow - 4, 0), 24), wc0 = min(max(qc - 8, 0), 48);
    const int lo = min(max(R4 * 4 - 4, 0), 24), hir = min(max(R4 * 4 - 1, 0), 24) + 7, nloc = hir - lo + 1, T = nloc + 4;
    LAS char* K_lds = lds + NA_LDS_K; LAS char* V_lds = lds + NA_LDS_V; LAS float* rp = (LAS float*)(lds + NA_LDS_RPB);
    LAS float* ws = (LAS float*)(lds + NA_LDS_WS) + wid * 64; LAS float* li_l = ws; LAS float* al_l = ws + 32;
    for (int i = tid; i < 465; i += NTHREADS) rp[i] = rpb[h * 465 + i] * L2E;
    const size_t qtok = (size_t)b * SEQ + qrow * 64 + qc;
    bf16x8 qr[4];
#pragma unroll
    for (int d0 = 0; d0 < 4; ++d0) qr[d0] = *reinterpret_cast<const bf16x8*>(qbuf + qtok * 1024 + h * 64 + d0 * 16 + hi * 8);
    const bf16_t* Kb = kbuf + (size_t)b * KVL * 1024 + h * 64; const bf16_t* Vb = vbuf + (size_t)b * KVL * 1024 + h * 64;
    const int srow = tid >> 3, sch = tid & 7;
    const int kst = AT_KSWZ64(srow, sch * 16), vst = v_st<2>(srow, sch * 8);
    const int vb0 = (int)(uintptr_t)V_lds + v_rd_base(lane);
    float m_reg = -1e30f, l_reg = 0.f; f32x16 o[2] = {};
    bf16x8 kreg[3], vreg[3];
#define NA_KROW(ti) ((ti) < nloc ? CTXL + (lo + (ti)) * 64 : ((ti) - nloc) * 64)
#define NA_LOAD(s, ti) do { if ((ti) < T) { const int kr0_ = NA_KROW(ti); kreg[s] = *reinterpret_cast<const bf16x8*>(Kb + (size_t)(kr0_ + srow) * 1024 + sch * 8); vreg[s] = *reinterpret_cast<const bf16x8*>(Vb + (size_t)(kr0_ + srow) * 1024 + sch * 8); } } while (0)
#define NA_WRITE(s) do { *(LAS bf16x8*)(K_lds + (s) * 8192 + kst) = kreg[s]; *(LAS bf16x8*)(V_lds + (s) * 8192 + vst) = vreg[s]; } while (0)
    NA_LOAD(0, 0); NA_LOAD(1, 1); NA_LOAD(2, 2);
    NA_WRITE(0); NA_LOAD(0, 3);
    __syncthreads();
#define NA_STEP(ti, S0, S1) do { \
        const bool local = (ti) < nloc; const int kr = lo + (ti); \
        const bool active = !local || (kr >= r0q && kr < r0q + 8); \
        if (active) { \
            f32x16 p0 = {}, p1 = {}; \
            const LAS char* Ks = K_lds + (S0) * 8192; \
              \
            { bf16x8 kf0[4], kf1[4]; \
              _Pragma("unroll") for (int d0 = 0; d0 < 4; ++d0) { const int cb = (d0 * 16 + hi * 8) * 2; \
                kf0[d0] = *reinterpret_cast<const LAS bf16x8*>(Ks + AT_KSWZ64(r32, cb)); kf1[d0] = *reinterpret_cast<const LAS bf16x8*>(Ks + AT_KSWZ64(32 + r32, cb)); } \
              __builtin_amdgcn_sched_barrier(0); \
              _Pragma("unroll") for (int d0 = 0; d0 < 4; ++d0) { \
                p0 = __builtin_amdgcn_mfma_f32_32x32x16_bf16(kf0[d0], qr[d0], p0, 0, 0, 0); \
                p1 = __builtin_amdgcn_mfma_f32_32x32x16_bf16(kf1[d0], qr[d0], p1, 0, 0, 0); } } \
            if (local) { float bb0[16], bb1[16];                                 \
                const LAS float* rb = rp + (kr - qrow + 7) * 31 + 15 - qc; \
                _Pragma("unroll") for (int r = 0; r < 16; ++r) { const int kc = crow(r, hi); bb0[r] = rb[kc]; bb1[r] = rb[kc + 32]; } \
                __builtin_amdgcn_sched_barrier(0); \
                _Pragma("unroll") for (int r = 0; r < 16; ++r) { const int kc = crow(r, hi); \
                    p0[r] = (kc >= wc0 && kc < wc0 + 16) ? fmaf(p0[r], SC2, bb0[r]) : -1e30f; \
                    p1[r] = (kc + 32 >= wc0 && kc + 32 < wc0 + 16) ? fmaf(p1[r], SC2, bb1[r]) : -1e30f; } \
            } \
            float pmax = p0[0]; \
            _Pragma("unroll") for (int r = 1; r < 16; ++r) pmax = fmaxf(pmax, p0[r]); \
            _Pragma("unroll") for (int r = 0; r < 16; ++r) pmax = fmaxf(pmax, p1[r]); \
            { auto rr = __builtin_amdgcn_permlane32_swap(__float_as_uint(pmax), __float_as_uint(pmax), false, false); pmax = fmaxf(__uint_as_float(rr[0]), __uint_as_float(rr[1])); } \
            if (!local) pmax *= SC2;                                             \
            const float mn = fmaxf(m_reg, pmax), alpha = __builtin_amdgcn_exp2f(m_reg - mn); m_reg = mn; \
            float ps = 0.f; \
            if (local) { _Pragma("unroll") for (int r = 0; r < 16; ++r) { p0[r] = __builtin_amdgcn_exp2f(p0[r] - mn); p1[r] = __builtin_amdgcn_exp2f(p1[r] - mn); ps += p0[r] + p1[r]; } } \
            else { _Pragma("unroll") for (int r = 0; r < 16; ++r) { p0[r] = __builtin_amdgcn_exp2f(fmaf(p0[r], SC2, -mn)); p1[r] = __builtin_amdgcn_exp2f(fmaf(p1[r], SC2, -mn)); ps += p0[r] + p1[r]; } } \
            { auto rr = __builtin_amdgcn_permlane32_swap(__float_as_uint(ps), __float_as_uint(ps), false, false); ps = __uint_as_float(rr[0]) + __uint_as_float(rr[1]); } \
            l_reg = l_reg * alpha + ps; \
            if (__any(alpha < 1.f)) { if (hi == 0) al_l[r32] = alpha; asm volatile("s_waitcnt lgkmcnt(0)" ::: "memory"); \
                _Pragma("unroll") for (int d = 0; d < 2; ++d) _Pragma("unroll") for (int r = 0; r < 16; ++r) o[d][r] *= al_l[crow(r, hi)]; } \
            bf16x8 pa0, pa1, pa2, pa3; \
            AT_PK4(p0, 0, pa0); AT_PK4(p0, 8, pa1); AT_PK4(p1, 0, pa2); AT_PK4(p1, 8, pa3); \
            const int vb = vb0 + (S0) * 8192; \
            pv_batch2(o[0], o[1], vb, pa0, pa1, pa2, pa3); \
        } \
        if ((ti) + 1 < T) { NA_WRITE(S1); NA_LOAD(S1, (ti) + 4); } \
        __syncthreads(); } while (0)
    for (int t3 = 0; t3 < T; t3 += 3) { NA_STEP(t3, 0, 1); NA_STEP(t3 + 1, 1, 2); NA_STEP(t3 + 2, 2, 0); }
    if (hi == 0) li_l[r32] = l_reg; asm volatile("s_waitcnt lgkmcnt(0)" ::: "memory");
    LAS bf16_t* ost = (LAS bf16_t*)(lds + NA_LDS_K) + wid * (32 * 72);
#pragma unroll
    for (int r = 0; r < 16; ++r) { const int orow = crow(r, hi); const float rl = __builtin_amdgcn_rcpf(li_l[orow]);
#pragma unroll
        for (int d0 = 0; d0 < 2; ++d0) { const unsigned w = cvt_pk_bf16(o[d0][r] * rl, 0.f); ost[orow * 72 + d0 * 32 + r32] = (bf16_t)(w & 0xffffu); } }
    asm volatile("s_waitcnt lgkmcnt(0)" ::: "memory");
    { bf16_t* op = obuf + ((size_t)b * SEQ + qrow * 64 + qc0) * 1024 + h * 64;
#pragma unroll
      for (int t = 0; t < 4; ++t) { const int ch = lane + 64 * t, orow = ch >> 3, c8 = (ch & 7) * 8;
          *(u32x4*)(op + (size_t)orow * 1024 + c8) = *(const LAS u32x4*)(ost + orow * 72 + c8); } }
    __syncthreads();
#undef NA_KROW
#undef NA_LOAD
#undef NA_WRITE
#undef NA_STEP
}
}

struct Params { const float* in[29]; float* out; unsigned char* ws; int ph_lo, ph_hi, li, pad; };
enum { I_X = 0, I_C, I_CTX, I_CCTX, I_ADAW, I_ADAB, I_MNG, I_MOEG, I_ROUTER, I_WGATE, I_WUP, I_WDOWN, I_DAWIN, I_LQ1, I_LK1, I_LQ2, I_LK2, I_SUBLN, I_DAWOUT,
       I_GMWIN, I_GMVG, I_GMWS, I_GMBS, I_GMWOUT, I_NAWIN, I_NARPB, I_NAWOUT, I_FNWOUT, I_FINALG };
struct Frame {
    LAS unsigned char* lds; const float* in[29]; unsigned char* ws; float* out;
    int tid, lane, wave, G, bid;
    template <class T> __device__ __forceinline__ T* W(size_t off) const { return (T*)(ws + off); }
};

struct TItem { const float* src; bf16_t* dst; int ldw, K, f8; };
__device__ __forceinline__ void titem_load(const TItem& t, int lane, float (&r)[32]) {
#pragma unroll
    for (int i = 0; i < 32; ++i) r[i] = t.src[(size_t)(2 * i + (lane >> 5)) * t.ldw + (lane & 31)];
}
__device__ __forceinline__ void titem_finish(const TItem& t, int lane, const float (&r)[32], LAS float* scr) {
#pragma unroll
    for (int i = 0; i < 32; ++i) scr[(2 * i + (lane >> 5)) * 33 + (lane & 31)] = r[i];
    LDS_WAIT(); asm volatile("" ::: "memory");
    if (t.f8) { const int c4 = lane & 3; unsigned char* d8 = (unsigned char*)t.dst;
#pragma unroll
        for (int j = 0; j < 2; ++j) { const int n = (lane >> 2) + 16 * j; const LAS float* s = scr + (16 * c4) * 33 + n; u32x4 o;
            o.x = gm::pk4_fp8(s[0 * 33] * gm::F8_SW, s[1 * 33] * gm::F8_SW, s[2 * 33] * gm::F8_SW, s[3 * 33] * gm::F8_SW); o.y = gm::pk4_fp8(s[4 * 33] * gm::F8_SW, s[5 * 33] * gm::F8_SW, s[6 * 33] * gm::F8_SW, s[7 * 33] * gm::F8_SW);
            o.z = gm::pk4_fp8(s[8 * 33] * gm::F8_SW, s[9 * 33] * gm::F8_SW, s[10 * 33] * gm::F8_SW, s[11 * 33] * gm::F8_SW); o.w = gm::pk4_fp8(s[12 * 33] * gm::F8_SW, s[13 * 33] * gm::F8_SW, s[14 * 33] * gm::F8_SW, s[15 * 33] * gm::F8_SW);
            *(u32x4*)(d8 + (size_t)n * t.K + 16 * c4) = o; }
        LDS_WAIT(); asm volatile("" ::: "memory"); return; }
    const int c = lane & 7;
#pragma unroll
    for (int j = 0; j < 4; ++j) { const int n = (lane >> 3) + 8 * j; const LAS float* s = scr + (8 * c) * 33 + n;
        u32x4 o; o.x = cvt_pk_bf16(s[0 * 33], s[1 * 33]); o.y = cvt_pk_bf16(s[2 * 33], s[3 * 33]); o.z = cvt_pk_bf16(s[4 * 33], s[5 * 33]); o.w = cvt_pk_bf16(s[6 * 33], s[7 * 33]);
        *(u32x4*)(t.dst + (size_t)n * t.K + 8 * c) = o; }
    LDS_WAIT(); asm volatile("" ::: "memory");
}
__device__ __forceinline__ TItem titem_make(const float* W, int ldw, int K, bf16_t* WT, int k0, int n0, int drow0) { TItem t; t.src = W + (size_t)k0 * ldw + n0; t.dst = WT + (size_t)drow0 * K + k0; t.ldw = ldw; t.K = K; t.f8 = 0; return t; }
__device__ __forceinline__ TItem titem_make8(const float* W, int ldw, int K, unsigned char* WT, int k0, int n0, int drow0) { TItem t; t.src = W + (size_t)k0 * ldw + n0; t.dst = (bf16_t*)(WT + (size_t)drow0 * K + k0); t.ldw = ldw; t.K = K; t.f8 = 1; return t; }
__device__ __forceinline__ TItem titem_plain(const float* W, int K, int N, bf16_t* WT, int item) { const int nblk = N / 32, kb = item / nblk, nb = item - kb * nblk; return titem_make(W, N, K, WT, 64 * kb, 32 * nb, 32 * nb); }
__device__ __forceinline__ TItem titem_moe(const Frame& F, int layer, int item) {
    const int kind = item / 8192, r = item - kind * 8192, e = r >> 9, it = r & 511, kb = it >> 5, nb = it & 31;
    const size_t eoff = ((size_t)layer * NE + e) * (size_t)(D * D);
    if (kind < 2) { const float* W = (kind == 0 ? F.in[I_WGATE] : F.in[I_WUP]) + eoff; unsigned char* WT = F.W<unsigned char>(WGU_OF(layer)) + (size_t)e * 2048 * 1024;
        const int n0 = 32 * nb; return titem_make8(W, D, D, WT, 64 * kb, n0, 256 * (n0 >> 7) + 128 * kind + (n0 & 127)); }
    const float* W = F.in[I_WDOWN] + eoff; unsigned char* WT = F.W<unsigned char>(WD_OF(layer)) + (size_t)e * 1024 * 1024; return titem_make8(W, D, D, WT, 64 * kb, 32 * nb, 32 * nb);
}
constexpr int MIX_J0 = 16 * 96, MIX_J1 = 16 * 32, MIX_J2 = 16 * 128, MIX_J3 = 32 * 32, MIX_J4 = 16 * 96, MIX_J5 = 16 * 32, MIX_J6 = 16 * 32, MIX_NJ = MIX_J0 + MIX_J1 + MIX_J2 + MIX_J3 + MIX_J4 + MIX_J5 + MIX_J6;
__device__ __forceinline__ TItem titem_mixer(const Frame& F, int it) { int r = it;
    if (r < MIX_J0) return titem_plain(F.in[I_DAWIN], 1024, 3072, F.W<bf16_t>(WS_WQKV0), r); r -= MIX_J0;
    if (r < MIX_J1) return titem_plain(F.in[I_DAWOUT], 1024, 1024, F.W<bf16_t>(WS_WO0), r); r -= MIX_J1;
    if (r < MIX_J2) return titem_plain(F.in[I_GMWIN], 1024, 4096, F.W<bf16_t>(WS_WGIN), r); r -= MIX_J2;
    if (r < MIX_J3) return titem_plain(F.in[I_GMWOUT], 2048, 1024, F.W<bf16_t>(WS_WGOUT), r); r -= MIX_J3;
    if (r < MIX_J4) return titem_plain(F.in[I_NAWIN], 1024, 3072, F.W<bf16_t>(WS_WQKV2), r); r -= MIX_J4;
    if (r < MIX_J5) return titem_plain(F.in[I_NAWOUT], 1024, 1024, F.W<bf16_t>(WS_WO2), r); r -= MIX_J5;
    return titem_plain(F.in[I_FNWOUT], 1024, 1024, F.W<bf16_t>(WS_WFO), r);
}
__device__ __forceinline__ void weights_range(const Frame& F, int layer, int n_mix, int i0, int i1, int gw, int nw) {
    LAS float* scr = (LAS float*)F.lds + F.wave * 2112;
    int it = i0 + gw; if (it >= i1) return;
    TItem cur = it < n_mix ? titem_mixer(F, it) : titem_moe(F, layer, it - n_mix); float ra[32], rb[32];
    titem_load(cur, F.lane, ra);
    for (;;) { const int nx = it + nw; const bool more = nx < i1; TItem nxt = cur;
        if (more) { nxt = nx < n_mix ? titem_mixer(F, nx) : titem_moe(F, layer, nx - n_mix); titem_load(nxt, F.lane, rb); }
        titem_finish(cur, F.lane, ra, scr);
        if (!more) break;
#pragma unroll
        for (int i = 0; i < 32; ++i) ra[i] = rb[i];
        cur = nxt; it = nx; }
}
__device__ __forceinline__ void moe_weights_phase(const Frame& F, int layer, int i0 = 0) { weights_range(F, layer, 0, i0, 24576, F.bid * NWAVES + F.wave, F.G * NWAVES); __syncthreads(); }
__device__ __forceinline__ void moe_weights_tail(const Frame& F, int layer, int i0, int per, int rank) {
    if (rank < 0) return;
    const int b0 = i0 + rank * per; weights_range(F, layer, 0, b0, b0 + per < 24576 ? b0 + per : 24576, F.wave, NWAVES); __syncthreads();
}
__device__ __forceinline__ void p0_prologue(const Frame& F, bool tails) {
    weights_range(F, 0, MIX_NJ, 0, tails ? MIX_NJ : MIX_NJ + 24576, F.bid * NWAVES + F.wave, F.G * NWAVES);
    const int gt = F.bid * NTHREADS + F.tid, NGT = F.G * NTHREADS;
    for (int i = gt; i < 1024; i += NGT) { const int pos = i >> 4, f = i & 15; const float inv = powf(10000.f, -(float)f / 16.f), ang = (float)pos * inv;
        F.W<float>(WS_ROPE)[i] = cosf(ang); F.W<float>(WS_ROPE + 4096)[i] = sinf(ang); }
    for (int i = gt; i < 512 * 256 / 8; i += NGT) { const int m = i >> 5, j0 = (i & 31) * 8; const int mm = m & 255; float v[8];
#pragma unroll
        for (int t = 0; t < 8; ++t) { const float x = (float)((mm * (j0 + t)) & 255) * (1.f / 128.f); v[t] = m < 256 ? cospif(x) : sinpif(x); }
        u32x4 w; w.x = cvt_pk_bf16(v[0], v[1]); w.y = cvt_pk_bf16(v[2], v[3]); w.z = cvt_pk_bf16(v[4], v[5]); w.w = cvt_pk_bf16(v[6], v[7]);
        *(u32x4*)(F.W<bf16_t>(WS_CS) + (size_t)i * 8) = w; }
    for (int i = gt; i < 2048 * 272; i += NGT) { const int k = i / 272, n0 = (i - k * 272) * 8; float v[8];
#pragma unroll
        for (int t = 0; t < 8; ++t) { const int np = n0 + t; const float x = (float)((k * (np & 1023)) & 2047) * (1.f / 1024.f);
            v[t] = np < 1024 ? cospif(x) : (np < 2048 ? -sinpif(x) : (np == 2048 ? ((k & 1) ? -1.f : 1.f) : 0.f)); }
        u32x4 w; w.x = cvt_pk_bf16(v[0], v[1]); w.y = cvt_pk_bf16(v[2], v[3]); w.z = cvt_pk_bf16(v[4], v[5]); w.w = cvt_pk_bf16(v[6], v[7]);
        *(u32x4*)(F.W<bf16_t>(WS_DP) + (size_t)i * 8) = w; }
    LAS float* sc = (LAS float*)F.lds;
    LAS float* part = (LAS float*)(F.lds + 73728);
    __syncthreads();
    { float cx[34];
#pragma unroll
      for (int q = 0; q < 34; ++q) { const int i = F.tid + NTHREADS * q, r = i >> 10, k = i & 1023; cx[q] = r < 16 ? F.in[I_C][r * 1024 + k] : F.in[I_CCTX][k]; }
#pragma unroll
      for (int q = 0; q < 34; ++q) sc[F.tid + NTHREADS * q] = cx[q] / (1.f + expf(-cx[q])); }
    __syncthreads();
    for (int item = F.bid; item < 4 * 192; item += F.G) { const int l = item / 192, c0 = (item - l * 192) * 32, cs = F.tid & 31, ks = F.tid >> 5;
        const float* wp = F.in[I_ADAW] + ((size_t)l * 1024 + (size_t)ks * 64) * MODW + c0 + cs;
        float a[17];
#pragma unroll
        for (int r = 0; r < 17; ++r) a[r] = 0.f;
        for (int k0 = 0; k0 < 64; k0 += 32) { float w[32];
#pragma unroll
            for (int kk = 0; kk < 32; ++kk) w[kk] = wp[(size_t)(k0 + kk) * MODW];
#pragma unroll
            for (int kk = 0; kk < 32; ++kk) {
#pragma unroll
                for (int r = 0; r < 17; ++r) a[r] = fmaf(sc[r * 1024 + ks * 64 + k0 + kk], w[kk], a[r]);
                __builtin_amdgcn_sched_barrier(0); } }
#pragma unroll
        for (int r = 0; r < 17; ++r) part[(ks * 17 + r) * 32 + cs] = a[r];
        __syncthreads();
        for (int i = F.tid; i < 17 * 32; i += NTHREADS) { const int r = i >> 5, cc = i & 31; float s = F.in[I_ADAB][l * MODW + c0 + cc];
#pragma unroll
            for (int q = 0; q < 16; ++q) s += part[(q * 17 + r) * 32 + cc];
            F.W<float>(WS_MOD)[((size_t)l * MODR + r) * MODW + c0 + cc] = s; }
        __syncthreads(); }
}

template <int CTRL> __device__ __forceinline__ float dpp_f(float x) { return __uint_as_float((unsigned)__builtin_amdgcn_mov_dpp((int)__float_as_uint(x), CTRL, 0xf, 0xf, true)); }
constexpr int DPP_X1 = 0xB1, DPP_X2 = 0x4E, DPP_ROR4 = 0x124, DPP_ROR8 = 0x128, DPP_ROR12 = 0x12C;
__device__ __forceinline__ float swap16_sum(float a, float b) { auto rr = __builtin_amdgcn_permlane16_swap(__float_as_uint(a), __float_as_uint(b), false, false); return __uint_as_float(rr[0]) + __uint_as_float(rr[1]); }
__device__ __forceinline__ float swap32_sum(float a, float b) { auto rr = __builtin_amdgcn_permlane32_swap(__float_as_uint(a), __float_as_uint(b), false, false); return __uint_as_float(rr[0]) + __uint_as_float(rr[1]); }
__device__ __forceinline__ float swap16_max(float a) { auto rr = __builtin_amdgcn_permlane16_swap(__float_as_uint(a), __float_as_uint(a), false, false); return fmaxf(__uint_as_float(rr[0]), __uint_as_float(rr[1])); }
__device__ __forceinline__ float swap32_max(float a) { auto rr = __builtin_amdgcn_permlane32_swap(__float_as_uint(a), __float_as_uint(a), false, false); return fmaxf(__uint_as_float(rr[0]), __uint_as_float(rr[1])); }
__device__ __forceinline__ float wave_sum64(float x) {
    x += dpp_f<DPP_ROR8>(x); x += dpp_f<DPP_ROR4>(x); x += dpp_f<DPP_X2>(x); x += dpp_f<DPP_X1>(x); x = swap16_sum(x, x); return swap32_sum(x, x);
}
template <int O> __device__ __forceinline__ float lane_xor(float x, int lane, bool x4a) {
    if (O == 1) return dpp_f<DPP_X1>(x);
    if (O == 2) return dpp_f<DPP_X2>(x);
    if (O == 4) { const float a = dpp_f<DPP_ROR4>(x), b = dpp_f<DPP_ROR12>(x); return x4a ? a : b; }
    if (O == 8) return dpp_f<DPP_ROR8>(x);
    if (O == 16) { auto rr = __builtin_amdgcn_permlane16_swap(__float_as_uint(x), __float_as_uint(x), false, false); return __uint_as_float((lane & 16) ? rr[0] : rr[1]); }
    auto rr = __builtin_amdgcn_permlane32_swap(__float_as_uint(x), __float_as_uint(x), false, false); return __uint_as_float((lane & 32) ? rr[0] : rr[1]);
}
struct NormArgs {
    const float* xsrc; float* xdst; const float* csrc; float* cdst;
    int do_lat, do_ctx, xbf, xcopy;
    const float* gain; const float* shift; const float* scale;
    bf16_t* hx;
    const bf16_t* ys; const int* tokslot; const int* tokslotc; const float* g2;
    int ctx_comb;
    const float* wrouter; float* aff;
    float* out;
};
constexpr int WRT_PITCH = 1028;
constexpr size_t WS_ZROW = WS_CTL + 768 * 1024;
struct NormVec { f32x4 g[4], sh[4], g2[4]; int mr; };
template <bool COMBINE, bool FINAL, bool ROUTER = false>
__device__ __forceinline__ void normvec_load(const NormArgs& A, int mr, int lane, NormVec& nv) {
    nv.mr = mr;
#pragma unroll
    for (int j = 0; j < 4; ++j) { nv.g[j] = ((const f32x4*)A.gain)[lane + 64 * j];
        if (!FINAL) { nv.sh[j] = ((const f32x4*)(A.shift + (size_t)mr * MODW))[lane + 64 * j]; const f32x4 sc = ((const f32x4*)(A.scale + (size_t)mr * MODW))[lane + 64 * j];
            nv.g[j] = nv.g[j] * (sc + 1.0f);
            if (ROUTER) { nv.g[j] = nv.g[j] * gm::F8_SX; nv.sh[j] = nv.sh[j] * gm::F8_SX; } }
        if (COMBINE) nv.g2[j] = ((const f32x4*)(A.g2 + (size_t)mr * MODW))[lane + 64 * j]; }
}
template <int R>
__device__ __forceinline__ void norm_load(const NormArgs& A, int row0, int rstep, int lane, f32x4 (&v)[R][4]) {
#pragma unroll
    for (int r = 0; r < R; ++r) { const int row = row0 + r * rstep;
        if (A.xbf) { const bf16_t* src = row >= NLAT ? (const bf16_t*)A.csrc + (size_t)(row - NLAT) * D : (const bf16_t*)A.xsrc + (size_t)row * D;
#pragma unroll
            for (int j = 0; j < 4; ++j) { const u32x2 w = ((const u32x2*)src)[lane + 64 * j]; v[r][j] = (f32x4){bf_lo(w.x), bf_hi(w.x), bf_lo(w.y), bf_hi(w.y)}; } }
        else { const float* src = row >= NLAT ? A.csrc + (size_t)(row - NLAT) * D : A.xsrc + (size_t)row * D;
#pragma unroll
            for (int j = 0; j < 4; ++j) v[r][j] = ((const f32x4*)src)[lane + 64 * j]; } }
}
template <bool COMBINE, bool ROUTER, bool FINAL, int R>
__device__ __forceinline__ void norm_rows(const NormArgs& A, const NormVec& nv, int row0, int rstep, int lane, const LAS float* wrT, const bf16_t* zrow, f32x4 (&v)[R][4], int hxfold = -1) {
    int row[R], b[R], mr[R]; bool ic[R];
#pragma unroll
    for (int r = 0; r < R; ++r) { row[r] = row0 + r * rstep; ic[r] = row[r] >= NLAT; b[r] = ic[r] ? (row[r] - NLAT) >> 8 : row[r] >> 11; mr[r] = ic[r] ? 16 : b[r]; }
    if (!COMBINE && !FINAL && A.xcopy) {
#pragma unroll
        for (int r = 0; r < R; ++r) { bf16_t* dst = ic[r] ? (bf16_t*)A.cdst + (size_t)(row[r] - NLAT) * D : (bf16_t*)A.xdst + (size_t)row[r] * D;
#pragma unroll
            for (int j = 0; j < 4; ++j) { u32x2 w; w.x = cvt_pk_bf16(v[r][j][0], v[r][j][1]); w.y = cvt_pk_bf16(v[r][j][2], v[r][j][3]); ((u32x2*)dst)[lane + 64 * j] = w; } } }
    if (COMBINE) {
        int myslot[R]; unsigned msk[R]; int tmax = 0;
#pragma unroll
        for (int r = 0; r < R; ++r) { myslot[r] = -1;
            if (lane < 16 && (!ic[r] || A.ctx_comb)) myslot[r] = ic[r] ? A.tokslotc[(b[r] * 16 + lane) * CTXL + ((row[r] - NLAT) & 255)] : A.tokslot[(b[r] * 16 + lane) * SEQ + (row[r] & 2047)]; }
#pragma unroll
        for (int r = 0; r < R; ++r) { msk[r] = (unsigned)__ballot(myslot[r] >= 0) & 0xffffu; const int c = __builtin_popcount(msk[r]); tmax = c > tmax ? c : tmax; }
        f32x4 a[R][4];
#pragma unroll
        for (int r = 0; r < R; ++r)
#pragma unroll
            for (int j = 0; j < 4; ++j) a[r][j] = (f32x4){0.f, 0.f, 0.f, 0.f};
        for (int t = 0; t < tmax; ++t) {
            unsigned w[R][4];
#pragma unroll
            for (int r = 0; r < R; ++r) { const unsigned m = msk[r]; const bool ok = m != 0u; const int e = ok ? __builtin_ctz(m) : 0; msk[r] = m & (m - 1u);
                const int sl = __builtin_amdgcn_readlane(myslot[r], e);
                const unsigned char* yr = ok ? (const unsigned char*)A.ys + ((size_t)e * gm::ES + (ic[r] ? 4096 + b[r] * CAPC : b[r] * CAP) + sl) * D : (const unsigned char*)zrow;
#pragma unroll
                for (int j = 0; j < 4; ++j) w[r][j] = ((const unsigned*)yr)[lane + 64 * j]; }
#pragma unroll
            for (int r = 0; r < R; ++r)
#pragma unroll
                for (int j = 0; j < 4; ++j) { const f32x2 lo = __builtin_amdgcn_cvt_pk_f32_fp8((int)w[r][j], false), hi2 = __builtin_amdgcn_cvt_pk_f32_fp8((int)w[r][j], true);
                    a[r][j] += (f32x4){lo[0], lo[1], hi2[0], hi2[1]}; }
        }
#pragma unroll
        for (int r = 0; r < R; ++r) { if (ic[r] && !A.ctx_comb) continue;
#pragma unroll
            for (int j = 0; j < 4; ++j) v[r][j] += nv.g2[j] * (a[r][j] * 0.03125f);
            if (!FINAL) { bf16_t* dst = ic[r] ? (bf16_t*)A.cdst + (size_t)(row[r] - NLAT) * D : (bf16_t*)A.xdst + (size_t)row[r] * D;
#pragma unroll
                for (int j = 0; j < 4; ++j) { u32x2 w; w.x = cvt_pk_bf16(v[r][j][0], v[r][j][1]); w.y = cvt_pk_bf16(v[r][j][2], v[r][j][3]); ((u32x2*)dst)[lane + 64 * j] = w; } } }
    }
    float ss[R];
#pragma unroll
    for (int r = 0; r < R; ++r) { ss[r] = 0.f;
#pragma unroll
        for (int j = 0; j < 4; ++j) ss[r] += (v[r][j][0] * v[r][j][0] + v[r][j][1] * v[r][j][1]) + (v[r][j][2] * v[r][j][2] + v[r][j][3] * v[r][j][3]); }
#pragma unroll
    for (int r = 0; r < R; ++r) ss[r] = wave_sum64(ss[r]);
    if (FINAL) {
#pragma unroll
        for (int r = 0; r < R; ++r) { const float rstd = __builtin_amdgcn_rsqf(ss[r] * (1.f / D) + EPS);
#pragma unroll
            for (int j = 0; j < 4; ++j) ((f32x4*)(A.out + (size_t)row[r] * D))[lane + 64 * j] = v[r][j] * rstd * nv.g[j]; }
        return;
    }
#pragma unroll
    for (int r = 0; r < R; ++r) { const float rstd = __builtin_amdgcn_rsqf(ss[r] * (1.f / D) + EPS);
#pragma unroll
        for (int j = 0; j < 4; ++j) { v[r][j] = v[r][j] * rstd * nv.g[j] + nv.sh[j];
            if (ROUTER) ((unsigned*)((unsigned char*)A.hx + (size_t)row[r] * D))[lane + 64 * j] = gm::pk4_fp8(v[r][j][0], v[r][j][1], v[r][j][2], v[r][j][3]);
            else if (hxfold < 0) { u32x2 w; w.x = cvt_pk_bf16(v[r][j][0], v[r][j][1]); w.y = cvt_pk_bf16(v[r][j][2], v[r][j][3]); ((u32x2*)(A.hx + (size_t)row[r] * D))[lane + 64 * j] = w; } } }
    if (hxfold >= 0) {
#pragma unroll
        for (int j = 0; j < 4; ++j) { const f32x4 a = R == 2 ? v[0][j] + v[R - 1][j] : v[0][j];
            u32x2 w; w.x = cvt_pk_bf16(a[0], a[1]); w.y = cvt_pk_bf16(a[2], a[3]); ((u32x2*)(A.hx + (size_t)hxfold * D))[lane + 64 * j] = w;
            if (R == 2) { const f32x4 d = v[0][j] - v[1][j]; u32x2 w2; w2.x = cvt_pk_bf16(d[0], d[1]); w2.y = cvt_pk_bf16(d[2], d[3]); ((u32x2*)(A.hx + (size_t)(hxfold + 1024) * D))[lane + 64 * j] = w2; } } }
    if (ROUTER) {
        float t1[R]; float lgs[R][16];
        f32x4 wb[2][4];
#define RT_LOAD(buf, e) do { _Pragma("unroll") for (int j = 0; j < 4; ++j) wb[buf][j] = *(const LAS f32x4*)(wrT + (e) * WRT_PITCH + 4 * lane + 256 * j); } while (0)
        RT_LOAD(0, 0);
#pragma unroll
        for (int e = 0; e < 16; ++e) {
            if (e + 1 < 16) RT_LOAD((e + 1) & 1, e + 1);
            __builtin_amdgcn_sched_barrier(0);
            f32x2 s_[R];
#pragma unroll
            for (int r = 0; r < R; ++r) s_[r] = (f32x2){0.f, 0.f};
#pragma unroll
            for (int j = 0; j < 4; ++j) { const f32x4 w = wb[e & 1][j]; const f32x2 wlo = (f32x2){w[0], w[1]}, whi = (f32x2){w[2], w[3]};
#pragma unroll
                for (int r = 0; r < R; ++r) { s_[r] = __builtin_elementwise_fma((f32x2){v[r][j][0], v[r][j][1]}, wlo, s_[r]); s_[r] = __builtin_elementwise_fma((f32x2){v[r][j][2], v[r][j][3]}, whi, s_[r]); } }
#pragma unroll
            for (int r = 0; r < R; ++r) lgs[r][e] = s_[r][0] + s_[r][1];
            __builtin_amdgcn_sched_barrier(0);
        }
#undef RT_LOAD
        const bool x4a = __builtin_amdgcn_mov_dpp(lane, DPP_ROR4, 0xf, 0xf, true) == (lane ^ 4);
#pragma unroll
        for (int r = 0; r < R; ++r) {
            float lg[16];
#pragma unroll
            for (int e = 0; e < 16; ++e) lg[e] = lgs[r][e];
            float t8[8], t4[4], t2[2];
#pragma unroll
            for (int k = 0; k < 8; ++k) t8[k] = swap32_sum(lg[k], lg[k + 8]);
#pragma unroll
            for (int k = 0; k < 4; ++k) t4[k] = swap16_sum(t8[k], t8[k + 4]);
            { const bool up = (lane & 8) != 0;
#pragma unroll
              for (int k = 0; k < 2; ++k) { const float keep = up ? t4[k + 2] : t4[k], send = up ? t4[k] : t4[k + 2]; t2[k] = keep + lane_xor<8>(send, lane, x4a); } }
            { const bool up = (lane & 4) != 0; const float keep = up ? t2[1] : t2[0], send = up ? t2[0] : t2[1]; t1[r] = keep + lane_xor<4>(send, lane, x4a); }
        }
#pragma unroll
        for (int r = 0; r < R; ++r) { t1[r] += lane_xor<2>(t1[r], lane, x4a); }
#pragma unroll
        for (int r = 0; r < R; ++r) { t1[r] += lane_xor<1>(t1[r], lane, x4a); }
        float mx[R], ex[R], sm[R];
#pragma unroll
        for (int r = 0; r < R; ++r) { float m = t1[r]; m = fmaxf(m, dpp_f<DPP_ROR8>(m)); m = fmaxf(m, dpp_f<DPP_ROR4>(m)); m = swap16_max(m); mx[r] = swap32_max(m); }
#pragma unroll
        for (int r = 0; r < R; ++r) { ex[r] = __builtin_amdgcn_exp2f((t1[r] - mx[r]) * 1.4426950408889634f); sm[r] = ex[r]; }
#pragma unroll
        for (int r = 0; r < R; ++r) { float q = sm[r]; q += dpp_f<DPP_ROR8>(q); q += dpp_f<DPP_ROR4>(q); q = swap16_sum(q, q); sm[r] = swap32_sum(q, q); }
#pragma unroll
        for (int r = 0; r < R; ++r) if ((lane & 3) == 0) A.aff[(size_t)row[r] * 16 + (lane >> 2)] = ex[r] * __builtin_amdgcn_rcpf(sm[r]);
    }
}
template <bool COMBINE, bool ROUTER, bool FINAL>
__device__ __forceinline__ void norm_phase(const Frame& F, const NormArgs& A) {
    constexpr int R = 2;
    LAS float* wrT = (LAS float*)F.lds;
    if (ROUTER) {
        float tmp[32];
#pragma unroll
        for (int k = 0; k < 32; ++k) tmp[k] = A.wrouter[F.tid + NTHREADS * k];
#pragma unroll
        for (int k = 0; k < 32; ++k) { const int i = F.tid + NTHREADS * k; wrT[(i & 15) * WRT_PITCH + (i >> 4)] = tmp[k] * (1.0f / gm::F8_SX); }
        __syncthreads(); }
    const bf16_t* zrow = (const bf16_t*)(F.ws + WS_ZROW);
    const int gw = F.bid * NWAVES + F.wave, NGW = F.G * NWAVES;
    NormVec nv; nv.mr = -1;
    for (int part = 0; part < 2; ++part) {
        if (part == 0 ? !A.do_lat : !A.do_ctx) continue;
        const int base = part == 0 ? 0 : NLAT, n = part == 0 ? NLAT : NCTX, rpw = (n + NGW - 1) / NGW;
        int row = base + gw * rpw; const int rend = (row + rpw < base + n) ? row + rpw : base + n;
        f32x4 va[R][4], vb[R][4];
        const auto same = [&](int r) { return r + 1 < rend && (part == 1 ? ((r - NLAT) >> 8) == ((r + 1 - NLAT) >> 8) : (r >> 11) == ((r + 1) >> 11)); };
        if (row < rend && same(row)) norm_load<R>(A, row, 1, F.lane, va);
        while (row < rend) {
            const int mr = part == 1 ? 16 : (row >> 11);
            if (mr != nv.mr) normvec_load<COMBINE, FINAL, ROUTER>(A, mr, F.lane, nv);
            if (same(row)) { const int nx = row + R; const bool more = nx < rend && same(nx);
                if (more) norm_load<R>(A, nx, 1, F.lane, vb);
                norm_rows<COMBINE, ROUTER, FINAL, R>(A, nv, row, 1, F.lane, wrT, zrow, va);
                if (more) {
#pragma unroll
                    for (int r = 0; r < R; ++r)
#pragma unroll
                        for (int j = 0; j < 4; ++j) va[r][j] = vb[r][j]; }
                else if (nx < rend && !more) {   }
                row = nx; }
            else { f32x4 v1[1][4]; norm_load<1>(A, row, 1, F.lane, v1); norm_rows<COMBINE, ROUTER, FINAL, 1>(A, nv, row, 1, F.lane, wrT, zrow, v1); row += 1;
                if (row < rend && same(row)) norm_load<R>(A, row, 1, F.lane, va); }
        }
    }
    __syncthreads();
}

constexpr int HF_ROWS = 2304;
template <bool COMBINE>
__device__ __forceinline__ void norm_fold_phase(const Frame& F, const NormArgs& A) {
    const bf16_t* zrow = (const bf16_t*)(F.ws + WS_ZROW);
    const int gw = F.bid * NWAVES + F.wave, NGW = F.G * NWAVES;
    constexpr int NPAIR = NB * 1023;
    NormVec nv; nv.mr = -1;
    { const int ipw = (NPAIR + NGW - 1) / NGW; int it = gw * ipw; const int iend = (it + ipw < NPAIR) ? it + ipw : NPAIR; f32x4 va[2][4], vb[2][4];
      if (it < iend) { const int b = it / 1023, n = 1 + it - b * 1023; norm_load<2>(A, b * SEQ + n, SEQ - 2 * n, F.lane, va); }
      for (; it < iend; ++it) { const int b = it / 1023, n = 1 + it - b * 1023; const int nx = it + 1; const bool more = nx < iend;
          if (b != nv.mr) normvec_load<COMBINE, false>(A, b, F.lane, nv);
          if (more) { const int b2 = nx / 1023, n2 = 1 + nx - b2 * 1023; norm_load<2>(A, b2 * SEQ + n2, SEQ - 2 * n2, F.lane, vb); }
          norm_rows<COMBINE, false, false, 2>(A, nv, b * SEQ + n, SEQ - 2 * n, F.lane, nullptr, zrow, va, b * HF_ROWS + n);
          if (more) {
#pragma unroll
              for (int r = 0; r < 2; ++r)
#pragma unroll
                  for (int j = 0; j < 4; ++j) va[r][j] = vb[r][j]; } } }
    for (int it = gw; it < 2 * NB; it += NGW) { const int b = it >> 1, hi = it & 1; f32x4 v1[1][4];
        if (b != nv.mr) normvec_load<COMBINE, false>(A, b, F.lane, nv);
        norm_load<1>(A, b * SEQ + hi * 1024, 0, F.lane, v1); norm_rows<COMBINE, false, false, 1>(A, nv, b * SEQ + hi * 1024, 0, F.lane, nullptr, zrow, v1, b * HF_ROWS + hi * 2048); }
    for (int it = gw; it < NB * 256; it += NGW) { const int b = it >> 8, q = it & 255; const int r = q == 0 ? 1024 : 2048 + q;
        u32x2 z; z.x = 0u; z.y = 0u;
#pragma unroll
        for (int j = 0; j < 4; ++j) ((u32x2*)(A.hx + ((size_t)b * HF_ROWS + r) * D))[F.lane + 64 * j] = z; }
    __syncthreads();
}

template <int NV, int NTOK, int CAPN>
__device__ __forceinline__ void select_unit(const Frame& F, const float* aff_base  , int* tokslot_out  , int* slot_row_out, float* slot_aff_out, int row_base) {
    LAS int* cnt = (LAS int*)F.lds;
    LAS int* tg = cnt + 64; LAS int* te = tg + NV * 8;
    unsigned v[NV]; bool ok[NV];
#pragma unroll
    for (int k = 0; k < NV; ++k) { const int n = F.tid + NTHREADS * k; ok[k] = n < NTOK; v[k] = ok[k] ? __float_as_uint(aff_base[(size_t)n * 16]) : 0u; }
    unsigned T = 0u;
    for (int bit = 29; bit >= 0; --bit) { const unsigned cand = T | (1u << bit); int cw = 0;
#pragma unroll
        for (int k = 0; k < NV; ++k) cw += __builtin_popcountll(__ballot(ok[k] && v[k] >= cand));
        LAS int* cb = cnt + (bit & 1) * 8;
        if (F.lane == 0) cb[F.wave] = cw;
        __syncthreads();
        int tot = 0;
#pragma unroll
        for (int w = 0; w < 8; ++w) tot += cb[w];
        if (tot >= CAPN) T = cand; }
    int pg[NV], pe[NV]; bool isg[NV], ise[NV];
#pragma unroll
    for (int k = 0; k < NV; ++k) { isg[k] = ok[k] && v[k] > T; ise[k] = ok[k] && v[k] == T;
        const unsigned long long mg = __ballot(isg[k]), me = __ballot(ise[k]); const unsigned long long below = (1ull << F.lane) - 1ull;
        pg[k] = __builtin_popcountll(mg & below); pe[k] = __builtin_popcountll(me & below);
        if (F.lane == 0) { tg[k * 8 + F.wave] = __builtin_popcountll(mg); te[k * 8 + F.wave] = __builtin_popcountll(me); } }
    __syncthreads();
    LAS int* xg = te + NV * 8; LAS int* xe = xg + NV * 8 + 1;
    if (F.tid == 0) { int ag = 0, ae = 0; for (int i = 0; i < NV * 8; ++i) { xg[i] = ag; xe[i] = ae; ag += tg[i]; ae += te[i]; } xg[NV * 8] = ag; }
    __syncthreads();
    const int totg = xg[NV * 8];
#pragma unroll
    for (int k = 0; k < NV; ++k) { const int og = xg[k * 8 + F.wave], oe = xe[k * 8 + F.wave];
        const int n = F.tid + NTHREADS * k;
        if (ok[k]) { int slot = -1;
            if (isg[k]) slot = og + pg[k];
            else if (ise[k]) { const int rk = oe + pe[k]; if (totg + rk < CAPN) slot = totg + rk; }
            tokslot_out[n] = slot;
            if (slot >= 0) { slot_row_out[slot] = row_base + n; slot_aff_out[slot] = __uint_as_float(v[k]); } } }
    __syncthreads();
}
__device__ __forceinline__ void topk_phase(const Frame& F, bool do_ctx) {
    const float* aff = F.W<float>(WS_AFF); int* slot_row = F.W<int>(WS_SLOTROW); float* slot_aff = F.W<float>(WS_SLOTAFF); int* tokslot = F.W<int>(WS_TOKSLOT); int* tokslotc = F.W<int>(WS_TOKSLOTC);
    const int nunits = do_ctx ? 512 : 256;
    for (int u = F.bid; u < nunits; u += F.G) {
        if (u < 256) { const int b = u >> 4, e = u & 15;
            select_unit<4, SEQ, CAP>(F, aff + (size_t)b * SEQ * 16 + e, tokslot + (b * 16 + e) * SEQ, slot_row + e * gm::ES + b * CAP, slot_aff + e * gm::ES + b * CAP, b * SEQ); }
        else { const int b = (u - 256) >> 4, e = u & 15;
            select_unit<1, CTXL, CAPC>(F, aff + ((size_t)NLAT + (size_t)b * CTXL) * 16 + e, tokslotc + (b * 16 + e) * CTXL, slot_row + e * gm::ES + 4096 + b * CAPC, slot_aff + e * gm::ES + 4096 + b * CAPC, NLAT + b * CTXL); }
    }
}

__device__ __forceinline__ void gm_prep_phase(const Frame& F) {
    const float* ws_ = F.in[I_GMWS]; const float* sumsq = F.W<float>(WS_SUMSQ); bf16_t* App = F.W<bf16_t>(RA_APP);
    LAS float* rs = (LAS float*)F.lds;
    for (int item = F.bid; item < NB * 9 * 2; item += F.G) { const int gq = item & 1, bc = item >> 1, b = bc / 9, cp = bc - b * 9;
        const size_t trow0 = cp == 0 ? (size_t)NLAT + (size_t)b * CTXL : (size_t)b * SEQ + (size_t)(cp - 1) * 256;
        if (F.tid < 256) { const f32x4* pa = (const f32x4*)(sumsq + (trow0 + F.tid) * 16); const f32x4 a0 = pa[0], a1 = pa[1], a2 = pa[2], a3 = pa[3];
            const float sm = (((a0[0] + a0[1]) + (a0[2] + a0[3])) + ((a1[0] + a1[1]) + (a1[2] + a1[3]))) + (((a2[0] + a2[1]) + (a2[2] + a2[3])) + ((a3[0] + a3[1]) + (a3[2] + a3[3])));
            rs[F.tid] = __builtin_amdgcn_rsqf(sm * (1.f / 2048.f) + EPS); }
        __syncthreads();
        constexpr int U = 4;
        for (int i0 = F.tid; i0 < 4 * 4096; i0 += U * NTHREADS) {
            f32x4 w0[U], w1[U];
#pragma unroll
            for (int q = 0; q < U; ++q) { const int i = i0 + q * NTHREADS; const int g = gq * 4 + (i >> 12), r = (i >> 4) & 255, k0 = (i & 15) * 8;
                const float* wp = ws_ + ((size_t)g * 128 + (r & 127)) * 128 + k0; w0[q] = *(const f32x4*)wp; w1[q] = *(const f32x4*)(wp + 4); }
#pragma unroll
            for (int q = 0; q < U; ++q) { const int i = i0 + q * NTHREADS; const int g = gq * 4 + (i >> 12), r = (i >> 4) & 255, k0 = (i & 15) * 8, tk = (r >> 7) * 128 + k0;
                const f32x4 r0 = *(const LAS f32x4*)(rs + tk), r1 = *(const LAS f32x4*)(rs + tk + 4);
                *(u32x4*)(App + ((size_t)(bc * 8 + g) * 4096 + (i & 4095)) * 8) = gm::pack8(w0[q] * r0, w1[q] * r1); }
        }
        __syncthreads();
    }
}

enum { PH_PRO = 0,
       PH_L0_N1, PH_L0_QKV, PH_L0_ATT, PH_L0_OUT, PH_L0_N2, PH_L0_TOPK, PH_L0_GU, PH_L0_DOWN,
       PH_L1_N1, PH_L1_GMIN, PH_L1_PREP, PH_L1_SPAT, PH_L1_OUT, PH_L1_N2, PH_L1_TOPK, PH_L1_GU, PH_L1_DOWN,
       PH_L2_N1, PH_L2_QKV, PH_L2_ATT, PH_L2_OUT, PH_L2_N2, PH_L2_TOPK, PH_L2_GU, PH_L2_DOWN,
       PH_L3_N1, PH_L3_CDFT, PH_L3_PDFT, PH_L3_OUT, PH_L3_N2, PH_L3_TOPK, PH_L3_GU, PH_L3_DOWN,
       PH_FINAL, NPHASES };

__device__ __forceinline__ const float* modp(const Frame& F, int layer, int j) { return F.W<float>(WS_MOD) + (size_t)layer * MODR * MODW + (size_t)j * D; }

template <bool COMBINE>
__device__ __forceinline__ void norm1_phase(const Frame& F, int layer, bool do_ctx, bool ctx_comb) {
    NormArgs A{};
    A.xsrc = COMBINE ? F.W<float>(WS_X) : F.in[I_X]; A.xdst = F.W<float>(WS_X); A.csrc = COMBINE ? F.W<float>(WS_CTX) : F.in[I_CTX]; A.cdst = F.W<float>(WS_CTX);
    A.do_lat = 1; A.do_ctx = do_ctx ? 1 : 0; A.xbf = COMBINE ? 1 : 0; A.xcopy = COMBINE ? 0 : 1;
    A.gain = F.in[I_MNG] + layer * D; A.shift = modp(F, layer, 0); A.scale = modp(F, layer, 1); A.hx = F.W<bf16_t>(WS_HX);
    A.ys = F.W<bf16_t>(RA_YS); A.tokslot = F.W<int>(WS_TOKSLOT); A.tokslotc = F.W<int>(WS_TOKSLOTC); A.g2 = modp(F, layer > 0 ? layer - 1 : 0, 5); A.ctx_comb = ctx_comb ? 1 : 0;
    norm_phase<COMBINE, false, false>(F, A);
}
__device__ __forceinline__ void norm2_phase(const Frame& F, int layer, bool do_ctx) {
    NormArgs A{};
    A.xsrc = F.W<float>(WS_X); A.csrc = F.W<float>(WS_CTX); A.do_lat = 1; A.do_ctx = do_ctx ? 1 : 0; A.xbf = 1;
    A.gain = F.in[I_MOEG] + layer * D; A.shift = modp(F, layer, 3); A.scale = modp(F, layer, 4); A.hx = F.W<bf16_t>(WS_HX);
    A.wrouter = F.in[I_ROUTER] + (size_t)layer * D * NE; A.aff = F.W<float>(WS_AFF);
    norm_phase<false, true, false>(F, A);
}
__device__ __forceinline__ void out_phase(const Frame& F, int layer, const char* A, unsigned lda, int K, size_t wofs, int nM) {
    gm::P_OUT p; p.A = A; p.B = (const char*)(F.ws + wofs); p.lda_ = lda; p.K_ = K; p.nM = nM;
    p.xb_ = F.W<bf16_t>(WS_X); p.cb_ = F.W<bf16_t>(WS_CTX); p.gate = modp(F, layer, 2);
    gm::gemm_phase(F.lds, p);
}
__device__ __forceinline__ void gu_phase(const Frame& F, int layer, bool with_ctx) {
    gm::P_GU p; p.hx = (const char*)(F.ws + WS_HX); p.W = (const char*)(F.ws + WGU_OF(layer)); p.hid = F.W<unsigned char>(RA_HID); p.slot_row = F.W<int>(WS_SLOTROW); p.nM = with_ctx ? 18 : 16;
    gm::gemm_phase(F.lds, p);
}
__device__ __forceinline__ void down_phase(const Frame& F, int layer, bool with_ctx) {
    gm::P_DOWN p; p.hid = (const char*)(F.ws + RA_HID); p.W = (const char*)(F.ws + WD_OF(layer)); p.ys = F.W<bf16_t>(RA_YS); p.slot_aff = F.W<float>(WS_SLOTAFF); p.nM = with_ctx ? 18 : 16;
    gm::gemm_phase(F.lds, p);
}

__global__ void __launch_bounds__(NTHREADS, 2) fwd(Params P) {
    extern __shared__ __attribute__((aligned(16))) unsigned char lds_raw[];
    Frame F;
    F.lds = (LAS unsigned char*)lds_raw; F.ws = P.ws; F.out = P.out;
#pragma unroll
    for (int i = 0; i < 29; ++i) F.in[i] = P.in[i];
    F.tid = threadIdx.x; F.lane = F.tid & 63; F.wave = __builtin_amdgcn_readfirstlane(F.tid >> 6); F.G = gridDim.x; F.bid = blockIdx.x;
    volatile LAS unsigned* MISC = (volatile LAS unsigned*)(F.lds + LDS_MISC);
    if (F.tid < 64) MISC[F.tid] = 0u;
    __syncthreads();
    const int lo = P.ph_lo, hi = P.ph_hi;
    const bool tails = (gridDim.x == 256);
    XcdBarrier bar = xcd_barrier_post((unsigned*)(F.ws + WS_CTL) + 1024 + (size_t)P.li * XCD_BAR_WORDS, MISC);
#ifdef MK_ONLY_PHASE
#define IN(k) ((k) == MK_ONLY_PHASE && lo <= (k) && (k) < hi)
#else
#define IN(k) (lo <= (k) && (k) < hi)
#endif
#define SEAM(k) do { if (IN(k) && IN((k) + 1)) xcd_barrier(bar); } while (0)
#define REFRESH() do { int tz_ = threadIdx.x; asm volatile("" : "+v"(tz_)); F.tid = tz_; F.lane = tz_ & 63; F.wave = __builtin_amdgcn_readfirstlane(tz_ >> 6); } while (0)

    if (IN(PH_PRO)) { REFRESH(); p0_prologue(F, tails); } SEAM(PH_PRO);

    if (IN(PH_L0_N1)) { REFRESH(); norm1_phase<false>(F, 0, true, false); } SEAM(PH_L0_N1);
    if (IN(PH_L0_QKV)) { REFRESH();
        gm::P_QKV0 p; p.A = (const char*)(F.ws + WS_HX); p.B = (const char*)(F.ws + WS_WQKV0); p.q = F.W<bf16_t>(RB_Q); p.k = F.W<bf16_t>(RB_K); p.v = F.W<bf16_t>(RB_V);
        p.ropeC = F.W<float>(WS_ROPE); p.ropeS = F.W<float>(WS_ROPE + 4096);
        gm::gemm_phase(F.lds, p);
        if (tails) moe_weights_tail(F, 1, 0, 48, F.bid - 192);
    } SEAM(PH_L0_QKV);
    if (IN(PH_L0_ATT)) { REFRESH();
        float lam;
        { const float a = F.in[I_LQ1][F.lane] * F.in[I_LK1][F.lane], b = F.in[I_LQ2][F.lane] * F.in[I_LK2][F.lane]; lam = expf(wave_sum(a)) - expf(wave_sum(b)) + 0.2f; }
        const bf16_t* q = F.W<bf16_t>(RB_Q); const bf16_t* k = F.W<bf16_t>(RB_K); const bf16_t* v = F.W<bf16_t>(RB_V); bf16_t* o = F.W<bf16_t>(RB_O);
        if (tails && ((F.bid >> 3) & 3) == 0) { const int rank = (F.bid >> 5) * 8 + (F.bid & 7);
            weights_range(F, 0, 0, rank * 384, rank * 384 + 384, F.wave, NWAVES);
            weights_range(F, 1, 0, 18432 + rank * 96, 18432 + rank * 96 + 96, F.wave, NWAVES);
            weights_range(F, 3, 0, 3072 + rank * 336, 3072 + rank * 336 + 336, F.wave, NWAVES);
            __syncthreads(); }
        { unsigned* qcnt = (unsigned*)(F.ws + WS_CTL) + 160000; volatile LAS unsigned* qslot = (volatile LAS unsigned*)(F.lds + LDS_MISC) + 8;
          const int myx = (int)(xb_xcc_id() & 7u);
          for (int s8 = 0; s8 < 8; ++s8) { const int x = (myx + s8) & 7;
            for (;;) {
                if (F.tid == 0) *qslot = __hip_atomic_fetch_add(qcnt + x * 64, 1u, __ATOMIC_RELAXED, __HIP_MEMORY_SCOPE_AGENT);
                __syncthreads();
                const int kq = (int)*qslot;
                if (kq >= 288) { __syncthreads(); break; }
                if (kq < 256) { const int bh = x + 8 * (kq >> 4), qb = kq & 15, b = bh >> 3, h = bh & 7; const size_t row0 = (size_t)b * SEQ + qb * 128;
                    at::diff_attn_unit_dma(q + (((size_t)b * 8 + h) * KVL + CTXL + qb * 128) * 128, k + ((size_t)b * 8 + h) * KVL * 128, v + ((size_t)b * 8 + h) * KVL * 128, o + row0 * D + h * 128, KVL, lam, 0.8f, F.in[I_SUBLN], (LAS char*)F.lds); }
                else { const int kk = kq - 256, bh = x + 8 * (kk >> 1), qb = kk & 1, b = bh >> 3, h = bh & 7; const size_t row0 = (size_t)NLAT + (size_t)b * CTXL + qb * 128;
                    at::diff_attn_unit_dma(q + (((size_t)b * 8 + h) * KVL + qb * 128) * 128, k + ((size_t)b * 8 + h) * KVL * 128, v + ((size_t)b * 8 + h) * KVL * 128, o + row0 * D + h * 128, CTXL, lam, 0.8f, F.in[I_SUBLN], (LAS char*)F.lds); }
            } } }
#ifdef MK_PROBE_ATT
        { bf16_t* od = F.W<bf16_t>(RA_HID);
          for (int u = F.bid; u < 2048 + 256; u += F.G) {
            if (u < 2048) { const int b = u >> 7, h = (u >> 4) & 7, qb = u & 15; const size_t row0 = (size_t)b * SEQ + qb * 128;
                at::diff_attn_unit<MK_PROBE_ATT>(q + (((size_t)b * 8 + h) * KVL + CTXL + qb * 128) * 128, k + ((size_t)b * 8 + h) * KVL * 128, v + ((size_t)b * 8 + h) * KVL * 128, od + row0 * D + h * 128, KVL, lam, 0.8f, F.in[I_SUBLN], (LAS char*)F.lds); }
            else { const int uu = u - 2048, b = uu >> 4, h = (uu >> 1) & 7, qb = uu & 1; const size_t row0 = (size_t)NLAT + (size_t)b * CTXL + qb * 128;
                at::diff_attn_unit<MK_PROBE_ATT>(q + (((size_t)b * 8 + h) * KVL + qb * 128) * 128, k + ((size_t)b * 8 + h) * KVL * 128, v + ((size_t)b * 8 + h) * KVL * 128, od + row0 * D + h * 128, CTXL, lam, 0.8f, F.in[I_SUBLN], (LAS char*)F.lds); }
          } }
#endif
    } SEAM(PH_L0_ATT);
    if (IN(PH_L0_OUT)) { REFRESH(); out_phase(F, 0, (const char*)(F.ws + RB_O), 2048, 1024, WS_WO0, 144); if (tails) moe_weights_tail(F, 1, 3072, 48, F.bid - 64); } SEAM(PH_L0_OUT);
    if (IN(PH_L0_N2)) { REFRESH(); norm2_phase(F, 0, true); } SEAM(PH_L0_N2);
    if (IN(PH_L0_TOPK)) { REFRESH(); topk_phase(F, true); } SEAM(PH_L0_TOPK);
    if (IN(PH_L0_GU)) { REFRESH(); gu_phase(F, 0, true); } SEAM(PH_L0_GU);
    if (IN(PH_L0_DOWN)) { REFRESH(); down_phase(F, 0, true); if (tails) moe_weights_tail(F, 1, 12288, 48, F.bid - 128); } SEAM(PH_L0_DOWN);

    if (IN(PH_L1_N1)) { REFRESH();
        norm1_phase<true>(F, 1, true, true);
        if (!tails) moe_weights_phase(F, 1, 0);
    } SEAM(PH_L1_N1);
    if (IN(PH_L1_GMIN)) { REFRESH();
        { gm::P_GMU p; p.hx = (const char*)(F.ws + WS_HX); p.W = (const char*)(F.ws + WS_WGIN); p.u_out = F.W<bf16_t>(RB_U); gm::gemm_phase(F.lds, p); }
        { gm::P_GMV p; p.hx = (const char*)(F.ws + WS_HX); p.W = (const char*)(F.ws + WS_WGIN); p.vT = F.W<bf16_t>(RB_VT); p.sumsq = F.W<float>(WS_SUMSQ); gm::gemm_phase(F.lds, p, F.G - 1 - F.bid); }
    } SEAM(PH_L1_GMIN);
    if (IN(PH_L1_PREP)) { REFRESH(); gm_prep_phase(F); } SEAM(PH_L1_PREP);
    if (IN(PH_L1_SPAT)) { REFRESH();
        gm::P_SPAT p; p.App = (const char*)(F.ws + RA_APP); p.vT = (const char*)(F.ws + RB_VT); p.u_io = F.W<bf16_t>(RB_U); p.v_g = F.in[I_GMVG]; p.b_s = F.in[I_GMBS]; p.zeros = (const char*)(F.ws + WS_CTL + 800 * 1024);
        gm::gemm_phase(F.lds, p);
    } SEAM(PH_L1_SPAT);
    if (IN(PH_L1_OUT)) { REFRESH(); out_phase(F, 1, (const char*)(F.ws + RB_U), 4096, 2048, WS_WGOUT, 144); if (tails) moe_weights_tail(F, 2, 0, 96, F.bid - 64); } SEAM(PH_L1_OUT);
    if (IN(PH_L1_N2)) { REFRESH(); norm2_phase(F, 1, true); } SEAM(PH_L1_N2);
    if (IN(PH_L1_TOPK)) { REFRESH(); topk_phase(F, true); } SEAM(PH_L1_TOPK);
    if (IN(PH_L1_GU)) { REFRESH(); gu_phase(F, 1, true); } SEAM(PH_L1_GU);
    if (IN(PH_L1_DOWN)) { REFRESH(); down_phase(F, 1, true); if (tails) moe_weights_tail(F, 2, 18432, 48, F.bid - 128); } SEAM(PH_L1_DOWN);

    if (IN(PH_L2_N1)) { REFRESH(); norm1_phase<true>(F, 2, true, true); if (!tails) moe_weights_phase(F, 2); } SEAM(PH_L2_N1);
    if (IN(PH_L2_QKV)) { REFRESH();
        gm::P_QKV2 p; p.A = (const char*)(F.ws + WS_HX); p.B = (const char*)(F.ws + WS_WQKV2); p.q = F.W<bf16_t>(RB_Q); p.k = F.W<bf16_t>(RB_K); p.v = F.W<bf16_t>(RB_V);
        gm::gemm_phase(F.lds, p);
        if (tails) moe_weights_tail(F, 3, 0, 48, F.bid - 192);
    } SEAM(PH_L2_QKV);
    if (IN(PH_L2_ATT)) { REFRESH();
        for (int u = F.bid; u < 2048; u += F.G) { const int b = u >> 7, h = (u >> 3) & 15, R4 = u & 7;
            at::natten_unit(F.W<bf16_t>(RB_Q), F.W<bf16_t>(RB_K), F.W<bf16_t>(RB_V), F.W<bf16_t>(RB_O), F.in[I_NARPB], b, h, R4, (LAS char*)F.lds); }
    } SEAM(PH_L2_ATT);
    if (IN(PH_L2_OUT)) { REFRESH(); out_phase(F, 2, (const char*)(F.ws + RB_O), 2048, 1024, WS_WO2, 128); } SEAM(PH_L2_OUT);
    if (IN(PH_L2_N2)) { REFRESH(); norm2_phase(F, 2, false); } SEAM(PH_L2_N2);
    if (IN(PH_L2_TOPK)) { REFRESH(); topk_phase(F, false); } SEAM(PH_L2_TOPK);
    if (IN(PH_L2_GU)) { REFRESH(); gu_phase(F, 2, false); } SEAM(PH_L2_GU);
    if (IN(PH_L2_DOWN)) { REFRESH(); down_phase(F, 2, false); } SEAM(PH_L2_DOWN);

    if (IN(PH_L3_N1)) { REFRESH();
        NormArgs A{};
        A.xsrc = F.W<float>(WS_X); A.xdst = F.W<float>(WS_X); A.csrc = F.W<float>(WS_CTX); A.cdst = F.W<float>(WS_CTX); A.do_lat = 1; A.do_ctx = 0; A.xbf = 1;
        A.gain = F.in[I_MNG] + 3 * D; A.shift = modp(F, 3, 0); A.scale = modp(F, 3, 1); A.hx = F.W<bf16_t>(WS_HX);
        A.ys = F.W<bf16_t>(RA_YS); A.tokslot = F.W<int>(WS_TOKSLOT); A.tokslotc = F.W<int>(WS_TOKSLOTC); A.g2 = modp(F, 2, 5); A.ctx_comb = 0;
        norm_fold_phase<true>(F, A);
        if (!tails) moe_weights_phase(F, 3, 0); } SEAM(PH_L3_N1);
    if (IN(PH_L3_CDFT)) { REFRESH();
        gm::P_CDFT p; p.CS = (const char*)(F.ws + WS_CS); p.hx = (const char*)(F.ws + WS_HX); p.PQt = F.W<bf16_t>(RB_PQ);
        gm::gemm_phase(F.lds, p);
    } SEAM(PH_L3_CDFT);
    if (IN(PH_L3_PDFT)) { REFRESH();
        gm::P_PDFT p; p.DP = (const char*)(F.ws + WS_DP); p.PQt = (const char*)(F.ws + RB_PQ); p.f = F.W<bf16_t>(RB_F);
        gm::gemm_phase(F.lds, p);
    } SEAM(PH_L3_PDFT);
    if (IN(PH_L3_OUT)) { REFRESH(); out_phase(F, 3, (const char*)(F.ws + RB_F), 2048, 1024, WS_WFO, 128); } SEAM(PH_L3_OUT);
    if (IN(PH_L3_N2)) { REFRESH(); norm2_phase(F, 3, false); } SEAM(PH_L3_N2);
    if (IN(PH_L3_TOPK)) { REFRESH(); topk_phase(F, false); } SEAM(PH_L3_TOPK);
    if (IN(PH_L3_GU)) { REFRESH(); gu_phase(F, 3, false); } SEAM(PH_L3_GU);
    if (IN(PH_L3_DOWN)) { REFRESH(); down_phase(F, 3, false); } SEAM(PH_L3_DOWN);

    if (IN(PH_FINAL)) { REFRESH();
        NormArgs A{};
        A.xsrc = F.W<float>(WS_X); A.do_lat = 1; A.do_ctx = 0; A.xbf = 1; A.gain = F.in[I_FINALG];
        A.ys = F.W<bf16_t>(RA_YS); A.tokslot = F.W<int>(WS_TOKSLOT); A.tokslotc = F.W<int>(WS_TOKSLOTC); A.g2 = modp(F, 3, 5); A.out = F.out;
        norm_phase<true, false, true>(F, A);
    }
#undef IN
#undef SEAM
}

extern "C" void kernel_launch(void* const* d_in, const int* in_sizes, int n_in, void* d_out, int out_size, void* d_ws, size_t ws_size, hipStream_t stream) {
    static int grid = 0;
    if (grid == 0) {
        if (n_in != 29 || in_sizes[0] != NLAT * D || out_size != NLAT * D || ws_size < WS_END) {
            fprintf(stderr, "kernel_launch: shape mismatch: n_in %d in0 %d out %d ws %zu (need >= %zu)\n", n_in, n_in > 0 ? in_sizes[0] : -1, out_size, ws_size, (size_t)WS_END); grid = -1; return; }
        int dev = 0, cus = 0, per_cu = 0;
        if (hipGetDevice(&dev) != hipSuccess || hipDeviceGetAttribute(&cus, hipDeviceAttributeMultiprocessorCount, dev) != hipSuccess) { grid = -1; return; }
        if (hipFuncSetAttribute((const void*)fwd, hipFuncAttributeMaxDynamicSharedMemorySize, LDS_BYTES) != hipSuccess) { fprintf(stderr, "kernel_launch: hipFuncSetAttribute failed\n"); grid = -1; return; }
        if (hipOccupancyMaxActiveBlocksPerMultiprocessor(&per_cu, (const void*)fwd, NTHREADS, LDS_BYTES) != hipSuccess || per_cu < 1) { fprintf(stderr, "kernel_launch: occupancy query says %d\n", per_cu); (void)hipGetLastError(); per_cu = 1; }
        grid = cus;
    }
    if (grid < 0) return;
    (void)hipMemsetAsync((char*)d_ws + WS_CTL, 0, CTL_BYTES, stream);
    Params p{};
    for (int i = 0; i < 29; ++i) p.in[i] = (const float*)d_in[i];
    p.out = (float*)d_out; p.ws = (unsigned char*)d_ws;
#ifndef MK_RANGES
#define MK_RANGES 0, NPHASES
#endif
    static const int ranges[] = { MK_RANGES };
    for (unsigned r = 0; r + 1 < sizeof(ranges) / sizeof(ranges[0]); r += 2) { p.ph_lo = ranges[r]; p.ph_hi = ranges[r + 1]; p.li = (int)(r / 2); hipLaunchKernelGGL(fwd, dim3(grid), dim3(NTHREADS), LDS_BYTES, stream, p); }
    const hipError_t le = hipPeekAtLastError();
    if (le != hipSuccess) fprintf(stderr, "kernel_launch: launch failed: %s\n", hipGetErrorName(le));
}
```

```cpp
#include <hip/hip_runtime.h>
#include <cstdio>
#include <cstdint>

#define LAS __attribute__((address_space(3)))
#define GAS __attribute__((address_space(1)))
typedef unsigned short bf16_t;
typedef short bf16x8 __attribute__((ext_vector_type(8)));
typedef short s16x4 __attribute__((ext_vector_type(4)));
typedef float f32x4 __attribute__((ext_vector_type(4)));
typedef float f32x2 __attribute__((ext_vector_type(2)));
typedef float f32x16 __attribute__((ext_vector_type(16)));
typedef unsigned u32x4 __attribute__((ext_vector_type(4)));
typedef unsigned u32x2 __attribute__((ext_vector_type(2)));

constexpr int D = 1024, NB = 16, SEQ = 2048, NLAT = NB * SEQ, CTXL = 256, NCTX = NB * CTXL, MALL = NLAT + NCTX;
constexpr int NE = 16, CAP = 256, CAPC = 32, KVL = CTXL + SEQ;
constexpr int MODW = 6 * D, MODR = 17;
constexpr float EPS = 1e-6f;
constexpr int NWAVES = 8, NTHREADS = 512;

constexpr size_t MiB = (size_t)1 << 20;
constexpr size_t WS_CTL = 0, CTL_BYTES = 1 * MiB;
constexpr size_t WS_MOD = 1 * MiB;
constexpr size_t WS_ROPE = 3 * MiB;
constexpr size_t WS_CS = 3 * MiB + 65536;
constexpr size_t WS_AFF = 4 * MiB;
constexpr size_t WS_SLOTROW = 7 * MiB;
constexpr size_t WS_SLOTAFF = 7 * MiB + 524288;
constexpr size_t WS_TOKSLOT = 8 * MiB;
constexpr size_t WS_TOKSLOTC = 10 * MiB;
constexpr size_t WS_SUMSQ = 21 * MiB;
constexpr size_t WS_DP = 12 * MiB;
constexpr size_t WS_WQKV0 = 28 * MiB, WS_WO0 = 34 * MiB, WS_WGIN = 36 * MiB, WS_WGOUT = 44 * MiB, WS_WQKV2 = 48 * MiB, WS_WO2 = 54 * MiB, WS_WFO = 56 * MiB;
constexpr size_t WS_WGU = 58 * MiB;
constexpr size_t WS_WD = 122 * MiB;
constexpr size_t WS_X = 154 * MiB;
constexpr size_t WS_CTX = 282 * MiB;
constexpr size_t WS_HX = 298 * MiB;
constexpr size_t WS_RA = 370 * MiB;
constexpr size_t WS_RB = 658 * MiB;
constexpr size_t WS_W2 = 946 * MiB;
constexpr size_t WS_END = 1042 * MiB;
constexpr size_t WGU_OF(int layer) { return layer == 3 ? WS_WGU + 32 * MiB : ((layer & 1) ? WS_W2 : WS_WGU); }
constexpr size_t WD_OF(int layer) { return layer == 3 ? WS_WD + 16 * MiB : ((layer & 1) ? WS_W2 + 64 * MiB : WS_WD); }
constexpr size_t RA_HID = WS_RA, RA_YS = WS_RA + 144 * MiB, RA_APP = WS_RA;
constexpr size_t RB_Q = WS_RB, RB_K = WS_RB + 72 * MiB, RB_V = WS_RB + 144 * MiB, RB_O = WS_RB + 216 * MiB;
constexpr size_t RB_U = WS_RB, RB_VT = WS_RB + 144 * MiB;
constexpr size_t RB_PQ = WS_RB, RB_F = WS_RB + 128 * MiB;

constexpr int LDS_RING = 131072;
constexpr int LDS_MISC = LDS_RING;
constexpr int LDS_BYTES = 147456;

#define LDS_WAIT() asm volatile("s_waitcnt lgkmcnt(0)" ::: "memory")
#define VM_WAIT() asm volatile("s_waitcnt vmcnt(0)" ::: "memory")
__device__ __forceinline__ unsigned cvt_pk_bf16(float lo, float hi) { unsigned r; asm volatile("v_cvt_pk_bf16_f32 %0, %1, %2" : "=v"(r) : "v"(lo), "v"(hi)); return r; }
__device__ __forceinline__ float bf_lo(unsigned w) { return __uint_as_float(w << 16); }
__device__ __forceinline__ float bf_hi(unsigned w) { return __uint_as_float(w & 0xffff0000u); }
__device__ __forceinline__ float wave_sum(float v) {
#pragma unroll
    for (int o = 1; o < 64; o <<= 1) v += __shfl_xor(v, o);
    return v;
}
__device__ __forceinline__ float fast_rcp(float x) { return __builtin_amdgcn_rcpf(x); }
__device__ __forceinline__ float silu_f(float x) { return x * fast_rcp(1.0f + __builtin_amdgcn_exp2f(-1.4426950408889634f * x)); }
__device__ __forceinline__ float gelu_tanh_f(float x) {
    const float y2 = 1.5957691216057308f * (x + 0.044715f * x * x * x);
    return x - x * fast_rcp(1.0f + __builtin_amdgcn_exp2f(1.4426950408889634f * y2));
}

__device__ __forceinline__ f32x4 gelu_tanh4(const f32x4 x) {
    constexpr float cp = -1.5957691216057308f * 1.4426950408889634f, ca = 0.044715f * cp;
    const f32x4 t = __builtin_elementwise_fma(x * x, (f32x4){ca, ca, ca, ca}, (f32x4){cp, cp, cp, cp}) * x; f32x4 e, r;
#pragma unroll
    for (int j = 0; j < 4; ++j) e[j] = __builtin_amdgcn_exp2f(t[j]);
    f32x2 dl = (f32x2){e[0], e[1]}, dh = (f32x2){e[2], e[3]};
#if defined(__HIP_DEVICE_COMPILE__)
    asm("v_pk_add_f32 %0, %1, 1.0 op_sel_hi:[1,0]" : "=v"(dl) : "v"(dl));
    asm("v_pk_add_f32 %0, %1, 1.0 op_sel_hi:[1,0]" : "=v"(dh) : "v"(dh));
#endif
    r[0] = __builtin_amdgcn_rcpf(dl[0]); r[1] = __builtin_amdgcn_rcpf(dl[1]); r[2] = __builtin_amdgcn_rcpf(dh[0]); r[3] = __builtin_amdgcn_rcpf(dh[1]);
    return x * r;
}

#define XB_TMO      128
#define XB_XCNT(j)  (256  + 64 * (j))
#define XB_XSUB(j)  (1280 + 64 * (j))
#define XB_XGEN(j)  (2304 + 64 * (j))
#define XB_TOP      3328
#define XB_TOPGEN   3392
#define XCD_BAR_WORDS 3456
#define XB_SPIN_CAP (1u << 18)
__device__ __forceinline__ unsigned xb_ld(unsigned* p)              { return __hip_atomic_load(p, __ATOMIC_RELAXED, __HIP_MEMORY_SCOPE_AGENT); }
__device__ __forceinline__ unsigned xb_add(unsigned* p, unsigned v) { return __hip_atomic_fetch_add(p, v, __ATOMIC_RELAXED, __HIP_MEMORY_SCOPE_AGENT); }
__device__ __forceinline__ unsigned xb_xcc_id() { return (unsigned)__builtin_amdgcn_s_getreg((3 << 11) | 20) & 0xFu; }
#define XB_SPIN(cond, bar) do { unsigned _sp = 0; while (cond) { __builtin_amdgcn_s_sleep(1); \
    if ((++_sp & 255u) == 0u) { if (xb_ld(&(bar)[XB_TMO])) break; if (_sp > XB_SPIN_CAP) { atomicAdd(&(bar)[XB_TMO], 1u); break; } } } } while (0)
struct XcdBarrier { unsigned* bar; unsigned x; volatile LAS unsigned* st; };
__device__ __forceinline__ XcdBarrier xcd_barrier_post(unsigned* bar, volatile LAS unsigned* st) {
    XcdBarrier b; b.bar = bar; b.x = xb_xcc_id(); b.st = st;
    if (threadIdx.x == 0) (void)xb_add(&bar[XB_XCNT(b.x)], 1u);
    return b;
}
__device__ __forceinline__ void xcd_barrier_complete(unsigned* bar, unsigned x, unsigned& nloc, unsigned& nx) {
    const unsigned G = gridDim.x * gridDim.y * gridDim.z;
    unsigned sum, cnt, mine, sp = 0u;
    for (;;) {
        sum = 0u; cnt = 0u; mine = 0u;
#pragma unroll
        for (unsigned j = 0; j < 16; ++j) { const unsigned c = xb_ld(&bar[XB_XCNT(j)]); sum += c; cnt += (c > 0u) ? 1u : 0u; mine = (j == x) ? c : mine; }
        if (sum == G) break;
        __builtin_amdgcn_s_sleep(1);
        if ((++sp & 255u) == 0u) { if (xb_ld(&bar[XB_TMO])) break; if (sp > XB_SPIN_CAP) { atomicAdd(&bar[XB_TMO], 1u); break; } }
    }
    nloc = mine > 0u ? mine : 1u; nx = cnt > 0u ? cnt : 1u;
}
__device__ __forceinline__ void xcd_barrier(const XcdBarrier& b) {
    asm volatile("s_waitcnt vmcnt(0)" ::: "memory");
    __syncthreads();
    if (threadIdx.x == 0) {
        unsigned* bar = b.bar;
        __builtin_amdgcn_s_waitcnt(0);
        unsigned nloc = b.st[0], nx = b.st[1];
        if (nloc == 0u) { xcd_barrier_complete(bar, b.x, nloc, nx); b.st[0] = nloc; b.st[1] = nx; }
        const unsigned old = xb_add(&bar[XB_XSUB(b.x)], 1u);
        const unsigned gen = old / nloc;
        if (old + 1u == (gen + 1u) * nloc) {
            __builtin_amdgcn_fence(__ATOMIC_RELEASE, "agent");
            asm volatile("s_waitcnt vmcnt(0)" ::: "memory");
            const unsigned og = xb_add(&bar[XB_TOP], 1u);
            const unsigned tg = og / nx;
            if (og + 1u == (tg + 1u) * nx) xb_add(&bar[XB_TOPGEN], 1u);
            else XB_SPIN(xb_ld(&bar[XB_TOPGEN]) == tg, bar);
            __builtin_amdgcn_fence(__ATOMIC_ACQUIRE, "agent");
            xb_add(&bar[XB_XGEN(b.x)], 1u);
            asm volatile("s_waitcnt vmcnt(0)" ::: "memory");
        } else {
            XB_SPIN(xb_ld(&bar[XB_XGEN(b.x)]) == gen, bar);
            __builtin_amdgcn_fence(__ATOMIC_ACQUIRE, "agent");
            asm volatile("s_waitcnt vmcnt(0)" ::: "memory");
        }
    }
    __syncthreads();
}

namespace gm {
constexpr int BM = 256, BK = 64, HALF = 128, HTB = HALF * BK * 2, STAGE_BYTES = 8 * HTB;
__device__ __forceinline__ int lds_byte(int r, int c) { const int st = (r >> 4) * 2 + (c >> 5), rr = r & 15, cc = c & 31, ob = rr * 64 + cc * 2; return st * 1024 + (ob ^ (((ob >> 9) & 1) << 5)); }
__device__ __forceinline__ void stage_rc(int b, int& R, int& C) { const int st = b / 1024, sb = b % 1024, swz = sb ^ (((sb >> 9) & 1) << 5); R = (st >> 1) * 16 + swz / 64; C = (st & 1) * 32 + (swz % 64) / 2; }
__device__ __forceinline__ int perm32(int rho) { const int n = rho >> 4, i = rho & 15; return 8 * (i >> 2) + 4 * n + (i & 3); }
struct Unit { int pm, pn, z; };
__device__ __forceinline__ int xcd_remap(int L, int nwg) { const int q = nwg / 8, r = nwg % 8, xcd = L % 8, off = L / 8; return (xcd < r ? xcd * (q + 1) : r * (q + 1) + (xcd - r) * q) + off; }
__device__ __forceinline__ void tile_of(int w, int nM, int nN, int& pm, int& pn) { const int nig = 8 * nN, gid = w / nig, fm = gid * 8, gsz = (nM - fm) < 8 ? (nM - fm) : 8; pm = fm + ((w % nig) % gsz); pn = (w % nig) / gsz; }

typedef f32x4 Acc[2][2][4][2];
#ifdef MK_F8_UNSCALED
constexpr int F8_ONE = 0;
#else
constexpr int F8_ONE = 0x7f7f7f7f;
#endif
constexpr float F8_SX = 8.0f, F8_SW = 64.0f, F8_SH = 4.0f;
__device__ __forceinline__ unsigned pk4_fp8(float a, float b, float c, float d) {
    int w = 0;
    w = __builtin_amdgcn_cvt_pk_fp8_f32(__builtin_amdgcn_fmed3f(a, -440.f, 440.f), __builtin_amdgcn_fmed3f(b, -440.f, 440.f), w, false);
    w = __builtin_amdgcn_cvt_pk_fp8_f32(__builtin_amdgcn_fmed3f(c, -440.f, 440.f), __builtin_amdgcn_fmed3f(d, -440.f, 440.f), w, true);
    return (unsigned)w;
}
typedef int i32x4_t __attribute__((ext_vector_type(4)));
typedef int i32x8_t __attribute__((ext_vector_type(8)));
__device__ __forceinline__ void mfma_f8(f32x4& c, const i32x8_t a, const i32x8_t b) {
#if !defined(__HIP_DEVICE_COMPILE__)
    (void)c; (void)a; (void)b;
#elif defined(MK_F8_UNSCALED)
    asm volatile("v_mfma_f32_16x16x128_f8f6f4 %0, %1, %2, %0" : "+v"(c) : "v"(a), "v"(b));
#else
    const int one = F8_ONE; asm volatile("v_mfma_scale_f32_16x16x128_f8f6f4 %0, %1, %2, %0, %3, %3 op_sel_hi:[0,0,0]" : "+v"(c) : "v"(a), "v"(b), "v"(one));
#endif
}
template <class P, class = void> struct is_f8 { static constexpr bool value = false; };
template <class P> struct is_f8<P, decltype((void)P::F8)> { static constexpr bool value = P::F8; };

template <class P>
__device__ __forceinline__ void gemm_phase(LAS unsigned char* lds, const P& p, int cu = -1) {
    int tid = threadIdx.x; asm volatile("" : "+v"(tid));
    const int wid = __builtin_amdgcn_readfirstlane(tid >> 6), lane = tid & 63, wr = wid >> 2, wc = wid & 3, fr = lane & 15, fq = lane >> 4;
    int K = p.K(); asm volatile("" : "+s"(K));
    const int nt = K / BK;
    const unsigned lda = p.lda(), ldb = p.ldb();
    const int G = gridDim.x, c = cu < 0 ? (int)blockIdx.x : cu, nwg = p.nunits();
    if (c >= nwg) return;
    unsigned voffA[2], voffB[2], cA2[2]; int RA[2];
#pragma unroll
    for (int i = 0; i < 2; ++i) { int R, C; stage_rc(tid * 16 + i * 8192, R, C); const int Rb = P::PERM ? ((R & ~31) + perm32(R & 31)) : R;
        RA[i] = R; cA2[i] = (unsigned)C * 2u; voffA[i] = (unsigned)R * lda + (unsigned)C * 2u; voffB[i] = (unsigned)Rb * ldb + (unsigned)C * 2u; }
    const size_t hstepA = (size_t)HALF * lda, hstepB = (size_t)HALF * ldb;
    const unsigned ldsw = (unsigned)wid * 1024u;
    const int aoff = lds_byte(wr * 64 + fr, fq * 8), boff = lds_byte(wc * 32 + fr, fq * 8);
    struct Src { const char* a; const char* b; unsigned ga[2][2]; };
    const char* araw = P::GATHER ? p.araw() : nullptr;
#define GM_GLDS(gp, lp) __builtin_amdgcn_global_load_lds((const unsigned*)(gp), (LAS unsigned*)(lp), 16, 0, 0)
#define GM_SA(b, h) (((b) * 2 + (h)) * HTB)
#define GM_SB(b, h) ((4 + (b) * 2 + (h)) * HTB)
#define GM_STAGE_B(bufoff, ptr) do { GM_GLDS((ptr) + voffB[0], lds + (bufoff) + ldsw); GM_GLDS((ptr) + voffB[1], lds + (bufoff) + ldsw + 8192); } while (0)
#define GM_STAGE_A(bufoff, S, h, koff) do { if constexpr (P::GATHER) { GM_GLDS(araw + (S).ga[h][0] + (koff), lds + (bufoff) + ldsw); GM_GLDS(araw + (S).ga[h][1] + (koff), lds + (bufoff) + ldsw + 8192); } \
        else if constexpr (P::AZERO) { const size_t ko_ = (size_t)(koff); const char* ab_ = ((ko_ >= 256) == ((h) == 1)) ? (S).a + (size_t)(h) * hstepA + (ko_ & 255) : p.zero_base(); \
            GM_GLDS(ab_ + voffA[0], lds + (bufoff) + ldsw); GM_GLDS(ab_ + voffA[1], lds + (bufoff) + ldsw + 8192); } \
        else { GM_GLDS((S).a + (size_t)(h) * hstepA + (koff) + voffA[0], lds + (bufoff) + ldsw); GM_GLDS((S).a + (size_t)(h) * hstepA + (koff) + voffA[1], lds + (bufoff) + ldsw + 8192); } } while (0)
#define GM_LDA(dst, b, h) do { _Pragma("unroll") for (int m = 0; m < 4; ++m) _Pragma("unroll") for (int k = 0; k < 2; ++k) dst[m][k] = *(const LAS bf16x8*)(lds + GM_SA(b, h) + aoff + m * 2048 + k * 1024); } while (0)
#define GM_LDB(dst, b, h) do { _Pragma("unroll") for (int n = 0; n < 2; ++n) _Pragma("unroll") for (int k = 0; k < 2; ++k) dst[n][k] = *(const LAS bf16x8*)(lds + GM_SB(b, h) + boff + n * 2048 + k * 1024); } while (0)
#define GM_CAT8(X) __builtin_shufflevector(__builtin_bit_cast(i32x4_t, X[0]), __builtin_bit_cast(i32x4_t, X[1]), 0, 1, 2, 3, 4, 5, 6, 7)
#define GM_MMA(ai, bj, At, Bt) do { __builtin_amdgcn_s_setprio(1); _Pragma("unroll") for (int m = 0; m < 4; ++m) _Pragma("unroll") for (int n = 0; n < 2; ++n) { \
        if constexpr (is_f8<P>::value) mfma_f8(acc[ai][bj][m][n], GM_CAT8(Bt[n]), GM_CAT8(At[m])); \
        else { _Pragma("unroll") for (int k = 0; k < 2; ++k) acc[ai][bj][m][n] = __builtin_amdgcn_mfma_f32_16x16x32_bf16(Bt[n][k], At[m][k], acc[ai][bj][m][n], 0, 0, 0); } } __builtin_amdgcn_s_setprio(0); } while (0)
#define GM_WAIT_V(n) asm volatile("s_waitcnt vmcnt(" #n ")" ::: "memory")
#define GM_WAIT_L(n) asm volatile("s_waitcnt lgkmcnt(" #n ")" ::: "memory")
#define GM_BAR __builtin_amdgcn_s_barrier()
#define GM_SCHED __builtin_amdgcn_sched_barrier(0)
#define GM_LOAD_SRC(S, u) do { (S).a = p.abase(u); (S).b = p.bbase(u); if constexpr (P::GATHER) { const int* _ix = p.gidx(u); _Pragma("unroll") for (int _h = 0; _h < 2; ++_h) _Pragma("unroll") for (int _i = 0; _i < 2; ++_i) \
        (S).ga[_h][_i] = (unsigned)_ix[_h * HALF + RA[_i]]; } } while (0)
#define GM_ADOPT(D, S) do { (D).a = (S).a; (D).b = (S).b; if constexpr (P::GATHER) { _Pragma("unroll") for (int _h = 0; _h < 2; ++_h) _Pragma("unroll") for (int _i = 0; _i < 2; ++_i) (D).ga[_h][_i] = (S).ga[_h][_i] * lda + cA2[_i]; } } while (0)
    Unit cur, nxt, nx2; int ui = 0;
    p.unit(xcd_remap(c, nwg), cur);
    Src cs, ns, fs;
    GM_LOAD_SRC(fs, cur); GM_ADOPT(cs, fs);
    bool has_next = ((long)G + c) < (long)nwg;
    if (has_next) { p.unit(xcd_remap(G + c, nwg), nxt); GM_LOAD_SRC(ns, nxt); } else { nxt = cur; ns = fs; }
    Acc acc;
#pragma unroll
    for (int a = 0; a < 2; ++a)
#pragma unroll
        for (int b = 0; b < 2; ++b)
#pragma unroll
            for (int m = 0; m < 4; ++m)
#pragma unroll
                for (int n = 0; n < 2; ++n) acc[a][b][m][n] = (f32x4){0.f, 0.f, 0.f, 0.f};
    bf16x8 At[4][2], B0[2][2], B1[2][2];
    GM_STAGE_B(GM_SB(0, 0), cs.b); GM_STAGE_B(GM_SB(0, 1), cs.b + hstepB); GM_STAGE_A(GM_SA(0, 0), cs, 0, 0); GM_STAGE_A(GM_SA(0, 1), cs, 1, 0);
    if (wr == 1) GM_BAR;
    GM_WAIT_V(2); GM_BAR;
    GM_STAGE_B(GM_SB(1, 0), cs.b + 128); GM_STAGE_A(GM_SA(1, 0), cs, 0, 128); GM_STAGE_B(GM_SB(1, 1), cs.b + hstepB + 128);
    GM_WAIT_V(6); GM_BAR;
    for (;;) {
#pragma clang loop unroll(disable)
        for (int t = 0; t < nt; t += 2) {
            const bool last = (t == nt - 2);
            GM_LDB(B0, 0, 0); GM_LDB(B1, 0, 1); GM_SCHED; GM_LDA(At, 0, 0); GM_STAGE_A(GM_SA(1, 1), cs, 1, (size_t)(t + 1) * 128);
            GM_WAIT_V(8); GM_WAIT_L(0); GM_BAR; GM_MMA(0, 0, At, B0); GM_MMA(0, 1, At, B1); GM_BAR; GM_SCHED;
            size_t kb;
            if (last) {
                if constexpr (P::GATHER) { asm volatile("" : "+v"(ns.ga[0][0]), "+v"(ns.ga[0][1]), "+v"(ns.ga[1][0]), "+v"(ns.ga[1][1])); }
                GM_ADOPT(cs, ns); kb = 0; } else kb = (size_t)(t + 2) * 128;
            GM_LDA(At, 0, 1); GM_STAGE_B(GM_SB(0, 0), cs.b + kb); GM_STAGE_B(GM_SB(0, 1), cs.b + hstepB + kb); GM_STAGE_A(GM_SA(0, 0), cs, 0, kb);
            GM_WAIT_V(8); GM_WAIT_L(0); GM_BAR; GM_MMA(1, 0, At, B0); GM_MMA(1, 1, At, B1); GM_BAR; GM_SCHED;
            GM_LDB(B0, 1, 0); GM_LDB(B1, 1, 1); GM_SCHED; GM_LDA(At, 1, 0); GM_STAGE_A(GM_SA(0, 1), cs, 1, kb);
            GM_WAIT_V(8); GM_WAIT_L(0); GM_BAR; GM_MMA(0, 0, At, B0); GM_MMA(0, 1, At, B1); GM_BAR; GM_SCHED;
            GM_LDA(At, 1, 1); GM_STAGE_B(GM_SB(1, 0), cs.b + kb + 128); GM_STAGE_B(GM_SB(1, 1), cs.b + hstepB + kb + 128); GM_STAGE_A(GM_SA(1, 0), cs, 0, kb + 128);
            GM_WAIT_V(8); GM_WAIT_L(0); GM_BAR; GM_MMA(1, 0, At, B0); GM_MMA(1, 1, At, B1); GM_BAR; GM_SCHED;
        }
        bool has_nx2 = false;
        if (has_next) { const long L2 = (long)(ui + 2) * G + c; has_nx2 = L2 < (long)nwg; if (has_nx2) { p.unit(xcd_remap((int)L2, nwg), nx2); GM_LOAD_SRC(ns, nx2); } }
        if constexpr (is_f8<P>::value) asm volatile("s_nop 7\n\ts_nop 7\n\ts_nop 7" ::: "memory");
        if (wr == 0) GM_BAR;
        { int t2 = threadIdx.x; asm volatile("" : "+v"(t2));
          const int w2 = __builtin_amdgcn_readfirstlane(t2 >> 6), l2 = t2 & 63; p.epi(acc, cur, w2 >> 2, w2 & 3, l2 & 15, l2 >> 4); }
        if (!has_next) break;
#pragma unroll
        for (int a = 0; a < 2; ++a)
#pragma unroll
            for (int b = 0; b < 2; ++b)
#pragma unroll
                for (int m = 0; m < 4; ++m)
#pragma unroll
                    for (int n = 0; n < 2; ++n) acc[a][b][m][n] = (f32x4){0.f, 0.f, 0.f, 0.f};
        cur = nxt; nxt = nx2; has_next = has_nx2; ++ui;
        if (wr == 1) GM_BAR;
    }
    GM_WAIT_V(0);
    GM_BAR;
#undef GM_GLDS
#undef GM_SA
#undef GM_SB
#undef GM_STAGE_A
#undef GM_STAGE_B
#undef GM_LDA
#undef GM_LDB
#undef GM_MMA
#undef GM_CAT8
#undef GM_WAIT_V
#undef GM_WAIT_L
#undef GM_BAR
#undef GM_SCHED
#undef GM_LOAD_SRC
}
}

namespace gm {
constexpr int ES = 4608;
__device__ __forceinline__ size_t kv_row0(int pm) { return pm < 128 ? (size_t)(pm >> 3) * KVL + CTXL + (size_t)(pm & 7) * 256 : (size_t)(pm - 128) * KVL; }
__device__ __forceinline__ u32x4 pack8(const f32x4 a, const f32x4 b) { u32x4 w; w.x = cvt_pk_bf16(a[0], a[1]); w.y = cvt_pk_bf16(a[2], a[3]); w.z = cvt_pk_bf16(b[0], b[1]); w.w = cvt_pk_bf16(b[2], b[3]); return w; }
#define GM_NOGATHER static constexpr bool AZERO = false; __device__ __forceinline__ const char* zero_base() const { return nullptr; } __device__ __forceinline__ const char* araw() const { return nullptr; } __device__ __forceinline__ const int* gidx(const Unit&) const { return nullptr; }
#define GM_DEV __device__ __forceinline__

struct P_QKV0 {
    static constexpr bool PERM = false, GATHER = false;
    const char* A; const char* B; bf16_t* q; bf16_t* k; bf16_t* v; const float* ropeC; const float* ropeS;
    GM_DEV int K() const { return 1024; } GM_DEV unsigned lda() const { return 2048; } GM_DEV unsigned ldb() const { return 2048; }
    GM_DEV int nunits() const { return 144 * 12; }
    GM_DEV void unit(int w, Unit& u) const { u.z = 0; tile_of(w, 144, 12, u.pm, u.pn); }
    GM_DEV const char* abase(const Unit& u) const { return A + (size_t)u.pm * 256 * 2048; }
    GM_DEV const char* bbase(const Unit& u) const { return B + (size_t)u.pn * 256 * 2048; }
    GM_NOGATHER
    GM_DEV void rope_store(Acc& acc, bf16_t* dst, const Unit& u, bool is_ctx, int wr, int wc, int fr, int fq) const {
        constexpr size_t rstride = 128, cstride = (size_t)KVL * 128;
        const int par = wc & 1;
#pragma unroll
        for (int ai = 0; ai < 2; ++ai)
#pragma unroll
            for (int m = 0; m < 4; ++m) { const int rl = ai * 128 + wr * 64 + m * 16 + fr;
                f32x4 c4 = (f32x4){1.f, 1.f, 1.f, 1.f}, s4 = (f32x4){0.f, 0.f, 0.f, 0.f};
                if (!is_ctx) { const int t = (u.pm & 7) * 256 + rl, pos = par ? (t & 63) : (t >> 6); c4 = *(const f32x4*)(ropeC + pos * 16 + 4 * fq); s4 = *(const f32x4*)(ropeS + pos * 16 + 4 * fq); }
#pragma unroll
                for (int bj = 0; bj < 2; ++bj) { const f32x4 x1 = acc[ai][bj][m][0], x2 = acc[ai][bj][m][1];
                    *(u32x4*)(dst + (size_t)rl * rstride + (size_t)bj * cstride) = pack8(x1 * c4 - x2 * s4, x1 * s4 + x2 * c4); }
                __builtin_amdgcn_sched_barrier(0); }
    }
    GM_DEV void epi(Acc& acc, const Unit& u, int wr, int wc, int fr, int fq) const {
        const int sect = u.pn >> 2, colt = (u.pn & 3) * 256; const bool is_ctx = u.pm >= 128;
        const int b = u.pm < 128 ? (u.pm >> 3) : (u.pm - 128); const size_t key0 = u.pm < 128 ? (size_t)CTXL + (size_t)(u.pm & 7) * 256 : 0;
        if (sect < 2) {
            bf16_t* d0 = q + (size_t)sect * (size_t)(k - q) + (((size_t)b * 8 + (colt >> 7)) * KVL + key0) * 128;
            rope_store(acc, d0 + wc * 32 + 8 * fq, u, is_ctx, wr, wc, fr, fq);
        } else {
            bf16_t* dst = v + (((size_t)b * 8 + (colt >> 7)) * KVL + key0) * 128 + wc * 32 + 4 * fq;
#pragma unroll
            for (int ai = 0; ai < 2; ++ai)
#pragma unroll
                for (int m = 0; m < 4; ++m) { const int rl = ai * 128 + wr * 64 + m * 16 + fr;
#pragma unroll
                    for (int bj = 0; bj < 2; ++bj)
#pragma unroll
                        for (int n = 0; n < 2; ++n) { const f32x4 x = acc[ai][bj][m][n]; u32x2 w; w.x = cvt_pk_bf16(x[0], x[1]); w.y = cvt_pk_bf16(x[2], x[3]);
                            *(u32x2*)(dst + (size_t)bj * KVL * 128 + (size_t)rl * 128 + 16 * n) = w; } }
        }
    }
};
struct P_QKV2 {
    static constexpr bool PERM = true, GATHER = false;
    const char* A; const char* B; bf16_t* q; bf16_t* k; bf16_t* v;
    GM_DEV int K() const { return 1024; } GM_DEV unsigned lda() const { return 2048; } GM_DEV unsigned ldb() const { return 2048; }
    GM_DEV int nunits() const { return 144 * 12; }
    GM_DEV void unit(int w, Unit& u) const { u.z = 0; tile_of(w, 144, 12, u.pm, u.pn); }
    GM_DEV const char* abase(const Unit& u) const { return A + (size_t)u.pm * 256 * 2048; }
    GM_DEV const char* bbase(const Unit& u) const { return B + (size_t)u.pn * 256 * 2048; }
    GM_NOGATHER
    GM_DEV void epi(Acc& acc, const Unit& u, int wr, int wc, int fr, int fq) const {
        const int sect = u.pn >> 2, colt = (u.pn & 3) * 256; const bool is_ctx = u.pm >= 128;
        if (sect == 0 && is_ctx) return;
        bf16_t* dst = sect == 0 ? q + (size_t)u.pm * 256 * 1024 : (sect == 1 ? k : v) + kv_row0(u.pm) * 1024;
#pragma unroll
        for (int ai = 0; ai < 2; ++ai)
#pragma unroll
            for (int m = 0; m < 4; ++m) { const int rl = ai * 128 + wr * 64 + m * 16 + fr;
#pragma unroll
                for (int bj = 0; bj < 2; ++bj) *(u32x4*)(dst + (size_t)rl * 1024 + colt + bj * 128 + wc * 32 + 8 * fq) = pack8(acc[ai][bj][m][0], acc[ai][bj][m][1]); }
    }
};
struct P_OUT {
    static constexpr bool PERM = true, GATHER = false;
    const char* A; const char* B; unsigned lda_; int K_, nM;
    bf16_t* xb_; bf16_t* cb_; const float* gate;
    GM_DEV int K() const { return K_; } GM_DEV unsigned lda() const { return lda_; } GM_DEV unsigned ldb() const { return (unsigned)K_ * 2u; }
    GM_DEV int nunits() const { return nM * 4; }
    GM_DEV void unit(int w, Unit& u) const { u.z = 0; tile_of(w, nM, 4, u.pm, u.pn); }
    GM_DEV const char* abase(const Unit& u) const { return A + (size_t)u.pm * 256 * lda_; }
    GM_DEV const char* bbase(const Unit& u) const { return B + (size_t)u.pn * 256 * (size_t)K_ * 2; }
    GM_NOGATHER
    GM_DEV void epi(Acc& acc, const Unit& u, int wr, int wc, int fr, int fq) const {
        const bool is_ctx = u.pm >= 128;
        const size_t t0 = is_ctx ? (size_t)(u.pm - 128) * 256 * 1024 : (size_t)u.pm * 256 * 1024;
        bf16_t* xs = (is_ctx ? cb_ : xb_) + t0;
        const int col0 = u.pn * 256 + wc * 32 + 8 * fq;
        const float* g = gate + (size_t)(is_ctx ? 16 : (u.pm >> 3)) * MODW + col0;
        f32x4 gv[2][2];
#pragma unroll
        for (int bj = 0; bj < 2; ++bj)
#pragma unroll
            for (int n = 0; n < 2; ++n) gv[bj][n] = *(const f32x4*)(g + bj * 128 + 4 * n);
        u32x4 xh[2][2];
#define PO_LOAD(slot, off_) do { _Pragma("unroll") for (int bj = 0; bj < 2; ++bj) xh[slot][bj] = *(const u32x4*)(xs + (off_) + bj * 128); } while (0)
        PO_LOAD(0, (size_t)(wr * 64 + fr) * 1024 + col0);
#pragma unroll
        for (int q = 0; q < 8; ++q) { const int ai = q >> 2, m = q & 3; const size_t off = (size_t)(ai * 128 + wr * 64 + m * 16 + fr) * 1024 + col0;
            if (q + 1 < 8) { const size_t off2 = (size_t)(((q + 1) >> 2) * 128 + wr * 64 + ((q + 1) & 3) * 16 + fr) * 1024 + col0; PO_LOAD((q + 1) & 1, off2); }
#pragma unroll
            for (int bj = 0; bj < 2; ++bj) { const u32x4 w = xh[q & 1][bj];
                const f32x4 x0 = (f32x4){bf_lo(w.x), bf_hi(w.x), bf_lo(w.y), bf_hi(w.y)}, x1 = (f32x4){bf_lo(w.z), bf_hi(w.z), bf_lo(w.w), bf_hi(w.w)};
                *(u32x4*)(xs + off + bj * 128) = pack8(x0 + gv[bj][0] * acc[ai][bj][m][0], x1 + gv[bj][1] * acc[ai][bj][m][1]); } }
#undef PO_LOAD
    }
};
struct P_GU {
    static constexpr bool PERM = true, GATHER = true, AZERO = false, F8 = true;
    GM_DEV const char* zero_base() const { return nullptr; }
    const char* hx; const char* W; unsigned char* hid; const int* slot_row; int nM;
    GM_DEV int K() const { return 512; } GM_DEV unsigned lda() const { return 1024; } GM_DEV unsigned ldb() const { return 1024; }
    GM_DEV int nunits() const { return NE * nM * 8; }
    GM_DEV void unit(int w, Unit& u) const { const int per = nM * 8; u.z = w / per; tile_of(w - u.z * per, nM, 8, u.pm, u.pn); }
    GM_DEV const char* abase(const Unit&) const { return hx; }
    GM_DEV const char* bbase(const Unit& u) const { return W + ((size_t)u.z * 2048 + (size_t)u.pn * 256) * 1024; }
    GM_DEV const char* araw() const { return hx; }
    GM_DEV const int* gidx(const Unit& u) const { return slot_row + u.z * ES + u.pm * 256; }
    GM_DEV void epi(Acc& acc, const Unit& u, int wr, int wc, int fr, int fq) const {
        unsigned char* dst = hid + ((size_t)u.z * ES + (size_t)u.pm * 256) * 1024 + u.pn * 128 + wc * 32 + 8 * fq;
        constexpr float ds = 1.0f / (F8_SX * F8_SW), c1 = -1.4426950408889634f * ds, kk = 1.0f / (F8_SH * ds * ds);
#pragma unroll
        for (int ai = 0; ai < 2; ++ai)
#pragma unroll
            for (int m = 0; m < 4; ++m) { const int rl = ai * 128 + wr * 64 + m * 16 + fr; f32x4 h[2];
#pragma unroll
                for (int n = 0; n < 2; ++n) { const f32x4 ag = acc[ai][0][m][n], au = acc[ai][1][m][n]; const f32x4 t = ag * c1; f32x4 e;
#pragma unroll
                    for (int j = 0; j < 4; ++j) e[j] = __builtin_amdgcn_exp2f(t[j]);
                    const f32x4 d = __builtin_elementwise_fma(e, (f32x4){kk, kk, kk, kk}, (f32x4){kk, kk, kk, kk}); f32x4 r;
#pragma unroll
                    for (int j = 0; j < 4; ++j) r[j] = __builtin_amdgcn_rcpf(d[j]);
                    h[n] = (ag * au) * r; }
                u32x2 w; w.x = pk4_fp8(h[0][0], h[0][1], h[0][2], h[0][3]); w.y = pk4_fp8(h[1][0], h[1][1], h[1][2], h[1][3]);
                *(u32x2*)(dst + (size_t)rl * 1024) = w; }
    }
};
struct P_DOWN {
    static constexpr bool PERM = true, GATHER = false, F8 = true;
    const char* hid; const char* W; bf16_t* ys; const float* slot_aff; int nM;
    GM_DEV int K() const { return 512; } GM_DEV unsigned lda() const { return 1024; } GM_DEV unsigned ldb() const { return 1024; }
    GM_DEV int nunits() const { return NE * nM * 4; }
    GM_DEV void unit(int w, Unit& u) const { const int per = nM * 4; u.z = w / per; tile_of(w - u.z * per, nM, 4, u.pm, u.pn); }
    GM_DEV const char* abase(const Unit& u) const { return hid + ((size_t)u.z * ES + (size_t)u.pm * 256) * 1024; }
    GM_DEV const char* bbase(const Unit& u) const { return W + ((size_t)u.z * 1024 + (size_t)u.pn * 256) * 1024; }
    GM_NOGATHER
    GM_DEV void epi(Acc& acc, const Unit& u, int wr, int wc, int fr, int fq) const {
        const size_t r0 = (size_t)u.z * ES + (size_t)u.pm * 256;
        unsigned char* dst8 = (unsigned char*)ys + r0 * 1024 + u.pn * 256 + wc * 32 + 8 * fq;
        float af[2][4];
#pragma unroll
        for (int ai = 0; ai < 2; ++ai)
#pragma unroll
            for (int m = 0; m < 4; ++m) af[ai][m] = slot_aff[r0 + ai * 128 + wr * 64 + m * 16 + fr];
#pragma unroll
        for (int ai = 0; ai < 2; ++ai)
#pragma unroll
            for (int m = 0; m < 4; ++m) { const int rl = ai * 128 + wr * 64 + m * 16 + fr; const float a = af[ai][m];
#pragma unroll
                for (int bj = 0; bj < 2; ++bj) { const f32x4 y0 = acc[ai][bj][m][0] * (a * (32.0f / (F8_SH * F8_SW))), y1 = acc[ai][bj][m][1] * (a * (32.0f / (F8_SH * F8_SW)));
                    int w0 = 0, w1 = 0;
                    w0 = __builtin_amdgcn_cvt_pk_fp8_f32(__builtin_amdgcn_fmed3f(y0[0], -440.f, 440.f), __builtin_amdgcn_fmed3f(y0[1], -440.f, 440.f), w0, false);
                    w0 = __builtin_amdgcn_cvt_pk_fp8_f32(__builtin_amdgcn_fmed3f(y0[2], -440.f, 440.f), __builtin_amdgcn_fmed3f(y0[3], -440.f, 440.f), w0, true);
                    w1 = __builtin_amdgcn_cvt_pk_fp8_f32(__builtin_amdgcn_fmed3f(y1[0], -440.f, 440.f), __builtin_amdgcn_fmed3f(y1[1], -440.f, 440.f), w1, false);
                    w1 = __builtin_amdgcn_cvt_pk_fp8_f32(__builtin_amdgcn_fmed3f(y1[2], -440.f, 440.f), __builtin_amdgcn_fmed3f(y1[3], -440.f, 440.f), w1, true);
                    u32x2 w; w.x = (unsigned)w0; w.y = (unsigned)w1; *(u32x2*)(dst8 + (size_t)rl * 1024 + bj * 128) = w; } }
    }
};
struct P_GMU {
    static constexpr bool PERM = true, GATHER = false;
    const char* hx; const char* W; bf16_t* u_out;
    GM_DEV int K() const { return 1024; } GM_DEV unsigned lda() const { return 2048; } GM_DEV unsigned ldb() const { return 2048; }
    GM_DEV int nunits() const { return 1152; }
    GM_DEV void unit(int w, Unit& u) const { u.z = 0; tile_of(w, 144, 8, u.pm, u.pn); }
    GM_DEV const char* abase(const Unit& u) const { return hx + (size_t)u.pm * 256 * 2048; }
    GM_DEV const char* bbase(const Unit& u) const { return W + (size_t)u.pn * 256 * 2048; }
    GM_NOGATHER
    GM_DEV void epi(Acc& acc, const Unit& u, int wr, int wc, int fr, int fq) const {
        bf16_t* dst = u_out + (size_t)u.pm * 256 * 2048 + u.pn * 256 + wc * 32 + 8 * fq;
#pragma unroll
        for (int ai = 0; ai < 2; ++ai)
#pragma unroll
            for (int m = 0; m < 4; ++m) { const int rl = ai * 128 + wr * 64 + m * 16 + fr;
#pragma unroll
                for (int bj = 0; bj < 2; ++bj) { const f32x4 g0 = gelu_tanh4(acc[ai][bj][m][0]), g1 = gelu_tanh4(acc[ai][bj][m][1]);
                    *(u32x4*)(dst + (size_t)rl * 2048 + bj * 128) = pack8(g0, g1); }
                __builtin_amdgcn_sched_barrier(0); }
    }
};
struct P_GMV {
    static constexpr bool PERM = true, GATHER = false;
    const char* hx; const char* W; bf16_t* vT; float* sumsq;
    GM_DEV int K() const { return 1024; } GM_DEV unsigned lda() const { return 2048; } GM_DEV unsigned ldb() const { return 2048; }
    GM_DEV int nunits() const { return 1152; }
    GM_DEV void unit(int w, Unit& u) const { u.z = 0; tile_of(w, 8, 144, u.pm, u.pn); }
    GM_DEV const char* abase(const Unit& u) const { return W + (size_t)(2048 + u.pm * 256) * 2048; }
    GM_DEV const char* bbase(const Unit& u) const { return hx + (size_t)u.pn * 256 * 2048; }
    GM_NOGATHER
    GM_DEV void epi(Acc& acc, const Unit& u, int wr, int wc, int fr, int fq) const {
        const bool is_ctx = u.pn >= 128; const int b = is_ctx ? u.pn - 128 : (u.pn >> 3);
        const int tok0 = is_ctx ? 0 : CTXL + (u.pn & 7) * 256, grow0 = is_ctx ? NLAT + b * CTXL : b * SEQ + (u.pn & 7) * 256;
        bf16_t* dst = vT + ((size_t)b * 2048 + (size_t)u.pm * 256) * KVL + tok0 + wc * 32 + 8 * fq;
#pragma unroll
        for (int bj = 0; bj < 2; ++bj) {
            f32x4 s0 = (f32x4){0.f, 0.f, 0.f, 0.f}, s1 = (f32x4){0.f, 0.f, 0.f, 0.f};
#pragma unroll
            for (int ai = 0; ai < 2; ++ai)
#pragma unroll
                for (int m = 0; m < 4; ++m) { const int rl = ai * 128 + wr * 64 + m * 16 + fr; const f32x4 g0 = gelu_tanh4(acc[ai][bj][m][0]), g1 = gelu_tanh4(acc[ai][bj][m][1]);
                    *(u32x4*)(dst + (size_t)rl * KVL + bj * 128) = pack8(g0, g1); s0 += g0 * g0; s1 += g1 * g1;
                    __builtin_amdgcn_sched_barrier(0); }
#pragma unroll
            for (int j = 0; j < 4; ++j) { float a = s0[j], c = s1[j];
                a += __shfl_xor(a, 1); a += __shfl_xor(a, 2); a += __shfl_xor(a, 4); a += __shfl_xor(a, 8);
                c += __shfl_xor(c, 1); c += __shfl_xor(c, 2); c += __shfl_xor(c, 4); c += __shfl_xor(c, 8);
                if (fr == 0) { float* pp = sumsq + (size_t)(grow0 + bj * 128 + wc * 32 + 8 * fq + j) * 16 + u.pm * 2 + wr; pp[0] = a; pp[64] = c; } }
        }
    }
};
struct P_SPAT {
    static constexpr bool PERM = true, GATHER = false, AZERO = true;
    const char* App; const char* vT; bf16_t* u_io; const float* v_g; const float* b_s; const char* zeros;
    GM_DEV const char* zero_base() const { return zeros; } GM_DEV const char* araw() const { return nullptr; } GM_DEV const int* gidx(const Unit&) const { return nullptr; }
    GM_DEV int K() const { return 256; } GM_DEV unsigned lda() const { return 256; } GM_DEV unsigned ldb() const { return KVL * 2; }
    GM_DEV int nunits() const { return NB * 9 * 8; }
    GM_DEV void unit(int w, Unit& u) const { u.z = w; u.pm = 0; u.pn = 0; }
    GM_DEV const char* abase(const Unit& u) const { return App + (size_t)u.z * 65536; }
    GM_DEV const char* bbase(const Unit& u) const { const int g = u.z & 7, bc = u.z >> 3, b = bc / 9, cp = bc - b * 9; return vT + (((size_t)b * 2048 + (size_t)g * 256) * KVL + (size_t)cp * 256) * 2; }
    GM_DEV void epi(Acc& acc, const Unit& u, int wr, int wc, int fr, int fq) const {
        const int g = u.z & 7, bc = u.z >> 3, b = bc / 9, cp = bc - b * 9;
        const size_t trow0 = cp == 0 ? (size_t)NLAT + (size_t)b * CTXL : (size_t)b * SEQ + (size_t)(cp - 1) * 256;
        const int ch0 = g * 256 + wc * 32 + 8 * fq;
        f32x4 vg[2][2];
#pragma unroll
        for (int bj = 0; bj < 2; ++bj)
#pragma unroll
            for (int n = 0; n < 2; ++n) vg[bj][n] = *(const f32x4*)(v_g + ch0 + bj * 128 + 4 * n);
        float bsv[8];
#pragma unroll
        for (int q = 0; q < 8; ++q) bsv[q] = b_s[g * 128 + (((q >> 2) * 128 + wr * 64 + (q & 3) * 16 + fr) & 127)];
        u32x4 ub[2][2];
#pragma unroll
        for (int bj = 0; bj < 2; ++bj) ub[0][bj] = *(const u32x4*)(u_io + (trow0 + wr * 64 + fr) * 2048 + ch0 + bj * 128);
#pragma unroll
        for (int q = 0; q < 8; ++q) { const int ai = q >> 2, m = q & 3, rl = ai * 128 + wr * 64 + m * 16 + fr; const float bs = bsv[q];
            bf16_t* up = u_io + (trow0 + rl) * 2048 + ch0;
            if (q + 1 < 8) { const int rl2 = ((q + 1) >> 2) * 128 + wr * 64 + ((q + 1) & 3) * 16 + fr;
#pragma unroll
                for (int bj = 0; bj < 2; ++bj) ub[(q + 1) & 1][bj] = *(const u32x4*)(u_io + (trow0 + rl2) * 2048 + ch0 + bj * 128); }
#pragma unroll
            for (int bj = 0; bj < 2; ++bj) { const u32x4 uw = ub[q & 1][bj];
                const f32x4 u0 = (f32x4){bf_lo(uw.x), bf_hi(uw.x), bf_lo(uw.y), bf_hi(uw.y)}, u1 = (f32x4){bf_lo(uw.z), bf_hi(uw.z), bf_lo(uw.w), bf_hi(uw.w)};
                *(u32x4*)(up + bj * 128) = pack8(u0 * (acc[ai][bj][m][0] * vg[bj][0] + bs), u1 * (acc[ai][bj][m][1] * vg[bj][1] + bs)); } }
    }
};
constexpr int PQ_LD = 2176;
struct P_CDFT {
    static constexpr bool PERM = true, GATHER = false;
    const char* CS; const char* hx; bf16_t* PQt;
    GM_DEV int K() const { return 256; } GM_DEV unsigned lda() const { return 512; } GM_DEV unsigned ldb() const { return 2048; }
    GM_DEV int nunits() const { return 4 * NB * 9; }
    GM_DEV void unit(int w, Unit& u) const { u.z = w / (NB * 9); const int r = w - u.z * (NB * 9); u.pn = r; const int tt = r % 9; u.pm = (tt >= 4 && tt < 8) ? 1 : 0; }
    GM_DEV const char* abase(const Unit& u) const { return CS + (size_t)u.pm * 256 * 512; }
    GM_DEV const char* bbase(const Unit& u) const { return hx + (size_t)u.pn * 256 * 2048 + (size_t)u.z * 512; }
    GM_NOGATHER
    GM_DEV void epi(Acc& acc, const Unit& u, int wr, int wc, int fr, int fq) const {
        const int b = u.pn / 9, tt = u.pn - b * 9;
        bf16_t* dst = PQt + ((size_t)b * 1024 + (size_t)u.z * 256) * PQ_LD + tt * 256 + wc * 32 + 8 * fq;
#pragma unroll
        for (int ai = 0; ai < 2; ++ai)
#pragma unroll
            for (int m = 0; m < 4; ++m) { const int rl = ai * 128 + wr * 64 + m * 16 + fr;
#pragma unroll
                for (int bj = 0; bj < 2; ++bj) { if (tt == 8 && bj == 1) continue;
                    *(u32x4*)(dst + (size_t)rl * PQ_LD + bj * 128) = pack8(acc[ai][bj][m][0] * 0.0625f, acc[ai][bj][m][1] * 0.0625f); } }
    }
};
struct P_PDFT {
    static constexpr bool PERM = true, GATHER = false;
    const char* DP; const char* PQt; bf16_t* f;
    GM_DEV int K() const { return PQ_LD; } GM_DEV unsigned lda() const { return PQ_LD * 2; } GM_DEV unsigned ldb() const { return PQ_LD * 2; }
    GM_DEV int nunits() const { return 512; }
    GM_DEV void unit(int w, Unit& u) const { u.z = w >> 5; tile_of(w & 31, 8, 4, u.pm, u.pn); }
    GM_DEV const char* abase(const Unit& u) const { return DP + (size_t)u.pm * 256 * (PQ_LD * 2); }
    GM_DEV const char* bbase(const Unit& u) const { return PQt + ((size_t)u.z * 1024 + (size_t)u.pn * 256) * (PQ_LD * 2); }
    GM_NOGATHER
    GM_DEV void epi(Acc& acc, const Unit& u, int wr, int wc, int fr, int fq) const {
        bf16_t* dst = f + ((size_t)u.z * 2048 + (size_t)u.pm * 256) * 1024 + u.pn * 256 + wc * 32 + 8 * fq; const float sc = 0.022097086912079608f;
#pragma unroll
        for (int ai = 0; ai < 2; ++ai)
#pragma unroll
            for (int m = 0; m < 4; ++m) { const int rl = ai * 128 + wr * 64 + m * 16 + fr;
#pragma unroll
                for (int bj = 0; bj < 2; ++bj) *(u32x4*)(dst + (size_t)rl * 1024 + bj * 128) = pack8(acc[ai][bj][m][0] * sc, acc[ai][bj][m][1] * sc); }
    }
};
}

namespace at {
constexpr float SCALE = 0.125f;
constexpr float THR = 8.f;
#define AT_SBAR() __builtin_amdgcn_sched_barrier(0)
#define AT_KSWZ(row, colB) ((row) * 256 + ((colB) ^ (((row) & 7) << 4)))
#define AT_KSWZ64(row, colB) ((row) * 128 + ((colB) ^ ((((row) >> 1) & 7) << 4)))
__device__ __forceinline__ int crow(int r, int hi) { return (r & 3) + 8 * (r >> 2) + 4 * hi; }
__device__ __forceinline__ void partialSM(f32x16& p0, f32x16& p1, float& m_reg, float& mn, float& alpha) {
    constexpr float C = SCALE * 1.4426950408889634f;
    float pmax = p0[0];
#pragma unroll
    for (int r = 1; r < 16; ++r) pmax = fmaxf(pmax, p0[r]);
#pragma unroll
    for (int r = 0; r < 16; ++r) pmax = fmaxf(pmax, p1[r]);
    { auto rr = __builtin_amdgcn_permlane32_swap(__float_as_uint(pmax), __float_as_uint(pmax), false, false);
      pmax = fmaxf(__uint_as_float(rr[0]), __uint_as_float(rr[1])); }
    if (__builtin_expect(__all(pmax - m_reg <= THR / SCALE), 1)) { mn = m_reg; alpha = 1.f; }
    else { mn = fmaxf(m_reg, pmax); alpha = __builtin_amdgcn_exp2f((m_reg - mn) * C); m_reg = mn; }
    const float mnC = -mn * C;
#pragma unroll
    for (int r = 0; r < 16; ++r) p0[r] = fmaf(p0[r], C, mnC);
#pragma unroll
    for (int r = 0; r < 16; ++r) p1[r] = fmaf(p1[r], C, mnC);
#pragma unroll
    for (int r = 0; r < 16; ++r) p0[r] = __builtin_amdgcn_exp2f(p0[r]);
}
#define AT_PK4(P, BASE, OUT) do { unsigned a0 = cvt_pk_bf16(P[BASE + 0], P[BASE + 1]), a1 = cvt_pk_bf16(P[BASE + 2], P[BASE + 3]);   \
    unsigned b0 = cvt_pk_bf16(P[BASE + 4], P[BASE + 5]), b1 = cvt_pk_bf16(P[BASE + 6], P[BASE + 7]);                              \
    auto r0 = __builtin_amdgcn_permlane32_swap(a0, b0, false, false); auto r1 = __builtin_amdgcn_permlane32_swap(a1, b1, false, false); \
    u32x4 w = {r0[0], r1[0], r0[1], r1[1]}; OUT = *reinterpret_cast<bf16x8*>(&w); } while (0)
__device__ __forceinline__ void finishSM(f32x16& p0, f32x16& p1, float alpha, float& l_reg, bf16x8& pa0, bf16x8& pa1, bf16x8& pa2, bf16x8& pa3) {
#pragma unroll
    for (int r = 0; r < 16; ++r) p1[r] = __builtin_amdgcn_exp2f(p1[r]);
    float ps = 0;
#pragma unroll
    for (int r = 0; r < 16; ++r) ps += p0[r];
#pragma unroll
    for (int r = 0; r < 16; ++r) ps += p1[r];
    { auto rr = __builtin_amdgcn_permlane32_swap(__float_as_uint(ps), __float_as_uint(ps), false, false);
      ps = __uint_as_float(rr[0]) + __uint_as_float(rr[1]); }
    l_reg = l_reg * alpha + ps;
    AT_PK4(p0, 0, pa0); AT_PK4(p0, 8, pa1); AT_PK4(p1, 0, pa2); AT_PK4(p1, 8, pa3);
}
__device__ __forceinline__ void qkt64(f32x16& p0, f32x16& p1, const LAS char* Ks, const bf16x8* qr, int r32, int hi, int cb0) {
    p0 = f32x16{}; p1 = f32x16{};
    bf16x8 k0[4], k1[4];
#pragma unroll
    for (int d0 = 0; d0 < 4; ++d0) { const int cb = cb0 + (d0 * 16 + hi * 8) * 2;
        k0[d0] = *reinterpret_cast<const LAS bf16x8*>(Ks + AT_KSWZ(r32, cb)); k1[d0] = *reinterpret_cast<const LAS bf16x8*>(Ks + AT_KSWZ(32 + r32, cb)); }
    __builtin_amdgcn_sched_barrier(0);
#pragma unroll
    for (int d0 = 0; d0 < 4; ++d0) { p0 = __builtin_amdgcn_mfma_f32_32x32x16_bf16(k0[d0], qr[d0], p0, 0, 0, 0); p1 = __builtin_amdgcn_mfma_f32_32x32x16_bf16(k1[d0], qr[d0], p1, 0, 0, 0); }
}
template <int NCB> __device__ __forceinline__ int v_st(int k, int c) { const int kk = (k & ~0xC) | ((k & 4) << 1) | ((k & 8) >> 1); return ((kk >> 3) * NCB + (c >> 5)) * 512 + ((kk & 7) * 32 + (c & 31)) * 2; }
__device__ __forceinline__ int v_rd_base(int lane) { return ((lane & 3) << 3) | (((lane >> 2) & 3) << 6) | (((lane >> 4) & 1) << 5) | (((lane >> 5) & 1) << 8); }
template <int NCB> constexpr int v_rd_off(int d0, int ks, int half) { return d0 * 512 + ks * (NCB * 1024) + half * (NCB * 512); }
template <int OFF> __device__ __forceinline__ s16x4 tr_read(int vb) {
    return __builtin_amdgcn_ds_read_tr16_b64_v4i16((LAS s16x4*)(uintptr_t)(unsigned)(vb + OFF));
}
template <int NCB, int D0> __device__ __forceinline__ void pv_one(f32x16& od, int vb, bf16x8 pa0, bf16x8 pa1, bf16x8 pa2, bf16x8 pa3) {
    const s16x4 l0 = tr_read<v_rd_off<NCB>(D0, 0, 0)>(vb), h0 = tr_read<v_rd_off<NCB>(D0, 0, 1)>(vb), l1 = tr_read<v_rd_off<NCB>(D0, 1, 0)>(vb), h1 = tr_read<v_rd_off<NCB>(D0, 1, 1)>(vb);
    const s16x4 l2 = tr_read<v_rd_off<NCB>(D0, 2, 0)>(vb), h2 = tr_read<v_rd_off<NCB>(D0, 2, 1)>(vb), l3 = tr_read<v_rd_off<NCB>(D0, 3, 0)>(vb), h3 = tr_read<v_rd_off<NCB>(D0, 3, 1)>(vb);
#define AT_PK(L, H) (bf16x8){L[0], L[1], L[2], L[3], H[0], H[1], H[2], H[3]}
    od = __builtin_amdgcn_mfma_f32_32x32x16_bf16(pa0, AT_PK(l0, h0), od, 0, 0, 0);
    od = __builtin_amdgcn_mfma_f32_32x32x16_bf16(pa1, AT_PK(l1, h1), od, 0, 0, 0);
    od = __builtin_amdgcn_mfma_f32_32x32x16_bf16(pa2, AT_PK(l2, h2), od, 0, 0, 0);
    od = __builtin_amdgcn_mfma_f32_32x32x16_bf16(pa3, AT_PK(l3, h3), od, 0, 0, 0);
#undef AT_PK
}

template <int NCB, int D0>
__device__ __forceinline__ void pv_pair(f32x16& o0, f32x16& o1, int vb, bf16x8 pa0, bf16x8 pa1, bf16x8 pa2, bf16x8 pa3) {
    s16x4 l[2][4], h[2][4];
    l[0][0] = tr_read<v_rd_off<NCB>(D0, 0, 0)>(vb); h[0][0] = tr_read<v_rd_off<NCB>(D0, 0, 1)>(vb); l[0][1] = tr_read<v_rd_off<NCB>(D0, 1, 0)>(vb); h[0][1] = tr_read<v_rd_off<NCB>(D0, 1, 1)>(vb);
    l[0][2] = tr_read<v_rd_off<NCB>(D0, 2, 0)>(vb); h[0][2] = tr_read<v_rd_off<NCB>(D0, 2, 1)>(vb); l[0][3] = tr_read<v_rd_off<NCB>(D0, 3, 0)>(vb); h[0][3] = tr_read<v_rd_off<NCB>(D0, 3, 1)>(vb);
    l[1][0] = tr_read<v_rd_off<NCB>(D0 + 1, 0, 0)>(vb); h[1][0] = tr_read<v_rd_off<NCB>(D0 + 1, 0, 1)>(vb); l[1][1] = tr_read<v_rd_off<NCB>(D0 + 1, 1, 0)>(vb); h[1][1] = tr_read<v_rd_off<NCB>(D0 + 1, 1, 1)>(vb);
    l[1][2] = tr_read<v_rd_off<NCB>(D0 + 1, 2, 0)>(vb); h[1][2] = tr_read<v_rd_off<NCB>(D0 + 1, 2, 1)>(vb); l[1][3] = tr_read<v_rd_off<NCB>(D0 + 1, 3, 0)>(vb); h[1][3] = tr_read<v_rd_off<NCB>(D0 + 1, 3, 1)>(vb);
    __builtin_amdgcn_sched_barrier(0);
#define AT_PK(L, H) (bf16x8){L[0], L[1], L[2], L[3], H[0], H[1], H[2], H[3]}
    o0 = __builtin_amdgcn_mfma_f32_32x32x16_bf16(pa0, AT_PK(l[0][0], h[0][0]), o0, 0, 0, 0); o1 = __builtin_amdgcn_mfma_f32_32x32x16_bf16(pa0, AT_PK(l[1][0], h[1][0]), o1, 0, 0, 0);
    o0 = __builtin_amdgcn_mfma_f32_32x32x16_bf16(pa1, AT_PK(l[0][1], h[0][1]), o0, 0, 0, 0); o1 = __builtin_amdgcn_mfma_f32_32x32x16_bf16(pa1, AT_PK(l[1][1], h[1][1]), o1, 0, 0, 0);
    o0 = __builtin_amdgcn_mfma_f32_32x32x16_bf16(pa2, AT_PK(l[0][2], h[0][2]), o0, 0, 0, 0); o1 = __builtin_amdgcn_mfma_f32_32x32x16_bf16(pa2, AT_PK(l[1][2], h[1][2]), o1, 0, 0, 0);
    o0 = __builtin_amdgcn_mfma_f32_32x32x16_bf16(pa3, AT_PK(l[0][3], h[0][3]), o0, 0, 0, 0); o1 = __builtin_amdgcn_mfma_f32_32x32x16_bf16(pa3, AT_PK(l[1][3], h[1][3]), o1, 0, 0, 0);
#undef AT_PK
    __builtin_amdgcn_sched_barrier(0);
}
__device__ __forceinline__ void pv_batch2(f32x16& o0, f32x16& o1, int vb, bf16x8 pa0, bf16x8 pa1, bf16x8 pa2, bf16x8 pa3) { pv_pair<2, 0>(o0, o1, vb, pa0, pa1, pa2, pa3); }

constexpr int DA_LDS_V = 0, DA_LDS_K = 32768, DA_LDS_WS = 69632, DA_XPITCH = 132;
template <int VARIANT = 0>
__device__ __forceinline__ void diff_attn_unit(const bf16_t* __restrict__ Qb, const bf16_t* __restrict__ Kh, const bf16_t* __restrict__ Vh, bf16_t* __restrict__ Ob,
                                               int seq, float lam, float oscale, const float* __restrict__ subg, LAS char* lds) {
    constexpr int LDK = 128, SHM_V = 16384, SHM_K = 16384, KVBLK = 64;
    constexpr float C = SCALE * 1.4426950408889634f;
    int tid = threadIdx.x; asm volatile("" : "+v"(tid));
    const int wid = __builtin_amdgcn_readfirstlane(tid >> 6), lane = tid & 63, r32 = lane & 31, hi = lane >> 5, jh = wid >> 2, wq = wid & 3;
    LAS char* V_lds = lds + DA_LDS_V; LAS char* K_lds = lds + DA_LDS_K;
    LAS float* ws = (LAS float*)(lds + DA_LDS_WS) + wid * 64; LAS float* li_l = ws; LAS float* al_l = ws + 32;
    float m_reg = -1e30f, l_reg = 0.f, alpha = 1.f; f32x16 o[4] = {}; bf16x8 qr[4];
    const bf16_t* Qw = Qb + (size_t)(wq * 32 + r32) * 128 + jh * 64 + hi * 8;
#pragma unroll
    for (int d0 = 0; d0 < 4; ++d0) qr[d0] = *reinterpret_cast<const bf16x8*>(Qw + d0 * 16);
    const int cb0 = jh * 128;
    const int sr = tid >> 4, sc = (tid & 15) * 8, vst0 = v_st<4>(sr, sc), vst1 = v_st<4>(32 + sr, sc), kst0 = AT_KSWZ(sr, sc * 2), kst1 = AT_KSWZ(32 + sr, sc * 2);
    const int vb0 = (int)(uintptr_t)V_lds + v_rd_base(lane);
    const int NT = seq / KVBLK;
    bf16x8 ek0[2], ek1[2], ev0[2], ev1[2];
#define DA_ELOAD(s, ev) do { const int kt_ = (ev) + 1; \
        if (kt_ < NT) { ek0[s] = *reinterpret_cast<const bf16x8*>(&Kh[(size_t)(kt_ * KVBLK + sr) * LDK + sc]); ek1[s] = *reinterpret_cast<const bf16x8*>(&Kh[(size_t)(kt_ * KVBLK + 32 + sr) * LDK + sc]); } \
        ev0[s] = *reinterpret_cast<const bf16x8*>(&Vh[(size_t)((ev) * KVBLK + sr) * LDK + sc]); ev1[s] = *reinterpret_cast<const bf16x8*>(&Vh[(size_t)((ev) * KVBLK + 32 + sr) * LDK + sc]); } while (0)
#define DA_EWRITE(s, ev) do { const int kt_ = (ev) + 1; \
        if (kt_ < NT) { *(LAS bf16x8*)(K_lds + (kt_ & 1) * SHM_K + kst0) = ek0[s]; *(LAS bf16x8*)(K_lds + (kt_ & 1) * SHM_K + kst1) = ek1[s]; } \
        *(LAS bf16x8*)(V_lds + ((ev) & 1) * SHM_V + vst0) = ev0[s]; *(LAS bf16x8*)(V_lds + ((ev) & 1) * SHM_V + vst1) = ev1[s]; } while (0)
#define DA_CONSUME(s) asm volatile("" :: "v"(ek0[s]), "v"(ek1[s]), "v"(ev0[s]), "v"(ev1[s]))
#define DA_STAGE(i) do { if ((i) & 1) { if (VARIANT == 4) DA_CONSUME(1); else DA_EWRITE(1, i); if ((i) + 2 < NT) DA_ELOAD(1, (i) + 2); } else { if (VARIANT == 4) DA_CONSUME(0); else DA_EWRITE(0, i); if ((i) + 2 < NT) DA_ELOAD(0, (i) + 2); } } while (0)
#define DA_RESC(a) do { if (__any((a) < 1.f)) { if (hi == 0) al_l[r32] = (a); asm volatile("s_waitcnt lgkmcnt(0)" ::: "memory"); \
    _Pragma("unroll") for (int d = 0; d < 4; ++d) _Pragma("unroll") for (int r = 0; r < 16; ++r) o[d][r] *= al_l[crow(r, hi)]; } } while (0)
#define DA_PV(vb) do { pv_pair<4, 0>(o[0], o[1], vb, pa0, pa1, pa2, pa3); pv_pair<4, 2>(o[2], o[3], vb, pa0, pa1, pa2, pa3); } while (0)
    f32x16 p0, p1; bf16x8 pa0, pa1, pa2, pa3;
    { const bf16x8 a0 = *reinterpret_cast<const bf16x8*>(&Kh[(size_t)sr * LDK + sc]), a1 = *reinterpret_cast<const bf16x8*>(&Kh[(size_t)(32 + sr) * LDK + sc]);
      *(LAS bf16x8*)(K_lds + kst0) = a0; *(LAS bf16x8*)(K_lds + kst1) = a1; }
    DA_ELOAD(0, 0); if (1 < NT) DA_ELOAD(1, 1);
    __syncthreads();
    if (jh == 1) __syncthreads();
    for (int i = 0; i < NT; ++i) {
        if (VARIANT != 1) { if (jh == 1) DA_STAGE(i); }
        if (i > 0 && VARIANT != 3) { DA_RESC(alpha); const int vb = vb0 + ((i - 1) & 1) * SHM_V; DA_PV(vb); }
        qkt64(p0, p1, K_lds + (i & 1) * SHM_K, qr, r32, hi, cb0);
        __syncthreads();
        if (VARIANT != 1) { if (jh == 0) DA_STAGE(i); }
        { float pmax = p0[0];
#pragma unroll
          for (int r = 1; r < 16; ++r) pmax = fmaxf(pmax, p0[r]);
#pragma unroll
          for (int r = 0; r < 16; ++r) pmax = fmaxf(pmax, p1[r]);
          { auto rr = __builtin_amdgcn_permlane32_swap(__float_as_uint(pmax), __float_as_uint(pmax), false, false); pmax = fmaxf(__uint_as_float(rr[0]), __uint_as_float(rr[1])); }
          float mn;
          if (__builtin_expect(__all(pmax - m_reg <= THR / SCALE), 1)) { mn = m_reg; alpha = 1.f; }
          else { mn = fmaxf(m_reg, pmax); alpha = __builtin_amdgcn_exp2f((m_reg - mn) * C); m_reg = mn; }
          const float mnC = -mn * C; float ps = 0.f;
#pragma unroll
          for (int r = 0; r < 16; ++r) { if (VARIANT == 2) { p0[r] = fmaf(p0[r], C, mnC); p1[r] = fmaf(p1[r], C, mnC); } else { p0[r] = __builtin_amdgcn_exp2f(fmaf(p0[r], C, mnC)); p1[r] = __builtin_amdgcn_exp2f(fmaf(p1[r], C, mnC)); } }
#pragma unroll
          for (int r = 0; r < 16; ++r) ps += p0[r] + p1[r];
          { auto rr = __builtin_amdgcn_permlane32_swap(__float_as_uint(ps), __float_as_uint(ps), false, false); ps = __uint_as_float(rr[0]) + __uint_as_float(rr[1]); }
          l_reg = l_reg * alpha + ps;
          AT_PK4(p0, 0, pa0); AT_PK4(p0, 8, pa1); AT_PK4(p1, 0, pa2); AT_PK4(p1, 8, pa3); }
        __syncthreads();
    }
    { DA_RESC(alpha); const int vb = vb0 + ((NT - 1) & 1) * SHM_V; DA_PV(vb); }
    if (jh == 0) __syncthreads();
    if (hi == 0) li_l[r32] = l_reg; asm volatile("s_waitcnt lgkmcnt(0)" ::: "memory");
    float rli[16];
#pragma unroll
    for (int r = 0; r < 16; ++r) rli[r] = __builtin_amdgcn_rcpf(li_l[crow(r, hi)]);
    __syncthreads();
    LAS float* X = (LAS float*)lds;
    if (jh == 1) {
#pragma unroll
        for (int r = 0; r < 16; ++r)
#pragma unroll
            for (int d0 = 0; d0 < 4; ++d0) X[(wq * 32 + crow(r, hi)) * DA_XPITCH + d0 * 32 + r32] = o[d0][r] * rli[r];
    }
    __syncthreads();
    if (jh == 0) {
#pragma unroll
        for (int r = 0; r < 16; ++r)
#pragma unroll
            for (int d0 = 0; d0 < 4; ++d0) { const int ix = (wq * 32 + crow(r, hi)) * DA_XPITCH + d0 * 32 + r32; X[ix] = o[d0][r] * rli[r] - lam * X[ix]; }
    }
    __syncthreads();
    { const int row = tid >> 2, qd = tid & 3; const LAS f32x4* xr = (const LAS f32x4*)(X + row * DA_XPITCH + qd * 32);
      f32x4 v[8]; float ss = 0.f;
#pragma unroll
      for (int i = 0; i < 8; ++i) { v[i] = xr[i]; ss += (v[i][0] * v[i][0] + v[i][1] * v[i][1]) + (v[i][2] * v[i][2] + v[i][3] * v[i][3]); }
      ss += __shfl_xor(ss, 1); ss += __shfl_xor(ss, 2);
      const float rs = __builtin_amdgcn_rsqf(ss * (1.f / 128.f) + EPS) * oscale;
      const f32x4* gp = (const f32x4*)(subg + qd * 32); f32x4 gq[8];
#pragma unroll
      for (int i = 0; i < 8; ++i) gq[i] = gp[i];
      bf16_t* op = Ob + (size_t)row * 1024 + qd * 32;
#pragma unroll
      for (int i = 0; i < 4; ++i) { const f32x4 a = v[2 * i] * rs * gq[2 * i], b = v[2 * i + 1] * rs * gq[2 * i + 1]; *(u32x4*)(op + 8 * i) = gm::pack8(a, b); } }
    __syncthreads();
#undef DA_ELOAD
#undef DA_EWRITE
#undef DA_STAGE
#undef DA_RESC
#undef DA_PV
}

constexpr int DD_LDS_K = 0, DD_LDS_V = 65536, DD_LDS_WS = 131072 + 256;
__device__ __forceinline__ void diff_attn_unit_dma(const bf16_t* __restrict__ Qb, const bf16_t* __restrict__ Kh, const bf16_t* __restrict__ Vh, bf16_t* __restrict__ Ob,
                                                   int seq, float lam, float oscale, const float* __restrict__ subg, LAS char* lds) {
    constexpr int LDK = 128, SLOT = 16384, KVBLK = 64;
    constexpr float C = SCALE * 1.4426950408889634f;
    int tid = threadIdx.x; asm volatile("" : "+v"(tid));
    const int wid = __builtin_amdgcn_readfirstlane(tid >> 6), lane = tid & 63, r32 = lane & 31, hi = lane >> 5, jh = wid >> 2, wq = wid & 3;
    LAS char* K_lds = lds + DD_LDS_K; LAS char* V_lds = lds + DD_LDS_V;
    LAS float* ws = (LAS float*)(lds + DD_LDS_WS) + wid * 64; LAS float* li_l = ws; LAS float* al_l = ws + 32;
    float m_reg = -1e30f, l_reg = 0.f, alpha = 1.f; f32x16 o[4] = {}; bf16x8 qr[4];
    const bf16_t* Qw = Qb + (size_t)(wq * 32 + r32) * 128 + jh * 64 + hi * 8;
#pragma unroll
    for (int d0 = 0; d0 < 4; ++d0) qr[d0] = *reinterpret_cast<const bf16x8*>(Qw + d0 * 16);
    const int cb0 = jh * 128;
    const int vb0 = (int)(uintptr_t)V_lds + v_rd_base(lane);
    const int NT = seq / KVBLK;
    unsigned koff[2], voff[2]; unsigned pbase[2];
#pragma unroll
    for (int j = 0; j < 2; ++j) { const int piece = j * 8 + wid; pbase[j] = (unsigned)piece * 1024u;
        const int krow = piece * 4 + (lane >> 4), kcolB = ((lane & 15) * 16) ^ ((krow & 7) << 4); koff[j] = (unsigned)(krow * LDK + (kcolB >> 1));
        const int sub = piece * 2 + (lane >> 5), kk = (sub >> 2) * 8 + ((lane & 31) >> 2), vk = (kk & ~0xC) | ((kk & 4) << 1) | ((kk & 8) >> 1), vc = (sub & 3) * 32 + (lane & 3) * 8; voff[j] = (unsigned)(vk * LDK + vc); }
#define DD_DMA(gp, lp) __builtin_amdgcn_global_load_lds((const unsigned*)(gp), (LAS unsigned*)(lp), 16, 0, 0)
#define DD_KTILE(t, slot) do { const bf16_t* g_ = Kh + (size_t)(t) * KVBLK * LDK; DD_DMA(g_ + koff[0], K_lds + (slot) * SLOT + pbase[0]); DD_DMA(g_ + koff[1], K_lds + (slot) * SLOT + pbase[1]); } while (0)
#define DD_VTILE(t, slot) do { const bf16_t* g_ = Vh + (size_t)(t) * KVBLK * LDK; DD_DMA(g_ + voff[0], V_lds + (slot) * SLOT + pbase[0]); DD_DMA(g_ + voff[1], V_lds + (slot) * SLOT + pbase[1]); } while (0)
#define DD_STAGE(e) do { asm volatile("s_waitcnt vmcnt(4)" ::: "memory"); const int kt_ = (e) + 3 < NT ? (e) + 3 : 0, vt_ = (e) + 2 < NT ? (e) + 2 : 0; DD_KTILE(kt_, ((e) + 3) & 3); DD_VTILE(vt_, ((e) + 2) & 3); } while (0)
#define DD_BAR() do { asm volatile("s_waitcnt lgkmcnt(0)" ::: "memory"); __builtin_amdgcn_s_barrier(); asm volatile("" ::: "memory"); } while (0)
#define DD_RESC(a) do { if (__any((a) < 1.f)) { if (hi == 0) al_l[r32] = (a); asm volatile("s_waitcnt lgkmcnt(0)" ::: "memory"); \
    _Pragma("unroll") for (int d = 0; d < 4; ++d) _Pragma("unroll") for (int r = 0; r < 16; ++r) o[d][r] *= al_l[crow(r, hi)]; } } while (0)
#define DD_PV(vb) do { pv_pair<4, 0>(o[0], o[1], vb, pa0, pa1, pa2, pa3); pv_pair<4, 2>(o[2], o[3], vb, pa0, pa1, pa2, pa3); } while (0)
    f32x16 p0, p1; bf16x8 pa0, pa1, pa2, pa3;
    DD_KTILE(0, 0); DD_KTILE(1, 1); DD_KTILE(2, 2); DD_VTILE(0, 0); DD_VTILE(1, 1);
    asm volatile("s_waitcnt vmcnt(0)" ::: "memory");
    asm volatile("" : "+v"(qr[0]), "+v"(qr[1]), "+v"(qr[2]), "+v"(qr[3]));
    DD_BAR();
    if (jh == 1) DD_BAR();
    for (int i = 0; i < NT; ++i) {
        if (jh == 1) DD_STAGE(i);
        if (i > 0) { DD_RESC(alpha); const int vb = vb0 + ((i - 1) & 3) * SLOT; DD_PV(vb); }
        qkt64(p0, p1, K_lds + (i & 3) * SLOT, qr, r32, hi, cb0);
        DD_BAR();
        if (jh == 0) DD_STAGE(i);
        { float pmax = p0[0];
#pragma unroll
          for (int r = 1; r < 16; ++r) pmax = fmaxf(pmax, p0[r]);
#pragma unroll
          for (int r = 0; r < 16; ++r) pmax = fmaxf(pmax, p1[r]);
          { auto rr = __builtin_amdgcn_permlane32_swap(__float_as_uint(pmax), __float_as_uint(pmax), false, false); pmax = fmaxf(__uint_as_float(rr[0]), __uint_as_float(rr[1])); }
          float mn;
          if (__builtin_expect(__all(pmax - m_reg <= THR / SCALE), 1)) { mn = m_reg; alpha = 1.f; }
          else { mn = fmaxf(m_reg, pmax); alpha = __builtin_amdgcn_exp2f((m_reg - mn) * C); m_reg = mn; }
          const float mnC = -mn * C; float ps = 0.f;
#pragma unroll
          for (int r = 0; r < 16; ++r) { p0[r] = __builtin_amdgcn_exp2f(fmaf(p0[r], C, mnC)); p1[r] = __builtin_amdgcn_exp2f(fmaf(p1[r], C, mnC)); }
#pragma unroll
          for (int r = 0; r < 16; ++r) ps += p0[r] + p1[r];
          { auto rr = __builtin_amdgcn_permlane32_swap(__float_as_uint(ps), __float_as_uint(ps), false, false); ps = __uint_as_float(rr[0]) + __uint_as_float(rr[1]); }
          l_reg = l_reg * alpha + ps;
          AT_PK4(p0, 0, pa0); AT_PK4(p0, 8, pa1); AT_PK4(p1, 0, pa2); AT_PK4(p1, 8, pa3); }
        DD_BAR();
    }
    { DD_RESC(alpha); const int vb = vb0 + ((NT - 1) & 3) * SLOT; DD_PV(vb); }
    asm volatile("s_waitcnt vmcnt(0)" ::: "memory");
    if (jh == 0) DD_BAR();
    if (hi == 0) li_l[r32] = l_reg; asm volatile("s_waitcnt lgkmcnt(0)" ::: "memory");
    float rli[16];
#pragma unroll
    for (int r = 0; r < 16; ++r) rli[r] = __builtin_amdgcn_rcpf(li_l[crow(r, hi)]);
    DD_BAR();
    LAS float* X = (LAS float*)lds;
    if (jh == 1) {
#pragma unroll
        for (int r = 0; r < 16; ++r)
#pragma unroll
            for (int d0 = 0; d0 < 4; ++d0) X[(wq * 32 + crow(r, hi)) * DA_XPITCH + d0 * 32 + r32] = o[d0][r] * rli[r];
    }
    DD_BAR();
    if (jh == 0) {
#pragma unroll
        for (int r = 0; r < 16; ++r)
#pragma unroll
            for (int d0 = 0; d0 < 4; ++d0) { const int ix = (wq * 32 + crow(r, hi)) * DA_XPITCH + d0 * 32 + r32; X[ix] = o[d0][r] * rli[r] - lam * X[ix]; }
    }
    DD_BAR();
    { const int row = tid >> 2, qd = tid & 3; const LAS f32x4* xr = (const LAS f32x4*)(X + row * DA_XPITCH + qd * 32);
      f32x4 v[8]; float ss = 0.f;
#pragma unroll
      for (int i = 0; i < 8; ++i) { v[i] = xr[i]; ss += (v[i][0] * v[i][0] + v[i][1] * v[i][1]) + (v[i][2] * v[i][2] + v[i][3] * v[i][3]); }
      ss += __shfl_xor(ss, 1); ss += __shfl_xor(ss, 2);
      const float rs = __builtin_amdgcn_rsqf(ss * (1.f / 128.f) + EPS) * oscale;
      const f32x4* gp = (const f32x4*)(subg + qd * 32); f32x4 gq[8];
#pragma unroll
      for (int i = 0; i < 8; ++i) gq[i] = gp[i];
      bf16_t* op = Ob + (size_t)row * 1024 + qd * 32;
#pragma unroll
      for (int i = 0; i < 4; ++i) { const f32x4 a = v[2 * i] * rs * gq[2 * i], b = v[2 * i + 1] * rs * gq[2 * i + 1]; *(u32x4*)(op + 8 * i) = gm::pack8(a, b); } }
    asm volatile("s_waitcnt vmcnt(0)" ::: "memory");
    DD_BAR();
#undef DD_DMA
#undef DD_KTILE
#undef DD_VTILE
#undef DD_STAGE
#undef DD_BAR
#undef DD_RESC
#undef DD_PV
}


template <int NCB, int D0, int KM>
__device__ __forceinline__ void pv_pair_km(f32x16& o0, f32x16& o1, int vb, bf16x8 pa0, bf16x8 pa1, bf16x8 pa2, bf16x8 pa3) {
    s16x4 l[2][4], h[2][4];
    if (KM & 1) { l[0][0] = tr_read<v_rd_off<NCB>(D0, 0, 0)>(vb); h[0][0] = tr_read<v_rd_off<NCB>(D0, 0, 1)>(vb); l[1][0] = tr_read<v_rd_off<NCB>(D0 + 1, 0, 0)>(vb); h[1][0] = tr_read<v_rd_off<NCB>(D0 + 1, 0, 1)>(vb); }
    if (KM & 2) { l[0][1] = tr_read<v_rd_off<NCB>(D0, 1, 0)>(vb); h[0][1] = tr_read<v_rd_off<NCB>(D0, 1, 1)>(vb); l[1][1] = tr_read<v_rd_off<NCB>(D0 + 1, 1, 0)>(vb); h[1][1] = tr_read<v_rd_off<NCB>(D0 + 1, 1, 1)>(vb); }
    if (KM & 4) { l[0][2] = tr_read<v_rd_off<NCB>(D0, 2, 0)>(vb); h[0][2] = tr_read<v_rd_off<NCB>(D0, 2, 1)>(vb); l[1][2] = tr_read<v_rd_off<NCB>(D0 + 1, 2, 0)>(vb); h[1][2] = tr_read<v_rd_off<NCB>(D0 + 1, 2, 1)>(vb); }
    if (KM & 8) { l[0][3] = tr_read<v_rd_off<NCB>(D0, 3, 0)>(vb); h[0][3] = tr_read<v_rd_off<NCB>(D0, 3, 1)>(vb); l[1][3] = tr_read<v_rd_off<NCB>(D0 + 1, 3, 0)>(vb); h[1][3] = tr_read<v_rd_off<NCB>(D0 + 1, 3, 1)>(vb); }
    __builtin_amdgcn_sched_barrier(0);
#define AT_PK(L, H) (bf16x8){L[0], L[1], L[2], L[3], H[0], H[1], H[2], H[3]}
    if (KM & 1) { o0 = __builtin_amdgcn_mfma_f32_32x32x16_bf16(pa0, AT_PK(l[0][0], h[0][0]), o0, 0, 0, 0); o1 = __builtin_amdgcn_mfma_f32_32x32x16_bf16(pa0, AT_PK(l[1][0], h[1][0]), o1, 0, 0, 0); }
    if (KM & 2) { o0 = __builtin_amdgcn_mfma_f32_32x32x16_bf16(pa1, AT_PK(l[0][1], h[0][1]), o0, 0, 0, 0); o1 = __builtin_amdgcn_mfma_f32_32x32x16_bf16(pa1, AT_PK(l[1][1], h[1][1]), o1, 0, 0, 0); }
    if (KM & 4) { o0 = __builtin_amdgcn_mfma_f32_32x32x16_bf16(pa2, AT_PK(l[0][2], h[0][2]), o0, 0, 0, 0); o1 = __builtin_amdgcn_mfma_f32_32x32x16_bf16(pa2, AT_PK(l[1][2], h[1][2]), o1, 0, 0, 0); }
    if (KM & 8) { o0 = __builtin_amdgcn_mfma_f32_32x32x16_bf16(pa3, AT_PK(l[0][3], h[0][3]), o0, 0, 0, 0); o1 = __builtin_amdgcn_mfma_f32_32x32x16_bf16(pa3, AT_PK(l[1][3], h[1][3]), o1, 0, 0, 0); }
#undef AT_PK
    __builtin_amdgcn_sched_barrier(0);
}
template <int MODE>
__device__ __forceinline__ void na_softmax_pv(f32x16& p0, f32x16& p1, f32x16 (&o)[2], float& m_reg, float& l_reg, const LAS float* rb, int hi, int r32, int wc0, LAS float* al_l, int vb) {
    constexpr float SC2 = SCALE * 1.4426950408889634f;
    constexpr int A0 = MODE == 2 ? 12 : 0, B1 = MODE == 1 ? 4 : 16;
    if (MODE != 0) { float bb0[16], bb1[16];
#pragma unroll
        for (int r = A0; r < 16; ++r) bb0[r] = rb[crow(r, hi)];
#pragma unroll
        for (int r = 0; r < B1; ++r) bb1[r] = rb[crow(r, hi) + 32];
        __builtin_amdgcn_sched_barrier(0);
#pragma unroll
        for (int r = A0; r < 16; ++r) { const int kc = crow(r, hi); p0[r] = (kc >= wc0 && kc < wc0 + 16) ? fmaf(p0[r], SC2, bb0[r]) : -1e30f; }
#pragma unroll
        for (int r = 0; r < B1; ++r) { const int kc = crow(r, hi) + 32; p1[r] = (kc >= wc0 && kc < wc0 + 16) ? fmaf(p1[r], SC2, bb1[r]) : -1e30f; } }
    float pmax = p0[A0];
#pragma unroll
    for (int r = A0 + 1; r < 16; ++r) pmax = fmaxf(pmax, p0[r]);
#pragma unroll
    for (int r = 0; r < B1; ++r) pmax = fmaxf(pmax, p1[r]);
    { auto rr = __builtin_amdgcn_permlane32_swap(__float_as_uint(pmax), __float_as_uint(pmax), false, false); pmax = fmaxf(__uint_as_float(rr[0]), __uint_as_float(rr[1])); }
    if (MODE == 0) pmax *= SC2;
    const float mn = fmaxf(m_reg, pmax), alpha = __builtin_amdgcn_exp2f(m_reg - mn); m_reg = mn;
    float ps = 0.f;
#pragma unroll
    for (int r = 0; r < 16; ++r) { if (r >= A0) { p0[r] = MODE == 0 ? __builtin_amdgcn_exp2f(fmaf(p0[r], SC2, -mn)) : __builtin_amdgcn_exp2f(p0[r] - mn); ps += p0[r]; } else p0[r] = 0.f; }
#pragma unroll
    for (int r = 0; r < 16; ++r) { if (r < B1) { p1[r] = MODE == 0 ? __builtin_amdgcn_exp2f(fmaf(p1[r], SC2, -mn)) : __builtin_amdgcn_exp2f(p1[r] - mn); ps += p1[r]; } else p1[r] = 0.f; }
    { auto rr = __builtin_amdgcn_permlane32_swap(__float_as_uint(ps), __float_as_uint(ps), false, false); ps = __uint_as_float(rr[0]) + __uint_as_float(rr[1]); }
    l_reg = l_reg * alpha + ps;
    if (__any(alpha < 1.f)) { if (hi == 0) al_l[r32] = alpha; asm volatile("s_waitcnt lgkmcnt(0)" ::: "memory");
#pragma unroll
        for (int d = 0; d < 2; ++d)
#pragma unroll
            for (int r = 0; r < 16; ++r) o[d][r] *= al_l[crow(r, hi)]; }
    bf16x8 pa0 = {}, pa1, pa2, pa3 = {};
    if (MODE != 2) AT_PK4(p0, 0, pa0);
    AT_PK4(p0, 8, pa1); AT_PK4(p1, 0, pa2);
    if (MODE != 1) AT_PK4(p1, 8, pa3);
    pv_pair_km<2, 0, (MODE == 0 ? 15 : (MODE == 1 ? 7 : 14))>(o[0], o[1], vb, pa0, pa1, pa2, pa3);
}
constexpr int NA_LDS_K = 0, NA_LDS_V = 24576, NA_LDS_RPB = 49152, NA_LDS_WS = 53248;
__device__ __forceinline__ void natten_unit(const bf16_t* __restrict__ qbuf, const bf16_t* __restrict__ kbuf, const bf16_t* __restrict__ vbuf, bf16_t* __restrict__ obuf,
                                            const float* __restrict__ rpb, int b, int h, int R4, LAS char* lds) {
    constexpr float L2E = 1.4426950408889634f, SC2 = SCALE * L2E;
    int tid = threadIdx.x; asm volatile("" : "+v"(tid));
    const int wid = __builtin_amdgcn_readfirstlane(tid >> 6), lane = tid & 63, r32 = lane & 31, hi = lane >> 5;
    const int qrow = R4 * 4 + (wid >> 1), qc0 = (wid & 1) * 32, qc = qc0 + r32;
    const int r0q = min(max(qrow - 4, 0), 24), wc0 = min(max(qc - 8, 0), 48);
    const int lo = min(max(R4 * 4 - 4, 0), 24), hir = min(max(R4 * 4 - 1, 0), 24) + 7, nloc = hir - lo + 1, T = nloc + 4;
    LAS char* K_lds = lds + NA_LDS_K; LAS char* V_lds = lds + NA_LDS_V; LAS float* rp = (LAS float*)(lds + NA_LDS_RPB);
    LAS float* ws = (LAS float*)(lds + NA_LDS_WS) + wid * 64; LAS float* li_l = ws; LAS float* al_l = ws + 32;
    for (int i = tid; i < 465; i += NTHREADS) rp[i] = rpb[h * 465 + i] * L2E;
    const size_t qtok = (size_t)b * SEQ + qrow * 64 + qc;
    bf16x8 qr[4];
#pragma unroll
    for (int d0 = 0; d0 < 4; ++d0) qr[d0] = *reinterpret_cast<const bf16x8*>(qbuf + qtok * 1024 + h * 64 + d0 * 16 + hi * 8);
    const bf16_t* Kb = kbuf + (size_t)b * KVL * 1024 + h * 64; const bf16_t* Vb = vbuf + (size_t)b * KVL * 1024 + h * 64;
    const int srow = tid >> 3, sch = tid & 7;
    const int kst = AT_KSWZ64(srow, sch * 16), vst = v_st<2>(srow, sch * 8);
    const int vb0 = (int)(uintptr_t)V_lds + v_rd_base(lane);
    float m_reg = -1e30f, l_reg = 0.f; f32x16 o[2] = {};
    const bool weven = (wid & 1) == 0;
    bf16x8 kreg[3], vreg[3];
#define NA_KROW(ti) ((ti) < nloc ? CTXL + (lo + (ti)) * 64 : ((ti) - nloc) * 64)
#define NA_LOAD(s, ti) do { if ((ti) < T) { const int kr0_ = NA_KROW(ti); kreg[s] = *reinterpret_cast<const bf16x8*>(Kb + (size_t)(kr0_ + srow) * 1024 + sch * 8); vreg[s] = *reinterpret_cast<const bf16x8*>(Vb + (size_t)(kr0_ + srow) * 1024 + sch * 8); } } while (0)
#define NA_WRITE(s) do { *(LAS bf16x8*)(K_lds + (s) * 8192 + kst) = kreg[s]; *(LAS bf16x8*)(V_lds + (s) * 8192 + vst) = vreg[s]; } while (0)
    NA_LOAD(0, 0); NA_LOAD(1, 1); NA_LOAD(2, 2);
    NA_WRITE(0); NA_LOAD(0, 3);
    __syncthreads();
#define NA_STEP(ti, S0, S1) do { \
        const bool local = (ti) < nloc; const int kr = lo + (ti); \
        const bool active = !local || (kr >= r0q && kr < r0q + 8); \
        if (active) { \
            f32x16 p0 = {}, p1 = {}; \
            const LAS char* Ks = K_lds + (S0) * 8192; \
              \
            { bf16x8 kf0[4], kf1[4]; \
              _Pragma("unroll") for (int d0 = 0; d0 < 4; ++d0) { const int cb = (d0 * 16 + hi * 8) * 2; \
                kf0[d0] = *reinterpret_cast<const LAS bf16x8*>(Ks + AT_KSWZ64(r32, cb)); kf1[d0] = *reinterpret_cast<const LAS bf16x8*>(Ks + AT_KSWZ64(32 + r32, cb)); } \
              __builtin_amdgcn_sched_barrier(0); \
              _Pragma("unroll") for (int d0 = 0; d0 < 4; ++d0) { \
                p0 = __builtin_amdgcn_mfma_f32_32x32x16_bf16(kf0[d0], qr[d0], p0, 0, 0, 0); \
                p1 = __builtin_amdgcn_mfma_f32_32x32x16_bf16(kf1[d0], qr[d0], p1, 0, 0, 0); } } \
            const int vb = vb0 + (S0) * 8192; \
            if (local) { const LAS float* rb = rp + (kr - qrow + 7) * 31 + 15 - qc; \
                if (weven) na_softmax_pv<1>(p0, p1, o, m_reg, l_reg, rb, hi, r32, wc0, al_l, vb); else na_softmax_pv<2>(p0, p1, o, m_reg, l_reg, rb, hi, r32, wc0, al_l, vb); } \
            else na_softmax_pv<0>(p0, p1, o, m_reg, l_reg, rp, hi, r32, wc0, al_l, vb); \
        } \
        if ((ti) + 1 < T) { NA_WRITE(S1); NA_LOAD(S1, (ti) + 4); } \
        __syncthreads(); } while (0)
    for (int t3 = 0; t3 < T; t3 += 3) { NA_STEP(t3, 0, 1); NA_STEP(t3 + 1, 1, 2); NA_STEP(t3 + 2, 2, 0); }
    if (hi == 0) li_l[r32] = l_reg; asm volatile("s_waitcnt lgkmcnt(0)" ::: "memory");
    LAS bf16_t* ost = (LAS bf16_t*)(lds + NA_LDS_K) + wid * (32 * 72);
#pragma unroll
    for (int r = 0; r < 16; ++r) { const int orow = crow(r, hi); const float rl = __builtin_amdgcn_rcpf(li_l[orow]);
#pragma unroll
        for (int d0 = 0; d0 < 2; ++d0) { const unsigned w = cvt_pk_bf16(o[d0][r] * rl, 0.f); ost[orow * 72 + d0 * 32 + r32] = (bf16_t)(w & 0xffffu); } }
    asm volatile("s_waitcnt lgkmcnt(0)" ::: "memory");
    { bf16_t* op = obuf + ((size_t)b * SEQ + qrow * 64 + qc0) * 1024 + h * 64;
#pragma unroll
      for (int t = 0; t < 4; ++t) { const int ch = lane + 64 * t, orow = ch >> 3, c8 = (ch & 7) * 8;
          *(u32x4*)(op + (size_t)orow * 1024 + c8) = *(const LAS u32x4*)(ost + orow * 72 + c8); } }
    __syncthreads();
#undef NA_KROW
#undef NA_LOAD
#undef NA_WRITE
#undef NA_STEP
}
}

struct Params { const float* in[29]; float* out; unsigned char* ws; int ph_lo, ph_hi, li, pad; };
enum { I_X = 0, I_C, I_CTX, I_CCTX, I_ADAW, I_ADAB, I_MNG, I_MOEG, I_ROUTER, I_WGATE, I_WUP, I_WDOWN, I_DAWIN, I_LQ1, I_LK1, I_LQ2, I_LK2, I_SUBLN, I_DAWOUT,
       I_GMWIN, I_GMVG, I_GMWS, I_GMBS, I_GMWOUT, I_NAWIN, I_NARPB, I_NAWOUT, I_FNWOUT, I_FINALG };
struct Frame {
    LAS unsigned char* lds; const float* in[29]; unsigned char* ws; float* out;
    int tid, lane, wave, G, bid;
    template <class T> __device__ __forceinline__ T* W(size_t off) const { return (T*)(ws + off); }
};

struct TItem { const float* src; bf16_t* dst; int ldw, K, f8; };
__device__ __forceinline__ void titem_load(const TItem& t, int lane, float (&r)[32]) {
#pragma unroll
    for (int i = 0; i < 32; ++i) r[i] = t.src[(size_t)(2 * i + (lane >> 5)) * t.ldw + (lane & 31)];
}
__device__ __forceinline__ void titem_finish(const TItem& t, int lane, const float (&r)[32], LAS float* scr) {
#pragma unroll
    for (int i = 0; i < 32; ++i) scr[(2 * i + (lane >> 5)) * 33 + (lane & 31)] = r[i];
    LDS_WAIT(); asm volatile("" ::: "memory");
    if (t.f8) { const int c4 = lane & 3; unsigned char* d8 = (unsigned char*)t.dst;
#pragma unroll
        for (int j = 0; j < 2; ++j) { const int n = (lane >> 2) + 16 * j; const LAS float* s = scr + (16 * c4) * 33 + n; u32x4 o;
            o.x = gm::pk4_fp8(s[0 * 33] * gm::F8_SW, s[1 * 33] * gm::F8_SW, s[2 * 33] * gm::F8_SW, s[3 * 33] * gm::F8_SW); o.y = gm::pk4_fp8(s[4 * 33] * gm::F8_SW, s[5 * 33] * gm::F8_SW, s[6 * 33] * gm::F8_SW, s[7 * 33] * gm::F8_SW);
            o.z = gm::pk4_fp8(s[8 * 33] * gm::F8_SW, s[9 * 33] * gm::F8_SW, s[10 * 33] * gm::F8_SW, s[11 * 33] * gm::F8_SW); o.w = gm::pk4_fp8(s[12 * 33] * gm::F8_SW, s[13 * 33] * gm::F8_SW, s[14 * 33] * gm::F8_SW, s[15 * 33] * gm::F8_SW);
            *(u32x4*)(d8 + (size_t)n * t.K + 16 * c4) = o; }
        LDS_WAIT(); asm volatile("" ::: "memory"); return; }
    const int c = lane & 7;
#pragma unroll
    for (int j = 0; j < 4; ++j) { const int n = (lane >> 3) + 8 * j; const LAS float* s = scr + (8 * c) * 33 + n;
        u32x4 o; o.x = cvt_pk_bf16(s[0 * 33], s[1 * 33]); o.y = cvt_pk_bf16(s[2 * 33], s[3 * 33]); o.z = cvt_pk_bf16(s[4 * 33], s[5 * 33]); o.w = cvt_pk_bf16(s[6 * 33], s[7 * 33]);
        *(u32x4*)(t.dst + (size_t)n * t.K + 8 * c) = o; }
    LDS_WAIT(); asm volatile("" ::: "memory");
}
__device__ __forceinline__ TItem titem_make(const float* W, int ldw, int K, bf16_t* WT, int k0, int n0, int drow0) { TItem t; t.src = W + (size_t)k0 * ldw + n0; t.dst = WT + (size_t)drow0 * K + k0; t.ldw = ldw; t.K = K; t.f8 = 0; return t; }
__device__ __forceinline__ TItem titem_make8(const float* W, int ldw, int K, unsigned char* WT, int k0, int n0, int drow0) { TItem t; t.src = W + (size_t)k0 * ldw + n0; t.dst = (bf16_t*)(WT + (size_t)drow0 * K + k0); t.ldw = ldw; t.K = K; t.f8 = 1; return t; }
__device__ __forceinline__ TItem titem_plain(const float* W, int K, int N, bf16_t* WT, int item) { const int nblk = N / 32, kb = item / nblk, nb = item - kb * nblk; return titem_make(W, N, K, WT, 64 * kb, 32 * nb, 32 * nb); }
__device__ __forceinline__ TItem titem_moe(const Frame& F, int layer, int item) {
    const int kind = item / 8192, r = item - kind * 8192, e = r >> 9, it = r & 511, kb = it >> 5, nb = it & 31;
    const size_t eoff = ((size_t)layer * NE + e) * (size_t)(D * D);
    if (kind < 2) { const float* W = (kind == 0 ? F.in[I_WGATE] : F.in[I_WUP]) + eoff; unsigned char* WT = F.W<unsigned char>(WGU_OF(layer)) + (size_t)e * 2048 * 1024;
        const int n0 = 32 * nb; return titem_make8(W, D, D, WT, 64 * kb, n0, 256 * (n0 >> 7) + 128 * kind + (n0 & 127)); }
    const float* W = F.in[I_WDOWN] + eoff; unsigned char* WT = F.W<unsigned char>(WD_OF(layer)) + (size_t)e * 1024 * 1024; return titem_make8(W, D, D, WT, 64 * kb, 32 * nb, 32 * nb);
}
constexpr int MIX_J0 = 16 * 96, MIX_J1 = 16 * 32, MIX_J2 = 16 * 128, MIX_J3 = 32 * 32, MIX_J4 = 16 * 96, MIX_J5 = 16 * 32, MIX_J6 = 16 * 32, MIX_NJ = MIX_J0 + MIX_J1 + MIX_J2 + MIX_J3 + MIX_J4 + MIX_J5 + MIX_J6;
__device__ __forceinline__ TItem titem_mixer(const Frame& F, int it) { int r = it;
    if (r < MIX_J0) return titem_plain(F.in[I_DAWIN], 1024, 3072, F.W<bf16_t>(WS_WQKV0), r); r -= MIX_J0;
    if (r < MIX_J1) return titem_plain(F.in[I_DAWOUT], 1024, 1024, F.W<bf16_t>(WS_WO0), r); r -= MIX_J1;
    if (r < MIX_J2) return titem_plain(F.in[I_GMWIN], 1024, 4096, F.W<bf16_t>(WS_WGIN), r); r -= MIX_J2;
    if (r < MIX_J3) return titem_plain(F.in[I_GMWOUT], 2048, 1024, F.W<bf16_t>(WS_WGOUT), r); r -= MIX_J3;
    if (r < MIX_J4) return titem_plain(F.in[I_NAWIN], 1024, 3072, F.W<bf16_t>(WS_WQKV2), r); r -= MIX_J4;
    if (r < MIX_J5) return titem_plain(F.in[I_NAWOUT], 1024, 1024, F.W<bf16_t>(WS_WO2), r); r -= MIX_J5;
    return titem_plain(F.in[I_FNWOUT], 1024, 1024, F.W<bf16_t>(WS_WFO), r);
}
__device__ __forceinline__ void weights_range(const Frame& F, int layer, int n_mix, int i0, int i1, int gw, int nw) {
    LAS float* scr = (LAS float*)F.lds + F.wave * 2112;
    int it = i0 + gw; if (it >= i1) return;
    TItem cur = it < n_mix ? titem_mixer(F, it) : titem_moe(F, layer, it - n_mix); float ra[32], rb[32];
    titem_load(cur, F.lane, ra);
    for (;;) { const int nx = it + nw; const bool more = nx < i1; TItem nxt = cur;
        if (more) { nxt = nx < n_mix ? titem_mixer(F, nx) : titem_moe(F, layer, nx - n_mix); titem_load(nxt, F.lane, rb); }
        titem_finish(cur, F.lane, ra, scr);
        if (!more) break;
#pragma unroll
        for (int i = 0; i < 32; ++i) ra[i] = rb[i];
        cur = nxt; it = nx; }
}
__device__ __forceinline__ void moe_weights_phase(const Frame& F, int layer, int i0 = 0) { weights_range(F, layer, 0, i0, 24576, F.bid * NWAVES + F.wave, F.G * NWAVES); __syncthreads(); }
__device__ __forceinline__ void moe_weights_tail(const Frame& F, int layer, int i0, int per, int rank) {
    if (rank < 0) return;
    const int b0 = i0 + rank * per; weights_range(F, layer, 0, b0, b0 + per < 24576 ? b0 + per : 24576, F.wave, NWAVES); __syncthreads();
}
__device__ __forceinline__ void p0_prologue(const Frame& F, bool tails) {
    weights_range(F, 0, MIX_NJ, 0, tails ? MIX_NJ : MIX_NJ + 24576, F.bid * NWAVES + F.wave, F.G * NWAVES);
    const int gt = F.bid * NTHREADS + F.tid, NGT = F.G * NTHREADS;
    for (int i = gt; i < 1024; i += NGT) { const int pos = i >> 4, f = i & 15; const float inv = powf(10000.f, -(float)f / 16.f), ang = (float)pos * inv;
        F.W<float>(WS_ROPE)[i] = cosf(ang); F.W<float>(WS_ROPE + 4096)[i] = sinf(ang); }
    for (int i = gt; i < 512 * 256 / 8; i += NGT) { const int m = i >> 5, j0 = (i & 31) * 8; const int mm = m & 255; float v[8];
#pragma unroll
        for (int t = 0; t < 8; ++t) { const float x = (float)((mm * (j0 + t)) & 255) * (1.f / 128.f); v[t] = m < 256 ? cospif(x) : sinpif(x); }
        u32x4 w; w.x = cvt_pk_bf16(v[0], v[1]); w.y = cvt_pk_bf16(v[2], v[3]); w.z = cvt_pk_bf16(v[4], v[5]); w.w = cvt_pk_bf16(v[6], v[7]);
        *(u32x4*)(F.W<bf16_t>(WS_CS) + (size_t)i * 8) = w; }
    for (int i = gt; i < 2048 * 272; i += NGT) { const int k = i / 272, n0 = (i - k * 272) * 8; float v[8];
#pragma unroll
        for (int t = 0; t < 8; ++t) { const int np = n0 + t; const float x = (float)((k * (np & 1023)) & 2047) * (1.f / 1024.f);
            v[t] = np < 1024 ? cospif(x) : (np < 2048 ? -sinpif(x) : (np == 2048 ? ((k & 1) ? -1.f : 1.f) : 0.f)); }
        u32x4 w; w.x = cvt_pk_bf16(v[0], v[1]); w.y = cvt_pk_bf16(v[2], v[3]); w.z = cvt_pk_bf16(v[4], v[5]); w.w = cvt_pk_bf16(v[6], v[7]);
        *(u32x4*)(F.W<bf16_t>(WS_DP) + (size_t)i * 8) = w; }
    LAS float* sc = (LAS float*)F.lds;
    LAS float* part = (LAS float*)(F.lds + 73728);
    __syncthreads();
    { float cx[34];
#pragma unroll
      for (int q = 0; q < 34; ++q) { const int i = F.tid + NTHREADS * q, r = i >> 10, k = i & 1023; cx[q] = r < 16 ? F.in[I_C][r * 1024 + k] : F.in[I_CCTX][k]; }
#pragma unroll
      for (int q = 0; q < 34; ++q) sc[F.tid + NTHREADS * q] = cx[q] / (1.f + expf(-cx[q])); }
    __syncthreads();
    for (int item = F.bid; item < 4 * 192; item += F.G) { const int l = item / 192, c0 = (item - l * 192) * 32, cs = F.tid & 31, ks = F.tid >> 5;
        const float* wp = F.in[I_ADAW] + ((size_t)l * 1024 + (size_t)ks * 64) * MODW + c0 + cs;
        float a[17];
#pragma unroll
        for (int r = 0; r < 17; ++r) a[r] = 0.f;
        for (int k0 = 0; k0 < 64; k0 += 32) { float w[32];
#pragma unroll
            for (int kk = 0; kk < 32; ++kk) w[kk] = wp[(size_t)(k0 + kk) * MODW];
#pragma unroll
            for (int kk = 0; kk < 32; ++kk) {
#pragma unroll
                for (int r = 0; r < 17; ++r) a[r] = fmaf(sc[r * 1024 + ks * 64 + k0 + kk], w[kk], a[r]);
                __builtin_amdgcn_sched_barrier(0); } }
#pragma unroll
        for (int r = 0; r < 17; ++r) part[(ks * 17 + r) * 32 + cs] = a[r];
        __syncthreads();
        for (int i = F.tid; i < 17 * 32; i += NTHREADS) { const int r = i >> 5, cc = i & 31; float s = F.in[I_ADAB][l * MODW + c0 + cc];
#pragma unroll
            for (int q = 0; q < 16; ++q) s += part[(q * 17 + r) * 32 + cc];
            F.W<float>(WS_MOD)[((size_t)l * MODR + r) * MODW + c0 + cc] = s; }
        __syncthreads(); }
}

template <int CTRL> __device__ __forceinline__ float dpp_f(float x) { return __uint_as_float((unsigned)__builtin_amdgcn_mov_dpp((int)__float_as_uint(x), CTRL, 0xf, 0xf, true)); }
constexpr int DPP_X1 = 0xB1, DPP_X2 = 0x4E, DPP_ROR4 = 0x124, DPP_ROR8 = 0x128, DPP_ROR12 = 0x12C;
__device__ __forceinline__ float swap16_sum(float a, float b) { auto rr = __builtin_amdgcn_permlane16_swap(__float_as_uint(a), __float_as_uint(b), false, false); return __uint_as_float(rr[0]) + __uint_as_float(rr[1]); }
__device__ __forceinline__ float swap32_sum(float a, float b) { auto rr = __builtin_amdgcn_permlane32_swap(__float_as_uint(a), __float_as_uint(b), false, false); return __uint_as_float(rr[0]) + __uint_as_float(rr[1]); }
__device__ __forceinline__ float swap16_max(float a) { auto rr = __builtin_amdgcn_permlane16_swap(__float_as_uint(a), __float_as_uint(a), false, false); return fmaxf(__uint_as_float(rr[0]), __uint_as_float(rr[1])); }
__device__ __forceinline__ float swap32_max(float a) { auto rr = __builtin_amdgcn_permlane32_swap(__float_as_uint(a), __float_as_uint(a), false, false); return fmaxf(__uint_as_float(rr[0]), __uint_as_float(rr[1])); }
__device__ __forceinline__ float wave_sum64(float x) {
    x += dpp_f<DPP_ROR8>(x); x += dpp_f<DPP_ROR4>(x); x += dpp_f<DPP_X2>(x); x += dpp_f<DPP_X1>(x); x = swap16_sum(x, x); return swap32_sum(x, x);
}
template <int O> __device__ __forceinline__ float lane_xor(float x, int lane, bool x4a) {
    if (O == 1) return dpp_f<DPP_X1>(x);
    if (O == 2) return dpp_f<DPP_X2>(x);
    if (O == 4) { const float a = dpp_f<DPP_ROR4>(x), b = dpp_f<DPP_ROR12>(x); return x4a ? a : b; }
    if (O == 8) return dpp_f<DPP_ROR8>(x);
    if (O == 16) { auto rr = __builtin_amdgcn_permlane16_swap(__float_as_uint(x), __float_as_uint(x), false, false); return __uint_as_float((lane & 16) ? rr[0] : rr[1]); }
    auto rr = __builtin_amdgcn_permlane32_swap(__float_as_uint(x), __float_as_uint(x), false, false); return __uint_as_float((lane & 32) ? rr[0] : rr[1]);
}
struct NormArgs {
    const float* xsrc; float* xdst; const float* csrc; float* cdst;
    int do_lat, do_ctx, xbf, xcopy;
    const float* gain; const float* shift; const float* scale;
    bf16_t* hx;
    const bf16_t* ys; const int* tokslot; const int* tokslotc; const float* g2;
    int ctx_comb;
    const float* wrouter; float* aff;
    float* out;
};
constexpr int WRT_PITCH = 1028;
constexpr size_t WS_ZROW = WS_CTL + 768 * 1024;
struct NormVec { f32x4 g[4], sh[4], g2[4]; int mr; };
template <bool COMBINE, bool FINAL, bool ROUTER = false>
__device__ __forceinline__ void normvec_load(const NormArgs& A, int mr, int lane, NormVec& nv) {
    nv.mr = mr;
#pragma unroll
    for (int j = 0; j < 4; ++j) { nv.g[j] = ((const f32x4*)A.gain)[lane + 64 * j];
        if (!FINAL) { nv.sh[j] = ((const f32x4*)(A.shift + (size_t)mr * MODW))[lane + 64 * j]; const f32x4 sc = ((const f32x4*)(A.scale + (size_t)mr * MODW))[lane + 64 * j];
            nv.g[j] = nv.g[j] * (sc + 1.0f);
            if (ROUTER) { nv.g[j] = nv.g[j] * gm::F8_SX; nv.sh[j] = nv.sh[j] * gm::F8_SX; } }
        if (COMBINE) nv.g2[j] = ((const f32x4*)(A.g2 + (size_t)mr * MODW))[lane + 64 * j]; }
}
template <int R>
__device__ __forceinline__ void norm_load(const NormArgs& A, int row0, int rstep, int lane, f32x4 (&v)[R][4]) {
#pragma unroll
    for (int r = 0; r < R; ++r) { const int row = row0 + r * rstep;
        if (A.xbf) { const bf16_t* src = row >= NLAT ? (const bf16_t*)A.csrc + (size_t)(row - NLAT) * D : (const bf16_t*)A.xsrc + (size_t)row * D;
#pragma unroll
            for (int j = 0; j < 4; ++j) { const u32x2 w = ((const u32x2*)src)[lane + 64 * j]; v[r][j] = (f32x4){bf_lo(w.x), bf_hi(w.x), bf_lo(w.y), bf_hi(w.y)}; } }
        else { const float* src = row >= NLAT ? A.csrc + (size_t)(row - NLAT) * D : A.xsrc + (size_t)row * D;
#pragma unroll
            for (int j = 0; j < 4; ++j) v[r][j] = ((const f32x4*)src)[lane + 64 * j]; } }
}
template <bool COMBINE, bool ROUTER, bool FINAL, int R>
__device__ __forceinline__ void norm_rows(const NormArgs& A, const NormVec& nv, int row0, int rstep, int lane, const LAS float* wrT, const bf16_t* zrow, f32x4 (&v)[R][4], int hxfold = -1) {
    int row[R], b[R], mr[R]; bool ic[R];
#pragma unroll
    for (int r = 0; r < R; ++r) { row[r] = row0 + r * rstep; ic[r] = row[r] >= NLAT; b[r] = ic[r] ? (row[r] - NLAT) >> 8 : row[r] >> 11; mr[r] = ic[r] ? 16 : b[r]; }
    if (!COMBINE && !FINAL && A.xcopy) {
#pragma unroll
        for (int r = 0; r < R; ++r) { bf16_t* dst = ic[r] ? (bf16_t*)A.cdst + (size_t)(row[r] - NLAT) * D : (bf16_t*)A.xdst + (size_t)row[r] * D;
#pragma unroll
            for (int j = 0; j < 4; ++j) { u32x2 w; w.x = cvt_pk_bf16(v[r][j][0], v[r][j][1]); w.y = cvt_pk_bf16(v[r][j][2], v[r][j][3]); ((u32x2*)dst)[lane + 64 * j] = w; } } }
    if (COMBINE) {
        int myslot[R]; unsigned msk[R]; int tmax = 0;
#pragma unroll
        for (int r = 0; r < R; ++r) { myslot[r] = -1;
            if (lane < 16 && (!ic[r] || A.ctx_comb)) myslot[r] = ic[r] ? A.tokslotc[(b[r] * 16 + lane) * CTXL + ((row[r] - NLAT) & 255)] : A.tokslot[(b[r] * 16 + lane) * SEQ + (row[r] & 2047)]; }
#pragma unroll
        for (int r = 0; r < R; ++r) { msk[r] = (unsigned)__ballot(myslot[r] >= 0) & 0xffffu; const int c = __builtin_popcount(msk[r]); tmax = c > tmax ? c : tmax; }
        f32x4 a[R][4];
#pragma unroll
        for (int r = 0; r < R; ++r)
#pragma unroll
            for (int j = 0; j < 4; ++j) a[r][j] = (f32x4){0.f, 0.f, 0.f, 0.f};
        for (int t = 0; t < tmax; ++t) {
            unsigned w[R][4];
#pragma unroll
            for (int r = 0; r < R; ++r) { const unsigned m = msk[r]; const bool ok = m != 0u; const int e = ok ? __builtin_ctz(m) : 0; msk[r] = m & (m - 1u);
                const int sl = __builtin_amdgcn_readlane(myslot[r], e);
                const unsigned char* yr = ok ? (const unsigned char*)A.ys + ((size_t)e * gm::ES + (ic[r] ? 4096 + b[r] * CAPC : b[r] * CAP) + sl) * D : (const unsigned char*)zrow;
#pragma unroll
                for (int j = 0; j < 4; ++j) w[r][j] = ((const unsigned*)yr)[lane + 64 * j]; }
#pragma unroll
            for (int r = 0; r < R; ++r)
#pragma unroll
                for (int j = 0; j < 4; ++j) { const f32x2 lo = __builtin_amdgcn_cvt_pk_f32_fp8((int)w[r][j], false), hi2 = __builtin_amdgcn_cvt_pk_f32_fp8((int)w[r][j], true);
                    a[r][j] += (f32x4){lo[0], lo[1], hi2[0], hi2[1]}; }
        }
#pragma unroll
        for (int r = 0; r < R; ++r) { if (ic[r] && !A.ctx_comb) continue;
#pragma unroll
            for (int j = 0; j < 4; ++j) v[r][j] += nv.g2[j] * (a[r][j] * 0.03125f);
            if (!FINAL) { bf16_t* dst = ic[r] ? (bf16_t*)A.cdst + (size_t)(row[r] - NLAT) * D : (bf16_t*)A.xdst + (size_t)row[r] * D;
#pragma unroll
                for (int j = 0; j < 4; ++j) { u32x2 w; w.x = cvt_pk_bf16(v[r][j][0], v[r][j][1]); w.y = cvt_pk_bf16(v[r][j][2], v[r][j][3]); ((u32x2*)dst)[lane + 64 * j] = w; } } }
    }
    float ss[R];
#pragma unroll
    for (int r = 0; r < R; ++r) { ss[r] = 0.f;
#pragma unroll
        for (int j = 0; j < 4; ++j) ss[r] += (v[r][j][0] * v[r][j][0] + v[r][j][1] * v[r][j][1]) + (v[r][j][2] * v[r][j][2] + v[r][j][3] * v[r][j][3]); }
#pragma unroll
    for (int r = 0; r < R; ++r) ss[r] = wave_sum64(ss[r]);
    if (FINAL) {
#pragma unroll
        for (int r = 0; r < R; ++r) { const float rstd = __builtin_amdgcn_rsqf(ss[r] * (1.f / D) + EPS);
#pragma unroll
            for (int j = 0; j < 4; ++j) ((f32x4*)(A.out + (size_t)row[r] * D))[lane + 64 * j] = v[r][j] * rstd * nv.g[j]; }
        return;
    }
#pragma unroll
    for (int r = 0; r < R; ++r) { const float rstd = __builtin_amdgcn_rsqf(ss[r] * (1.f / D) + EPS);
#pragma unroll
        for (int j = 0; j < 4; ++j) { v[r][j] = v[r][j] * rstd * nv.g[j] + nv.sh[j];
            if (ROUTER) ((unsigned*)((unsigned char*)A.hx + (size_t)row[r] * D))[lane + 64 * j] = gm::pk4_fp8(v[r][j][0], v[r][j][1], v[r][j][2], v[r][j][3]);
            else if (hxfold < 0) { u32x2 w; w.x = cvt_pk_bf16(v[r][j][0], v[r][j][1]); w.y = cvt_pk_bf16(v[r][j][2], v[r][j][3]); ((u32x2*)(A.hx + (size_t)row[r] * D))[lane + 64 * j] = w; } } }
    if (hxfold >= 0) {
#pragma unroll
        for (int j = 0; j < 4; ++j) { const f32x4 a = R == 2 ? v[0][j] + v[R - 1][j] : v[0][j];
            u32x2 w; w.x = cvt_pk_bf16(a[0], a[1]); w.y = cvt_pk_bf16(a[2], a[3]); ((u32x2*)(A.hx + (size_t)hxfold * D))[lane + 64 * j] = w;
            if (R == 2) { const f32x4 d = v[0][j] - v[1][j]; u32x2 w2; w2.x = cvt_pk_bf16(d[0], d[1]); w2.y = cvt_pk_bf16(d[2], d[3]); ((u32x2*)(A.hx + (size_t)(hxfold + 1024) * D))[lane + 64 * j] = w2; } } }
    if (ROUTER) {
        float t1[R]; float lgs[R][16];
        f32x4 wb[2][4];
#define RT_LOAD(buf, e) do { _Pragma("unroll") for (int j = 0; j < 4; ++j) wb[buf][j] = *(const LAS f32x4*)(wrT + (e) * WRT_PITCH + 4 * lane + 256 * j); } while (0)
        RT_LOAD(0, 0);
#pragma unroll
        for (int e = 0; e < 16; ++e) {
            if (e + 1 < 16) RT_LOAD((e + 1) & 1, e + 1);
            __builtin_amdgcn_sched_barrier(0);
            f32x2 s_[R];
#pragma unroll
            for (int r = 0; r < R; ++r) s_[r] = (f32x2){0.f, 0.f};
#pragma unroll
            for (int j = 0; j < 4; ++j) { const f32x4 w = wb[e & 1][j]; const f32x2 wlo = (f32x2){w[0], w[1]}, whi = (f32x2){w[2], w[3]};
#pragma unroll
                for (int r = 0; r < R; ++r) { s_[r] = __builtin_elementwise_fma((f32x2){v[r][j][0], v[r][j][1]}, wlo, s_[r]); s_[r] = __builtin_elementwise_fma((f32x2){v[r][j][2], v[r][j][3]}, whi, s_[r]); } }
#pragma unroll
            for (int r = 0; r < R; ++r) lgs[r][e] = s_[r][0] + s_[r][1];
            __builtin_amdgcn_sched_barrier(0);
        }
#undef RT_LOAD
        const bool x4a = __builtin_amdgcn_mov_dpp(lane, DPP_ROR4, 0xf, 0xf, true) == (lane ^ 4);
#pragma unroll
        for (int r = 0; r < R; ++r) {
            float lg[16];
#pragma unroll
            for (int e = 0; e < 16; ++e) lg[e] = lgs[r][e];
            float t8[8], t4[4], t2[2];
#pragma unroll
            for (int k = 0; k < 8; ++k) t8[k] = swap32_sum(lg[k], lg[k + 8]);
#pragma unroll
            for (int k = 0; k < 4; ++k) t4[k] = swap16_sum(t8[k], t8[k + 4]);
            { const bool up = (lane & 8) != 0;
#pragma unroll
              for (int k = 0; k < 2; ++k) { const float keep = up ? t4[k + 2] : t4[k], send = up ? t4[k] : t4[k + 2]; t2[k] = keep + lane_xor<8>(send, lane, x4a); } }
            { const bool up = (lane & 4) != 0; const float keep = up ? t2[1] : t2[0], send = up ? t2[0] : t2[1]; t1[r] = keep + lane_xor<4>(send, lane, x4a); }
        }
#pragma unroll
        for (int r = 0; r < R; ++r) { t1[r] += lane_xor<2>(t1[r], lane, x4a); }
#pragma unroll
        for (int r = 0; r < R; ++r) { t1[r] += lane_xor<1>(t1[r], lane, x4a); }
        float mx[R], ex[R], sm[R];
#pragma unroll
        for (int r = 0; r < R; ++r) { float m = t1[r]; m = fmaxf(m, dpp_f<DPP_ROR8>(m)); m = fmaxf(m, dpp_f<DPP_ROR4>(m)); m = swap16_max(m); mx[r] = swap32_max(m); }
#pragma unroll
        for (int r = 0; r < R; ++r) { ex[r] = __builtin_amdgcn_exp2f((t1[r] - mx[r]) * 1.4426950408889634f); sm[r] = ex[r]; }
#pragma unroll
        for (int r = 0; r < R; ++r) { float q = sm[r]; q += dpp_f<DPP_ROR8>(q); q += dpp_f<DPP_ROR4>(q); q = swap16_sum(q, q); sm[r] = swap32_sum(q, q); }
#pragma unroll
        for (int r = 0; r < R; ++r) if ((lane & 3) == 0) A.aff[(size_t)row[r] * 16 + (lane >> 2)] = ex[r] * __builtin_amdgcn_rcpf(sm[r]);
    }
}
template <bool COMBINE, bool ROUTER, bool FINAL>
__device__ __forceinline__ void norm_phase(const Frame& F, const NormArgs& A) {
    constexpr int R = 2;
    LAS float* wrT = (LAS float*)F.lds;
    if (ROUTER) {
        float tmp[32];
#pragma unroll
        for (int k = 0; k < 32; ++k) tmp[k] = A.wrouter[F.tid + NTHREADS * k];
#pragma unroll
        for (int k = 0; k < 32; ++k) { const int i = F.tid + NTHREADS * k; wrT[(i & 15) * WRT_PITCH + (i >> 4)] = tmp[k] * (1.0f / gm::F8_SX); }
        __syncthreads(); }
    const bf16_t* zrow = (const bf16_t*)(F.ws + WS_ZROW);
    const int gw = F.bid * NWAVES + F.wave, NGW = F.G * NWAVES;
    NormVec nv; nv.mr = -1;
    for (int part = 0; part < 2; ++part) {
        if (part == 0 ? !A.do_lat : !A.do_ctx) continue;
        const int base = part == 0 ? 0 : NLAT, n = part == 0 ? NLAT : NCTX, rpw = (n + NGW - 1) / NGW;
        int row = base + gw * rpw; const int rend = (row + rpw < base + n) ? row + rpw : base + n;
        f32x4 va[R][4], vb[R][4];
        const auto same = [&](int r) { return r + 1 < rend && (part == 1 ? ((r - NLAT) >> 8) == ((r + 1 - NLAT) >> 8) : (r >> 11) == ((r + 1) >> 11)); };
        if (row < rend && same(row)) norm_load<R>(A, row, 1, F.lane, va);
        while (row < rend) {
            const int mr = part == 1 ? 16 : (row >> 11);
            if (mr != nv.mr) normvec_load<COMBINE, FINAL, ROUTER>(A, mr, F.lane, nv);
            if (same(row)) { const int nx = row + R; const bool more = nx < rend && same(nx);
                if (more) norm_load<R>(A, nx, 1, F.lane, vb);
                norm_rows<COMBINE, ROUTER, FINAL, R>(A, nv, row, 1, F.lane, wrT, zrow, va);
                if (more) {
#pragma unroll
                    for (int r = 0; r < R; ++r)
#pragma unroll
                        for (int j = 0; j < 4; ++j) va[r][j] = vb[r][j]; }
                else if (nx < rend && !more) {   }
                row = nx; }
            else { f32x4 v1[1][4]; norm_load<1>(A, row, 1, F.lane, v1); norm_rows<COMBINE, ROUTER, FINAL, 1>(A, nv, row, 1, F.lane, wrT, zrow, v1); row += 1;
                if (row < rend && same(row)) norm_load<R>(A, row, 1, F.lane, va); }
        }
    }
    __syncthreads();
}

constexpr int HF_ROWS = 2304;
template <bool COMBINE>
__device__ __forceinline__ void norm_fold_phase(const Frame& F, const NormArgs& A) {
    const bf16_t* zrow = (const bf16_t*)(F.ws + WS_ZROW);
    const int gw = F.bid * NWAVES + F.wave, NGW = F.G * NWAVES;
    constexpr int NPAIR = NB * 1023;
    NormVec nv; nv.mr = -1;
    { const int ipw = (NPAIR + NGW - 1) / NGW; int it = gw * ipw; const int iend = (it + ipw < NPAIR) ? it + ipw : NPAIR; f32x4 va[2][4], vb[2][4];
      if (it < iend) { const int b = it / 1023, n = 1 + it - b * 1023; norm_load<2>(A, b * SEQ + n, SEQ - 2 * n, F.lane, va); }
      for (; it < iend; ++it) { const int b = it / 1023, n = 1 + it - b * 1023; const int nx = it + 1; const bool more = nx < iend;
          if (b != nv.mr) normvec_load<COMBINE, false>(A, b, F.lane, nv);
          if (more) { const int b2 = nx / 1023, n2 = 1 + nx - b2 * 1023; norm_load<2>(A, b2 * SEQ + n2, SEQ - 2 * n2, F.lane, vb); }
          norm_rows<COMBINE, false, false, 2>(A, nv, b * SEQ + n, SEQ - 2 * n, F.lane, nullptr, zrow, va, b * HF_ROWS + n);
          if (more) {
#pragma unroll
              for (int r = 0; r < 2; ++r)
#pragma unroll
                  for (int j = 0; j < 4; ++j) va[r][j] = vb[r][j]; } } }
    for (int it = gw; it < 2 * NB; it += NGW) { const int b = it >> 1, hi = it & 1; f32x4 v1[1][4];
        if (b != nv.mr) normvec_load<COMBINE, false>(A, b, F.lane, nv);
        norm_load<1>(A, b * SEQ + hi * 1024, 0, F.lane, v1); norm_rows<COMBINE, false, false, 1>(A, nv, b * SEQ + hi * 1024, 0, F.lane, nullptr, zrow, v1, b * HF_ROWS + hi * 2048); }
    for (int it = gw; it < NB * 256; it += NGW) { const int b = it >> 8, q = it & 255; const int r = q == 0 ? 1024 : 2048 + q;
        u32x2 z; z.x = 0u; z.y = 0u;
#pragma unroll
        for (int j = 0; j < 4; ++j) ((u32x2*)(A.hx + ((size_t)b * HF_ROWS + r) * D))[F.lane + 64 * j] = z; }
    __syncthreads();
}

template <int NV, int NTOK, int CAPN>
__device__ __forceinline__ void select_unit(const Frame& F, const float* aff_base  , int* tokslot_out  , int* slot_row_out, float* slot_aff_out, int row_base) {
    LAS int* cnt = (LAS int*)F.lds;
    LAS int* tg = cnt + 64; LAS int* te = tg + NV * 8;
    unsigned v[NV]; bool ok[NV];
#pragma unroll
    for (int k = 0; k < NV; ++k) { const int n = F.tid + NTHREADS * k; ok[k] = n < NTOK; v[k] = ok[k] ? __float_as_uint(aff_base[(size_t)n * 16]) : 0u; }
    unsigned T = 0u;
    for (int bit = 29; bit >= 0; --bit) { const unsigned cand = T | (1u << bit); int cw = 0;
#pragma unroll
        for (int k = 0; k < NV; ++k) cw += __builtin_popcountll(__ballot(ok[k] && v[k] >= cand));
        LAS int* cb = cnt + (bit & 1) * 8;
        if (F.lane == 0) cb[F.wave] = cw;
        __syncthreads();
        int tot = 0;
#pragma unroll
        for (int w = 0; w < 8; ++w) tot += cb[w];
        if (tot >= CAPN) T = cand; }
    int pg[NV], pe[NV]; bool isg[NV], ise[NV];
#pragma unroll
    for (int k = 0; k < NV; ++k) { isg[k] = ok[k] && v[k] > T; ise[k] = ok[k] && v[k] == T;
        const unsigned long long mg = __ballot(isg[k]), me = __ballot(ise[k]); const unsigned long long below = (1ull << F.lane) - 1ull;
        pg[k] = __builtin_popcountll(mg & below); pe[k] = __builtin_popcountll(me & below);
        if (F.lane == 0) { tg[k * 8 + F.wave] = __builtin_popcountll(mg); te[k * 8 + F.wave] = __builtin_popcountll(me); } }
    __syncthreads();
    LAS int* xg = te + NV * 8; LAS int* xe = xg + NV * 8 + 1;
    if (F.tid == 0) { int ag = 0, ae = 0; for (int i = 0; i < NV * 8; ++i) { xg[i] = ag; xe[i] = ae; ag += tg[i]; ae += te[i]; } xg[NV * 8] = ag; }
    __syncthreads();
    const int totg = xg[NV * 8];
#pragma unroll
    for (int k = 0; k < NV; ++k) { const int og = xg[k * 8 + F.wave], oe = xe[k * 8 + F.wave];
        const int n = F.tid + NTHREADS * k;
        if (ok[k]) { int slot = -1;
            if (isg[k]) slot = og + pg[k];
            else if (ise[k]) { const int rk = oe + pe[k]; if (totg + rk < CAPN) slot = totg + rk; }
            tokslot_out[n] = slot;
            if (slot >= 0) { slot_row_out[slot] = row_base + n; slot_aff_out[slot] = __uint_as_float(v[k]); } } }
    __syncthreads();
}
__device__ __forceinline__ void topk_phase(const Frame& F, bool do_ctx) {
    const float* aff = F.W<float>(WS_AFF); int* slot_row = F.W<int>(WS_SLOTROW); float* slot_aff = F.W<float>(WS_SLOTAFF); int* tokslot = F.W<int>(WS_TOKSLOT); int* tokslotc = F.W<int>(WS_TOKSLOTC);
    const int nunits = do_ctx ? 512 : 256;
    for (int u = F.bid; u < nunits; u += F.G) {
        if (u < 256) { const int b = u >> 4, e = u & 15;
            select_unit<4, SEQ, CAP>(F, aff + (size_t)b * SEQ * 16 + e, tokslot + (b * 16 + e) * SEQ, slot_row + e * gm::ES + b * CAP, slot_aff + e * gm::ES + b * CAP, b * SEQ); }
        else { const int b = (u - 256) >> 4, e = u & 15;
            select_unit<1, CTXL, CAPC>(F, aff + ((size_t)NLAT + (size_t)b * CTXL) * 16 + e, tokslotc + (b * 16 + e) * CTXL, slot_row + e * gm::ES + 4096 + b * CAPC, slot_aff + e * gm::ES + 4096 + b * CAPC, NLAT + b * CTXL); }
    }
}

__device__ __forceinline__ void gm_prep_phase(const Frame& F) {
    const float* ws_ = F.in[I_GMWS]; const float* sumsq = F.W<float>(WS_SUMSQ); bf16_t* App = F.W<bf16_t>(RA_APP);
    LAS float* rs = (LAS float*)F.lds;
    for (int item = F.bid; item < NB * 9 * 2; item += F.G) { const int gq = item & 1, bc = item >> 1, b = bc / 9, cp = bc - b * 9;
        const size_t trow0 = cp == 0 ? (size_t)NLAT + (size_t)b * CTXL : (size_t)b * SEQ + (size_t)(cp - 1) * 256;
        if (F.tid < 256) { const f32x4* pa = (const f32x4*)(sumsq + (trow0 + F.tid) * 16); const f32x4 a0 = pa[0], a1 = pa[1], a2 = pa[2], a3 = pa[3];
            const float sm = (((a0[0] + a0[1]) + (a0[2] + a0[3])) + ((a1[0] + a1[1]) + (a1[2] + a1[3]))) + (((a2[0] + a2[1]) + (a2[2] + a2[3])) + ((a3[0] + a3[1]) + (a3[2] + a3[3])));
            rs[F.tid] = __builtin_amdgcn_rsqf(sm * (1.f / 2048.f) + EPS); }
        __syncthreads();
        constexpr int U = 4;
        for (int i0 = F.tid; i0 < 4 * 4096; i0 += U * NTHREADS) {
            f32x4 w0[U], w1[U];
#pragma unroll
            for (int q = 0; q < U; ++q) { const int i = i0 + q * NTHREADS; const int g = gq * 4 + (i >> 12), r = (i >> 4) & 255, k0 = (i & 15) * 8;
                const float* wp = ws_ + ((size_t)g * 128 + (r & 127)) * 128 + k0; w0[q] = *(const f32x4*)wp; w1[q] = *(const f32x4*)(wp + 4); }
#pragma unroll
            for (int q = 0; q < U; ++q) { const int i = i0 + q * NTHREADS; const int g = gq * 4 + (i >> 12), r = (i >> 4) & 255, k0 = (i & 15) * 8, tk = (r >> 7) * 128 + k0;
                const f32x4 r0 = *(const LAS f32x4*)(rs + tk), r1 = *(const LAS f32x4*)(rs + tk + 4);
                *(u32x4*)(App + ((size_t)(bc * 8 + g) * 4096 + (i & 4095)) * 8) = gm::pack8(w0[q] * r0, w1[q] * r1); }
        }
        __syncthreads();
    }
}

enum { PH_PRO = 0,
       PH_L0_N1, PH_L0_QKV, PH_L0_ATT, PH_L0_OUT, PH_L0_N2, PH_L0_TOPK, PH_L0_GU, PH_L0_DOWN,
       PH_L1_N1, PH_L1_GMIN, PH_L1_PREP, PH_L1_SPAT, PH_L1_OUT, PH_L1_N2, PH_L1_TOPK, PH_L1_GU, PH_L1_DOWN,
       PH_L2_N1, PH_L2_QKV, PH_L2_ATT, PH_L2_OUT, PH_L2_N2, PH_L2_TOPK, PH_L2_GU, PH_L2_DOWN,
       PH_L3_N1, PH_L3_CDFT, PH_L3_PDFT, PH_L3_OUT, PH_L3_N2, PH_L3_TOPK, PH_L3_GU, PH_L3_DOWN,
       PH_FINAL, NPHASES };

__device__ __forceinline__ const float* modp(const Frame& F, int layer, int j) { return F.W<float>(WS_MOD) + (size_t)layer * MODR * MODW + (size_t)j * D; }

template <bool COMBINE>
__device__ __forceinline__ void norm1_phase(const Frame& F, int layer, bool do_ctx, bool ctx_comb) {
    NormArgs A{};
    A.xsrc = COMBINE ? F.W<float>(WS_X) : F.in[I_X]; A.xdst = F.W<float>(WS_X); A.csrc = COMBINE ? F.W<float>(WS_CTX) : F.in[I_CTX]; A.cdst = F.W<float>(WS_CTX);
    A.do_lat = 1; A.do_ctx = do_ctx ? 1 : 0; A.xbf = COMBINE ? 1 : 0; A.xcopy = COMBINE ? 0 : 1;
    A.gain = F.in[I_MNG] + layer * D; A.shift = modp(F, layer, 0); A.scale = modp(F, layer, 1); A.hx = F.W<bf16_t>(WS_HX);
    A.ys = F.W<bf16_t>(RA_YS); A.tokslot = F.W<int>(WS_TOKSLOT); A.tokslotc = F.W<int>(WS_TOKSLOTC); A.g2 = modp(F, layer > 0 ? layer - 1 : 0, 5); A.ctx_comb = ctx_comb ? 1 : 0;
    norm_phase<COMBINE, false, false>(F, A);
}
__device__ __forceinline__ void norm2_phase(const Frame& F, int layer, bool do_ctx) {
    NormArgs A{};
    A.xsrc = F.W<float>(WS_X); A.csrc = F.W<float>(WS_CTX); A.do_lat = 1; A.do_ctx = do_ctx ? 1 : 0; A.xbf = 1;
    A.gain = F.in[I_MOEG] + layer * D; A.shift = modp(F, layer, 3); A.scale = modp(F, layer, 4); A.hx = F.W<bf16_t>(WS_HX);
    A.wrouter = F.in[I_ROUTER] + (size_t)layer * D * NE; A.aff = F.W<float>(WS_AFF);
    norm_phase<false, true, false>(F, A);
}
__device__ __forceinline__ void out_phase(const Frame& F, int layer, const char* A, unsigned lda, int K, size_t wofs, int nM) {
    gm::P_OUT p; p.A = A; p.B = (const char*)(F.ws + wofs); p.lda_ = lda; p.K_ = K; p.nM = nM;
    p.xb_ = F.W<bf16_t>(WS_X); p.cb_ = F.W<bf16_t>(WS_CTX); p.gate = modp(F, layer, 2);
    gm::gemm_phase(F.lds, p);
}
__device__ __forceinline__ void gu_phase(const Frame& F, int layer, bool with_ctx) {
    gm::P_GU p; p.hx = (const char*)(F.ws + WS_HX); p.W = (const char*)(F.ws + WGU_OF(layer)); p.hid = F.W<unsigned char>(RA_HID); p.slot_row = F.W<int>(WS_SLOTROW); p.nM = with_ctx ? 18 : 16;
    gm::gemm_phase(F.lds, p);
}
__device__ __forceinline__ void down_phase(const Frame& F, int layer, bool with_ctx) {
    gm::P_DOWN p; p.hid = (const char*)(F.ws + RA_HID); p.W = (const char*)(F.ws + WD_OF(layer)); p.ys = F.W<bf16_t>(RA_YS); p.slot_aff = F.W<float>(WS_SLOTAFF); p.nM = with_ctx ? 18 : 16;
    gm::gemm_phase(F.lds, p);
}

__global__ void __launch_bounds__(NTHREADS, 2) fwd(Params P) {
    extern __shared__ __attribute__((aligned(16))) unsigned char lds_raw[];
    Frame F;
    F.lds = (LAS unsigned char*)lds_raw; F.ws = P.ws; F.out = P.out;
#pragma unroll
    for (int i = 0; i < 29; ++i) F.in[i] = P.in[i];
    F.tid = threadIdx.x; F.lane = F.tid & 63; F.wave = __builtin_amdgcn_readfirstlane(F.tid >> 6); F.G = gridDim.x; F.bid = blockIdx.x;
    volatile LAS unsigned* MISC = (volatile LAS unsigned*)(F.lds + LDS_MISC);
    if (F.tid < 64) MISC[F.tid] = 0u;
    __syncthreads();
    const int lo = P.ph_lo, hi = P.ph_hi;
    const bool tails = (gridDim.x == 256);
    XcdBarrier bar = xcd_barrier_post((unsigned*)(F.ws + WS_CTL) + 1024 + (size_t)P.li * XCD_BAR_WORDS, MISC);
#ifdef MK_ONLY_PHASE
#define IN(k) ((k) == MK_ONLY_PHASE && lo <= (k) && (k) < hi)
#else
#define IN(k) (lo <= (k) && (k) < hi)
#endif
#define SEAM(k) do { if (IN(k) && IN((k) + 1)) xcd_barrier(bar); } while (0)
#define REFRESH() do { int tz_ = threadIdx.x; asm volatile("" : "+v"(tz_)); F.tid = tz_; F.lane = tz_ & 63; F.wave = __builtin_amdgcn_readfirstlane(tz_ >> 6); } while (0)

    if (IN(PH_PRO)) { REFRESH(); p0_prologue(F, tails); } SEAM(PH_PRO);

    if (IN(PH_L0_N1)) { REFRESH(); norm1_phase<false>(F, 0, true, false); } SEAM(PH_L0_N1);
    if (IN(PH_L0_QKV)) { REFRESH();
        gm::P_QKV0 p; p.A = (const char*)(F.ws + WS_HX); p.B = (const char*)(F.ws + WS_WQKV0); p.q = F.W<bf16_t>(RB_Q); p.k = F.W<bf16_t>(RB_K); p.v = F.W<bf16_t>(RB_V);
        p.ropeC = F.W<float>(WS_ROPE); p.ropeS = F.W<float>(WS_ROPE + 4096);
        gm::gemm_phase(F.lds, p);
        if (tails) moe_weights_tail(F, 1, 0, 48, F.bid - 192);
    } SEAM(PH_L0_QKV);
    if (IN(PH_L0_ATT)) { REFRESH();
        float lam;
        { const float a = F.in[I_LQ1][F.lane] * F.in[I_LK1][F.lane], b = F.in[I_LQ2][F.lane] * F.in[I_LK2][F.lane]; lam = expf(wave_sum(a)) - expf(wave_sum(b)) + 0.2f; }
        const bf16_t* q = F.W<bf16_t>(RB_Q); const bf16_t* k = F.W<bf16_t>(RB_K); const bf16_t* v = F.W<bf16_t>(RB_V); bf16_t* o = F.W<bf16_t>(RB_O);
        if (tails && ((F.bid >> 3) & 3) == 0) { const int rank = (F.bid >> 5) * 8 + (F.bid & 7);
            weights_range(F, 0, 0, rank * 384, rank * 384 + 384, F.wave, NWAVES);
            weights_range(F, 1, 0, 18432 + rank * 96, 18432 + rank * 96 + 96, F.wave, NWAVES);
            weights_range(F, 3, 0, 3072 + rank * 336, 3072 + rank * 336 + 336, F.wave, NWAVES);
            __syncthreads(); }
        { unsigned* qcnt = (unsigned*)(F.ws + WS_CTL) + 160000; volatile LAS unsigned* qslot = (volatile LAS unsigned*)(F.lds + LDS_MISC) + 8;
          const int myx = (int)(xb_xcc_id() & 7u);
          for (int s8 = 0; s8 < 8; ++s8) { const int x = (myx + s8) & 7;
            for (;;) {
                if (F.tid == 0) *qslot = __hip_atomic_fetch_add(qcnt + x * 64, 1u, __ATOMIC_RELAXED, __HIP_MEMORY_SCOPE_AGENT);
                __syncthreads();
                const int kq = (int)*qslot;
                if (kq >= 288) { __syncthreads(); break; }
                if (kq < 256) { const int bh = x + 8 * (kq >> 4), qb = kq & 15, b = bh >> 3, h = bh & 7; const size_t row0 = (size_t)b * SEQ + qb * 128;
                    at::diff_attn_unit_dma(q + (((size_t)b * 8 + h) * KVL + CTXL + qb * 128) * 128, k + ((size_t)b * 8 + h) * KVL * 128, v + ((size_t)b * 8 + h) * KVL * 128, o + row0 * D + h * 128, KVL, lam, 0.8f, F.in[I_SUBLN], (LAS char*)F.lds); }
                else { const int kk = kq - 256, bh = x + 8 * (kk >> 1), qb = kk & 1, b = bh >> 3, h = bh & 7; const size_t row0 = (size_t)NLAT + (size_t)b * CTXL + qb * 128;
                    at::diff_attn_unit_dma(q + (((size_t)b * 8 + h) * KVL + qb * 128) * 128, k + ((size_t)b * 8 + h) * KVL * 128, v + ((size_t)b * 8 + h) * KVL * 128, o + row0 * D + h * 128, CTXL, lam, 0.8f, F.in[I_SUBLN], (LAS char*)F.lds); }
            } } }
#ifdef MK_PROBE_ATT
        { bf16_t* od = F.W<bf16_t>(RA_HID);
          for (int u = F.bid; u < 2048 + 256; u += F.G) {
            if (u < 2048) { const int b = u >> 7, h = (u >> 4) & 7, qb = u & 15; const size_t row0 = (size_t)b * SEQ + qb * 128;
                at::diff_attn_unit<MK_PROBE_ATT>(q + (((size_t)b * 8 + h) * KVL + CTXL + qb * 128) * 128, k + ((size_t)b * 8 + h) * KVL * 128, v + ((size_t)b * 8 + h) * KVL * 128, od + row0 * D + h * 128, KVL, lam, 0.8f, F.in[I_SUBLN], (LAS char*)F.lds); }
            else { const int uu = u - 2048, b = uu >> 4, h = (uu >> 1) & 7, qb = uu & 1; const size_t row0 = (size_t)NLAT + (size_t)b * CTXL + qb * 128;
                at::diff_attn_unit<MK_PROBE_ATT>(q + (((size_t)b * 8 + h) * KVL + qb * 128) * 128, k + ((size_t)b * 8 + h) * KVL * 128, v + ((size_t)b * 8 + h) * KVL * 128, od + row0 * D + h * 128, CTXL, lam, 0.8f, F.in[I_SUBLN], (LAS char*)F.lds); }
          } }
#endif
    } SEAM(PH_L0_ATT);
    if (IN(PH_L0_OUT)) { REFRESH(); out_phase(F, 0, (const char*)(F.ws + RB_O), 2048, 1024, WS_WO0, 144); if (tails) moe_weights_tail(F, 1, 3072, 48, F.bid - 64); } SEAM(PH_L0_OUT);
    if (IN(PH_L0_N2)) { REFRESH(); norm2_phase(F, 0, true); } SEAM(PH_L0_N2);
    if (IN(PH_L0_TOPK)) { REFRESH(); topk_phase(F, true); } SEAM(PH_L0_TOPK);
    if (IN(PH_L0_GU)) { REFRESH(); gu_phase(F, 0, true); } SEAM(PH_L0_GU);
    if (IN(PH_L0_DOWN)) { REFRESH(); down_phase(F, 0, true); if (tails) moe_weights_tail(F, 1, 12288, 48, F.bid - 128); } SEAM(PH_L0_DOWN);

    if (IN(PH_L1_N1)) { REFRESH();
        norm1_phase<true>(F, 1, true, true);
        if (!tails) moe_weights_phase(F, 1, 0);
    } SEAM(PH_L1_N1);
    if (IN(PH_L1_GMIN)) { REFRESH();
        { gm::P_GMU p; p.hx = (const char*)(F.ws + WS_HX); p.W = (const char*)(F.ws + WS_WGIN); p.u_out = F.W<bf16_t>(RB_U); gm::gemm_phase(F.lds, p); }
        { gm::P_GMV p; p.hx = (const char*)(F.ws + WS_HX); p.W = (const char*)(F.ws + WS_WGIN); p.vT = F.W<bf16_t>(RB_VT); p.sumsq = F.W<float>(WS_SUMSQ); gm::gemm_phase(F.lds, p, F.G - 1 - F.bid); }
    } SEAM(PH_L1_GMIN);
    if (IN(PH_L1_PREP)) { REFRESH(); gm_prep_phase(F); } SEAM(PH_L1_PREP);
    if (IN(PH_L1_SPAT)) { REFRESH();
        gm::P_SPAT p; p.App = (const char*)(F.ws + RA_APP); p.vT = (const char*)(F.ws + RB_VT); p.u_io = F.W<bf16_t>(RB_U); p.v_g = F.in[I_GMVG]; p.b_s = F.in[I_GMBS]; p.zeros = (const char*)(F.ws + WS_CTL + 800 * 1024);
        gm::gemm_phase(F.lds, p);
    } SEAM(PH_L1_SPAT);
    if (IN(PH_L1_OUT)) { REFRESH(); out_phase(F, 1, (const char*)(F.ws + RB_U), 4096, 2048, WS_WGOUT, 144); if (tails) moe_weights_tail(F, 2, 0, 96, F.bid - 64); } SEAM(PH_L1_OUT);
    if (IN(PH_L1_N2)) { REFRESH(); norm2_phase(F, 1, true); } SEAM(PH_L1_N2);
    if (IN(PH_L1_TOPK)) { REFRESH(); topk_phase(F, true); } SEAM(PH_L1_TOPK);
    if (IN(PH_L1_GU)) { REFRESH(); gu_phase(F, 1, true); } SEAM(PH_L1_GU);
    if (IN(PH_L1_DOWN)) { REFRESH(); down_phase(F, 1, true); if (tails) moe_weights_tail(F, 2, 18432, 48, F.bid - 128); } SEAM(PH_L1_DOWN);

    if (IN(PH_L2_N1)) { REFRESH(); norm1_phase<true>(F, 2, true, true); if (!tails) moe_weights_phase(F, 2); } SEAM(PH_L2_N1);
    if (IN(PH_L2_QKV)) { REFRESH();
        gm::P_QKV2 p; p.A = (const char*)(F.ws + WS_HX); p.B = (const char*)(F.ws + WS_WQKV2); p.q = F.W<bf16_t>(RB_Q); p.k = F.W<bf16_t>(RB_K); p.v = F.W<bf16_t>(RB_V);
        gm::gemm_phase(F.lds, p);
        if (tails) moe_weights_tail(F, 3, 0, 48, F.bid - 192);
    } SEAM(PH_L2_QKV);
    if (IN(PH_L2_ATT)) { REFRESH();
        for (int u = F.bid; u < 2048; u += F.G) { const int b = u >> 7, h = (u >> 3) & 15, R4 = u & 7;
            at::natten_unit(F.W<bf16_t>(RB_Q), F.W<bf16_t>(RB_K), F.W<bf16_t>(RB_V), F.W<bf16_t>(RB_O), F.in[I_NARPB], b, h, R4, (LAS char*)F.lds); }
    } SEAM(PH_L2_ATT);
    if (IN(PH_L2_OUT)) { REFRESH(); out_phase(F, 2, (const char*)(F.ws + RB_O), 2048, 1024, WS_WO2, 128); } SEAM(PH_L2_OUT);
    if (IN(PH_L2_N2)) { REFRESH(); norm2_phase(F, 2, false); } SEAM(PH_L2_N2);
    if (IN(PH_L2_TOPK)) { REFRESH(); topk_phase(F, false); } SEAM(PH_L2_TOPK);
    if (IN(PH_L2_GU)) { REFRESH(); gu_phase(F, 2, false); } SEAM(PH_L2_GU);
    if (IN(PH_L2_DOWN)) { REFRESH(); down_phase(F, 2, false); } SEAM(PH_L2_DOWN);

    if (IN(PH_L3_N1)) { REFRESH();
        NormArgs A{};
        A.xsrc = F.W<float>(WS_X); A.xdst = F.W<float>(WS_X); A.csrc = F.W<float>(WS_CTX); A.cdst = F.W<float>(WS_CTX); A.do_lat = 1; A.do_ctx = 0; A.xbf = 1;
        A.gain = F.in[I_MNG] + 3 * D; A.shift = modp(F, 3, 0); A.scale = modp(F, 3, 1); A.hx = F.W<bf16_t>(WS_HX);
        A.ys = F.W<bf16_t>(RA_YS); A.tokslot = F.W<int>(WS_TOKSLOT); A.tokslotc = F.W<int>(WS_TOKSLOTC); A.g2 = modp(F, 2, 5); A.ctx_comb = 0;
        norm_fold_phase<true>(F, A);
        if (!tails) moe_weights_phase(F, 3, 0); } SEAM(PH_L3_N1);
    if (IN(PH_L3_CDFT)) { REFRESH();
        gm::P_CDFT p; p.CS = (const char*)(F.ws + WS_CS); p.hx = (const char*)(F.ws + WS_HX); p.PQt = F.W<bf16_t>(RB_PQ);
        gm::gemm_phase(F.lds, p);
    } SEAM(PH_L3_CDFT);
    if (IN(PH_L3_PDFT)) { REFRESH();
        gm::P_PDFT p; p.DP = (const char*)(F.ws + WS_DP); p.PQt = (const char*)(F.ws + RB_PQ); p.f = F.W<bf16_t>(RB_F);
        gm::gemm_phase(F.lds, p);
    } SEAM(PH_L3_PDFT);
    if (IN(PH_L3_OUT)) { REFRESH(); out_phase(F, 3, (const char*)(F.ws + RB_F), 2048, 1024, WS_WFO, 128); } SEAM(PH_L3_OUT);
    if (IN(PH_L3_N2)) { REFRESH(); norm2_phase(F, 3, false); } SEAM(PH_L3_N2);
    if (IN(PH_L3_TOPK)) { REFRESH(); topk_phase(F, false); } SEAM(PH_L3_TOPK);
    if (IN(PH_L3_GU)) { REFRESH(); gu_phase(F, 3, false); } SEAM(PH_L3_GU);
    if (IN(PH_L3_DOWN)) { REFRESH(); down_phase(F, 3, false); } SEAM(PH_L3_DOWN);

    if (IN(PH_FINAL)) { REFRESH();
        NormArgs A{};
        A.xsrc = F.W<float>(WS_X); A.do_lat = 1; A.do_ctx = 0; A.xbf = 1; A.gain = F.in[I_FINALG];
        A.ys = F.W<bf16_t>(RA_YS); A.tokslot = F.W<int>(WS_TOKSLOT); A.tokslotc = F.W<int>(WS_TOKSLOTC); A.g2 = modp(F, 3, 5); A.out = F.out;
        norm_phase<true, false, true>(F, A);
    }
#undef IN
#undef SEAM
}

extern "C" void kernel_launch(void* const* d_in, const int* in_sizes, int n_in, void* d_out, int out_size, void* d_ws, size_t ws_size, hipStream_t stream) {
    static int grid = 0;
    if (grid == 0) {
        if (n_in != 29 || in_sizes[0] != NLAT * D || out_size != NLAT * D || ws_size < WS_END) {
            fprintf(stderr, "kernel_launch: shape mismatch: n_in %d in0 %d out %d ws %zu (need >= %zu)\n", n_in, n_in > 0 ? in_sizes[0] : -1, out_size, ws_size, (size_t)WS_END); grid = -1; return; }
        int dev = 0, cus = 0, per_cu = 0;
        if (hipGetDevice(&dev) != hipSuccess || hipDeviceGetAttribute(&cus, hipDeviceAttributeMultiprocessorCount, dev) != hipSuccess) { grid = -1; return; }
        if (hipFuncSetAttribute((const void*)fwd, hipFuncAttributeMaxDynamicSharedMemorySize, LDS_BYTES) != hipSuccess) { fprintf(stderr, "kernel_launch: hipFuncSetAttribute failed\n"); grid = -1; return; }
        if (hipOccupancyMaxActiveBlocksPerMultiprocessor(&per_cu, (const void*)fwd, NTHREADS, LDS_BYTES) != hipSuccess || per_cu < 1) { fprintf(stderr, "kernel_launch: occupancy query says %d\n", per_cu); (void)hipGetLastError(); per_cu = 1; }
        grid = cus;
    }
    if (grid < 0) return;
    (void)hipMemsetAsync((char*)d_ws + WS_CTL, 0, CTL_BYTES, stream);
    Params p{};
    for (int i = 0; i < 29; ++i) p.in[i] = (const float*)d_in[i];
    p.out = (float*)d_out; p.ws = (unsigned char*)d_ws;
#ifndef MK_RANGES
#define MK_RANGES 0, NPHASES
#endif
    static const int ranges[] = { MK_RANGES };
    for (unsigned r = 0; r + 1 < sizeof(ranges) / sizeof(ranges[0]); r += 2) { p.ph_lo = ranges[r]; p.ph_hi = ranges[r + 1]; p.li = (int)(r / 2); hipLaunchKernelGGL(fwd, dim3(grid), dim3(NTHREADS), LDS_BYTES, stream, p); }
    const hipError_t le = hipPeekAtLastError();
    if (le != hipSuccess) fprintf(stderr, "kernel_launch: launch failed: %s\n", hipGetErrorName(le));
}
```

```cpp
#include <hip/hip_runtime.h>
#include <cstdio>
#include <cstdint>

#define LAS __attribute__((address_space(3)))
#define GAS __attribute__((address_space(1)))
typedef unsigned short bf16_t;
typedef short bf16x8 __attribute__((ext_vector_type(8)));
typedef short s16x4 __attribute__((ext_vector_type(4)));
typedef float f32x4 __attribute__((ext_vector_type(4)));
typedef float f32x2 __attribute__((ext_vector_type(2)));
typedef float f32x16 __attribute__((ext_vector_type(16)));
typedef unsigned u32x4 __attribute__((ext_vector_type(4)));
typedef unsigned u32x2 __attribute__((ext_vector_type(2)));

constexpr int D = 1024, NB = 16, SEQ = 2048, NLAT = NB * SEQ, CTXL = 256, NCTX = NB * CTXL, MALL = NLAT + NCTX;
constexpr int NE = 16, CAP = 256, CAPC = 32, KVL = CTXL + SEQ;
constexpr int MODW = 6 * D, MODR = 17;
constexpr float EPS = 1e-6f;
constexpr int NWAVES = 8, NTHREADS = 512;

constexpr size_t MiB = (size_t)1 << 20;
constexpr size_t WS_CTL = 0, CTL_BYTES = 1 * MiB;
constexpr size_t WS_MOD = 1 * MiB;
constexpr size_t WS_ROPE = 3 * MiB;
constexpr size_t WS_CS = 3 * MiB + 65536;
constexpr size_t WS_AFF = 4 * MiB;
constexpr size_t WS_SLOTROW = 7 * MiB;
constexpr size_t WS_SLOTAFF = 7 * MiB + 524288;
constexpr size_t WS_TOKSLOT = 8 * MiB;
constexpr size_t WS_TOKSLOTC = 10 * MiB;
constexpr size_t WS_SUMSQ = 21 * MiB;
constexpr size_t WS_DP = 12 * MiB;
constexpr size_t WS_WQKV0 = 28 * MiB, WS_WO0 = 34 * MiB, WS_WGIN = 36 * MiB, WS_WGOUT = 44 * MiB, WS_WQKV2 = 48 * MiB, WS_WO2 = 54 * MiB, WS_WFO = 56 * MiB;
constexpr size_t WS_WGU = 58 * MiB;
constexpr size_t WS_WD = 122 * MiB;
constexpr size_t WS_X = 154 * MiB;
constexpr size_t WS_CTX = 282 * MiB;
constexpr size_t WS_HX = 298 * MiB;
constexpr size_t WS_RA = 370 * MiB;
constexpr size_t WS_RB = 658 * MiB;
constexpr size_t WS_W2 = 946 * MiB;
constexpr size_t WS_END = 1042 * MiB;
constexpr size_t WGU_OF(int layer) { return layer == 3 ? WS_WGU + 32 * MiB : ((layer & 1) ? WS_W2 : WS_WGU); }
constexpr size_t WD_OF(int layer) { return layer == 3 ? WS_WD + 16 * MiB : ((layer & 1) ? WS_W2 + 64 * MiB : WS_WD); }
constexpr size_t RA_HID = WS_RA, RA_YS = WS_RA + 144 * MiB, RA_APP = WS_RA;
constexpr size_t RB_Q = WS_RB, RB_K = WS_RB + 72 * MiB, RB_V = WS_RB + 144 * MiB, RB_O = WS_RB + 216 * MiB;
constexpr size_t RB_U = WS_RB, RB_VT = WS_RB + 144 * MiB;
constexpr size_t RB_PQ = WS_RB, RB_F = WS_RB + 128 * MiB;

constexpr int LDS_RING = 131072;
constexpr int LDS_MISC = LDS_RING;
constexpr int LDS_BYTES = 147456;

#define LDS_WAIT() asm volatile("s_waitcnt lgkmcnt(0)" ::: "memory")
#define VM_WAIT() asm volatile("s_waitcnt vmcnt(0)" ::: "memory")
__device__ __forceinline__ unsigned cvt_pk_bf16(float lo, float hi) { unsigned r; asm volatile("v_cvt_pk_bf16_f32 %0, %1, %2" : "=v"(r) : "v"(lo), "v"(hi)); return r; }
__device__ __forceinline__ float bf_lo(unsigned w) { return __uint_as_float(w << 16); }
__device__ __forceinline__ float bf_hi(unsigned w) { return __uint_as_float(w & 0xffff0000u); }
__device__ __forceinline__ float wave_sum(float v) {
#pragma unroll
    for (int o = 1; o < 64; o <<= 1) v += __shfl_xor(v, o);
    return v;
}
__device__ __forceinline__ float fast_rcp(float x) { return __builtin_amdgcn_rcpf(x); }
__device__ __forceinline__ float silu_f(float x) { return x * fast_rcp(1.0f + __builtin_amdgcn_exp2f(-1.4426950408889634f * x)); }
__device__ __forceinline__ float gelu_tanh_f(float x) {
    const float y2 = 1.5957691216057308f * (x + 0.044715f * x * x * x);
    return x - x * fast_rcp(1.0f + __builtin_amdgcn_exp2f(1.4426950408889634f * y2));
}

__device__ __forceinline__ f32x4 gelu_tanh4(const f32x4 x) {
    constexpr float cp = -1.5957691216057308f * 1.4426950408889634f, ca = 0.044715f * cp;
    const f32x4 t = __builtin_elementwise_fma(x * x, (f32x4){ca, ca, ca, ca}, (f32x4){cp, cp, cp, cp}) * x; f32x4 e, r;
#pragma unroll
    for (int j = 0; j < 4; ++j) e[j] = __builtin_amdgcn_exp2f(t[j]);
    f32x2 dl = (f32x2){e[0], e[1]}, dh = (f32x2){e[2], e[3]};
#if defined(__HIP_DEVICE_COMPILE__)
    asm("v_pk_add_f32 %0, %1, 1.0 op_sel_hi:[1,0]" : "=v"(dl) : "v"(dl));
    asm("v_pk_add_f32 %0, %1, 1.0 op_sel_hi:[1,0]" : "=v"(dh) : "v"(dh));
#endif
    r[0] = __builtin_amdgcn_rcpf(dl[0]); r[1] = __builtin_amdgcn_rcpf(dl[1]); r[2] = __builtin_amdgcn_rcpf(dh[0]); r[3] = __builtin_amdgcn_rcpf(dh[1]);
    return x * r;
}

#define XB_TMO      128
#define XB_XCNT(j)  (256  + 64 * (j))
#define XB_XSUB(j)  (1280 + 64 * (j))
#define XB_XGEN(j)  (2304 + 64 * (j))
#define XB_TOP      3328
#define XB_TOPGEN   3392
#define XCD_BAR_WORDS 3456
#define XB_SPIN_CAP (1u << 18)
__device__ __forceinline__ unsigned xb_ld(unsigned* p)              { return __hip_atomic_load(p, __ATOMIC_RELAXED, __HIP_MEMORY_SCOPE_AGENT); }
__device__ __forceinline__ unsigned xb_add(unsigned* p, unsigned v) { return __hip_atomic_fetch_add(p, v, __ATOMIC_RELAXED, __HIP_MEMORY_SCOPE_AGENT); }
__device__ __forceinline__ unsigned xb_xcc_id() { return (unsigned)__builtin_amdgcn_s_getreg((3 << 11) | 20) & 0xFu; }
#define XB_SPIN(cond, bar) do { unsigned _sp = 0; while (cond) { __builtin_amdgcn_s_sleep(1); \
    if ((++_sp & 255u) == 0u) { if (xb_ld(&(bar)[XB_TMO])) break; if (_sp > XB_SPIN_CAP) { atomicAdd(&(bar)[XB_TMO], 1u); break; } } } } while (0)
struct XcdBarrier { unsigned* bar; unsigned x; volatile LAS unsigned* st; };
__device__ __forceinline__ XcdBarrier xcd_barrier_post(unsigned* bar, volatile LAS unsigned* st) {
    XcdBarrier b; b.bar = bar; b.x = xb_xcc_id(); b.st = st;
    if (threadIdx.x == 0) (void)xb_add(&bar[XB_XCNT(b.x)], 1u);
    return b;
}
__device__ __forceinline__ void xcd_barrier_complete(unsigned* bar, unsigned x, unsigned& nloc, unsigned& nx) {
    const unsigned G = gridDim.x * gridDim.y * gridDim.z;
    unsigned sum, cnt, mine, sp = 0u;
    for (;;) {
        sum = 0u; cnt = 0u; mine = 0u;
#pragma unroll
        for (unsigned j = 0; j < 16; ++j) { const unsigned c = xb_ld(&bar[XB_XCNT(j)]); sum += c; cnt += (c > 0u) ? 1u : 0u; mine = (j == x) ? c : mine; }
        if (sum == G) break;
        __builtin_amdgcn_s_sleep(1);
        if ((++sp & 255u) == 0u) { if (xb_ld(&bar[XB_TMO])) break; if (sp > XB_SPIN_CAP) { atomicAdd(&bar[XB_TMO], 1u); break; } }
    }
    nloc = mine > 0u ? mine : 1u; nx = cnt > 0u ? cnt : 1u;
}
__device__ __forceinline__ void xcd_barrier(const XcdBarrier& b) {
    asm volatile("s_waitcnt vmcnt(0)" ::: "memory");
    __syncthreads();
    if (threadIdx.x == 0) {
        unsigned* bar = b.bar;
        __builtin_amdgcn_s_waitcnt(0);
        unsigned nloc = b.st[0], nx = b.st[1];
        if (nloc == 0u) { xcd_barrier_complete(bar, b.x, nloc, nx); b.st[0] = nloc; b.st[1] = nx; }
        const unsigned old = xb_add(&bar[XB_XSUB(b.x)], 1u);
        const unsigned gen = old / nloc;
        if (old + 1u == (gen + 1u) * nloc) {
            __builtin_amdgcn_fence(__ATOMIC_RELEASE, "agent");
            asm volatile("s_waitcnt vmcnt(0)" ::: "memory");
            const unsigned og = xb_add(&bar[XB_TOP], 1u);
            const unsigned tg = og / nx;
            if (og + 1u == (tg + 1u) * nx) xb_add(&bar[XB_TOPGEN], 1u);
            else XB_SPIN(xb_ld(&bar[XB_TOPGEN]) == tg, bar);
            __builtin_amdgcn_fence(__ATOMIC_ACQUIRE, "agent");
            xb_add(&bar[XB_XGEN(b.x)], 1u);
            asm volatile("s_waitcnt vmcnt(0)" ::: "memory");
        } else {
            XB_SPIN(xb_ld(&bar[XB_XGEN(b.x)]) == gen, bar);
            __builtin_amdgcn_fence(__ATOMIC_ACQUIRE, "agent");
            asm volatile("s_waitcnt vmcnt(0)" ::: "memory");
        }
    }
    __syncthreads();
}

namespace gm {
constexpr int BM = 256, BK = 64, HALF = 128, HTB = HALF * BK * 2, STAGE_BYTES = 8 * HTB;
__device__ __forceinline__ int lds_byte(int r, int c) { const int st = (r >> 4) * 2 + (c >> 5), rr = r & 15, cc = c & 31, ob = rr * 64 + cc * 2; return st * 1024 + (ob ^ (((ob >> 9) & 1) << 5)); }
__device__ __forceinline__ void stage_rc(int b, int& R, int& C) { const int st = b / 1024, sb = b % 1024, swz = sb ^ (((sb >> 9) & 1) << 5); R = (st >> 1) * 16 + swz / 64; C = (st & 1) * 32 + (swz % 64) / 2; }
__device__ __forceinline__ int perm32(int rho) { const int n = rho >> 4, i = rho & 15; return 8 * (i >> 2) + 4 * n + (i & 3); }
struct Unit { int pm, pn, z; };
__device__ __forceinline__ int xcd_remap(int L, int nwg) { const int q = nwg / 8, r = nwg % 8, xcd = L % 8, off = L / 8; return (xcd < r ? xcd * (q + 1) : r * (q + 1) + (xcd - r) * q) + off; }
__device__ __forceinline__ void tile_of(int w, int nM, int nN, int& pm, int& pn) { const int nig = 8 * nN, gid = w / nig, fm = gid * 8, gsz = (nM - fm) < 8 ? (nM - fm) : 8; pm = fm + ((w % nig) % gsz); pn = (w % nig) / gsz; }

typedef f32x4 Acc[2][2][4][2];
#ifdef MK_F8_UNSCALED
constexpr int F8_ONE = 0;
#else
constexpr int F8_ONE = 0x7f7f7f7f;
#endif
constexpr float F8_SX = 8.0f, F8_SW = 64.0f, F8_SH = 4.0f;
__device__ __forceinline__ unsigned pk4_fp8(float a, float b, float c, float d) {
    int w = 0;
    w = __builtin_amdgcn_cvt_pk_fp8_f32(__builtin_amdgcn_fmed3f(a, -440.f, 440.f), __builtin_amdgcn_fmed3f(b, -440.f, 440.f), w, false);
    w = __builtin_amdgcn_cvt_pk_fp8_f32(__builtin_amdgcn_fmed3f(c, -440.f, 440.f), __builtin_amdgcn_fmed3f(d, -440.f, 440.f), w, true);
    return (unsigned)w;
}
typedef int i32x4_t __attribute__((ext_vector_type(4)));
typedef int i32x8_t __attribute__((ext_vector_type(8)));
__device__ __forceinline__ void mfma_f8(f32x4& c, const i32x8_t a, const i32x8_t b) {
#if !defined(__HIP_DEVICE_COMPILE__)
    (void)c; (void)a; (void)b;
#elif defined(MK_F8_UNSCALED)
    asm volatile("v_mfma_f32_16x16x128_f8f6f4 %0, %1, %2, %0" : "+v"(c) : "v"(a), "v"(b));
#else
    const int one = F8_ONE; asm volatile("v_mfma_scale_f32_16x16x128_f8f6f4 %0, %1, %2, %0, %3, %3 op_sel_hi:[0,0,0]" : "+v"(c) : "v"(a), "v"(b), "v"(one));
#endif
}
template <class P, class = void> struct is_f8 { static constexpr bool value = false; };
template <class P> struct is_f8<P, decltype((void)P::F8)> { static constexpr bool value = P::F8; };

template <class P>
__device__ __forceinline__ void gemm_phase(LAS unsigned char* lds, const P& p, int cu = -1) {
    int tid = threadIdx.x; asm volatile("" : "+v"(tid));
    const int wid = __builtin_amdgcn_readfirstlane(tid >> 6), lane = tid & 63, wr = wid >> 2, wc = wid & 3, fr = lane & 15, fq = lane >> 4;
    int K = p.K(); asm volatile("" : "+s"(K));
    const int nt = K / BK;
    const unsigned lda = p.lda(), ldb = p.ldb();
    const int G = gridDim.x, c = cu < 0 ? (int)blockIdx.x : cu, nwg = p.nunits();
    if (c >= nwg) return;
    unsigned voffA[2], voffB[2], cA2[2]; int RA[2];
#pragma unroll
    for (int i = 0; i < 2; ++i) { int R, C; stage_rc(tid * 16 + i * 8192, R, C); const int Rb = P::PERM ? ((R & ~31) + perm32(R & 31)) : R;
        RA[i] = R; cA2[i] = (unsigned)C * 2u; voffA[i] = (unsigned)R * lda + (unsigned)C * 2u; voffB[i] = (unsigned)Rb * ldb + (unsigned)C * 2u; }
    const size_t hstepA = (size_t)HALF * lda, hstepB = (size_t)HALF * ldb;
    const unsigned ldsw = (unsigned)wid * 1024u;
    const int aoff = lds_byte(wr * 64 + fr, fq * 8), boff = lds_byte(wc * 32 + fr, fq * 8);
    struct Src { const char* a; const char* b; unsigned ga[2][2]; };
    const char* araw = P::GATHER ? p.araw() : nullptr;
#define GM_GLDS(gp, lp) __builtin_amdgcn_global_load_lds((const unsigned*)(gp), (LAS unsigned*)(lp), 16, 0, 0)
#define GM_SA(b, h) (((b) * 2 + (h)) * HTB)
#define GM_SB(b, h) ((4 + (b) * 2 + (h)) * HTB)
#define GM_STAGE_B(bufoff, ptr) do { GM_GLDS((ptr) + voffB[0], lds + (bufoff) + ldsw); GM_GLDS((ptr) + voffB[1], lds + (bufoff) + ldsw + 8192); } while (0)
#define GM_STAGE_A(bufoff, S, h, koff) do { if constexpr (P::GATHER) { GM_GLDS(araw + (S).ga[h][0] + (koff), lds + (bufoff) + ldsw); GM_GLDS(araw + (S).ga[h][1] + (koff), lds + (bufoff) + ldsw + 8192); } \
        else if constexpr (P::AZERO) { const size_t ko_ = (size_t)(koff); const char* ab_ = ((ko_ >= 256) == ((h) == 1)) ? (S).a + (size_t)(h) * hstepA + (ko_ & 255) : p.zero_base(); \
            GM_GLDS(ab_ + voffA[0], lds + (bufoff) + ldsw); GM_GLDS(ab_ + voffA[1], lds + (bufoff) + ldsw + 8192); } \
        else { GM_GLDS((S).a + (size_t)(h) * hstepA + (koff) + voffA[0], lds + (bufoff) + ldsw); GM_GLDS((S).a + (size_t)(h) * hstepA + (koff) + voffA[1], lds + (bufoff) + ldsw + 8192); } } while (0)
#define GM_LDA(dst, b, h) do { _Pragma("unroll") for (int m = 0; m < 4; ++m) _Pragma("unroll") for (int k = 0; k < 2; ++k) dst[m][k] = *(const LAS bf16x8*)(lds + GM_SA(b, h) + aoff + m * 2048 + k * 1024); } while (0)
#define GM_LDB(dst, b, h) do { _Pragma("unroll") for (int n = 0; n < 2; ++n) _Pragma("unroll") for (int k = 0; k < 2; ++k) dst[n][k] = *(const LAS bf16x8*)(lds + GM_SB(b, h) + boff + n * 2048 + k * 1024); } while (0)
#define GM_CAT8(X) __builtin_shufflevector(__builtin_bit_cast(i32x4_t, X[0]), __builtin_bit_cast(i32x4_t, X[1]), 0, 1, 2, 3, 4, 5, 6, 7)
#define GM_MMA(ai, bj, At, Bt) do { __builtin_amdgcn_s_setprio(1); _Pragma("unroll") for (int m = 0; m < 4; ++m) _Pragma("unroll") for (int n = 0; n < 2; ++n) { \
        if constexpr (is_f8<P>::value) mfma_f8(acc[ai][bj][m][n], GM_CAT8(Bt[n]), GM_CAT8(At[m])); \
        else { _Pragma("unroll") for (int k = 0; k < 2; ++k) acc[ai][bj][m][n] = __builtin_amdgcn_mfma_f32_16x16x32_bf16(Bt[n][k], At[m][k], acc[ai][bj][m][n], 0, 0, 0); } } __builtin_amdgcn_s_setprio(0); } while (0)
#define GM_WAIT_V(n) asm volatile("s_waitcnt vmcnt(" #n ")" ::: "memory")
#define GM_WAIT_L(n) asm volatile("s_waitcnt lgkmcnt(" #n ")" ::: "memory")
#define GM_BAR __builtin_amdgcn_s_barrier()
#define GM_SCHED __builtin_amdgcn_sched_barrier(0)
#define GM_LOAD_SRC(S, u) do { (S).a = p.abase(u); (S).b = p.bbase(u); if constexpr (P::GATHER) { const int* _ix = p.gidx(u); _Pragma("unroll") for (int _h = 0; _h < 2; ++_h) _Pragma("unroll") for (int _i = 0; _i < 2; ++_i) \
        (S).ga[_h][_i] = (unsigned)_ix[_h * HALF + RA[_i]]; } } while (0)
#define GM_ADOPT(D, S) do { (D).a = (S).a; (D).b = (S).b; if constexpr (P::GATHER) { _Pragma("unroll") for (int _h = 0; _h < 2; ++_h) _Pragma("unroll") for (int _i = 0; _i < 2; ++_i) (D).ga[_h][_i] = (S).ga[_h][_i] * lda + cA2[_i]; } } while (0)
    Unit cur, nxt, nx2; int ui = 0;
    p.unit(xcd_remap(c, nwg), cur);
    Src cs, ns, fs;
    GM_LOAD_SRC(fs, cur); GM_ADOPT(cs, fs);
    bool has_next = ((long)G + c) < (long)nwg;
    if (has_next) { p.unit(xcd_remap(G + c, nwg), nxt); GM_LOAD_SRC(ns, nxt); } else { nxt = cur; ns = fs; }
    Acc acc;
#pragma unroll
    for (int a = 0; a < 2; ++a)
#pragma unroll
        for (int b = 0; b < 2; ++b)
#pragma unroll
            for (int m = 0; m < 4; ++m)
#pragma unroll
                for (int n = 0; n < 2; ++n) acc[a][b][m][n] = (f32x4){0.f, 0.f, 0.f, 0.f};
    bf16x8 At[4][2], B0[2][2], B1[2][2];
    GM_STAGE_B(GM_SB(0, 0), cs.b); GM_STAGE_B(GM_SB(0, 1), cs.b + hstepB); GM_STAGE_A(GM_SA(0, 0), cs, 0, 0); GM_STAGE_A(GM_SA(0, 1), cs, 1, 0);
    if (wr == 1) GM_BAR;
    GM_WAIT_V(2); GM_BAR;
    GM_STAGE_B(GM_SB(1, 0), cs.b + 128); GM_STAGE_A(GM_SA(1, 0), cs, 0, 128); GM_STAGE_B(GM_SB(1, 1), cs.b + hstepB + 128);
    GM_WAIT_V(6); GM_BAR;
    for (;;) {
#pragma clang loop unroll(disable)
        for (int t = 0; t < nt; t += 2) {
            const bool last = (t == nt - 2);
            GM_LDB(B0, 0, 0); GM_LDB(B1, 0, 1); GM_SCHED; GM_LDA(At, 0, 0); GM_STAGE_A(GM_SA(1, 1), cs, 1, (size_t)(t + 1) * 128);
            GM_WAIT_V(8); GM_WAIT_L(0); GM_BAR; GM_MMA(0, 0, At, B0); GM_MMA(0, 1, At, B1); GM_BAR; GM_SCHED;
            size_t kb;
            if (last) {
                if constexpr (P::GATHER) { asm volatile("" : "+v"(ns.ga[0][0]), "+v"(ns.ga[0][1]), "+v"(ns.ga[1][0]), "+v"(ns.ga[1][1])); }
                GM_ADOPT(cs, ns); kb = 0; } else kb = (size_t)(t + 2) * 128;
            GM_LDA(At, 0, 1); GM_STAGE_B(GM_SB(0, 0), cs.b + kb); GM_STAGE_B(GM_SB(0, 1), cs.b + hstepB + kb); GM_STAGE_A(GM_SA(0, 0), cs, 0, kb);
            GM_WAIT_V(8); GM_WAIT_L(0); GM_BAR; GM_MMA(1, 0, At, B0); GM_MMA(1, 1, At, B1); GM_BAR; GM_SCHED;
            GM_LDB(B0, 1, 0); GM_LDB(B1, 1, 1); GM_SCHED; GM_LDA(At, 1, 0); GM_STAGE_A(GM_SA(0, 1), cs, 1, kb);
            GM_WAIT_V(8); GM_WAIT_L(0); GM_BAR; GM_MMA(0, 0, At, B0); GM_MMA(0, 1, At, B1); GM_BAR; GM_SCHED;
            GM_LDA(At, 1, 1); GM_STAGE_B(GM_SB(1, 0), cs.b + kb + 128); GM_STAGE_B(GM_SB(1, 1), cs.b + hstepB + kb + 128); GM_STAGE_A(GM_SA(1, 0), cs, 0, kb + 128);
            GM_WAIT_V(8); GM_WAIT_L(0); GM_BAR; GM_MMA(1, 0, At, B0); GM_MMA(1, 1, At, B1); GM_BAR; GM_SCHED;
        }
        bool has_nx2 = false;
        if (has_next) { const long L2 = (long)(ui + 2) * G + c; has_nx2 = L2 < (long)nwg; if (has_nx2) { p.unit(xcd_remap((int)L2, nwg), nx2); GM_LOAD_SRC(ns, nx2); } }
        if constexpr (is_f8<P>::value) asm volatile("s_nop 7\n\ts_nop 7\n\ts_nop 7" ::: "memory");
        if (wr == 0) GM_BAR;
        { int t2 = threadIdx.x; asm volatile("" : "+v"(t2));
          const int w2 = __builtin_amdgcn_readfirstlane(t2 >> 6), l2 = t2 & 63; p.epi(acc, cur, w2 >> 2, w2 & 3, l2 & 15, l2 >> 4); }
        if (!has_next) break;
#pragma unroll
        for (int a = 0; a < 2; ++a)
#pragma unroll
            for (int b = 0; b < 2; ++b)
#pragma unroll
                for (int m = 0; m < 4; ++m)
#pragma unroll
                    for (int n = 0; n < 2; ++n) acc[a][b][m][n] = (f32x4){0.f, 0.f, 0.f, 0.f};
        cur = nxt; nxt = nx2; has_next = has_nx2; ++ui;
        if (wr == 1) GM_BAR;
    }
    GM_WAIT_V(0);
    GM_BAR;
#undef GM_GLDS
#undef GM_SA
#undef GM_SB
#undef GM_STAGE_A
#undef GM_STAGE_B
#undef GM_LDA
#undef GM_LDB
#undef GM_MMA
#undef GM_CAT8
#undef GM_WAIT_V
#undef GM_WAIT_L
#undef GM_BAR
#undef GM_SCHED
#undef GM_LOAD_SRC
}
}

namespace gm {
constexpr int ES = 4608;
__device__ __forceinline__ size_t kv_row0(int pm) { return pm < 128 ? (size_t)(pm >> 3) * KVL + CTXL + (size_t)(pm & 7) * 256 : (size_t)(pm - 128) * KVL; }
__device__ __forceinline__ u32x4 pack8(const f32x4 a, const f32x4 b) { u32x4 w; w.x = cvt_pk_bf16(a[0], a[1]); w.y = cvt_pk_bf16(a[2], a[3]); w.z = cvt_pk_bf16(b[0], b[1]); w.w = cvt_pk_bf16(b[2], b[3]); return w; }
#define GM_NOGATHER static constexpr bool AZERO = false; __device__ __forceinline__ const char* zero_base() const { return nullptr; } __device__ __forceinline__ const char* araw() const { return nullptr; } __device__ __forceinline__ const int* gidx(const Unit&) const { return nullptr; }
#define GM_DEV __device__ __forceinline__

struct P_QKV0 {
    static constexpr bool PERM = false, GATHER = false;
    const char* A; const char* B; bf16_t* q; bf16_t* k; bf16_t* v; const float* ropeC; const float* ropeS;
    GM_DEV int K() const { return 1024; } GM_DEV unsigned lda() const { return 2048; } GM_DEV unsigned ldb() const { return 2048; }
    GM_DEV int nunits() const { return 144 * 12; }
    GM_DEV void unit(int w, Unit& u) const { u.z = 0; tile_of(w, 144, 12, u.pm, u.pn); }
    GM_DEV const char* abase(const Unit& u) const { return A + (size_t)u.pm * 256 * 2048; }
    GM_DEV const char* bbase(const Unit& u) const { return B + (size_t)u.pn * 256 * 2048; }
    GM_NOGATHER
    GM_DEV void rope_store(Acc& acc, bf16_t* dst, const Unit& u, bool is_ctx, int wr, int wc, int fr, int fq) const {
        constexpr size_t rstride = 128, cstride = (size_t)KVL * 128;
        const int par = wc & 1;
#pragma unroll
        for (int ai = 0; ai < 2; ++ai)
#pragma unroll
            for (int m = 0; m < 4; ++m) { const int rl = ai * 128 + wr * 64 + m * 16 + fr;
                f32x4 c4 = (f32x4){1.f, 1.f, 1.f, 1.f}, s4 = (f32x4){0.f, 0.f, 0.f, 0.f};
                if (!is_ctx) { const int t = (u.pm & 7) * 256 + rl, pos = par ? (t & 63) : (t >> 6); c4 = *(const f32x4*)(ropeC + pos * 16 + 4 * fq); s4 = *(const f32x4*)(ropeS + pos * 16 + 4 * fq); }
#pragma unroll
                for (int bj = 0; bj < 2; ++bj) { const f32x4 x1 = acc[ai][bj][m][0], x2 = acc[ai][bj][m][1];
                    *(u32x4*)(dst + (size_t)rl * rstride + (size_t)bj * cstride) = pack8(x1 * c4 - x2 * s4, x1 * s4 + x2 * c4); }
                __builtin_amdgcn_sched_barrier(0); }
    }
    GM_DEV void epi(Acc& acc, const Unit& u, int wr, int wc, int fr, int fq) const {
        const int sect = u.pn >> 2, colt = (u.pn & 3) * 256; const bool is_ctx = u.pm >= 128;
        const int b = u.pm < 128 ? (u.pm >> 3) : (u.pm - 128); const size_t key0 = u.pm < 128 ? (size_t)CTXL + (size_t)(u.pm & 7) * 256 : 0;
        if (sect < 2) {
            bf16_t* d0 = q + (size_t)sect * (size_t)(k - q) + (((size_t)b * 8 + (colt >> 7)) * KVL + key0) * 128;
            rope_store(acc, d0 + wc * 32 + 8 * fq, u, is_ctx, wr, wc, fr, fq);
        } else {
            bf16_t* dst = v + (((size_t)b * 8 + (colt >> 7)) * KVL + key0) * 128 + wc * 32 + 4 * fq;
#pragma unroll
            for (int ai = 0; ai < 2; ++ai)
#pragma unroll
                for (int m = 0; m < 4; ++m) { const int rl = ai * 128 + wr * 64 + m * 16 + fr;
#pragma unroll
                    for (int bj = 0; bj < 2; ++bj)
#pragma unroll
                        for (int n = 0; n < 2; ++n) { const f32x4 x = acc[ai][bj][m][n]; u32x2 w; w.x = cvt_pk_bf16(x[0], x[1]); w.y = cvt_pk_bf16(x[2], x[3]);
                            *(u32x2*)(dst + (size_t)bj * KVL * 128 + (size_t)rl * 128 + 16 * n) = w; } }
        }
    }
};
struct P_QKV2 {
    static constexpr bool PERM = true, GATHER = false;
    const char* A; const char* B; bf16_t* q; bf16_t* k; bf16_t* v;
    GM_DEV int K() const { return 1024; } GM_DEV unsigned lda() const { return 2048; } GM_DEV unsigned ldb() const { return 2048; }
    GM_DEV int nunits() const { return 144 * 12; }
    GM_DEV void unit(int w, Unit& u) const { u.z = 0; tile_of(w, 144, 12, u.pm, u.pn); }
    GM_DEV const char* abase(const Unit& u) const { return A + (size_t)u.pm * 256 * 2048; }
    GM_DEV const char* bbase(const Unit& u) const { return B + (size_t)u.pn * 256 * 2048; }
    GM_NOGATHER
    GM_DEV void epi(Acc& acc, const Unit& u, int wr, int wc, int fr, int fq) const {
        const int sect = u.pn >> 2, colt = (u.pn & 3) * 256; const bool is_ctx = u.pm >= 128;
        if (sect == 0 && is_ctx) return;
        bf16_t* dst = sect == 0 ? q + (size_t)u.pm * 256 * 1024 : (sect == 1 ? k : v) + kv_row0(u.pm) * 1024;
#pragma unroll
        for (int ai = 0; ai < 2; ++ai)
#pragma unroll
            for (int m = 0; m < 4; ++m) { const int rl = ai * 128 + wr * 64 + m * 16 + fr;
#pragma unroll
                for (int bj = 0; bj < 2; ++bj) *(u32x4*)(dst + (size_t)rl * 1024 + colt + bj * 128 + wc * 32 + 8 * fq) = pack8(acc[ai][bj][m][0], acc[ai][bj][m][1]); }
    }
};
struct P_OUT {
    static constexpr bool PERM = true, GATHER = false;
    const char* A; const char* B; unsigned lda_; int K_, nM;
    bf16_t* xb_; bf16_t* cb_; const float* gate;
    GM_DEV int K() const { return K_; } GM_DEV unsigned lda() const { return lda_; } GM_DEV unsigned ldb() const { return (unsigned)K_ * 2u; }
    GM_DEV int nunits() const { return nM * 4; }
    GM_DEV void unit(int w, Unit& u) const { u.z = 0; tile_of(w, nM, 4, u.pm, u.pn); }
    GM_DEV const char* abase(const Unit& u) const { return A + (size_t)u.pm * 256 * lda_; }
    GM_DEV const char* bbase(const Unit& u) const { return B + (size_t)u.pn * 256 * (size_t)K_ * 2; }
    GM_NOGATHER
    GM_DEV void epi(Acc& acc, const Unit& u, int wr, int wc, int fr, int fq) const {
        const bool is_ctx = u.pm >= 128;
        const size_t t0 = is_ctx ? (size_t)(u.pm - 128) * 256 * 1024 : (size_t)u.pm * 256 * 1024;
        bf16_t* xs = (is_ctx ? cb_ : xb_) + t0;
        const int col0 = u.pn * 256 + wc * 32 + 8 * fq;
        const float* g = gate + (size_t)(is_ctx ? 16 : (u.pm >> 3)) * MODW + col0;
        f32x4 gv[2][2];
#pragma unroll
        for (int bj = 0; bj < 2; ++bj)
#pragma unroll
            for (int n = 0; n < 2; ++n) gv[bj][n] = *(const f32x4*)(g + bj * 128 + 4 * n);
        u32x4 xh[2][2];
#define PO_LOAD(slot, off_) do { _Pragma("unroll") for (int bj = 0; bj < 2; ++bj) xh[slot][bj] = *(const u32x4*)(xs + (off_) + bj * 128); } while (0)
        PO_LOAD(0, (size_t)(wr * 64 + fr) * 1024 + col0);
#pragma unroll
        for (int q = 0; q < 8; ++q) { const int ai = q >> 2, m = q & 3; const size_t off = (size_t)(ai * 128 + wr * 64 + m * 16 + fr) * 1024 + col0;
            if (q + 1 < 8) { const size_t off2 = (size_t)(((q + 1) >> 2) * 128 + wr * 64 + ((q + 1) & 3) * 16 + fr) * 1024 + col0; PO_LOAD((q + 1) & 1, off2); }
#pragma unroll
            for (int bj = 0; bj < 2; ++bj) { const u32x4 w = xh[q & 1][bj];
                const f32x4 x0 = (f32x4){bf_lo(w.x), bf_hi(w.x), bf_lo(w.y), bf_hi(w.y)}, x1 = (f32x4){bf_lo(w.z), bf_hi(w.z), bf_lo(w.w), bf_hi(w.w)};
                *(u32x4*)(xs + off + bj * 128) = pack8(x0 + gv[bj][0] * acc[ai][bj][m][0], x1 + gv[bj][1] * acc[ai][bj][m][1]); } }
#undef PO_LOAD
    }
};
struct P_GU {
    static constexpr bool PERM = true, GATHER = true, AZERO = false, F8 = true;
    GM_DEV const char* zero_base() const { return nullptr; }
    const char* hx; const char* W; unsigned char* hid; const int* slot_row; int nM;
    GM_DEV int K() const { return 512; } GM_DEV unsigned lda() const { return 1024; } GM_DEV unsigned ldb() const { return 1024; }
    GM_DEV int nunits() const { return NE * nM * 8; }
    GM_DEV void unit(int w, Unit& u) const { const int per = nM * 8; u.z = w / per; tile_of(w - u.z * per, nM, 8, u.pm, u.pn); }
    GM_DEV const char* abase(const Unit&) const { return hx; }
    GM_DEV const char* bbase(const Unit& u) const { return W + ((size_t)u.z * 2048 + (size_t)u.pn * 256) * 1024; }
    GM_DEV const char* araw() const { return hx; }
    GM_DEV const int* gidx(const Unit& u) const { return slot_row + u.z * ES + u.pm * 256; }
    GM_DEV void epi(Acc& acc, const Unit& u, int wr, int wc, int fr, int fq) const {
        unsigned char* dst = hid + ((size_t)u.z * ES + (size_t)u.pm * 256) * 1024 + u.pn * 128 + wc * 32 + 8 * fq;
        constexpr float ds = 1.0f / (F8_SX * F8_SW), c1 = -1.4426950408889634f * ds, kk = 1.0f / (F8_SH * ds * ds);
#pragma unroll
        for (int ai = 0; ai < 2; ++ai)
#pragma unroll
            for (int m = 0; m < 4; ++m) { const int rl = ai * 128 + wr * 64 + m * 16 + fr; f32x4 h[2];
#pragma unroll
                for (int n = 0; n < 2; ++n) { const f32x4 ag = acc[ai][0][m][n], au = acc[ai][1][m][n]; const f32x4 t = ag * c1; f32x4 e;
#pragma unroll
                    for (int j = 0; j < 4; ++j) e[j] = __builtin_amdgcn_exp2f(t[j]);
                    const f32x4 d = __builtin_elementwise_fma(e, (f32x4){kk, kk, kk, kk}, (f32x4){kk, kk, kk, kk}); f32x4 r;
#pragma unroll
                    for (int j = 0; j < 4; ++j) r[j] = __builtin_amdgcn_rcpf(d[j]);
                    h[n] = (ag * au) * r; }
                u32x2 w; w.x = pk4_fp8(h[0][0], h[0][1], h[0][2], h[0][3]); w.y = pk4_fp8(h[1][0], h[1][1], h[1][2], h[1][3]);
                *(u32x2*)(dst + (size_t)rl * 1024) = w; }
    }
};
struct P_DOWN {
    static constexpr bool PERM = true, GATHER = false, F8 = true;
    const char* hid; const char* W; bf16_t* ys; const float* slot_aff; int nM;
    GM_DEV int K() const { return 512; } GM_DEV unsigned lda() const { return 1024; } GM_DEV unsigned ldb() const { return 1024; }
    GM_DEV int nunits() const { return NE * nM * 4; }
    GM_DEV void unit(int w, Unit& u) const { const int per = nM * 4; u.z = w / per; tile_of(w - u.z * per, nM, 4, u.pm, u.pn); }
    GM_DEV const char* abase(const Unit& u) const { return hid + ((size_t)u.z * ES + (size_t)u.pm * 256) * 1024; }
    GM_DEV const char* bbase(const Unit& u) const { return W + ((size_t)u.z * 1024 + (size_t)u.pn * 256) * 1024; }
    GM_NOGATHER
    GM_DEV void epi(Acc& acc, const Unit& u, int wr, int wc, int fr, int fq) const {
        const size_t r0 = (size_t)u.z * ES + (size_t)u.pm * 256;
        unsigned char* dst8 = (unsigned char*)ys + r0 * 1024 + u.pn * 256 + wc * 32 + 8 * fq;
        float af[2][4];
#pragma unroll
        for (int ai = 0; ai < 2; ++ai)
#pragma unroll
            for (int m = 0; m < 4; ++m) af[ai][m] = slot_aff[r0 + ai * 128 + wr * 64 + m * 16 + fr];
#pragma unroll
        for (int ai = 0; ai < 2; ++ai)
#pragma unroll
            for (int m = 0; m < 4; ++m) { const int rl = ai * 128 + wr * 64 + m * 16 + fr; const float a = af[ai][m];
#pragma unroll
                for (int bj = 0; bj < 2; ++bj) { const f32x4 y0 = acc[ai][bj][m][0] * (a * (32.0f / (F8_SH * F8_SW))), y1 = acc[ai][bj][m][1] * (a * (32.0f / (F8_SH * F8_SW)));
                    int w0 = 0, w1 = 0;
                    w0 = __builtin_amdgcn_cvt_pk_fp8_f32(__builtin_amdgcn_fmed3f(y0[0], -440.f, 440.f), __builtin_amdgcn_fmed3f(y0[1], -440.f, 440.f), w0, false);
                    w0 = __builtin_amdgcn_cvt_pk_fp8_f32(__builtin_amdgcn_fmed3f(y0[2], -440.f, 440.f), __builtin_amdgcn_fmed3f(y0[3], -440.f, 440.f), w0, true);
                    w1 = __builtin_amdgcn_cvt_pk_fp8_f32(__builtin_amdgcn_fmed3f(y1[0], -440.f, 440.f), __builtin_amdgcn_fmed3f(y1[1], -440.f, 440.f), w1, false);
                    w1 = __builtin_amdgcn_cvt_pk_fp8_f32(__builtin_amdgcn_fmed3f(y1[2], -440.f, 440.f), __builtin_amdgcn_fmed3f(y1[3], -440.f, 440.f), w1, true);
                    u32x2 w; w.x = (unsigned)w0; w.y = (unsigned)w1; *(u32x2*)(dst8 + (size_t)rl * 1024 + bj * 128) = w; } }
    }
};
struct P_GMU {
    static constexpr bool PERM = true, GATHER = false;
    const char* hx; const char* W; bf16_t* u_out;
    GM_DEV int K() const { return 1024; } GM_DEV unsigned lda() const { return 2048; } GM_DEV unsigned ldb() const { return 2048; }
    GM_DEV int nunits() const { return 1152; }
    GM_DEV void unit(int w, Unit& u) const { u.z = 0; tile_of(w, 144, 8, u.pm, u.pn); }
    GM_DEV const char* abase(const Unit& u) const { return hx + (size_t)u.pm * 256 * 2048; }
    GM_DEV const char* bbase(const Unit& u) const { return W + (size_t)u.pn * 256 * 2048; }
    GM_NOGATHER
    GM_DEV void epi(Acc& acc, const Unit& u, int wr, int wc, int fr, int fq) const {
        bf16_t* dst = u_out + (size_t)u.pm * 256 * 2048 + u.pn * 256 + wc * 32 + 8 * fq;
#pragma unroll
        for (int ai = 0; ai < 2; ++ai)
#pragma unroll
            for (int m = 0; m < 4; ++m) { const int rl = ai * 128 + wr * 64 + m * 16 + fr;
#pragma unroll
                for (int bj = 0; bj < 2; ++bj) { const f32x4 g0 = gelu_tanh4(acc[ai][bj][m][0]), g1 = gelu_tanh4(acc[ai][bj][m][1]);
                    *(u32x4*)(dst + (size_t)rl * 2048 + bj * 128) = pack8(g0, g1); }
                __builtin_amdgcn_sched_barrier(0); }
    }
};
struct P_GMV {
    static constexpr bool PERM = true, GATHER = false;
    const char* hx; const char* W; bf16_t* vT; float* sumsq;
    GM_DEV int K() const { return 1024; } GM_DEV unsigned lda() const { return 2048; } GM_DEV unsigned ldb() const { return 2048; }
    GM_DEV int nunits() const { return 1152; }
    GM_DEV void unit(int w, Unit& u) const { u.z = 0; tile_of(w, 8, 144, u.pm, u.pn); }
    GM_DEV const char* abase(const Unit& u) const { return W + (size_t)(2048 + u.pm * 256) * 2048; }
    GM_DEV const char* bbase(const Unit& u) const { return hx + (size_t)u.pn * 256 * 2048; }
    GM_NOGATHER
    GM_DEV void epi(Acc& acc, const Unit& u, int wr, int wc, int fr, int fq) const {
        const bool is_ctx = u.pn >= 128; const int b = is_ctx ? u.pn - 128 : (u.pn >> 3);
        const int tok0 = is_ctx ? 0 : CTXL + (u.pn & 7) * 256, grow0 = is_ctx ? NLAT + b * CTXL : b * SEQ + (u.pn & 7) * 256;
        bf16_t* dst = vT + ((size_t)b * 2048 + (size_t)u.pm * 256) * KVL + tok0 + wc * 32 + 8 * fq;
#pragma unroll
        for (int bj = 0; bj < 2; ++bj) {
            f32x4 s0 = (f32x4){0.f, 0.f, 0.f, 0.f}, s1 = (f32x4){0.f, 0.f, 0.f, 0.f};
#pragma unroll
            for (int ai = 0; ai < 2; ++ai)
#pragma unroll
                for (int m = 0; m < 4; ++m) { const int rl = ai * 128 + wr * 64 + m * 16 + fr; const f32x4 g0 = gelu_tanh4(acc[ai][bj][m][0]), g1 = gelu_tanh4(acc[ai][bj][m][1]);
                    *(u32x4*)(dst + (size_t)rl * KVL + bj * 128) = pack8(g0, g1); s0 += g0 * g0; s1 += g1 * g1;
                    __builtin_amdgcn_sched_barrier(0); }
#pragma unroll
            for (int j = 0; j < 4; ++j) { float a = s0[j], c = s1[j];
                a += __shfl_xor(a, 1); a += __shfl_xor(a, 2); a += __shfl_xor(a, 4); a += __shfl_xor(a, 8);
                c += __shfl_xor(c, 1); c += __shfl_xor(c, 2); c += __shfl_xor(c, 4); c += __shfl_xor(c, 8);
                if (fr == 0) { float* pp = sumsq + (size_t)(grow0 + bj * 128 + wc * 32 + 8 * fq + j) * 16 + u.pm * 2 + wr; pp[0] = a; pp[64] = c; } }
        }
    }
};
struct P_SPAT {
    static constexpr bool PERM = true, GATHER = false, AZERO = true;
    const char* App; const char* vT; bf16_t* u_io; const float* v_g; const float* b_s; const char* zeros;
    GM_DEV const char* zero_base() const { return zeros; } GM_DEV const char* araw() const { return nullptr; } GM_DEV const int* gidx(const Unit&) const { return nullptr; }
    GM_DEV int K() const { return 256; } GM_DEV unsigned lda() const { return 256; } GM_DEV unsigned ldb() const { return KVL * 2; }
    GM_DEV int nunits() const { return NB * 9 * 8; }
    GM_DEV void unit(int w, Unit& u) const { u.z = w; u.pm = 0; u.pn = 0; }
    GM_DEV const char* abase(const Unit& u) const { return App + (size_t)u.z * 65536; }
    GM_DEV const char* bbase(const Unit& u) const { const int g = u.z & 7, bc = u.z >> 3, b = bc / 9, cp = bc - b * 9; return vT + (((size_t)b * 2048 + (size_t)g * 256) * KVL + (size_t)cp * 256) * 2; }
    GM_DEV void epi(Acc& acc, const Unit& u, int wr, int wc, int fr, int fq) const {
        const int g = u.z & 7, bc = u.z >> 3, b = bc / 9, cp = bc - b * 9;
        const size_t trow0 = cp == 0 ? (size_t)NLAT + (size_t)b * CTXL : (size_t)b * SEQ + (size_t)(cp - 1) * 256;
        const int ch0 = g * 256 + wc * 32 + 8 * fq;
        f32x4 vg[2][2];
#pragma unroll
        for (int bj = 0; bj < 2; ++bj)
#pragma unroll
            for (int n = 0; n < 2; ++n) vg[bj][n] = *(const f32x4*)(v_g + ch0 + bj * 128 + 4 * n);
        float bsv[8];
#pragma unroll
        for (int q = 0; q < 8; ++q) bsv[q] = b_s[g * 128 + (((q >> 2) * 128 + wr * 64 + (q & 3) * 16 + fr) & 127)];
        u32x4 ub[2][2];
#pragma unroll
        for (int bj = 0; bj < 2; ++bj) ub[0][bj] = *(const u32x4*)(u_io + (trow0 + wr * 64 + fr) * 2048 + ch0 + bj * 128);
#pragma unroll
        for (int q = 0; q < 8; ++q) { const int ai = q >> 2, m = q & 3, rl = ai * 128 + wr * 64 + m * 16 + fr; const float bs = bsv[q];
            bf16_t* up = u_io + (trow0 + rl) * 2048 + ch0;
            if (q + 1 < 8) { const int rl2 = ((q + 1) >> 2) * 128 + wr * 64 + ((q + 1) & 3) * 16 + fr;
#pragma unroll
                for (int bj = 0; bj < 2; ++bj) ub[(q + 1) & 1][bj] = *(const u32x4*)(u_io + (trow0 + rl2) * 2048 + ch0 + bj * 128); }
#pragma unroll
            for (int bj = 0; bj < 2; ++bj) { const u32x4 uw = ub[q & 1][bj];
                const f32x4 u0 = (f32x4){bf_lo(uw.x), bf_hi(uw.x), bf_lo(uw.y), bf_hi(uw.y)}, u1 = (f32x4){bf_lo(uw.z), bf_hi(uw.z), bf_lo(uw.w), bf_hi(uw.w)};
                *(u32x4*)(up + bj * 128) = pack8(u0 * (acc[ai][bj][m][0] * vg[bj][0] + bs), u1 * (acc[ai][bj][m][1] * vg[bj][1] + bs)); } }
    }
};
constexpr int PQ_LD = 2176;
struct P_CDFT {
    static constexpr bool PERM = true, GATHER = false;
    const char* CS; const char* hx; bf16_t* PQt;
    GM_DEV int K() const { return 256; } GM_DEV unsigned lda() const { return 512; } GM_DEV unsigned ldb() const { return 2048; }
    GM_DEV int nunits() const { return 4 * NB * 9; }
    GM_DEV void unit(int w, Unit& u) const { u.z = w / (NB * 9); const int r = w - u.z * (NB * 9); u.pn = r; const int tt = r % 9; u.pm = (tt >= 4 && tt < 8) ? 1 : 0; }
    GM_DEV const char* abase(const Unit& u) const { return CS + (size_t)u.pm * 256 * 512; }
    GM_DEV const char* bbase(const Unit& u) const { return hx + (size_t)u.pn * 256 * 2048 + (size_t)u.z * 512; }
    GM_NOGATHER
    GM_DEV void epi(Acc& acc, const Unit& u, int wr, int wc, int fr, int fq) const {
        const int b = u.pn / 9, tt = u.pn - b * 9;
        bf16_t* dst = PQt + ((size_t)b * 1024 + (size_t)u.z * 256) * PQ_LD + tt * 256 + wc * 32 + 8 * fq;
#pragma unroll
        for (int ai = 0; ai < 2; ++ai)
#pragma unroll
            for (int m = 0; m < 4; ++m) { const int rl = ai * 128 + wr * 64 + m * 16 + fr;
#pragma unroll
                for (int bj = 0; bj < 2; ++bj) { if (tt == 8 && bj == 1) continue;
                    *(u32x4*)(dst + (size_t)rl * PQ_LD + bj * 128) = pack8(acc[ai][bj][m][0] * 0.0625f, acc[ai][bj][m][1] * 0.0625f); } }
    }
};
struct P_PDFT {
    static constexpr bool PERM = true, GATHER = false;
    const char* DP; const char* PQt; bf16_t* f;
    GM_DEV int K() const { return PQ_LD; } GM_DEV unsigned lda() const { return PQ_LD * 2; } GM_DEV unsigned ldb() const { return PQ_LD * 2; }
    GM_DEV int nunits() const { return 512; }
    GM_DEV void unit(int w, Unit& u) const { u.z = w >> 5; tile_of(w & 31, 8, 4, u.pm, u.pn); }
    GM_DEV const char* abase(const Unit& u) const { return DP + (size_t)u.pm * 256 * (PQ_LD * 2); }
    GM_DEV const char* bbase(const Unit& u) const { return PQt + ((size_t)u.z * 1024 + (size_t)u.pn * 256) * (PQ_LD * 2); }
    GM_NOGATHER
    GM_DEV void epi(Acc& acc, const Unit& u, int wr, int wc, int fr, int fq) const {
        bf16_t* dst = f + ((size_t)u.z * 2048 + (size_t)u.pm * 256) * 1024 + u.pn * 256 + wc * 32 + 8 * fq; const float sc = 0.022097086912079608f;
#pragma unroll
        for (int ai = 0; ai < 2; ++ai)
#pragma unroll
            for (int m = 0; m < 4; ++m) { const int rl = ai * 128 + wr * 64 + m * 16 + fr;
#pragma unroll
                for (int bj = 0; bj < 2; ++bj) *(u32x4*)(dst + (size_t)rl * 1024 + bj * 128) = pack8(acc[ai][bj][m][0] * sc, acc[ai][bj][m][1] * sc); }
    }
};
}

namespace at {
constexpr float SCALE = 0.125f;
constexpr float THR = 8.f;
#define AT_SBAR() __builtin_amdgcn_sched_barrier(0)
#define AT_KSWZ(row, colB) ((row) * 256 + ((colB) ^ (((row) & 7) << 4)))
#define AT_KSWZ64(row, colB) ((row) * 128 + ((colB) ^ ((((row) >> 1) & 7) << 4)))
__device__ __forceinline__ int crow(int r, int hi) { return (r & 3) + 8 * (r >> 2) + 4 * hi; }
__device__ __forceinline__ void partialSM(f32x16& p0, f32x16& p1, float& m_reg, float& mn, float& alpha) {
    constexpr float C = SCALE * 1.4426950408889634f;
    float pmax = p0[0];
#pragma unroll
    for (int r = 1; r < 16; ++r) pmax = fmaxf(pmax, p0[r]);
#pragma unroll
    for (int r = 0; r < 16; ++r) pmax = fmaxf(pmax, p1[r]);
    { auto rr = __builtin_amdgcn_permlane32_swap(__float_as_uint(pmax), __float_as_uint(pmax), false, false);
      pmax = fmaxf(__uint_as_float(rr[0]), __uint_as_float(rr[1])); }
    if (__builtin_expect(__all(pmax - m_reg <= THR / SCALE), 1)) { mn = m_reg; alpha = 1.f; }
    else { mn = fmaxf(m_reg, pmax); alpha = __builtin_amdgcn_exp2f((m_reg - mn) * C); m_reg = mn; }
    const float mnC = -mn * C;
#pragma unroll
    for (int r = 0; r < 16; ++r) p0[r] = fmaf(p0[r], C, mnC);
#pragma unroll
    for (int r = 0; r < 16; ++r) p1[r] = fmaf(p1[r], C, mnC);
#pragma unroll
    for (int r = 0; r < 16; ++r) p0[r] = __builtin_amdgcn_exp2f(p0[r]);
}
#define AT_PK4(P, BASE, OUT) do { unsigned a0 = cvt_pk_bf16(P[BASE + 0], P[BASE + 1]), a1 = cvt_pk_bf16(P[BASE + 2], P[BASE + 3]);   \
    unsigned b0 = cvt_pk_bf16(P[BASE + 4], P[BASE + 5]), b1 = cvt_pk_bf16(P[BASE + 6], P[BASE + 7]);                              \
    auto r0 = __builtin_amdgcn_permlane32_swap(a0, b0, false, false); auto r1 = __builtin_amdgcn_permlane32_swap(a1, b1, false, false); \
    u32x4 w = {r0[0], r1[0], r0[1], r1[1]}; OUT = *reinterpret_cast<bf16x8*>(&w); } while (0)
__device__ __forceinline__ void finishSM(f32x16& p0, f32x16& p1, float alpha, float& l_reg, bf16x8& pa0, bf16x8& pa1, bf16x8& pa2, bf16x8& pa3) {
#pragma unroll
    for (int r = 0; r < 16; ++r) p1[r] = __builtin_amdgcn_exp2f(p1[r]);
    float ps = 0;
#pragma unroll
    for (int r = 0; r < 16; ++r) ps += p0[r];
#pragma unroll
    for (int r = 0; r < 16; ++r) ps += p1[r];
    { auto rr = __builtin_amdgcn_permlane32_swap(__float_as_uint(ps), __float_as_uint(ps), false, false);
      ps = __uint_as_float(rr[0]) + __uint_as_float(rr[1]); }
    l_reg = l_reg * alpha + ps;
    AT_PK4(p0, 0, pa0); AT_PK4(p0, 8, pa1); AT_PK4(p1, 0, pa2); AT_PK4(p1, 8, pa3);
}
__device__ __forceinline__ void qkt64(f32x16& p0, f32x16& p1, const LAS char* Ks, const bf16x8* qr, int r32, int hi, int cb0) {
    p0 = f32x16{}; p1 = f32x16{};
    bf16x8 k0[4], k1[4];
#pragma unroll
    for (int d0 = 0; d0 < 4; ++d0) { const int cb = cb0 + (d0 * 16 + hi * 8) * 2;
        k0[d0] = *reinterpret_cast<const LAS bf16x8*>(Ks + AT_KSWZ(r32, cb)); k1[d0] = *reinterpret_cast<const LAS bf16x8*>(Ks + AT_KSWZ(32 + r32, cb)); }
    __builtin_amdgcn_sched_barrier(0);
#pragma unroll
    for (int d0 = 0; d0 < 4; ++d0) { p0 = __builtin_amdgcn_mfma_f32_32x32x16_bf16(k0[d0], qr[d0], p0, 0, 0, 0); p1 = __builtin_amdgcn_mfma_f32_32x32x16_bf16(k1[d0], qr[d0], p1, 0, 0, 0); }
}
template <int NCB> __device__ __forceinline__ int v_st(int k, int c) { const int kk = (k & ~0xC) | ((k & 4) << 1) | ((k & 8) >> 1); return ((kk >> 3) * NCB + (c >> 5)) * 512 + ((kk & 7) * 32 + (c & 31)) * 2; }
__device__ __forceinline__ int v_rd_base(int lane) { return ((lane & 3) << 3) | (((lane >> 2) & 3) << 6) | (((lane >> 4) & 1) << 5) | (((lane >> 5) & 1) << 8); }
template <int NCB> constexpr int v_rd_off(int d0, int ks, int half) { return d0 * 512 + ks * (NCB * 1024) + half * (NCB * 512); }
template <int OFF> __device__ __forceinline__ s16x4 tr_read(int vb) {
    return __builtin_amdgcn_ds_read_tr16_b64_v4i16((LAS s16x4*)(uintptr_t)(unsigned)(vb + OFF));
}
template <int NCB, int D0> __device__ __forceinline__ void pv_one(f32x16& od, int vb, bf16x8 pa0, bf16x8 pa1, bf16x8 pa2, bf16x8 pa3) {
    const s16x4 l0 = tr_read<v_rd_off<NCB>(D0, 0, 0)>(vb), h0 = tr_read<v_rd_off<NCB>(D0, 0, 1)>(vb), l1 = tr_read<v_rd_off<NCB>(D0, 1, 0)>(vb), h1 = tr_read<v_rd_off<NCB>(D0, 1, 1)>(vb);
    const s16x4 l2 = tr_read<v_rd_off<NCB>(D0, 2, 0)>(vb), h2 = tr_read<v_rd_off<NCB>(D0, 2, 1)>(vb), l3 = tr_read<v_rd_off<NCB>(D0, 3, 0)>(vb), h3 = tr_read<v_rd_off<NCB>(D0, 3, 1)>(vb);
#define AT_PK(L, H) (bf16x8){L[0], L[1], L[2], L[3], H[0], H[1], H[2], H[3]}
    od = __builtin_amdgcn_mfma_f32_32x32x16_bf16(pa0, AT_PK(l0, h0), od, 0, 0, 0);
    od = __builtin_amdgcn_mfma_f32_32x32x16_bf16(pa1, AT_PK(l1, h1), od, 0, 0, 0);
    od = __builtin_amdgcn_mfma_f32_32x32x16_bf16(pa2, AT_PK(l2, h2), od, 0, 0, 0);
    od = __builtin_amdgcn_mfma_f32_32x32x16_bf16(pa3, AT_PK(l3, h3), od, 0, 0, 0);
#undef AT_PK
}

template <int NCB, int D0>
__device__ __forceinline__ void pv_pair(f32x16& o0, f32x16& o1, int vb, bf16x8 pa0, bf16x8 pa1, bf16x8 pa2, bf16x8 pa3) {
    s16x4 l[2][4], h[2][4];
    l[0][0] = tr_read<v_rd_off<NCB>(D0, 0, 0)>(vb); h[0][0] = tr_read<v_rd_off<NCB>(D0, 0, 1)>(vb); l[0][1] = tr_read<v_rd_off<NCB>(D0, 1, 0)>(vb); h[0][1] = tr_read<v_rd_off<NCB>(D0, 1, 1)>(vb);
    l[0][2] = tr_read<v_rd_off<NCB>(D0, 2, 0)>(vb); h[0][2] = tr_read<v_rd_off<NCB>(D0, 2, 1)>(vb); l[0][3] = tr_read<v_rd_off<NCB>(D0, 3, 0)>(vb); h[0][3] = tr_read<v_rd_off<NCB>(D0, 3, 1)>(vb);
    l[1][0] = tr_read<v_rd_off<NCB>(D0 + 1, 0, 0)>(vb); h[1][0] = tr_read<v_rd_off<NCB>(D0 + 1, 0, 1)>(vb); l[1][1] = tr_read<v_rd_off<NCB>(D0 + 1, 1, 0)>(vb); h[1][1] = tr_read<v_rd_off<NCB>(D0 + 1, 1, 1)>(vb);
    l[1][2] = tr_read<v_rd_off<NCB>(D0 + 1, 2, 0)>(vb); h[1][2] = tr_read<v_rd_off<NCB>(D0 + 1, 2, 1)>(vb); l[1][3] = tr_read<v_rd_off<NCB>(D0 + 1, 3, 0)>(vb); h[1][3] = tr_read<v_rd_off<NCB>(D0 + 1, 3, 1)>(vb);
    __builtin_amdgcn_sched_barrier(0);
#define AT_PK(L, H) (bf16x8){L[0], L[1], L[2], L[3], H[0], H[1], H[2], H[3]}
    o0 = __builtin_amdgcn_mfma_f32_32x32x16_bf16(pa0, AT_PK(l[0][0], h[0][0]), o0, 0, 0, 0); o1 = __builtin_amdgcn_mfma_f32_32x32x16_bf16(pa0, AT_PK(l[1][0], h[1][0]), o1, 0, 0, 0);
    o0 = __builtin_amdgcn_mfma_f32_32x32x16_bf16(pa1, AT_PK(l[0][1], h[0][1]), o0, 0, 0, 0); o1 = __builtin_amdgcn_mfma_f32_32x32x16_bf16(pa1, AT_PK(l[1][1], h[1][1]), o1, 0, 0, 0);
    o0 = __builtin_amdgcn_mfma_f32_32x32x16_bf16(pa2, AT_PK(l[0][2], h[0][2]), o0, 0, 0, 0); o1 = __builtin_amdgcn_mfma_f32_32x32x16_bf16(pa2, AT_PK(l[1][2], h[1][2]), o1, 0, 0, 0);
    o0 = __builtin_amdgcn_mfma_f32_32x32x16_bf16(pa3, AT_PK(l[0][3], h[0][3]), o0, 0, 0, 0); o1 = __builtin_amdgcn_mfma_f32_32x32x16_bf16(pa3, AT_PK(l[1][3], h[1][3]), o1, 0, 0, 0);
#undef AT_PK
    __builtin_amdgcn_sched_barrier(0);
}
__device__ __forceinline__ void pv_batch2(f32x16& o0, f32x16& o1, int vb, bf16x8 pa0, bf16x8 pa1, bf16x8 pa2, bf16x8 pa3) { pv_pair<2, 0>(o0, o1, vb, pa0, pa1, pa2, pa3); }

constexpr int DA_LDS_V = 0, DA_LDS_K = 32768, DA_LDS_WS = 69632, DA_XPITCH = 132;
template <int VARIANT = 0>
__device__ __forceinline__ void diff_attn_unit(const bf16_t* __restrict__ Qb, const bf16_t* __restrict__ Kh, const bf16_t* __restrict__ Vh, bf16_t* __restrict__ Ob,
                                               int seq, float lam, float oscale, const float* __restrict__ subg, LAS char* lds) {
    constexpr int LDK = 128, SHM_V = 16384, SHM_K = 16384, KVBLK = 64;
    constexpr float C = SCALE * 1.4426950408889634f;
    int tid = threadIdx.x; asm volatile("" : "+v"(tid));
    const int wid = __builtin_amdgcn_readfirstlane(tid >> 6), lane = tid & 63, r32 = lane & 31, hi = lane >> 5, jh = wid >> 2, wq = wid & 3;
    LAS char* V_lds = lds + DA_LDS_V; LAS char* K_lds = lds + DA_LDS_K;
    LAS float* ws = (LAS float*)(lds + DA_LDS_WS) + wid * 64; LAS float* li_l = ws; LAS float* al_l = ws + 32;
    float m_reg = -1e30f, l_reg = 0.f, alpha = 1.f; f32x16 o[4] = {}; bf16x8 qr[4];
    const bf16_t* Qw = Qb + (size_t)(wq * 32 + r32) * 128 + jh * 64 + hi * 8;
#pragma unroll
    for (int d0 = 0; d0 < 4; ++d0) qr[d0] = *reinterpret_cast<const bf16x8*>(Qw + d0 * 16);
    const int cb0 = jh * 128;
    const int sr = tid >> 4, sc = (tid & 15) * 8, vst0 = v_st<4>(sr, sc), vst1 = v_st<4>(32 + sr, sc), kst0 = AT_KSWZ(sr, sc * 2), kst1 = AT_KSWZ(32 + sr, sc * 2);
    const int vb0 = (int)(uintptr_t)V_lds + v_rd_base(lane);
    const int NT = seq / KVBLK;
    bf16x8 ek0[2], ek1[2], ev0[2], ev1[2];
#define DA_ELOAD(s, ev) do { const int kt_ = (ev) + 1; \
        if (kt_ < NT) { ek0[s] = *reinterpret_cast<const bf16x8*>(&Kh[(size_t)(kt_ * KVBLK + sr) * LDK + sc]); ek1[s] = *reinterpret_cast<const bf16x8*>(&Kh[(size_t)(kt_ * KVBLK + 32 + sr) * LDK + sc]); } \
        ev0[s] = *reinterpret_cast<const bf16x8*>(&Vh[(size_t)((ev) * KVBLK + sr) * LDK + sc]); ev1[s] = *reinterpret_cast<const bf16x8*>(&Vh[(size_t)((ev) * KVBLK + 32 + sr) * LDK + sc]); } while (0)
#define DA_EWRITE(s, ev) do { const int kt_ = (ev) + 1; \
        if (kt_ < NT) { *(LAS bf16x8*)(K_lds + (kt_ & 1) * SHM_K + kst0) = ek0[s]; *(LAS bf16x8*)(K_lds + (kt_ & 1) * SHM_K + kst1) = ek1[s]; } \
        *(LAS bf16x8*)(V_lds + ((ev) & 1) * SHM_V + vst0) = ev0[s]; *(LAS bf16x8*)(V_lds + ((ev) & 1) * SHM_V + vst1) = ev1[s]; } while (0)
#define DA_CONSUME(s) asm volatile("" :: "v"(ek0[s]), "v"(ek1[s]), "v"(ev0[s]), "v"(ev1[s]))
#define DA_STAGE(i) do { if ((i) & 1) { if (VARIANT == 4) DA_CONSUME(1); else DA_EWRITE(1, i); if ((i) + 2 < NT) DA_ELOAD(1, (i) + 2); } else { if (VARIANT == 4) DA_CONSUME(0); else DA_EWRITE(0, i); if ((i) + 2 < NT) DA_ELOAD(0, (i) + 2); } } while (0)
#define DA_RESC(a) do { if (__any((a) < 1.f)) { if (hi == 0) al_l[r32] = (a); asm volatile("s_waitcnt lgkmcnt(0)" ::: "memory"); \
    _Pragma("unroll") for (int d = 0; d < 4; ++d) _Pragma("unroll") for (int r = 0; r < 16; ++r) o[d][r] *= al_l[crow(r, hi)]; } } while (0)
#define DA_PV(vb) do { pv_pair<4, 0>(o[0], o[1], vb, pa0, pa1, pa2, pa3); pv_pair<4, 2>(o[2], o[3], vb, pa0, pa1, pa2, pa3); } while (0)
    f32x16 p0, p1; bf16x8 pa0, pa1, pa2, pa3;
    { const bf16x8 a0 = *reinterpret_cast<const bf16x8*>(&Kh[(size_t)sr * LDK + sc]), a1 = *reinterpret_cast<const bf16x8*>(&Kh[(size_t)(32 + sr) * LDK + sc]);
      *(LAS bf16x8*)(K_lds + kst0) = a0; *(LAS bf16x8*)(K_lds + kst1) = a1; }
    DA_ELOAD(0, 0); if (1 < NT) DA_ELOAD(1, 1);
    __syncthreads();
    if (jh == 1) __syncthreads();
    for (int i = 0; i < NT; ++i) {
        if (VARIANT != 1) { if (jh == 1) DA_STAGE(i); }
        if (i > 0 && VARIANT != 3) { DA_RESC(alpha); const int vb = vb0 + ((i - 1) & 1) * SHM_V; DA_PV(vb); }
        qkt64(p0, p1, K_lds + (i & 1) * SHM_K, qr, r32, hi, cb0);
        __syncthreads();
        if (VARIANT != 1) { if (jh == 0) DA_STAGE(i); }
        { float pmax = p0[0];
#pragma unroll
          for (int r = 1; r < 16; ++r) pmax = fmaxf(pmax, p0[r]);
#pragma unroll
          for (int r = 0; r < 16; ++r) pmax = fmaxf(pmax, p1[r]);
          { auto rr = __builtin_amdgcn_permlane32_swap(__float_as_uint(pmax), __float_as_uint(pmax), false, false); pmax = fmaxf(__uint_as_float(rr[0]), __uint_as_float(rr[1])); }
          float mn;
          if (__builtin_expect(__all(pmax - m_reg <= THR / SCALE), 1)) { mn = m_reg; alpha = 1.f; }
          else { mn = fmaxf(m_reg, pmax); alpha = __builtin_amdgcn_exp2f((m_reg - mn) * C); m_reg = mn; }
          const float mnC = -mn * C; float ps = 0.f;
#pragma unroll
          for (int r = 0; r < 16; ++r) { if (VARIANT == 2) { p0[r] = fmaf(p0[r], C, mnC); p1[r] = fmaf(p1[r], C, mnC); } else { p0[r] = __builtin_amdgcn_exp2f(fmaf(p0[r], C, mnC)); p1[r] = __builtin_amdgcn_exp2f(fmaf(p1[r], C, mnC)); } }
#pragma unroll
          for (int r = 0; r < 16; ++r) ps += p0[r] + p1[r];
          { auto rr = __builtin_amdgcn_permlane32_swap(__float_as_uint(ps), __float_as_uint(ps), false, false); ps = __uint_as_float(rr[0]) + __uint_as_float(rr[1]); }
          l_reg = l_reg * alpha + ps;
          AT_PK4(p0, 0, pa0); AT_PK4(p0, 8, pa1); AT_PK4(p1, 0, pa2); AT_PK4(p1, 8, pa3); }
        __syncthreads();
    }
    { DA_RESC(alpha); const int vb = vb0 + ((NT - 1) & 1) * SHM_V; DA_PV(vb); }
    if (jh == 0) __syncthreads();
    if (hi == 0) li_l[r32] = l_reg; asm volatile("s_waitcnt lgkmcnt(0)" ::: "memory");
    float rli[16];
#pragma unroll
    for (int r = 0; r < 16; ++r) rli[r] = __builtin_amdgcn_rcpf(li_l[crow(r, hi)]);
    __syncthreads();
    LAS float* X = (LAS float*)lds;
    if (jh == 1) {
#pragma unroll
        for (int r = 0; r < 16; ++r)
#pragma unroll
            for (int d0 = 0; d0 < 4; ++d0) X[(wq * 32 + crow(r, hi)) * DA_XPITCH + d0 * 32 + r32] = o[d0][r] * rli[r];
    }
    __syncthreads();
    if (jh == 0) {
#pragma unroll
        for (int r = 0; r < 16; ++r)
#pragma unroll
            for (int d0 = 0; d0 < 4; ++d0) { const int ix = (wq * 32 + crow(r, hi)) * DA_XPITCH + d0 * 32 + r32; X[ix] = o[d0][r] * rli[r] - lam * X[ix]; }
    }
    __syncthreads();
    { const int row = tid >> 2, qd = tid & 3; const LAS f32x4* xr = (const LAS f32x4*)(X + row * DA_XPITCH + qd * 32);
      f32x4 v[8]; float ss = 0.f;
#pragma unroll
      for (int i = 0; i < 8; ++i) { v[i] = xr[i]; ss += (v[i][0] * v[i][0] + v[i][1] * v[i][1]) + (v[i][2] * v[i][2] + v[i][3] * v[i][3]); }
      ss += __shfl_xor(ss, 1); ss += __shfl_xor(ss, 2);
      const float rs = __builtin_amdgcn_rsqf(ss * (1.f / 128.f) + EPS) * oscale;
      const f32x4* gp = (const f32x4*)(subg + qd * 32); f32x4 gq[8];
#pragma unroll
      for (int i = 0; i < 8; ++i) gq[i] = gp[i];
      bf16_t* op = Ob + (size_t)row * 1024 + qd * 32;
#pragma unroll
      for (int i = 0; i < 4; ++i) { const f32x4 a = v[2 * i] * rs * gq[2 * i], b = v[2 * i + 1] * rs * gq[2 * i + 1]; *(u32x4*)(op + 8 * i) = gm::pack8(a, b); } }
    __syncthreads();
#undef DA_ELOAD
#undef DA_EWRITE
#undef DA_STAGE
#undef DA_RESC
#undef DA_PV
}

constexpr int DD_LDS_K = 0, DD_LDS_V = 65536, DD_LDS_WS = 131072 + 256;
__device__ __forceinline__ void diff_attn_unit_dma(const bf16_t* __restrict__ Qb, const bf16_t* __restrict__ Kh, const bf16_t* __restrict__ Vh, bf16_t* __restrict__ Ob,
                                                   int seq, float lam, float oscale, const float* __restrict__ subg, LAS char* lds) {
    constexpr int LDK = 128, SLOT = 16384, KVBLK = 64;
    constexpr float C = SCALE * 1.4426950408889634f;
    int tid = threadIdx.x; asm volatile("" : "+v"(tid));
    const int wid = __builtin_amdgcn_readfirstlane(tid >> 6), lane = tid & 63, r32 = lane & 31, hi = lane >> 5, jh = wid >> 2, wq = wid & 3;
    LAS char* K_lds = lds + DD_LDS_K; LAS char* V_lds = lds + DD_LDS_V;
    LAS float* ws = (LAS float*)(lds + DD_LDS_WS) + wid * 64; LAS float* li_l = ws; LAS float* al_l = ws + 32;
    float m_reg = -1e30f, l_reg = 0.f, alpha = 1.f; f32x16 o[4] = {}; bf16x8 qr[4];
    const bf16_t* Qw = Qb + (size_t)(wq * 32 + r32) * 128 + jh * 64 + hi * 8;
#pragma unroll
    for (int d0 = 0; d0 < 4; ++d0) qr[d0] = *reinterpret_cast<const bf16x8*>(Qw + d0 * 16);
    const int cb0 = jh * 128;
    const int vb0 = (int)(uintptr_t)V_lds + v_rd_base(lane);
    const int NT = seq / KVBLK;
    unsigned koff[2], voff[2]; unsigned pbase[2];
#pragma unroll
    for (int j = 0; j < 2; ++j) { const int piece = j * 8 + wid; pbase[j] = (unsigned)piece * 1024u;
        const int krow = piece * 4 + (lane >> 4), kcolB = ((lane & 15) * 16) ^ ((krow & 7) << 4); koff[j] = (unsigned)(krow * LDK + (kcolB >> 1));
        const int sub = piece * 2 + (lane >> 5), kk = (sub >> 2) * 8 + ((lane & 31) >> 2), vk = (kk & ~0xC) | ((kk & 4) << 1) | ((kk & 8) >> 1), vc = (sub & 3) * 32 + (lane & 3) * 8; voff[j] = (unsigned)(vk * LDK + vc); }
#define DD_DMA(gp, lp) __builtin_amdgcn_global_load_lds((const unsigned*)(gp), (LAS unsigned*)(lp), 16, 0, 0)
#define DD_KTILE(t, slot) do { const bf16_t* g_ = Kh + (size_t)(t) * KVBLK * LDK; DD_DMA(g_ + koff[0], K_lds + (slot) * SLOT + pbase[0]); DD_DMA(g_ + koff[1], K_lds + (slot) * SLOT + pbase[1]); } while (0)
#define DD_VTILE(t, slot) do { const bf16_t* g_ = Vh + (size_t)(t) * KVBLK * LDK; DD_DMA(g_ + voff[0], V_lds + (slot) * SLOT + pbase[0]); DD_DMA(g_ + voff[1], V_lds + (slot) * SLOT + pbase[1]); } while (0)
#define DD_STAGE(e) do { asm volatile("s_waitcnt vmcnt(4)" ::: "memory"); const int kt_ = (e) + 3 < NT ? (e) + 3 : 0, vt_ = (e) + 2 < NT ? (e) + 2 : 0; DD_KTILE(kt_, ((e) + 3) & 3); DD_VTILE(vt_, ((e) + 2) & 3); } while (0)
#define DD_BAR() do { asm volatile("s_waitcnt lgkmcnt(0)" ::: "memory"); __builtin_amdgcn_s_barrier(); asm volatile("" ::: "memory"); } while (0)
#define DD_RESC(a) do { if (__any((a) < 1.f)) { if (hi == 0) al_l[r32] = (a); asm volatile("s_waitcnt lgkmcnt(0)" ::: "memory"); \
    _Pragma("unroll") for (int d = 0; d < 4; ++d) _Pragma("unroll") for (int r = 0; r < 16; ++r) o[d][r] *= al_l[crow(r, hi)]; } } while (0)
#define DD_PV(vb) do { pv_pair<4, 0>(o[0], o[1], vb, pa0, pa1, pa2, pa3); pv_pair<4, 2>(o[2], o[3], vb, pa0, pa1, pa2, pa3); } while (0)
    f32x16 p0, p1; bf16x8 pa0, pa1, pa2, pa3;
    DD_KTILE(0, 0); DD_KTILE(1, 1); DD_KTILE(2, 2); DD_VTILE(0, 0); DD_VTILE(1, 1);
    asm volatile("s_waitcnt vmcnt(0)" ::: "memory");
    asm volatile("" : "+v"(qr[0]), "+v"(qr[1]), "+v"(qr[2]), "+v"(qr[3]));
    DD_BAR();
    if (jh == 1) DD_BAR();
    for (int i = 0; i < NT; ++i) {
        if (jh == 1) DD_STAGE(i);
        if (i > 0) { DD_RESC(alpha); const int vb = vb0 + ((i - 1) & 3) * SLOT; DD_PV(vb); }
        qkt64(p0, p1, K_lds + (i & 3) * SLOT, qr, r32, hi, cb0);
        DD_BAR();
        if (jh == 0) DD_STAGE(i);
        { float pmax = p0[0];
#pragma unroll
          for (int r = 1; r < 16; ++r) pmax = fmaxf(pmax, p0[r]);
#pragma unroll
          for (int r = 0; r < 16; ++r) pmax = fmaxf(pmax, p1[r]);
          { auto rr = __builtin_amdgcn_permlane32_swap(__float_as_uint(pmax), __float_as_uint(pmax), false, false); pmax = fmaxf(__uint_as_float(rr[0]), __uint_as_float(rr[1])); }
          float mn;
          if (__builtin_expect(__all(pmax - m_reg <= THR / SCALE), 1)) { mn = m_reg; alpha = 1.f; }
          else { mn = fmaxf(m_reg, pmax); alpha = __builtin_amdgcn_exp2f((m_reg - mn) * C); m_reg = mn; }
          const float mnC = -mn * C; float ps = 0.f;
#pragma unroll
          for (int r = 0; r < 16; ++r) { p0[r] = __builtin_amdgcn_exp2f(fmaf(p0[r], C, mnC)); p1[r] = __builtin_amdgcn_exp2f(fmaf(p1[r], C, mnC)); }
#pragma unroll
          for (int r = 0; r < 16; ++r) ps += p0[r] + p1[r];
          { auto rr = __builtin_amdgcn_permlane32_swap(__float_as_uint(ps), __float_as_uint(ps), false, false); ps = __uint_as_float(rr[0]) + __uint_as_float(rr[1]); }
          l_reg = l_reg * alpha + ps;
          AT_PK4(p0, 0, pa0); AT_PK4(p0, 8, pa1); AT_PK4(p1, 0, pa2); AT_PK4(p1, 8, pa3); }
        DD_BAR();
    }
    { DD_RESC(alpha); const int vb = vb0 + ((NT - 1) & 3) * SLOT; DD_PV(vb); }
    asm volatile("s_waitcnt vmcnt(0)" ::: "memory");
    if (jh == 0) DD_BAR();
    if (hi == 0) li_l[r32] = l_reg; asm volatile("s_waitcnt lgkmcnt(0)" ::: "memory");
    float rli[16];
#pragma unroll
    for (int r = 0; r < 16; ++r) rli[r] = __builtin_amdgcn_rcpf(li_l[crow(r, hi)]);
    DD_BAR();
    LAS float* X = (LAS float*)lds;
    if (jh == 1) {
#pragma unroll
        for (int r = 0; r < 16; ++r)
#pragma unroll
            for (int d0 = 0; d0 < 4; ++d0) X[(wq * 32 + crow(r, hi)) * DA_XPITCH + d0 * 32 + r32] = o[d0][r] * rli[r];
    }
    DD_BAR();
    if (jh == 0) {
#pragma unroll
        for (int r = 0; r < 16; ++r)
#pragma unroll
            for (int d0 = 0; d0 < 4; ++d0) { const int ix = (wq * 32 + crow(r, hi)) * DA_XPITCH + d0 * 32 + r32; X[ix] = o[d0][r] * rli[r] - lam * X[ix]; }
    }
    DD_BAR();
    { const int row = tid >> 2, qd = tid & 3; const LAS f32x4* xr = (const LAS f32x4*)(X + row * DA_XPITCH + qd * 32);
      f32x4 v[8]; float ss = 0.f;
#pragma unroll
      for (int i = 0; i < 8; ++i) { v[i] = xr[i]; ss += (v[i][0] * v[i][0] + v[i][1] * v[i][1]) + (v[i][2] * v[i][2] + v[i][3] * v[i][3]); }
      ss += __shfl_xor(ss, 1); ss += __shfl_xor(ss, 2);
      const float rs = __builtin_amdgcn_rsqf(ss * (1.f / 128.f) + EPS) * oscale;
      const f32x4* gp = (const f32x4*)(subg + qd * 32); f32x4 gq[8];
#pragma unroll
      for (int i = 0; i < 8; ++i) gq[i] = gp[i];
      bf16_t* op = Ob + (size_t)row * 1024 + qd * 32;
#pragma unroll
      for (int i = 0; i < 4; ++i) { const f32x4 a = v[2 * i] * rs * gq[2 * i], b = v[2 * i + 1] * rs * gq[2 * i + 1]; *(u32x4*)(op + 8 * i) = gm::pack8(a, b); } }
    asm volatile("s_waitcnt vmcnt(0)" ::: "memory");
    DD_BAR();
#undef DD_DMA
#undef DD_KTILE
#undef DD_VTILE
#undef DD_STAGE
#undef DD_BAR
#undef DD_RESC
#undef DD_PV
}


template <int NCB, int D0, int KM>
__device__ __forceinline__ void pv_pair_km(f32x16& o0, f32x16& o1, int vb, bf16x8 pa0, bf16x8 pa1, bf16x8 pa2, bf16x8 pa3) {
    s16x4 l[2][4], h[2][4];
    if (KM & 1) { l[0][0] = tr_read<v_rd_off<NCB>(D0, 0, 0)>(vb); h[0][0] = tr_read<v_rd_off<NCB>(D0, 0, 1)>(vb); l[1][0] = tr_read<v_rd_off<NCB>(D0 + 1, 0, 0)>(vb); h[1][0] = tr_read<v_rd_off<NCB>(D0 + 1, 0, 1)>(vb); }
    if (KM & 2) { l[0][1] = tr_read<v_rd_off<NCB>(D0, 1, 0)>(vb); h[0][1] = tr_read<v_rd_off<NCB>(D0, 1, 1)>(vb); l[1][1] = tr_read<v_rd_off<NCB>(D0 + 1, 1, 0)>(vb); h[1][1] = tr_read<v_rd_off<NCB>(D0 + 1, 1, 1)>(vb); }
    if (KM & 4) { l[0][2] = tr_read<v_rd_off<NCB>(D0, 2, 0)>(vb); h[0][2] = tr_read<v_rd_off<NCB>(D0, 2, 1)>(vb); l[1][2] = tr_read<v_rd_off<NCB>(D0 + 1, 2, 0)>(vb); h[1][2] = tr_read<v_rd_off<NCB>(D0 + 1, 2, 1)>(vb); }
    if (KM & 8) { l[0][3] = tr_read<v_rd_off<NCB>(D0, 3, 0)>(vb); h[0][3] = tr_read<v_rd_off<NCB>(D0, 3, 1)>(vb); l[1][3] = tr_read<v_rd_off<NCB>(D0 + 1, 3, 0)>(vb); h[1][3] = tr_read<v_rd_off<NCB>(D0 + 1, 3, 1)>(vb); }
    __builtin_amdgcn_sched_barrier(0);
#define AT_PK(L, H) (bf16x8){L[0], L[1], L[2], L[3], H[0], H[1], H[2], H[3]}
    if (KM & 1) { o0 = __builtin_amdgcn_mfma_f32_32x32x16_bf16(pa0, AT_PK(l[0][0], h[0][0]), o0, 0, 0, 0); o1 = __builtin_amdgcn_mfma_f32_32x32x16_bf16(pa0, AT_PK(l[1][0], h[1][0]), o1, 0, 0, 0); }
    if (KM & 2) { o0 = __builtin_amdgcn_mfma_f32_32x32x16_bf16(pa1, AT_PK(l[0][1], h[0][1]), o0, 0, 0, 0); o1 = __builtin_amdgcn_mfma_f32_32x32x16_bf16(pa1, AT_PK(l[1][1], h[1][1]), o1, 0, 0, 0); }
    if (KM & 4) { o0 = __builtin_amdgcn_mfma_f32_32x32x16_bf16(pa2, AT_PK(l[0][2], h[0][2]), o0, 0, 0, 0); o1 = __builtin_amdgcn_mfma_f32_32x32x16_bf16(pa2, AT_PK(l[1][2], h[1][2]), o1, 0, 0, 0); }
    if (KM & 8) { o0 = __builtin_amdgcn_mfma_f32_32x32x16_bf16(pa3, AT_PK(l[0][3], h[0][3]), o0, 0, 0, 0); o1 = __builtin_amdgcn_mfma_f32_32x32x16_bf16(pa3, AT_PK(l[1][3], h[1][3]), o1, 0, 0, 0); }
#undef AT_PK
    __builtin_amdgcn_sched_barrier(0);
}
template <int MODE>
__device__ __forceinline__ void na_softmax_pv(f32x16& p0, f32x16& p1, f32x16 (&o)[2], float& m_reg, float& l_reg, const LAS float* rb, int hi, int r32, int wc0, LAS float* al_l, int vb) {
    constexpr float SC2 = SCALE * 1.4426950408889634f;
    constexpr int A0 = MODE == 2 ? 12 : 0, B1 = MODE == 1 ? 4 : 16;
    if (MODE != 0) { float bb0[16], bb1[16];
#pragma unroll
        for (int r = A0; r < 16; ++r) bb0[r] = rb[crow(r, hi)];
#pragma unroll
        for (int r = 0; r < B1; ++r) bb1[r] = rb[crow(r, hi) + 32];
        __builtin_amdgcn_sched_barrier(0);
#pragma unroll
        for (int r = A0; r < 16; ++r) { const int kc = crow(r, hi); p0[r] = (kc >= wc0 && kc < wc0 + 16) ? fmaf(p0[r], SC2, bb0[r]) : -1e30f; }
#pragma unroll
        for (int r = 0; r < B1; ++r) { const int kc = crow(r, hi) + 32; p1[r] = (kc >= wc0 && kc < wc0 + 16) ? fmaf(p1[r], SC2, bb1[r]) : -1e30f; } }
    float pmax = p0[A0];
#pragma unroll
    for (int r = A0 + 1; r < 16; ++r) pmax = fmaxf(pmax, p0[r]);
#pragma unroll
    for (int r = 0; r < B1; ++r) pmax = fmaxf(pmax, p1[r]);
    { auto rr = __builtin_amdgcn_permlane32_swap(__float_as_uint(pmax), __float_as_uint(pmax), false, false); pmax = fmaxf(__uint_as_float(rr[0]), __uint_as_float(rr[1])); }
    if (MODE == 0) pmax *= SC2;
    const float mn = fmaxf(m_reg, pmax), alpha = __builtin_amdgcn_exp2f(m_reg - mn); m_reg = mn;
    float ps = 0.f;
#pragma unroll
    for (int r = 0; r < 16; ++r) { if (r >= A0) { p0[r] = MODE == 0 ? __builtin_amdgcn_exp2f(fmaf(p0[r], SC2, -mn)) : __builtin_amdgcn_exp2f(p0[r] - mn); ps += p0[r]; } else p0[r] = 0.f; }
#pragma unroll
    for (int r = 0; r < 16; ++r) { if (r < B1) { p1[r] = MODE == 0 ? __builtin_amdgcn_exp2f(fmaf(p1[r], SC2, -mn)) : __builtin_amdgcn_exp2f(p1[r] - mn); ps += p1[r]; } else p1[r] = 0.f; }
    { auto rr = __builtin_amdgcn_permlane32_swap(__float_as_uint(ps), __float_as_uint(ps), false, false); ps = __uint_as_float(rr[0]) + __uint_as_float(rr[1]); }
    l_reg = l_reg * alpha + ps;
    if (__any(alpha < 1.f)) { if (hi == 0) al_l[r32] = alpha; asm volatile("s_waitcnt lgkmcnt(0)" ::: "memory");
#pragma unroll
        for (int d = 0; d < 2; ++d)
#pragma unroll
            for (int r = 0; r < 16; ++r) o[d][r] *= al_l[crow(r, hi)]; }
    bf16x8 pa0 = {}, pa1, pa2, pa3 = {};
    if (MODE != 2) AT_PK4(p0, 0, pa0);
    AT_PK4(p0, 8, pa1); AT_PK4(p1, 0, pa2);
    if (MODE != 1) AT_PK4(p1, 8, pa3);
    pv_pair_km<2, 0, (MODE == 0 ? 15 : (MODE == 1 ? 7 : 14))>(o[0], o[1], vb, pa0, pa1, pa2, pa3);
}
constexpr int NA_LDS_K = 0, NA_LDS_V = 24576, NA_LDS_RPB = 49152, NA_LDS_WS = 53248, NA_LDS_KB = 57344, NA_LDS_VB = 81920;
__device__ __forceinline__ void natten_unit(const bf16_t* __restrict__ qbuf, const bf16_t* __restrict__ kbuf, const bf16_t* __restrict__ vbuf, bf16_t* __restrict__ obuf,
                                            const float* __restrict__ rpb, int b, int h, int R4, LAS char* lds) {
    constexpr float L2E = 1.4426950408889634f, SC2 = SCALE * L2E;
    int tid = threadIdx.x; asm volatile("" : "+v"(tid));
    const int wid = __builtin_amdgcn_readfirstlane(tid >> 6), lane = tid & 63, r32 = lane & 31, hi = lane >> 5;
    const int qrow = R4 * 4 + (wid >> 1), qc0 = (wid & 1) * 32, qc = qc0 + r32;
    const int r0q = min(max(qrow - 4, 0), 24), wc0 = min(max(qc - 8, 0), 48);
    const int lo = min(max(R4 * 4 - 4, 0), 24), hir = min(max(R4 * 4 - 1, 0), 24) + 7, nb = hir - lo + 1 - 8;
    constexpr int nloc = 8, T = 12;
    const int rowi = wid >> 1;
    LAS char* K_lds = lds + NA_LDS_K; LAS char* V_lds = lds + NA_LDS_V; LAS float* rp = (LAS float*)(lds + NA_LDS_RPB);
    LAS float* ws = (LAS float*)(lds + NA_LDS_WS) + wid * 64; LAS float* li_l = ws; LAS float* al_l = ws + 32;
    for (int i = tid; i < 465; i += NTHREADS) rp[i] = rpb[h * 465 + i] * L2E;
    const size_t qtok = (size_t)b * SEQ + qrow * 64 + qc;
    bf16x8 qr[4];
#pragma unroll
    for (int d0 = 0; d0 < 4; ++d0) qr[d0] = *reinterpret_cast<const bf16x8*>(qbuf + qtok * 1024 + h * 64 + d0 * 16 + hi * 8);
    const bf16_t* Kb = kbuf + (size_t)b * KVL * 1024 + h * 64; const bf16_t* Vb = vbuf + (size_t)b * KVL * 1024 + h * 64;
    const int srow = tid >> 3, sch = tid & 7;
    const int kst = AT_KSWZ64(srow, sch * 16), vst = v_st<2>(srow, sch * 8);
    const int vb0 = (int)(uintptr_t)V_lds + v_rd_base(lane);
    float m_reg = -1e30f, l_reg = 0.f; f32x16 o[2] = {};
    const bool weven = (wid & 1) == 0;
    bf16x8 kreg[3], vreg[3];
#define NA_KROW(ti) ((ti) < nloc ? CTXL + (lo + (ti)) * 64 : ((ti) - nloc) * 64)
#define NA_LOAD(s, ti) do { if ((ti) < T) { const int kr0_ = NA_KROW(ti); kreg[s] = *reinterpret_cast<const bf16x8*>(Kb + (size_t)(kr0_ + srow) * 1024 + sch * 8); vreg[s] = *reinterpret_cast<const bf16x8*>(Vb + (size_t)(kr0_ + srow) * 1024 + sch * 8); } } while (0)
#define NA_WRITE(s) do { *(LAS bf16x8*)(K_lds + (s) * 8192 + kst) = kreg[s]; *(LAS bf16x8*)(V_lds + (s) * 8192 + vst) = vreg[s]; } while (0)
    NA_LOAD(0, 0); NA_LOAD(1, 1); NA_LOAD(2, 2);
    if (nb) { bf16x8 kb2[3], vb2[3];
#pragma unroll
        for (int j = 0; j < 3; ++j) { const int kr0_ = CTXL + (lo + 8 + j) * 64; kb2[j] = *reinterpret_cast<const bf16x8*>(Kb + (size_t)(kr0_ + srow) * 1024 + sch * 8); vb2[j] = *reinterpret_cast<const bf16x8*>(Vb + (size_t)(kr0_ + srow) * 1024 + sch * 8); }
#pragma unroll
        for (int j = 0; j < 3; ++j) { *(LAS bf16x8*)(lds + NA_LDS_KB + j * 8192 + kst) = kb2[j]; *(LAS bf16x8*)(lds + NA_LDS_VB + j * 8192 + vst) = vb2[j]; } }
    NA_WRITE(0); NA_LOAD(0, 3);
    __syncthreads();
#define NA_STEP(ti, S0, S1) do { \
        const bool local = (ti) < nloc; \
        const bool useb = local && nb != 0 && (ti) < rowi;                    \
        const int kr = useb ? lo + 8 + (ti) : lo + (ti); \
        const bool active = !local || (kr >= r0q && kr < r0q + 8); \
        if (active) { \
            f32x16 p0 = {}, p1 = {}; \
            const LAS char* Ks = useb ? lds + NA_LDS_KB + (ti) * 8192 : K_lds + (S0) * 8192; \
              \
            { bf16x8 kf0[4], kf1[4]; \
              _Pragma("unroll") for (int d0 = 0; d0 < 4; ++d0) { const int cb = (d0 * 16 + hi * 8) * 2; \
                kf0[d0] = *reinterpret_cast<const LAS bf16x8*>(Ks + AT_KSWZ64(r32, cb)); kf1[d0] = *reinterpret_cast<const LAS bf16x8*>(Ks + AT_KSWZ64(32 + r32, cb)); } \
              __builtin_amdgcn_sched_barrier(0); \
              _Pragma("unroll") for (int d0 = 0; d0 < 4; ++d0) { \
                p0 = __builtin_amdgcn_mfma_f32_32x32x16_bf16(kf0[d0], qr[d0], p0, 0, 0, 0); \
                p1 = __builtin_amdgcn_mfma_f32_32x32x16_bf16(kf1[d0], qr[d0], p1, 0, 0, 0); } } \
            const int vb = useb ? vb0 + (NA_LDS_VB - NA_LDS_V) + (ti) * 8192 : vb0 + (S0) * 8192; \
            if (local) { const LAS float* rb = rp + (kr - qrow + 7) * 31 + 15 - qc; \
                if (weven) na_softmax_pv<1>(p0, p1, o, m_reg, l_reg, rb, hi, r32, wc0, al_l, vb); else na_softmax_pv<2>(p0, p1, o, m_reg, l_reg, rb, hi, r32, wc0, al_l, vb); } \
            else na_softmax_pv<0>(p0, p1, o, m_reg, l_reg, rp, hi, r32, wc0, al_l, vb); \
        } \
        if ((ti) + 1 < T) { NA_WRITE(S1); NA_LOAD(S1, (ti) + 4); } \
        __syncthreads(); } while (0)
    for (int t3 = 0; t3 < T; t3 += 3) { NA_STEP(t3, 0, 1); NA_STEP(t3 + 1, 1, 2); NA_STEP(t3 + 2, 2, 0); }
    if (hi == 0) li_l[r32] = l_reg; asm volatile("s_waitcnt lgkmcnt(0)" ::: "memory");
    LAS bf16_t* ost = (LAS bf16_t*)(lds + NA_LDS_K) + wid * (32 * 72);
#pragma unroll
    for (int r = 0; r < 16; ++r) { const int orow = crow(r, hi); const float rl = __builtin_amdgcn_rcpf(li_l[orow]);
#pragma unroll
        for (int d0 = 0; d0 < 2; ++d0) { const unsigned w = cvt_pk_bf16(o[d0][r] * rl, 0.f); ost[orow * 72 + d0 * 32 + r32] = (bf16_t)(w & 0xffffu); } }
    asm volatile("s_waitcnt lgkmcnt(0)" ::: "memory");
    { bf16_t* op = obuf + ((size_t)b * SEQ + qrow * 64 + qc0) * 1024 + h * 64;
#pragma unroll
      for (int t = 0; t < 4; ++t) { const int ch = lane + 64 * t, orow = ch >> 3, c8 = (ch & 7) * 8;
          *(u32x4*)(op + (size_t)orow * 1024 + c8) = *(const LAS u32x4*)(ost + orow * 72 + c8); } }
    __syncthreads();
#undef NA_KROW
#undef NA_LOAD
#undef NA_WRITE
#undef NA_STEP
}
}

struct Params { const float* in[29]; float* out; unsigned char* ws; int ph_lo, ph_hi, li, pad; };
enum { I_X = 0, I_C, I_CTX, I_CCTX, I_ADAW, I_ADAB, I_MNG, I_MOEG, I_ROUTER, I_WGATE, I_WUP, I_WDOWN, I_DAWIN, I_LQ1, I_LK1, I_LQ2, I_LK2, I_SUBLN, I_DAWOUT,
       I_GMWIN, I_GMVG, I_GMWS, I_GMBS, I_GMWOUT, I_NAWIN, I_NARPB, I_NAWOUT, I_FNWOUT, I_FINALG };
struct Frame {
    LAS unsigned char* lds; const float* in[29]; unsigned char* ws; float* out;
    int tid, lane, wave, G, bid;
    template <class T> __device__ __forceinline__ T* W(size_t off) const { return (T*)(ws + off); }
};

struct TItem { const float* src; bf16_t* dst; int ldw, K, f8; };
__device__ __forceinline__ void titem_load(const TItem& t, int lane, float (&r)[32]) {
#pragma unroll
    for (int i = 0; i < 32; ++i) r[i] = t.src[(size_t)(2 * i + (lane >> 5)) * t.ldw + (lane & 31)];
}
__device__ __forceinline__ void titem_finish(const TItem& t, int lane, const float (&r)[32], LAS float* scr) {
#pragma unroll
    for (int i = 0; i < 32; ++i) scr[(2 * i + (lane >> 5)) * 33 + (lane & 31)] = r[i];
    LDS_WAIT(); asm volatile("" ::: "memory");
    if (t.f8) { const int c4 = lane & 3; unsigned char* d8 = (unsigned char*)t.dst;
#pragma unroll
        for (int j = 0; j < 2; ++j) { const int n = (lane >> 2) + 16 * j; const LAS float* s = scr + (16 * c4) * 33 + n; u32x4 o;
            o.x = gm::pk4_fp8(s[0 * 33] * gm::F8_SW, s[1 * 33] * gm::F8_SW, s[2 * 33] * gm::F8_SW, s[3 * 33] * gm::F8_SW); o.y = gm::pk4_fp8(s[4 * 33] * gm::F8_SW, s[5 * 33] * gm::F8_SW, s[6 * 33] * gm::F8_SW, s[7 * 33] * gm::F8_SW);
            o.z = gm::pk4_fp8(s[8 * 33] * gm::F8_SW, s[9 * 33] * gm::F8_SW, s[10 * 33] * gm::F8_SW, s[11 * 33] * gm::F8_SW); o.w = gm::pk4_fp8(s[12 * 33] * gm::F8_SW, s[13 * 33] * gm::F8_SW, s[14 * 33] * gm::F8_SW, s[15 * 33] * gm::F8_SW);
            *(u32x4*)(d8 + (size_t)n * t.K + 16 * c4) = o; }
        LDS_WAIT(); asm volatile("" ::: "memory"); return; }
    const int c = lane & 7;
#pragma unroll
    for (int j = 0; j < 4; ++j) { const int n = (lane >> 3) + 8 * j; const LAS float* s = scr + (8 * c) * 33 + n;
        u32x4 o; o.x = cvt_pk_bf16(s[0 * 33], s[1 * 33]); o.y = cvt_pk_bf16(s[2 * 33], s[3 * 33]); o.z = cvt_pk_bf16(s[4 * 33], s[5 * 33]); o.w = cvt_pk_bf16(s[6 * 33], s[7 * 33]);
        *(u32x4*)(t.dst + (size_t)n * t.K + 8 * c) = o; }
    LDS_WAIT(); asm volatile("" ::: "memory");
}
__device__ __forceinline__ TItem titem_make(const float* W, int ldw, int K, bf16_t* WT, int k0, int n0, int drow0) { TItem t; t.src = W + (size_t)k0 * ldw + n0; t.dst = WT + (size_t)drow0 * K + k0; t.ldw = ldw; t.K = K; t.f8 = 0; return t; }
__device__ __forceinline__ TItem titem_make8(const float* W, int ldw, int K, unsigned char* WT, int k0, int n0, int drow0) { TItem t; t.src = W + (size_t)k0 * ldw + n0; t.dst = (bf16_t*)(WT + (size_t)drow0 * K + k0); t.ldw = ldw; t.K = K; t.f8 = 1; return t; }
__device__ __forceinline__ TItem titem_plain(const float* W, int K, int N, bf16_t* WT, int item) { const int nblk = N / 32, kb = item / nblk, nb = item - kb * nblk; return titem_make(W, N, K, WT, 64 * kb, 32 * nb, 32 * nb); }
__device__ __forceinline__ TItem titem_moe(const Frame& F, int layer, int item) {
    const int kind = item / 8192, r = item - kind * 8192, e = r >> 9, it = r & 511, kb = it >> 5, nb = it & 31;
    const size_t eoff = ((size_t)layer * NE + e) * (size_t)(D * D);
    if (kind < 2) { const float* W = (kind == 0 ? F.in[I_WGATE] : F.in[I_WUP]) + eoff; unsigned char* WT = F.W<unsigned char>(WGU_OF(layer)) + (size_t)e * 2048 * 1024;
        const int n0 = 32 * nb; return titem_make8(W, D, D, WT, 64 * kb, n0, 256 * (n0 >> 7) + 128 * kind + (n0 & 127)); }
    const float* W = F.in[I_WDOWN] + eoff; unsigned char* WT = F.W<unsigned char>(WD_OF(layer)) + (size_t)e * 1024 * 1024; return titem_make8(W, D, D, WT, 64 * kb, 32 * nb, 32 * nb);
}
constexpr int MIX_J0 = 16 * 96, MIX_J1 = 16 * 32, MIX_J2 = 16 * 128, MIX_J3 = 32 * 32, MIX_J4 = 16 * 96, MIX_J5 = 16 * 32, MIX_J6 = 16 * 32, MIX_NJ = MIX_J0 + MIX_J1 + MIX_J2 + MIX_J3 + MIX_J4 + MIX_J5 + MIX_J6;
__device__ __forceinline__ TItem titem_mixer(const Frame& F, int it) { int r = it;
    if (r < MIX_J0) return titem_plain(F.in[I_DAWIN], 1024, 3072, F.W<bf16_t>(WS_WQKV0), r); r -= MIX_J0;
    if (r < MIX_J1) return titem_plain(F.in[I_DAWOUT], 1024, 1024, F.W<bf16_t>(WS_WO0), r); r -= MIX_J1;
    if (r < MIX_J2) return titem_plain(F.in[I_GMWIN], 1024, 4096, F.W<bf16_t>(WS_WGIN), r); r -= MIX_J2;
    if (r < MIX_J3) return titem_plain(F.in[I_GMWOUT], 2048, 1024, F.W<bf16_t>(WS_WGOUT), r); r -= MIX_J3;
    if (r < MIX_J4) return titem_plain(F.in[I_NAWIN], 1024, 3072, F.W<bf16_t>(WS_WQKV2), r); r -= MIX_J4;
    if (r < MIX_J5) return titem_plain(F.in[I_NAWOUT], 1024, 1024, F.W<bf16_t>(WS_WO2), r); r -= MIX_J5;
    return titem_plain(F.in[I_FNWOUT], 1024, 1024, F.W<bf16_t>(WS_WFO), r);
}
__device__ __forceinline__ void weights_range(const Frame& F, int layer, int n_mix, int i0, int i1, int gw, int nw) {
    LAS float* scr = (LAS float*)F.lds + F.wave * 2112;
    int it = i0 + gw; if (it >= i1) return;
    TItem cur = it < n_mix ? titem_mixer(F, it) : titem_moe(F, layer, it - n_mix); float ra[32], rb[32];
    titem_load(cur, F.lane, ra);
    for (;;) { const int nx = it + nw; const bool more = nx < i1; TItem nxt = cur;
        if (more) { nxt = nx < n_mix ? titem_mixer(F, nx) : titem_moe(F, layer, nx - n_mix); titem_load(nxt, F.lane, rb); }
        titem_finish(cur, F.lane, ra, scr);
        if (!more) break;
#pragma unroll
        for (int i = 0; i < 32; ++i) ra[i] = rb[i];
        cur = nxt; it = nx; }
}
__device__ __forceinline__ void moe_weights_phase(const Frame& F, int layer, int i0 = 0) { weights_range(F, layer, 0, i0, 24576, F.bid * NWAVES + F.wave, F.G * NWAVES); __syncthreads(); }
__device__ __forceinline__ void moe_weights_tail(const Frame& F, int layer, int i0, int per, int rank) {
    if (rank < 0) return;
    const int b0 = i0 + rank * per; weights_range(F, layer, 0, b0, b0 + per < 24576 ? b0 + per : 24576, F.wave, NWAVES); __syncthreads();
}
__device__ __forceinline__ void p0_prologue(const Frame& F, bool tails) {
    weights_range(F, 0, MIX_NJ, 0, tails ? MIX_NJ : MIX_NJ + 24576, F.bid * NWAVES + F.wave, F.G * NWAVES);
    const int gt = F.bid * NTHREADS + F.tid, NGT = F.G * NTHREADS;
    for (int i = gt; i < 1024; i += NGT) { const int pos = i >> 4, f = i & 15; const float inv = powf(10000.f, -(float)f / 16.f), ang = (float)pos * inv;
        F.W<float>(WS_ROPE)[i] = cosf(ang); F.W<float>(WS_ROPE + 4096)[i] = sinf(ang); }
    for (int i = gt; i < 512 * 256 / 8; i += NGT) { const int m = i >> 5, j0 = (i & 31) * 8; const int mm = m & 255; float v[8];
#pragma unroll
        for (int t = 0; t < 8; ++t) { const float x = (float)((mm * (j0 + t)) & 255) * (1.f / 128.f); v[t] = m < 256 ? cospif(x) : sinpif(x); }
        u32x4 w; w.x = cvt_pk_bf16(v[0], v[1]); w.y = cvt_pk_bf16(v[2], v[3]); w.z = cvt_pk_bf16(v[4], v[5]); w.w = cvt_pk_bf16(v[6], v[7]);
        *(u32x4*)(F.W<bf16_t>(WS_CS) + (size_t)i * 8) = w; }
    for (int i = gt; i < 2048 * 272; i += NGT) { const int k = i / 272, n0 = (i - k * 272) * 8; float v[8];
#pragma unroll
        for (int t = 0; t < 8; ++t) { const int np = n0 + t; const float x = (float)((k * (np & 1023)) & 2047) * (1.f / 1024.f);
            v[t] = np < 1024 ? cospif(x) : (np < 2048 ? -sinpif(x) : (np == 2048 ? ((k & 1) ? -1.f : 1.f) : 0.f)); }
        u32x4 w; w.x = cvt_pk_bf16(v[0], v[1]); w.y = cvt_pk_bf16(v[2], v[3]); w.z = cvt_pk_bf16(v[4], v[5]); w.w = cvt_pk_bf16(v[6], v[7]);
        *(u32x4*)(F.W<bf16_t>(WS_DP) + (size_t)i * 8) = w; }
    LAS float* sc = (LAS float*)F.lds;
    LAS float* part = (LAS float*)(F.lds + 73728);
    __syncthreads();
    { float cx[34];
#pragma unroll
      for (int q = 0; q < 34; ++q) { const int i = F.tid + NTHREADS * q, r = i >> 10, k = i & 1023; cx[q] = r < 16 ? F.in[I_C][r * 1024 + k] : F.in[I_CCTX][k]; }
#pragma unroll
      for (int q = 0; q < 34; ++q) sc[F.tid + NTHREADS * q] = cx[q] / (1.f + expf(-cx[q])); }
    __syncthreads();
    for (int item = F.bid; item < 4 * 192; item += F.G) { const int l = item / 192, c0 = (item - l * 192) * 32, cs = F.tid & 31, ks = F.tid >> 5;
        const float* wp = F.in[I_ADAW] + ((size_t)l * 1024 + (size_t)ks * 64) * MODW + c0 + cs;
        float a[17];
#pragma unroll
        for (int r = 0; r < 17; ++r) a[r] = 0.f;
        for (int k0 = 0; k0 < 64; k0 += 32) { float w[32];
#pragma unroll
            for (int kk = 0; kk < 32; ++kk) w[kk] = wp[(size_t)(k0 + kk) * MODW];
#pragma unroll
            for (int kk = 0; kk < 32; ++kk) {
#pragma unroll
                for (int r = 0; r < 17; ++r) a[r] = fmaf(sc[r * 1024 + ks * 64 + k0 + kk], w[kk], a[r]);
                __builtin_amdgcn_sched_barrier(0); } }
#pragma unroll
        for (int r = 0; r < 17; ++r) part[(ks * 17 + r) * 32 + cs] = a[r];
        __syncthreads();
        for (int i = F.tid; i < 17 * 32; i += NTHREADS) { const int r = i >> 5, cc = i & 31; float s = F.in[I_ADAB][l * MODW + c0 + cc];
#pragma unroll
            for (int q = 0; q < 16; ++q) s += part[(q * 17 + r) * 32 + cc];
            F.W<float>(WS_MOD)[((size_t)l * MODR + r) * MODW + c0 + cc] = s; }
        __syncthreads(); }
}

template <int CTRL> __device__ __forceinline__ float dpp_f(float x) { return __uint_as_float((unsigned)__builtin_amdgcn_mov_dpp((int)__float_as_uint(x), CTRL, 0xf, 0xf, true)); }
constexpr int DPP_X1 = 0xB1, DPP_X2 = 0x4E, DPP_ROR4 = 0x124, DPP_ROR8 = 0x128, DPP_ROR12 = 0x12C;
__device__ __forceinline__ float swap16_sum(float a, float b) { auto rr = __builtin_amdgcn_permlane16_swap(__float_as_uint(a), __float_as_uint(b), false, false); return __uint_as_float(rr[0]) + __uint_as_float(rr[1]); }
__device__ __forceinline__ float swap32_sum(float a, float b) { auto rr = __builtin_amdgcn_permlane32_swap(__float_as_uint(a), __float_as_uint(b), false, false); return __uint_as_float(rr[0]) + __uint_as_float(rr[1]); }
__device__ __forceinline__ float swap16_max(float a) { auto rr = __builtin_amdgcn_permlane16_swap(__float_as_uint(a), __float_as_uint(a), false, false); return fmaxf(__uint_as_float(rr[0]), __uint_as_float(rr[1])); }
__device__ __forceinline__ float swap32_max(float a) { auto rr = __builtin_amdgcn_permlane32_swap(__float_as_uint(a), __float_as_uint(a), false, false); return fmaxf(__uint_as_float(rr[0]), __uint_as_float(rr[1])); }
__device__ __forceinline__ float wave_sum64(float x) {
    x += dpp_f<DPP_ROR8>(x); x += dpp_f<DPP_ROR4>(x); x += dpp_f<DPP_X2>(x); x += dpp_f<DPP_X1>(x); x = swap16_sum(x, x); return swap32_sum(x, x);
}
template <int O> __device__ __forceinline__ float lane_xor(float x, int lane, bool x4a) {
    if (O == 1) return dpp_f<DPP_X1>(x);
    if (O == 2) return dpp_f<DPP_X2>(x);
    if (O == 4) { const float a = dpp_f<DPP_ROR4>(x), b = dpp_f<DPP_ROR12>(x); return x4a ? a : b; }
    if (O == 8) return dpp_f<DPP_ROR8>(x);
    if (O == 16) { auto rr = __builtin_amdgcn_permlane16_swap(__float_as_uint(x), __float_as_uint(x), false, false); return __uint_as_float((lane & 16) ? rr[0] : rr[1]); }
    auto rr = __builtin_amdgcn_permlane32_swap(__float_as_uint(x), __float_as_uint(x), false, false); return __uint_as_float((lane & 32) ? rr[0] : rr[1]);
}
struct NormArgs {
    const float* xsrc; float* xdst; const float* csrc; float* cdst;
    int do_lat, do_ctx, xbf, xcopy;
    const float* gain; const float* shift; const float* scale;
    bf16_t* hx;
    const bf16_t* ys; const int* tokslot; const int* tokslotc; const float* g2;
    int ctx_comb;
    const float* wrouter; float* aff;
    float* out;
};
constexpr int WRT_PITCH = 1028;
constexpr size_t WS_ZROW = WS_CTL + 768 * 1024;
struct NormVec { f32x4 g[4], sh[4], g2[4]; int mr; };
template <bool COMBINE, bool FINAL, bool ROUTER = false>
__device__ __forceinline__ void normvec_load(const NormArgs& A, int mr, int lane, NormVec& nv) {
    nv.mr = mr;
#pragma unroll
    for (int j = 0; j < 4; ++j) { nv.g[j] = ((const f32x4*)A.gain)[lane + 64 * j];
        if (!FINAL) { nv.sh[j] = ((const f32x4*)(A.shift + (size_t)mr * MODW))[lane + 64 * j]; const f32x4 sc = ((const f32x4*)(A.scale + (size_t)mr * MODW))[lane + 64 * j];
            nv.g[j] = nv.g[j] * (sc + 1.0f);
            if (ROUTER) { nv.g[j] = nv.g[j] * gm::F8_SX; nv.sh[j] = nv.sh[j] * gm::F8_SX; } }
        if (COMBINE) nv.g2[j] = ((const f32x4*)(A.g2 + (size_t)mr * MODW))[lane + 64 * j]; }
}
template <int R>
__device__ __forceinline__ void norm_load(const NormArgs& A, int row0, int rstep, int lane, f32x4 (&v)[R][4]) {
#pragma unroll
    for (int r = 0; r < R; ++r) { const int row = row0 + r * rstep;
        if (A.xbf) { const bf16_t* src = row >= NLAT ? (const bf16_t*)A.csrc + (size_t)(row - NLAT) * D : (const bf16_t*)A.xsrc + (size_t)row * D;
#pragma unroll
            for (int j = 0; j < 4; ++j) { const u32x2 w = ((const u32x2*)src)[lane + 64 * j]; v[r][j] = (f32x4){bf_lo(w.x), bf_hi(w.x), bf_lo(w.y), bf_hi(w.y)}; } }
        else { const float* src = row >= NLAT ? A.csrc + (size_t)(row - NLAT) * D : A.xsrc + (size_t)row * D;
#pragma unroll
            for (int j = 0; j < 4; ++j) v[r][j] = ((const f32x4*)src)[lane + 64 * j]; } }
}
template <bool COMBINE, bool ROUTER, bool FINAL, int R>
__device__ __forceinline__ void norm_rows(const NormArgs& A, const NormVec& nv, int row0, int rstep, int lane, const LAS float* wrT, const bf16_t* zrow, f32x4 (&v)[R][4], int hxfold = -1) {
    int row[R], b[R], mr[R]; bool ic[R];
#pragma unroll
    for (int r = 0; r < R; ++r) { row[r] = row0 + r * rstep; ic[r] = row[r] >= NLAT; b[r] = ic[r] ? (row[r] - NLAT) >> 8 : row[r] >> 11; mr[r] = ic[r] ? 16 : b[r]; }
    if (!COMBINE && !FINAL && A.xcopy) {
#pragma unroll
        for (int r = 0; r < R; ++r) { bf16_t* dst = ic[r] ? (bf16_t*)A.cdst + (size_t)(row[r] - NLAT) * D : (bf16_t*)A.xdst + (size_t)row[r] * D;
#pragma unroll
            for (int j = 0; j < 4; ++j) { u32x2 w; w.x = cvt_pk_bf16(v[r][j][0], v[r][j][1]); w.y = cvt_pk_bf16(v[r][j][2], v[r][j][3]); ((u32x2*)dst)[lane + 64 * j] = w; } } }
    if (COMBINE) {
        int myslot[R]; unsigned msk[R]; int tmax = 0;
#pragma unroll
        for (int r = 0; r < R; ++r) { myslot[r] = -1;
            if (lane < 16 && (!ic[r] || A.ctx_comb)) myslot[r] = ic[r] ? A.tokslotc[(b[r] * 16 + lane) * CTXL + ((row[r] - NLAT) & 255)] : A.tokslot[(b[r] * 16 + lane) * SEQ + (row[r] & 2047)]; }
#pragma unroll
        for (int r = 0; r < R; ++r) { msk[r] = (unsigned)__ballot(myslot[r] >= 0) & 0xffffu; const int c = __builtin_popcount(msk[r]); tmax = c > tmax ? c : tmax; }
        f32x4 a[R][4];
#pragma unroll
        for (int r = 0; r < R; ++r)
#pragma unroll
            for (int j = 0; j < 4; ++j) a[r][j] = (f32x4){0.f, 0.f, 0.f, 0.f};
        for (int t = 0; t < tmax; ++t) {
            unsigned w[R][4];
#pragma unroll
            for (int r = 0; r < R; ++r) { const unsigned m = msk[r]; const bool ok = m != 0u; const int e = ok ? __builtin_ctz(m) : 0; msk[r] = m & (m - 1u);
                const int sl = __builtin_amdgcn_readlane(myslot[r], e);
                const unsigned char* yr = ok ? (const unsigned char*)A.ys + ((size_t)e * gm::ES + (ic[r] ? 4096 + b[r] * CAPC : b[r] * CAP) + sl) * D : (const unsigned char*)zrow;
#pragma unroll
                for (int j = 0; j < 4; ++j) w[r][j] = ((const unsigned*)yr)[lane + 64 * j]; }
#pragma unroll
            for (int r = 0; r < R; ++r)
#pragma unroll
                for (int j = 0; j < 4; ++j) { const f32x2 lo = __builtin_amdgcn_cvt_pk_f32_fp8((int)w[r][j], false), hi2 = __builtin_amdgcn_cvt_pk_f32_fp8((int)w[r][j], true);
                    a[r][j] += (f32x4){lo[0], lo[1], hi2[0], hi2[1]}; }
        }
#pragma unroll
        for (int r = 0; r < R; ++r) { if (ic[r] && !A.ctx_comb) continue;
#pragma unroll
            for (int j = 0; j < 4; ++j) v[r][j] += nv.g2[j] * (a[r][j] * 0.03125f);
            if (!FINAL) { bf16_t* dst = ic[r] ? (bf16_t*)A.cdst + (size_t)(row[r] - NLAT) * D : (bf16_t*)A.xdst + (size_t)row[r] * D;
#pragma unroll
                for (int j = 0; j < 4; ++j) { u32x2 w; w.x = cvt_pk_bf16(v[r][j][0], v[r][j][1]); w.y = cvt_pk_bf16(v[r][j][2], v[r][j][3]); ((u32x2*)dst)[lane + 64 * j] = w; } } }
    }
    float ss[R];
#pragma unroll
    for (int r = 0; r < R; ++r) { ss[r] = 0.f;
#pragma unroll
        for (int j = 0; j < 4; ++j) ss[r] += (v[r][j][0] * v[r][j][0] + v[r][j][1] * v[r][j][1]) + (v[r][j][2] * v[r][j][2] + v[r][j][3] * v[r][j][3]); }
#pragma unroll
    for (int r = 0; r < R; ++r) ss[r] = wave_sum64(ss[r]);
    if (FINAL) {
#pragma unroll
        for (int r = 0; r < R; ++r) { const float rstd = __builtin_amdgcn_rsqf(ss[r] * (1.f / D) + EPS);
#pragma unroll
            for (int j = 0; j < 4; ++j) ((f32x4*)(A.out + (size_t)row[r] * D))[lane + 64 * j] = v[r][j] * rstd * nv.g[j]; }
        return;
    }
#pragma unroll
    for (int r = 0; r < R; ++r) { const float rstd = __builtin_amdgcn_rsqf(ss[r] * (1.f / D) + EPS);
#pragma unroll
        for (int j = 0; j < 4; ++j) { v[r][j] = v[r][j] * rstd * nv.g[j] + nv.sh[j];
            if (ROUTER) ((unsigned*)((unsigned char*)A.hx + (size_t)row[r] * D))[lane + 64 * j] = gm::pk4_fp8(v[r][j][0], v[r][j][1], v[r][j][2], v[r][j][3]);
            else if (hxfold < 0) { u32x2 w; w.x = cvt_pk_bf16(v[r][j][0], v[r][j][1]); w.y = cvt_pk_bf16(v[r][j][2], v[r][j][3]); ((u32x2*)(A.hx + (size_t)row[r] * D))[lane + 64 * j] = w; } } }
    if (hxfold >= 0) {
#pragma unroll
        for (int j = 0; j < 4; ++j) { const f32x4 a = R == 2 ? v[0][j] + v[R - 1][j] : v[0][j];
            u32x2 w; w.x = cvt_pk_bf16(a[0], a[1]); w.y = cvt_pk_bf16(a[2], a[3]); ((u32x2*)(A.hx + (size_t)hxfold * D))[lane + 64 * j] = w;
            if (R == 2) { const f32x4 d = v[0][j] - v[1][j]; u32x2 w2; w2.x = cvt_pk_bf16(d[0], d[1]); w2.y = cvt_pk_bf16(d[2], d[3]); ((u32x2*)(A.hx + (size_t)(hxfold + 1024) * D))[lane + 64 * j] = w2; } } }
    if (ROUTER) {
        float t1[R]; float lgs[R][16];
        f32x4 wb[2][4];
#define RT_LOAD(buf, e) do { _Pragma("unroll") for (int j = 0; j < 4; ++j) wb[buf][j] = *(const LAS f32x4*)(wrT + (e) * WRT_PITCH + 4 * lane + 256 * j); } while (0)
        RT_LOAD(0, 0);
#pragma unroll
        for (int e = 0; e < 16; ++e) {
            if (e + 1 < 16) RT_LOAD((e + 1) & 1, e + 1);
            __builtin_amdgcn_sched_barrier(0);
            f32x2 s_[R];
#pragma unroll
            for (int r = 0; r < R; ++r) s_[r] = (f32x2){0.f, 0.f};
#pragma unroll
            for (int j = 0; j < 4; ++j) { const f32x4 w = wb[e & 1][j]; const f32x2 wlo = (f32x2){w[0], w[1]}, whi = (f32x2){w[2], w[3]};
#pragma unroll
                for (int r = 0; r < R; ++r) { s_[r] = __builtin_elementwise_fma((f32x2){v[r][j][0], v[r][j][1]}, wlo, s_[r]); s_[r] = __builtin_elementwise_fma((f32x2){v[r][j][2], v[r][j][3]}, whi, s_[r]); } }
#pragma unroll
            for (int r = 0; r < R; ++r) lgs[r][e] = s_[r][0] + s_[r][1];
            __builtin_amdgcn_sched_barrier(0);
        }
#undef RT_LOAD
        const bool x4a = __builtin_amdgcn_mov_dpp(lane, DPP_ROR4, 0xf, 0xf, true) == (lane ^ 4);
#pragma unroll
        for (int r = 0; r < R; ++r) {
            float lg[16];
#pragma unroll
            for (int e = 0; e < 16; ++e) lg[e] = lgs[r][e];
            float t8[8], t4[4], t2[2];
#pragma unroll
            for (int k = 0; k < 8; ++k) t8[k] = swap32_sum(lg[k], lg[k + 8]);
#pragma unroll
            for (int k = 0; k < 4; ++k) t4[k] = swap16_sum(t8[k], t8[k + 4]);
            { const bool up = (lane & 8) != 0;
#pragma unroll
              for (int k = 0; k < 2; ++k) { const float keep = up ? t4[k + 2] : t4[k], send = up ? t4[k] : t4[k + 2]; t2[k] = keep + lane_xor<8>(send, lane, x4a); } }
            { const bool up = (lane & 4) != 0; const float keep = up ? t2[1] : t2[0], send = up ? t2[0] : t2[1]; t1[r] = keep + lane_xor<4>(send, lane, x4a); }
        }
#pragma unroll
        for (int r = 0; r < R; ++r) { t1[r] += lane_xor<2>(t1[r], lane, x4a); }
#pragma unroll
        for (int r = 0; r < R; ++r) { t1[r] += lane_xor<1>(t1[r], lane, x4a); }
        float mx[R], ex[R], sm[R];
#pragma unroll
        for (int r = 0; r < R; ++r) { float m = t1[r]; m = fmaxf(m, dpp_f<DPP_ROR8>(m)); m = fmaxf(m, dpp_f<DPP_ROR4>(m)); m = swap16_max(m); mx[r] = swap32_max(m); }
#pragma unroll
        for (int r = 0; r < R; ++r) { ex[r] = __builtin_amdgcn_exp2f((t1[r] - mx[r]) * 1.4426950408889634f); sm[r] = ex[r]; }
#pragma unroll
        for (int r = 0; r < R; ++r) { float q = sm[r]; q += dpp_f<DPP_ROR8>(q); q += dpp_f<DPP_ROR4>(q); q = swap16_sum(q, q); sm[r] = swap32_sum(q, q); }
#pragma unroll
        for (int r = 0; r < R; ++r) if ((lane & 3) == 0) A.aff[(size_t)row[r] * 16 + (lane >> 2)] = ex[r] * __builtin_amdgcn_rcpf(sm[r]);
    }
}
template <bool COMBINE, bool ROUTER, bool FINAL>
__device__ __forceinline__ void norm_phase(const Frame& F, const NormArgs& A) {
    constexpr int R = 2;
    LAS float* wrT = (LAS float*)F.lds;
    if (ROUTER) {
        float tmp[32];
#pragma unroll
        for (int k = 0; k < 32; ++k) tmp[k] = A.wrouter[F.tid + NTHREADS * k];
#pragma unroll
        for (int k = 0; k < 32; ++k) { const int i = F.tid + NTHREADS * k; wrT[(i & 15) * WRT_PITCH + (i >> 4)] = tmp[k] * (1.0f / gm::F8_SX); }
        __syncthreads(); }
    const bf16_t* zrow = (const bf16_t*)(F.ws + WS_ZROW);
    const int gw = F.bid * NWAVES + F.wave, NGW = F.G * NWAVES;
    NormVec nv; nv.mr = -1;
    for (int part = 0; part < 2; ++part) {
        if (part == 0 ? !A.do_lat : !A.do_ctx) continue;
        const int base = part == 0 ? 0 : NLAT, n = part == 0 ? NLAT : NCTX, rpw = (n + NGW - 1) / NGW;
        int row = base + gw * rpw; const int rend = (row + rpw < base + n) ? row + rpw : base + n;
        f32x4 va[R][4], vb[R][4];
        const auto same = [&](int r) { return r + 1 < rend && (part == 1 ? ((r - NLAT) >> 8) == ((r + 1 - NLAT) >> 8) : (r >> 11) == ((r + 1) >> 11)); };
        if (row < rend && same(row)) norm_load<R>(A, row, 1, F.lane, va);
        while (row < rend) {
            const int mr = part == 1 ? 16 : (row >> 11);
            if (mr != nv.mr) normvec_load<COMBINE, FINAL, ROUTER>(A, mr, F.lane, nv);
            if (same(row)) { const int nx = row + R; const bool more = nx < rend && same(nx);
                if (more) norm_load<R>(A, nx, 1, F.lane, vb);
                norm_rows<COMBINE, ROUTER, FINAL, R>(A, nv, row, 1, F.lane, wrT, zrow, va);
                if (more) {
#pragma unroll
                    for (int r = 0; r < R; ++r)
#pragma unroll
                        for (int j = 0; j < 4; ++j) va[r][j] = vb[r][j]; }
                else if (nx < rend && !more) {   }
                row = nx; }
            else { f32x4 v1[1][4]; norm_load<1>(A, row, 1, F.lane, v1); norm_rows<COMBINE, ROUTER, FINAL, 1>(A, nv, row, 1, F.lane, wrT, zrow, v1); row += 1;
                if (row < rend && same(row)) norm_load<R>(A, row, 1, F.lane, va); }
        }
    }
    __syncthreads();
}

constexpr int HF_ROWS = 2304;
template <bool COMBINE>
__device__ __forceinline__ void norm_fold_phase(const Frame& F, const NormArgs& A) {
    const bf16_t* zrow = (const bf16_t*)(F.ws + WS_ZROW);
    const int gw = F.bid * NWAVES + F.wave, NGW = F.G * NWAVES;
    constexpr int NPAIR = NB * 1023;
    NormVec nv; nv.mr = -1;
    { const int ipw = (NPAIR + NGW - 1) / NGW; int it = gw * ipw; const int iend = (it + ipw < NPAIR) ? it + ipw : NPAIR; f32x4 va[2][4], vb[2][4];
      if (it < iend) { const int b = it / 1023, n = 1 + it - b * 1023; norm_load<2>(A, b * SEQ + n, SEQ - 2 * n, F.lane, va); }
      for (; it < iend; ++it) { const int b = it / 1023, n = 1 + it - b * 1023; const int nx = it + 1; const bool more = nx < iend;
          if (b != nv.mr) normvec_load<COMBINE, false>(A, b, F.lane, nv);
          if (more) { const int b2 = nx / 1023, n2 = 1 + nx - b2 * 1023; norm_load<2>(A, b2 * SEQ + n2, SEQ - 2 * n2, F.lane, vb); }
          norm_rows<COMBINE, false, false, 2>(A, nv, b * SEQ + n, SEQ - 2 * n, F.lane, nullptr, zrow, va, b * HF_ROWS + n);
          if (more) {
#pragma unroll
              for (int r = 0; r < 2; ++r)
#pragma unroll
                  for (int j = 0; j < 4; ++j) va[r][j] = vb[r][j]; } } }
    for (int it = gw; it < 2 * NB; it += NGW) { const int b = it >> 1, hi = it & 1; f32x4 v1[1][4];
        if (b != nv.mr) normvec_load<COMBINE, false>(A, b, F.lane, nv);
        norm_load<1>(A, b * SEQ + hi * 1024, 0, F.lane, v1); norm_rows<COMBINE, false, false, 1>(A, nv, b * SEQ + hi * 1024, 0, F.lane, nullptr, zrow, v1, b * HF_ROWS + hi * 2048); }
    for (int it = gw; it < NB * 256; it += NGW) { const int b = it >> 8, q = it & 255; const int r = q == 0 ? 1024 : 2048 + q;
        u32x2 z; z.x = 0u; z.y = 0u;
#pragma unroll
        for (int j = 0; j < 4; ++j) ((u32x2*)(A.hx + ((size_t)b * HF_ROWS + r) * D))[F.lane + 64 * j] = z; }
    __syncthreads();
}

template <int NV, int NTOK, int CAPN>
__device__ __forceinline__ void select_unit(const Frame& F, const float* aff_base  , int* tokslot_out  , int* slot_row_out, float* slot_aff_out, int row_base) {
    LAS int* cnt = (LAS int*)F.lds;
    LAS int* tg = cnt + 64; LAS int* te = tg + NV * 8;
    unsigned v[NV]; bool ok[NV];
#pragma unroll
    for (int k = 0; k < NV; ++k) { const int n = F.tid + NTHREADS * k; ok[k] = n < NTOK; v[k] = ok[k] ? __float_as_uint(aff_base[(size_t)n * 16]) : 0u; }
    unsigned T = 0u;
    for (int bit = 29; bit >= 0; --bit) { const unsigned cand = T | (1u << bit); int cw = 0;
#pragma unroll
        for (int k = 0; k < NV; ++k) cw += __builtin_popcountll(__ballot(ok[k] && v[k] >= cand));
        LAS int* cb = cnt + (bit & 1) * 8;
        if (F.lane == 0) cb[F.wave] = cw;
        __syncthreads();
        int tot = 0;
#pragma unroll
        for (int w = 0; w < 8; ++w) tot += cb[w];
        if (tot >= CAPN) T = cand; }
    int pg[NV], pe[NV]; bool isg[NV], ise[NV];
#pragma unroll
    for (int k = 0; k < NV; ++k) { isg[k] = ok[k] && v[k] > T; ise[k] = ok[k] && v[k] == T;
        const unsigned long long mg = __ballot(isg[k]), me = __ballot(ise[k]); const unsigned long long below = (1ull << F.lane) - 1ull;
        pg[k] = __builtin_popcountll(mg & below); pe[k] = __builtin_popcountll(me & below);
        if (F.lane == 0) { tg[k * 8 + F.wave] = __builtin_popcountll(mg); te[k * 8 + F.wave] = __builtin_popcountll(me); } }
    __syncthreads();
    LAS int* xg = te + NV * 8; LAS int* xe = xg + NV * 8 + 1;
    if (F.tid == 0) { int ag = 0, ae = 0; for (int i = 0; i < NV * 8; ++i) { xg[i] = ag; xe[i] = ae; ag += tg[i]; ae += te[i]; } xg[NV * 8] = ag; }
    __syncthreads();
    const int totg = xg[NV * 8];
#pragma unroll
    for (int k = 0; k < NV; ++k) { const int og = xg[k * 8 + F.wave], oe = xe[k * 8 + F.wave];
        const int n = F.tid + NTHREADS * k;
        if (ok[k]) { int slot = -1;
            if (isg[k]) slot = og + pg[k];
            else if (ise[k]) { const int rk = oe + pe[k]; if (totg + rk < CAPN) slot = totg + rk; }
            tokslot_out[n] = slot;
            if (slot >= 0) { slot_row_out[slot] = row_base + n; slot_aff_out[slot] = __uint_as_float(v[k]); } } }
    __syncthreads();
}
__device__ __forceinline__ void topk_phase(const Frame& F, bool do_ctx) {
    const float* aff = F.W<float>(WS_AFF); int* slot_row = F.W<int>(WS_SLOTROW); float* slot_aff = F.W<float>(WS_SLOTAFF); int* tokslot = F.W<int>(WS_TOKSLOT); int* tokslotc = F.W<int>(WS_TOKSLOTC);
    const int nunits = do_ctx ? 512 : 256;
    for (int u = F.bid; u < nunits; u += F.G) {
        if (u < 256) { const int b = u >> 4, e = u & 15;
            select_unit<4, SEQ, CAP>(F, aff + (size_t)b * SEQ * 16 + e, tokslot + (b * 16 + e) * SEQ, slot_row + e * gm::ES + b * CAP, slot_aff + e * gm::ES + b * CAP, b * SEQ); }
        else { const int b = (u - 256) >> 4, e = u & 15;
            select_unit<1, CTXL, CAPC>(F, aff + ((size_t)NLAT + (size_t)b * CTXL) * 16 + e, tokslotc + (b * 16 + e) * CTXL, slot_row + e * gm::ES + 4096 + b * CAPC, slot_aff + e * gm::ES + 4096 + b * CAPC, NLAT + b * CTXL); }
    }
}

__device__ __forceinline__ void gm_prep_phase(const Frame& F) {
    const float* ws_ = F.in[I_GMWS]; const float* sumsq = F.W<float>(WS_SUMSQ); bf16_t* App = F.W<bf16_t>(RA_APP);
    LAS float* rs = (LAS float*)F.lds;
    for (int item = F.bid; item < NB * 9 * 2; item += F.G) { const int gq = item & 1, bc = item >> 1, b = bc / 9, cp = bc - b * 9;
        const size_t trow0 = cp == 0 ? (size_t)NLAT + (size_t)b * CTXL : (size_t)b * SEQ + (size_t)(cp - 1) * 256;
        if (F.tid < 256) { const f32x4* pa = (const f32x4*)(sumsq + (trow0 + F.tid) * 16); const f32x4 a0 = pa[0], a1 = pa[1], a2 = pa[2], a3 = pa[3];
            const float sm = (((a0[0] + a0[1]) + (a0[2] + a0[3])) + ((a1[0] + a1[1]) + (a1[2] + a1[3]))) + (((a2[0] + a2[1]) + (a2[2] + a2[3])) + ((a3[0] + a3[1]) + (a3[2] + a3[3])));
            rs[F.tid] = __builtin_amdgcn_rsqf(sm * (1.f / 2048.f) + EPS); }
        __syncthreads();
        constexpr int U = 4;
        for (int i0 = F.tid; i0 < 4 * 4096; i0 += U * NTHREADS) {
            f32x4 w0[U], w1[U];
#pragma unroll
            for (int q = 0; q < U; ++q) { const int i = i0 + q * NTHREADS; const int g = gq * 4 + (i >> 12), r = (i >> 4) & 255, k0 = (i & 15) * 8;
                const float* wp = ws_ + ((size_t)g * 128 + (r & 127)) * 128 + k0; w0[q] = *(const f32x4*)wp; w1[q] = *(const f32x4*)(wp + 4); }
#pragma unroll
            for (int q = 0; q < U; ++q) { const int i = i0 + q * NTHREADS; const int g = gq * 4 + (i >> 12), r = (i >> 4) & 255, k0 = (i & 15) * 8, tk = (r >> 7) * 128 + k0;
                const f32x4 r0 = *(const LAS f32x4*)(rs + tk), r1 = *(const LAS f32x4*)(rs + tk + 4);
                *(u32x4*)(App + ((size_t)(bc * 8 + g) * 4096 + (i & 4095)) * 8) = gm::pack8(w0[q] * r0, w1[q] * r1); }
        }
        __syncthreads();
    }
}

enum { PH_PRO = 0,
       PH_L0_N1, PH_L0_QKV, PH_L0_ATT, PH_L0_OUT, PH_L0_N2, PH_L0_TOPK, PH_L0_GU, PH_L0_DOWN,
       PH_L1_N1, PH_L1_GMIN, PH_L1_PREP, PH_L1_SPAT, PH_L1_OUT, PH_L1_N2, PH_L1_TOPK, PH_L1_GU, PH_L1_DOWN,
       PH_L2_N1, PH_L2_QKV, PH_L2_ATT, PH_L2_OUT, PH_L2_N2, PH_L2_TOPK, PH_L2_GU, PH_L2_DOWN,
       PH_L3_N1, PH_L3_CDFT, PH_L3_PDFT, PH_L3_OUT, PH_L3_N2, PH_L3_TOPK, PH_L3_GU, PH_L3_DOWN,
       PH_FINAL, NPHASES };

__device__ __forceinline__ const float* modp(const Frame& F, int layer, int j) { return F.W<float>(WS_MOD) + (size_t)layer * MODR * MODW + (size_t)j * D; }

template <bool COMBINE>
__device__ __forceinline__ void norm1_phase(const Frame& F, int layer, bool do_ctx, bool ctx_comb) {
    NormArgs A{};
    A.xsrc = COMBINE ? F.W<float>(WS_X) : F.in[I_X]; A.xdst = F.W<float>(WS_X); A.csrc = COMBINE ? F.W<float>(WS_CTX) : F.in[I_CTX]; A.cdst = F.W<float>(WS_CTX);
    A.do_lat = 1; A.do_ctx = do_ctx ? 1 : 0; A.xbf = COMBINE ? 1 : 0; A.xcopy = COMBINE ? 0 : 1;
    A.gain = F.in[I_MNG] + layer * D; A.shift = modp(F, layer, 0); A.scale = modp(F, layer, 1); A.hx = F.W<bf16_t>(WS_HX);
    A.ys = F.W<bf16_t>(RA_YS); A.tokslot = F.W<int>(WS_TOKSLOT); A.tokslotc = F.W<int>(WS_TOKSLOTC); A.g2 = modp(F, layer > 0 ? layer - 1 : 0, 5); A.ctx_comb = ctx_comb ? 1 : 0;
    norm_phase<COMBINE, false, false>(F, A);
}
__device__ __forceinline__ void norm2_phase(const Frame& F, int layer, bool do_ctx) {
    NormArgs A{};
    A.xsrc = F.W<float>(WS_X); A.csrc = F.W<float>(WS_CTX); A.do_lat = 1; A.do_ctx = do_ctx ? 1 : 0; A.xbf = 1;
    A.gain = F.in[I_MOEG] + layer * D; A.shift = modp(F, layer, 3); A.scale = modp(F, layer, 4); A.hx = F.W<bf16_t>(WS_HX);
    A.wrouter = F.in[I_ROUTER] + (size_t)layer * D * NE; A.aff = F.W<float>(WS_AFF);
    norm_phase<false, true, false>(F, A);
}
__device__ __forceinline__ void out_phase(const Frame& F, int layer, const char* A, unsigned lda, int K, size_t wofs, int nM) {
    gm::P_OUT p; p.A = A; p.B = (const char*)(F.ws + wofs); p.lda_ = lda; p.K_ = K; p.nM = nM;
    p.xb_ = F.W<bf16_t>(WS_X); p.cb_ = F.W<bf16_t>(WS_CTX); p.gate = modp(F, layer, 2);
    gm::gemm_phase(F.lds, p);
}
__device__ __forceinline__ void gu_phase(const Frame& F, int layer, bool with_ctx) {
    gm::P_GU p; p.hx = (const char*)(F.ws + WS_HX); p.W = (const char*)(F.ws + WGU_OF(layer)); p.hid = F.W<unsigned char>(RA_HID); p.slot_row = F.W<int>(WS_SLOTROW); p.nM = with_ctx ? 18 : 16;
    gm::gemm_phase(F.lds, p);
}
__device__ __forceinline__ void down_phase(const Frame& F, int layer, bool with_ctx) {
    gm::P_DOWN p; p.hid = (const char*)(F.ws + RA_HID); p.W = (const char*)(F.ws + WD_OF(layer)); p.ys = F.W<bf16_t>(RA_YS); p.slot_aff = F.W<float>(WS_SLOTAFF); p.nM = with_ctx ? 18 : 16;
    gm::gemm_phase(F.lds, p);
}

__global__ void __launch_bounds__(NTHREADS, 2) fwd(Params P) {
    extern __shared__ __attribute__((aligned(16))) unsigned char lds_raw[];
    Frame F;
    F.lds = (LAS unsigned char*)lds_raw; F.ws = P.ws; F.out = P.out;
#pragma unroll
    for (int i = 0; i < 29; ++i) F.in[i] = P.in[i];
    F.tid = threadIdx.x; F.lane = F.tid & 63; F.wave = __builtin_amdgcn_readfirstlane(F.tid >> 6); F.G = gridDim.x; F.bid = blockIdx.x;
    volatile LAS unsigned* MISC = (volatile LAS unsigned*)(F.lds + LDS_MISC);
    if (F.tid < 64) MISC[F.tid] = 0u;
    __syncthreads();
    const int lo = P.ph_lo, hi = P.ph_hi;
    const bool tails = (gridDim.x == 256);
    XcdBarrier bar = xcd_barrier_post((unsigned*)(F.ws + WS_CTL) + 1024 + (size_t)P.li * XCD_BAR_WORDS, MISC);
#ifdef MK_ONLY_PHASE
#define IN(k) ((k) == MK_ONLY_PHASE && lo <= (k) && (k) < hi)
#else
#define IN(k) (lo <= (k) && (k) < hi)
#endif
#define SEAM(k) do { if (IN(k) && IN((k) + 1)) xcd_barrier(bar); } while (0)
#define REFRESH() do { int tz_ = threadIdx.x; asm volatile("" : "+v"(tz_)); F.tid = tz_; F.lane = tz_ & 63; F.wave = __builtin_amdgcn_readfirstlane(tz_ >> 6); } while (0)

    if (IN(PH_PRO)) { REFRESH(); p0_prologue(F, tails); } SEAM(PH_PRO);

    if (IN(PH_L0_N1)) { REFRESH(); norm1_phase<false>(F, 0, true, false); } SEAM(PH_L0_N1);
    if (IN(PH_L0_QKV)) { REFRESH();
        gm::P_QKV0 p; p.A = (const char*)(F.ws + WS_HX); p.B = (const char*)(F.ws + WS_WQKV0); p.q = F.W<bf16_t>(RB_Q); p.k = F.W<bf16_t>(RB_K); p.v = F.W<bf16_t>(RB_V);
        p.ropeC = F.W<float>(WS_ROPE); p.ropeS = F.W<float>(WS_ROPE + 4096);
        gm::gemm_phase(F.lds, p);
        if (tails) moe_weights_tail(F, 1, 0, 48, F.bid - 192);
    } SEAM(PH_L0_QKV);
    if (IN(PH_L0_ATT)) { REFRESH();
        float lam;
        { const float a = F.in[I_LQ1][F.lane] * F.in[I_LK1][F.lane], b = F.in[I_LQ2][F.lane] * F.in[I_LK2][F.lane]; lam = expf(wave_sum(a)) - expf(wave_sum(b)) + 0.2f; }
        const bf16_t* q = F.W<bf16_t>(RB_Q); const bf16_t* k = F.W<bf16_t>(RB_K); const bf16_t* v = F.W<bf16_t>(RB_V); bf16_t* o = F.W<bf16_t>(RB_O);
        if (tails && ((F.bid >> 3) & 3) == 0) { const int rank = (F.bid >> 5) * 8 + (F.bid & 7);
            weights_range(F, 0, 0, rank * 384, rank * 384 + 384, F.wave, NWAVES);
            weights_range(F, 1, 0, 18432 + rank * 96, 18432 + rank * 96 + 96, F.wave, NWAVES);
            weights_range(F, 3, 0, 3072 + rank * 336, 3072 + rank * 336 + 336, F.wave, NWAVES);
            __syncthreads(); }
        { unsigned* qcnt = (unsigned*)(F.ws + WS_CTL) + 160000; volatile LAS unsigned* qslot = (volatile LAS unsigned*)(F.lds + LDS_MISC) + 8;
          const int myx = (int)(xb_xcc_id() & 7u);
          for (int s8 = 0; s8 < 8; ++s8) { const int x = (myx + s8) & 7;
            for (;;) {
                if (F.tid == 0) *qslot = __hip_atomic_fetch_add(qcnt + x * 64, 1u, __ATOMIC_RELAXED, __HIP_MEMORY_SCOPE_AGENT);
                __syncthreads();
                const int kq = (int)*qslot;
                if (kq >= 288) { __syncthreads(); break; }
                if (kq < 256) { const int bh = x + 8 * (kq >> 4), qb = kq & 15, b = bh >> 3, h = bh & 7; const size_t row0 = (size_t)b * SEQ + qb * 128;
                    at::diff_attn_unit_dma(q + (((size_t)b * 8 + h) * KVL + CTXL + qb * 128) * 128, k + ((size_t)b * 8 + h) * KVL * 128, v + ((size_t)b * 8 + h) * KVL * 128, o + row0 * D + h * 128, KVL, lam, 0.8f, F.in[I_SUBLN], (LAS char*)F.lds); }
                else { const int kk = kq - 256, bh = x + 8 * (kk >> 1), qb = kk & 1, b = bh >> 3, h = bh & 7; const size_t row0 = (size_t)NLAT + (size_t)b * CTXL + qb * 128;
                    at::diff_attn_unit_dma(q + (((size_t)b * 8 + h) * KVL + qb * 128) * 128, k + ((size_t)b * 8 + h) * KVL * 128, v + ((size_t)b * 8 + h) * KVL * 128, o + row0 * D + h * 128, CTXL, lam, 0.8f, F.in[I_SUBLN], (LAS char*)F.lds); }
            } } }
#ifdef MK_PROBE_ATT
        { bf16_t* od = F.W<bf16_t>(RA_HID);
          for (int u = F.bid; u < 2048 + 256; u += F.G) {
            if (u < 2048) { const int b = u >> 7, h = (u >> 4) & 7, qb = u & 15; const size_t row0 = (size_t)b * SEQ + qb * 128;
                at::diff_attn_unit<MK_PROBE_ATT>(q + (((size_t)b * 8 + h) * KVL + CTXL + qb * 128) * 128, k + ((size_t)b * 8 + h) * KVL * 128, v + ((size_t)b * 8 + h) * KVL * 128, od + row0 * D + h * 128, KVL, lam, 0.8f, F.in[I_SUBLN], (LAS char*)F.lds); }
            else { const int uu = u - 2048, b = uu >> 4, h = (uu >> 1) & 7, qb = uu & 1; const size_t row0 = (size_t)NLAT + (size_t)b * CTXL + qb * 128;
                at::diff_attn_unit<MK_PROBE_ATT>(q + (((size_t)b * 8 + h) * KVL + qb * 128) * 128, k + ((size_t)b * 8 + h) * KVL * 128, v + ((size_t)b * 8 + h) * KVL * 128, od + row0 * D + h * 128, CTXL, lam, 0.8f, F.in[I_SUBLN], (LAS char*)F.lds); }
          } }
#endif
    } SEAM(PH_L0_ATT);
    if (IN(PH_L0_OUT)) { REFRESH(); out_phase(F, 0, (const char*)(F.ws + RB_O), 2048, 1024, WS_WO0, 144); if (tails) moe_weights_tail(F, 1, 3072, 48, F.bid - 64); } SEAM(PH_L0_OUT);
    if (IN(PH_L0_N2)) { REFRESH(); norm2_phase(F, 0, true); } SEAM(PH_L0_N2);
    if (IN(PH_L0_TOPK)) { REFRESH(); topk_phase(F, true); } SEAM(PH_L0_TOPK);
    if (IN(PH_L0_GU)) { REFRESH(); gu_phase(F, 0, true); } SEAM(PH_L0_GU);
    if (IN(PH_L0_DOWN)) { REFRESH(); down_phase(F, 0, true); if (tails) moe_weights_tail(F, 1, 12288, 48, F.bid - 128); } SEAM(PH_L0_DOWN);

    if (IN(PH_L1_N1)) { REFRESH();
        norm1_phase<true>(F, 1, true, true);
        if (!tails) moe_weights_phase(F, 1, 0);
    } SEAM(PH_L1_N1);
    if (IN(PH_L1_GMIN)) { REFRESH();
        { gm::P_GMU p; p.hx = (const char*)(F.ws + WS_HX); p.W = (const char*)(F.ws + WS_WGIN); p.u_out = F.W<bf16_t>(RB_U); gm::gemm_phase(F.lds, p); }
        { gm::P_GMV p; p.hx = (const char*)(F.ws + WS_HX); p.W = (const char*)(F.ws + WS_WGIN); p.vT = F.W<bf16_t>(RB_VT); p.sumsq = F.W<float>(WS_SUMSQ); gm::gemm_phase(F.lds, p, F.G - 1 - F.bid); }
    } SEAM(PH_L1_GMIN);
    if (IN(PH_L1_PREP)) { REFRESH(); gm_prep_phase(F); } SEAM(PH_L1_PREP);
    if (IN(PH_L1_SPAT)) { REFRESH();
        gm::P_SPAT p; p.App = (const char*)(F.ws + RA_APP); p.vT = (const char*)(F.ws + RB_VT); p.u_io = F.W<bf16_t>(RB_U); p.v_g = F.in[I_GMVG]; p.b_s = F.in[I_GMBS]; p.zeros = (const char*)(F.ws + WS_CTL + 800 * 1024);
        gm::gemm_phase(F.lds, p);
    } SEAM(PH_L1_SPAT);
    if (IN(PH_L1_OUT)) { REFRESH(); out_phase(F, 1, (const char*)(F.ws + RB_U), 4096, 2048, WS_WGOUT, 144); if (tails) moe_weights_tail(F, 2, 0, 96, F.bid - 64); } SEAM(PH_L1_OUT);
    if (IN(PH_L1_N2)) { REFRESH(); norm2_phase(F, 1, true); } SEAM(PH_L1_N2);
    if (IN(PH_L1_TOPK)) { REFRESH(); topk_phase(F, true); } SEAM(PH_L1_TOPK);
    if (IN(PH_L1_GU)) { REFRESH(); gu_phase(F, 1, true); } SEAM(PH_L1_GU);
    if (IN(PH_L1_DOWN)) { REFRESH(); down_phase(F, 1, true); if (tails) moe_weights_tail(F, 2, 18432, 48, F.bid - 128); } SEAM(PH_L1_DOWN);

    if (IN(PH_L2_N1)) { REFRESH(); norm1_phase<true>(F, 2, true, true); if (!tails) moe_weights_phase(F, 2); } SEAM(PH_L2_N1);
    if (IN(PH_L2_QKV)) { REFRESH();
        gm::P_QKV2 p; p.A = (const char*)(F.ws + WS_HX); p.B = (const char*)(F.ws + WS_WQKV2); p.q = F.W<bf16_t>(RB_Q); p.k = F.W<bf16_t>(RB_K); p.v = F.W<bf16_t>(RB_V);
        gm::gemm_phase(F.lds, p);
        if (tails) moe_weights_tail(F, 3, 0, 48, F.bid - 192);
    } SEAM(PH_L2_QKV);
    if (IN(PH_L2_ATT)) { REFRESH();
        for (int u = F.bid; u < 2048; u += F.G) { const int b = u >> 7, h = (u >> 3) & 15, R4 = u & 7;
            at::natten_unit(F.W<bf16_t>(RB_Q), F.W<bf16_t>(RB_K), F.W<bf16_t>(RB_V), F.W<bf16_t>(RB_O), F.in[I_NARPB], b, h, R4, (LAS char*)F.lds); }
    } SEAM(PH_L2_ATT);
    if (IN(PH_L2_OUT)) { REFRESH(); out_phase(F, 2, (const char*)(F.ws + RB_O), 2048, 1024, WS_WO2, 128); } SEAM(PH_L2_OUT);
    if (IN(PH_L2_N2)) { REFRESH(); norm2_phase(F, 2, false); } SEAM(PH_L2_N2);
    if (IN(PH_L2_TOPK)) { REFRESH(); topk_phase(F, false); } SEAM(PH_L2_TOPK);
    if (IN(PH_L2_GU)) { REFRESH(); gu_phase(F, 2, false); } SEAM(PH_L2_GU);
    if (IN(PH_L2_DOWN)) { REFRESH(); down_phase(F, 2, false); } SEAM(PH_L2_DOWN);

    if (IN(PH_L3_N1)) { REFRESH();
        NormArgs A{};
        A.xsrc = F.W<float>(WS_X); A.xdst = F.W<float>(WS_X); A.csrc = F.W<float>(WS_CTX); A.cdst = F.W<float>(WS_CTX); A.do_lat = 1; A.do_ctx = 0; A.xbf = 1;
        A.gain = F.in[I_MNG] + 3 * D; A.shift = modp(F, 3, 0); A.scale = modp(F, 3, 1); A.hx = F.W<bf16_t>(WS_HX);
        A.ys = F.W<bf16_t>(RA_YS); A.tokslot = F.W<int>(WS_TOKSLOT); A.tokslotc = F.W<int>(WS_TOKSLOTC); A.g2 = modp(F, 2, 5); A.ctx_comb = 0;
        norm_fold_phase<true>(F, A);
        if (!tails) moe_weights_phase(F, 3, 0); } SEAM(PH_L3_N1);
    if (IN(PH_L3_CDFT)) { REFRESH();
        gm::P_CDFT p; p.CS = (const char*)(F.ws + WS_CS); p.hx = (const char*)(F.ws + WS_HX); p.PQt = F.W<bf16_t>(RB_PQ);
        gm::gemm_phase(F.lds, p);
    } SEAM(PH_L3_CDFT);
    if (IN(PH_L3_PDFT)) { REFRESH();
        gm::P_PDFT p; p.DP = (const char*)(F.ws + WS_DP); p.PQt = (const char*)(F.ws + RB_PQ); p.f = F.W<bf16_t>(RB_F);
        gm::gemm_phase(F.lds, p);
    } SEAM(PH_L3_PDFT);
    if (IN(PH_L3_OUT)) { REFRESH(); out_phase(F, 3, (const char*)(F.ws + RB_F), 2048, 1024, WS_WFO, 128); } SEAM(PH_L3_OUT);
    if (IN(PH_L3_N2)) { REFRESH(); norm2_phase(F, 3, false); } SEAM(PH_L3_N2);
    if (IN(PH_L3_TOPK)) { REFRESH(); topk_phase(F, false); } SEAM(PH_L3_TOPK);
    if (IN(PH_L3_GU)) { REFRESH(); gu_phase(F, 3, false); } SEAM(PH_L3_GU);
    if (IN(PH_L3_DOWN)) { REFRESH(); down_phase(F, 3, false); } SEAM(PH_L3_DOWN);

    if (IN(PH_FINAL)) { REFRESH();
        NormArgs A{};
        A.xsrc = F.W<float>(WS_X); A.do_lat = 1; A.do_ctx = 0; A.xbf = 1; A.gain = F.in[I_FINALG];
        A.ys = F.W<bf16_t>(RA_YS); A.tokslot = F.W<int>(WS_TOKSLOT); A.tokslotc = F.W<int>(WS_TOKSLOTC); A.g2 = modp(F, 3, 5); A.out = F.out;
        norm_phase<true, false, true>(F, A);
    }
#undef IN
#undef SEAM
}

extern "C" void kernel_launch(void* const* d_in, const int* in_sizes, int n_in, void* d_out, int out_size, void* d_ws, size_t ws_size, hipStream_t stream) {
    static int grid = 0;
    if (grid == 0) {
        if (n_in != 29 || in_sizes[0] != NLAT * D || out_size != NLAT * D || ws_size < WS_END) {
            fprintf(stderr, "kernel_launch: shape mismatch: n_in %d in0 %d out %d ws %zu (need >= %zu)\n", n_in, n_in > 0 ? in_sizes[0] : -1, out_size, ws_size, (size_t)WS_END); grid = -1; return; }
        int dev = 0, cus = 0, per_cu = 0;
        if (hipGetDevice(&dev) != hipSuccess || hipDeviceGetAttribute(&cus, hipDeviceAttributeMultiprocessorCount, dev) != hipSuccess) { grid = -1; return; }
        if (hipFuncSetAttribute((const void*)fwd, hipFuncAttributeMaxDynamicSharedMemorySize, LDS_BYTES) != hipSuccess) { fprintf(stderr, "kernel_launch: hipFuncSetAttribute failed\n"); grid = -1; return; }
        if (hipOccupancyMaxActiveBlocksPerMultiprocessor(&per_cu, (const void*)fwd, NTHREADS, LDS_BYTES) != hipSuccess || per_cu < 1) { fprintf(stderr, "kernel_launch: occupancy query says %d\n", per_cu); (void)hipGetLastError(); per_cu = 1; }
        grid = cus;
    }
    if (grid < 0) return;
    (void)hipMemsetAsync((char*)d_ws + WS_CTL, 0, CTL_BYTES, stream);
    Params p{};
    for (int i = 0; i < 29; ++i) p.in[i] = (const float*)d_in[i];
    p.out = (float*)d_out; p.ws = (unsigned char*)d_ws;
#ifndef MK_RANGES
#define MK_RANGES 0, NPHASES
#endif
    static const int ranges[] = { MK_RANGES };
    for (unsigned r = 0; r + 1 < sizeof(ranges) / sizeof(ranges[0]); r += 2) { p.ph_lo = ranges[r]; p.ph_hi = ranges[r + 1]; p.li = (int)(r / 2); hipLaunchKernelGGL(fwd, dim3(grid), dim3(NTHREADS), LDS_BYTES, stream, p); }
    const hipError_t le = hipPeekAtLastError();
    if (le != hipSuccess) fprintf(stderr, "kernel_launch: launch failed: %s\n", hipGetErrorName(le));
}
```

```cpp
#include <hip/hip_runtime.h>
#include <cstdio>
#include <cstdint>

#define LAS __attribute__((address_space(3)))
#define GAS __attribute__((address_space(1)))
typedef unsigned short bf16_t;
typedef short bf16x8 __attribute__((ext_vector_type(8)));
typedef short s16x4 __attribute__((ext_vector_type(4)));
typedef float f32x4 __attribute__((ext_vector_type(4)));
typedef float f32x2 __attribute__((ext_vector_type(2)));
typedef float f32x16 __attribute__((ext_vector_type(16)));
typedef unsigned u32x4 __attribute__((ext_vector_type(4)));
typedef unsigned u32x2 __attribute__((ext_vector_type(2)));

constexpr int D = 1024, NB = 16, SEQ = 2048, NLAT = NB * SEQ, CTXL = 256, NCTX = NB * CTXL, MALL = NLAT + NCTX;
constexpr int NE = 16, CAP = 256, CAPC = 32, KVL = CTXL + SEQ;
constexpr int MODW = 6 * D, MODR = 17;
constexpr float EPS = 1e-6f;
constexpr int NWAVES = 8, NTHREADS = 512;

constexpr size_t MiB = (size_t)1 << 20;
constexpr size_t WS_CTL = 0, CTL_BYTES = 1 * MiB;
constexpr size_t WS_MOD = 1 * MiB;
constexpr size_t WS_ROPE = 3 * MiB;
constexpr size_t WS_CS = 3 * MiB + 65536;
constexpr size_t WS_AFF = 4 * MiB;
constexpr size_t WS_SLOTROW = 7 * MiB;
constexpr size_t WS_SLOTAFF = 7 * MiB + 524288;
constexpr size_t WS_TOKSLOT = 8 * MiB;
constexpr size_t WS_TOKSLOTC = 10 * MiB;
constexpr size_t WS_SUMSQ = 21 * MiB;
constexpr size_t WS_DP = 12 * MiB;
constexpr size_t WS_WQKV0 = 28 * MiB, WS_WO0 = 34 * MiB, WS_WGIN = 36 * MiB, WS_WGOUT = 44 * MiB, WS_WQKV2 = 48 * MiB, WS_WO2 = 54 * MiB, WS_WFO = 56 * MiB;
constexpr size_t WS_WGU = 58 * MiB;
constexpr size_t WS_WD = 122 * MiB;
constexpr size_t WS_X = 154 * MiB;
constexpr size_t WS_CTX = 282 * MiB;
constexpr size_t WS_HX = 298 * MiB;
constexpr size_t WS_RA = 370 * MiB;
constexpr size_t WS_RB = 658 * MiB;
constexpr size_t WS_W2 = 946 * MiB;
constexpr size_t WS_END = 1042 * MiB;
constexpr size_t WGU_OF(int layer) { return layer == 3 ? WS_WGU + 32 * MiB : ((layer & 1) ? WS_W2 : WS_WGU); }
constexpr size_t WD_OF(int layer) { return layer == 3 ? WS_WD + 16 * MiB : ((layer & 1) ? WS_W2 + 64 * MiB : WS_WD); }
constexpr size_t RA_HID = WS_RA, RA_YS = WS_RA + 144 * MiB, RA_APP = WS_RA;
constexpr size_t RB_Q = WS_RB, RB_K = WS_RB + 72 * MiB, RB_V = WS_RB + 144 * MiB, RB_O = WS_RB + 216 * MiB;
constexpr size_t RB_U = WS_RB, RB_VT = WS_RB + 144 * MiB;
constexpr size_t RB_PQ = WS_RB, RB_F = WS_RB + 128 * MiB;

constexpr int LDS_RING = 131072;
constexpr int LDS_MISC = LDS_RING;
constexpr int LDS_BYTES = 147456;

#define LDS_WAIT() asm volatile("s_waitcnt lgkmcnt(0)" ::: "memory")
#define VM_WAIT() asm volatile("s_waitcnt vmcnt(0)" ::: "memory")
__device__ __forceinline__ unsigned cvt_pk_bf16(float lo, float hi) { unsigned r; asm volatile("v_cvt_pk_bf16_f32 %0, %1, %2" : "=v"(r) : "v"(lo), "v"(hi)); return r; }
__device__ __forceinline__ float bf_lo(unsigned w) { return __uint_as_float(w << 16); }
__device__ __forceinline__ float bf_hi(unsigned w) { return __uint_as_float(w & 0xffff0000u); }
__device__ __forceinline__ float wave_sum(float v) {
#pragma unroll
    for (int o = 1; o < 64; o <<= 1) v += __shfl_xor(v, o);
    return v;
}
__device__ __forceinline__ float fast_rcp(float x) { return __builtin_amdgcn_rcpf(x); }
__device__ __forceinline__ float silu_f(float x) { return x * fast_rcp(1.0f + __builtin_amdgcn_exp2f(-1.4426950408889634f * x)); }
__device__ __forceinline__ float gelu_tanh_f(float x) {
    const float y2 = 1.5957691216057308f * (x + 0.044715f * x * x * x);
    return x - x * fast_rcp(1.0f + __builtin_amdgcn_exp2f(1.4426950408889634f * y2));
}

__device__ __forceinline__ f32x4 gelu_tanh4(const f32x4 x) {
    constexpr float cp = -1.5957691216057308f * 1.4426950408889634f, ca = 0.044715f * cp;
    const f32x4 t = __builtin_elementwise_fma(x * x, (f32x4){ca, ca, ca, ca}, (f32x4){cp, cp, cp, cp}) * x; f32x4 e, r;
#pragma unroll
    for (int j = 0; j < 4; ++j) e[j] = __builtin_amdgcn_exp2f(t[j]);
    f32x2 dl = (f32x2){e[0], e[1]}, dh = (f32x2){e[2], e[3]};
#if defined(__HIP_DEVICE_COMPILE__)
    asm("v_pk_add_f32 %0, %1, 1.0 op_sel_hi:[1,0]" : "=v"(dl) : "v"(dl));
    asm("v_pk_add_f32 %0, %1, 1.0 op_sel_hi:[1,0]" : "=v"(dh) : "v"(dh));
#endif
    r[0] = __builtin_amdgcn_rcpf(dl[0]); r[1] = __builtin_amdgcn_rcpf(dl[1]); r[2] = __builtin_amdgcn_rcpf(dh[0]); r[3] = __builtin_amdgcn_rcpf(dh[1]);
    return x * r;
}

#define XB_TMO      128
#define XB_XCNT(j)  (256  + 64 * (j))
#define XB_XSUB(j)  (1280 + 64 * (j))
#define XB_XGEN(j)  (2304 + 64 * (j))
#define XB_TOP      3328
#define XB_TOPGEN   3392
#define XCD_BAR_WORDS 3456
#define XB_SPIN_CAP (1u << 18)
__device__ __forceinline__ unsigned xb_ld(unsigned* p)              { return __hip_atomic_load(p, __ATOMIC_RELAXED, __HIP_MEMORY_SCOPE_AGENT); }
__device__ __forceinline__ unsigned xb_add(unsigned* p, unsigned v) { return __hip_atomic_fetch_add(p, v, __ATOMIC_RELAXED, __HIP_MEMORY_SCOPE_AGENT); }
__device__ __forceinline__ unsigned xb_xcc_id() { return (unsigned)__builtin_amdgcn_s_getreg((3 << 11) | 20) & 0xFu; }
#define XB_SPIN(cond, bar) do { unsigned _sp = 0; while (cond) { __builtin_amdgcn_s_sleep(1); \
    if ((++_sp & 255u) == 0u) { if (xb_ld(&(bar)[XB_TMO])) break; if (_sp > XB_SPIN_CAP) { atomicAdd(&(bar)[XB_TMO], 1u); break; } } } } while (0)
struct XcdBarrier { unsigned* bar; unsigned x; volatile LAS unsigned* st; };
__device__ __forceinline__ XcdBarrier xcd_barrier_post(unsigned* bar, volatile LAS unsigned* st) {
    XcdBarrier b; b.bar = bar; b.x = xb_xcc_id(); b.st = st;
    if (threadIdx.x == 0) (void)xb_add(&bar[XB_XCNT(b.x)], 1u);
    return b;
}
__device__ __forceinline__ void xcd_barrier_complete(unsigned* bar, unsigned x, unsigned& nloc, unsigned& nx) {
    const unsigned G = gridDim.x * gridDim.y * gridDim.z;
    unsigned sum, cnt, mine, sp = 0u;
    for (;;) {
        sum = 0u; cnt = 0u; mine = 0u;
#pragma unroll
        for (unsigned j = 0; j < 16; ++j) { const unsigned c = xb_ld(&bar[XB_XCNT(j)]); sum += c; cnt += (c > 0u) ? 1u : 0u; mine = (j == x) ? c : mine; }
        if (sum == G) break;
        __builtin_amdgcn_s_sleep(1);
        if ((++sp & 255u) == 0u) { if (xb_ld(&bar[XB_TMO])) break; if (sp > XB_SPIN_CAP) { atomicAdd(&bar[XB_TMO], 1u); break; } }
    }
    nloc = mine > 0u ? mine : 1u; nx = cnt > 0u ? cnt : 1u;
}
__device__ __forceinline__ void xcd_barrier(const XcdBarrier& b) {
    asm volatile("s_waitcnt vmcnt(0)" ::: "memory");
    __syncthreads();
    if (threadIdx.x == 0) {
        unsigned* bar = b.bar;
        __builtin_amdgcn_s_waitcnt(0);
        unsigned nloc = b.st[0], nx = b.st[1];
        if (nloc == 0u) { xcd_barrier_complete(bar, b.x, nloc, nx); b.st[0] = nloc; b.st[1] = nx; }
        const unsigned old = xb_add(&bar[XB_XSUB(b.x)], 1u);
        const unsigned gen = old / nloc;
        if (old + 1u == (gen + 1u) * nloc) {
            __builtin_amdgcn_fence(__ATOMIC_RELEASE, "agent");
            asm volatile("s_waitcnt vmcnt(0)" ::: "memory");
            const unsigned og = xb_add(&bar[XB_TOP], 1u);
            const unsigned tg = og / nx;
            if (og + 1u == (tg + 1u) * nx) xb_add(&bar[XB_TOPGEN], 1u);
            else XB_SPIN(xb_ld(&bar[XB_TOPGEN]) == tg, bar);
            __builtin_amdgcn_fence(__ATOMIC_ACQUIRE, "agent");
            xb_add(&bar[XB_XGEN(b.x)], 1u);
            asm volatile("s_waitcnt vmcnt(0)" ::: "memory");
        } else {
            XB_SPIN(xb_ld(&bar[XB_XGEN(b.x)]) == gen, bar);
            __builtin_amdgcn_fence(__ATOMIC_ACQUIRE, "agent");
            asm volatile("s_waitcnt vmcnt(0)" ::: "memory");
        }
    }
    __syncthreads();
}

namespace gm {
constexpr int BM = 256, BK = 64, HALF = 128, HTB = HALF * BK * 2, STAGE_BYTES = 8 * HTB;
__device__ __forceinline__ int lds_byte(int r, int c) { const int st = (r >> 4) * 2 + (c >> 5), rr = r & 15, cc = c & 31, ob = rr * 64 + cc * 2; return st * 1024 + (ob ^ (((ob >> 9) & 1) << 5)); }
__device__ __forceinline__ void stage_rc(int b, int& R, int& C) { const int st = b / 1024, sb = b % 1024, swz = sb ^ (((sb >> 9) & 1) << 5); R = (st >> 1) * 16 + swz / 64; C = (st & 1) * 32 + (swz % 64) / 2; }
__device__ __forceinline__ int perm32(int rho) { const int n = rho >> 4, i = rho & 15; return 8 * (i >> 2) + 4 * n + (i & 3); }
struct Unit { int pm, pn, z; };
__device__ __forceinline__ int xcd_remap(int L, int nwg) { const int q = nwg / 8, r = nwg % 8, xcd = L % 8, off = L / 8; return (xcd < r ? xcd * (q + 1) : r * (q + 1) + (xcd - r) * q) + off; }
__device__ __forceinline__ void tile_of(int w, int nM, int nN, int& pm, int& pn) { const int nig = 8 * nN, gid = w / nig, fm = gid * 8, gsz = (nM - fm) < 8 ? (nM - fm) : 8; pm = fm + ((w % nig) % gsz); pn = (w % nig) / gsz; }

typedef f32x4 Acc[2][2][4][2];
#ifdef MK_F8_UNSCALED
constexpr int F8_ONE = 0;
#else
constexpr int F8_ONE = 0x7f7f7f7f;
#endif
constexpr float F8_SX = 8.0f, F8_SW = 64.0f, F8_SH = 4.0f;
__device__ __forceinline__ unsigned pk4_fp8(float a, float b, float c, float d) {
    int w = 0;
    w = __builtin_amdgcn_cvt_pk_fp8_f32(__builtin_amdgcn_fmed3f(a, -440.f, 440.f), __builtin_amdgcn_fmed3f(b, -440.f, 440.f), w, false);
    w = __builtin_amdgcn_cvt_pk_fp8_f32(__builtin_amdgcn_fmed3f(c, -440.f, 440.f), __builtin_amdgcn_fmed3f(d, -440.f, 440.f), w, true);
    return (unsigned)w;
}
typedef int i32x4_t __attribute__((ext_vector_type(4)));
typedef int i32x8_t __attribute__((ext_vector_type(8)));
__device__ __forceinline__ void mfma_f8(f32x4& c, const i32x8_t a, const i32x8_t b) {
#if !defined(__HIP_DEVICE_COMPILE__)
    (void)c; (void)a; (void)b;
#elif defined(MK_F8_UNSCALED)
    asm volatile("v_mfma_f32_16x16x128_f8f6f4 %0, %1, %2, %0" : "+v"(c) : "v"(a), "v"(b));
#else
    const int one = F8_ONE; asm volatile("v_mfma_scale_f32_16x16x128_f8f6f4 %0, %1, %2, %0, %3, %3 op_sel_hi:[0,0,0]" : "+v"(c) : "v"(a), "v"(b), "v"(one));
#endif
}
template <class P, class = void> struct is_f8 { static constexpr bool value = false; };
template <class P> struct is_f8<P, decltype((void)P::F8)> { static constexpr bool value = P::F8; };

template <class P>
__device__ __forceinline__ void gemm_phase(LAS unsigned char* lds, const P& p, int cu = -1) {
    int tid = threadIdx.x; asm volatile("" : "+v"(tid));
    const int wid = __builtin_amdgcn_readfirstlane(tid >> 6), lane = tid & 63, wr = wid >> 2, wc = wid & 3, fr = lane & 15, fq = lane >> 4;
    int K = p.K(); asm volatile("" : "+s"(K));
    const int nt = K / BK;
    const unsigned lda = p.lda(), ldb = p.ldb();
    const int G = gridDim.x, c = cu < 0 ? (int)blockIdx.x : cu, nwg = p.nunits();
    if (c >= nwg) return;
    unsigned voffA[2], voffB[2], cA2[2]; int RA[2];
#pragma unroll
    for (int i = 0; i < 2; ++i) { int R, C; stage_rc(tid * 16 + i * 8192, R, C); const int Rb = P::PERM ? ((R & ~31) + perm32(R & 31)) : R;
        RA[i] = R; cA2[i] = (unsigned)C * 2u; voffA[i] = (unsigned)R * lda + (unsigned)C * 2u; voffB[i] = (unsigned)Rb * ldb + (unsigned)C * 2u; }
    const size_t hstepA = (size_t)HALF * lda, hstepB = (size_t)HALF * ldb;
    const unsigned ldsw = (unsigned)wid * 1024u;
    const int aoff = lds_byte(wr * 64 + fr, fq * 8), boff = lds_byte(wc * 32 + fr, fq * 8);
    struct Src { const char* a; const char* b; unsigned ga[2][2]; };
    const char* araw = P::GATHER ? p.araw() : nullptr;
#define GM_GLDS(gp, lp) __builtin_amdgcn_global_load_lds((const unsigned*)(gp), (LAS unsigned*)(lp), 16, 0, 0)
#define GM_SA(b, h) (((b) * 2 + (h)) * HTB)
#define GM_SB(b, h) ((4 + (b) * 2 + (h)) * HTB)
#define GM_STAGE_B(bufoff, ptr) do { GM_GLDS((ptr) + voffB[0], lds + (bufoff) + ldsw); GM_GLDS((ptr) + voffB[1], lds + (bufoff) + ldsw + 8192); } while (0)
#define GM_STAGE_A(bufoff, S, h, koff) do { if constexpr (P::GATHER) { GM_GLDS(araw + (S).ga[h][0] + (koff), lds + (bufoff) + ldsw); GM_GLDS(araw + (S).ga[h][1] + (koff), lds + (bufoff) + ldsw + 8192); } \
        else if constexpr (P::AZERO) { const size_t ko_ = (size_t)(koff); const char* ab_ = ((ko_ >= 256) == ((h) == 1)) ? (S).a + (size_t)(h) * hstepA + (ko_ & 255) : p.zero_base(); \
            GM_GLDS(ab_ + voffA[0], lds + (bufoff) + ldsw); GM_GLDS(ab_ + voffA[1], lds + (bufoff) + ldsw + 8192); } \
        else { GM_GLDS((S).a + (size_t)(h) * hstepA + (koff) + voffA[0], lds + (bufoff) + ldsw); GM_GLDS((S).a + (size_t)(h) * hstepA + (koff) + voffA[1], lds + (bufoff) + ldsw + 8192); } } while (0)
#define GM_LDA(dst, b, h) do { _Pragma("unroll") for (int m = 0; m < 4; ++m) _Pragma("unroll") for (int k = 0; k < 2; ++k) dst[m][k] = *(const LAS bf16x8*)(lds + GM_SA(b, h) + aoff + m * 2048 + k * 1024); } while (0)
#define GM_LDB(dst, b, h) do { _Pragma("unroll") for (int n = 0; n < 2; ++n) _Pragma("unroll") for (int k = 0; k < 2; ++k) dst[n][k] = *(const LAS bf16x8*)(lds + GM_SB(b, h) + boff + n * 2048 + k * 1024); } while (0)
#define GM_CAT8(X) __builtin_shufflevector(__builtin_bit_cast(i32x4_t, X[0]), __builtin_bit_cast(i32x4_t, X[1]), 0, 1, 2, 3, 4, 5, 6, 7)
#define GM_MMA(ai, bj, At, Bt) do { __builtin_amdgcn_s_setprio(1); _Pragma("unroll") for (int m = 0; m < 4; ++m) _Pragma("unroll") for (int n = 0; n < 2; ++n) { \
        if constexpr (is_f8<P>::value) mfma_f8(acc[ai][bj][m][n], GM_CAT8(Bt[n]), GM_CAT8(At[m])); \
        else { _Pragma("unroll") for (int k = 0; k < 2; ++k) acc[ai][bj][m][n] = __builtin_amdgcn_mfma_f32_16x16x32_bf16(Bt[n][k], At[m][k], acc[ai][bj][m][n], 0, 0, 0); } } __builtin_amdgcn_s_setprio(0); } while (0)
#define GM_WAIT_V(n) asm volatile("s_waitcnt vmcnt(" #n ")" ::: "memory")
#define GM_WAIT_L(n) asm volatile("s_waitcnt lgkmcnt(" #n ")" ::: "memory")
#define GM_BAR __builtin_amdgcn_s_barrier()
#define GM_SCHED __builtin_amdgcn_sched_barrier(0)
#define GM_LOAD_SRC(S, u) do { (S).a = p.abase(u); (S).b = p.bbase(u); if constexpr (P::GATHER) { const int* _ix = p.gidx(u); _Pragma("unroll") for (int _h = 0; _h < 2; ++_h) _Pragma("unroll") for (int _i = 0; _i < 2; ++_i) \
        (S).ga[_h][_i] = (unsigned)_ix[_h * HALF + RA[_i]]; } } while (0)
#define GM_ADOPT(D, S) do { (D).a = (S).a; (D).b = (S).b; if constexpr (P::GATHER) { _Pragma("unroll") for (int _h = 0; _h < 2; ++_h) _Pragma("unroll") for (int _i = 0; _i < 2; ++_i) (D).ga[_h][_i] = (S).ga[_h][_i] * lda + cA2[_i]; } } while (0)
    Unit cur, nxt, nx2; int ui = 0;
    p.unit(xcd_remap(c, nwg), cur);
    Src cs, ns, fs;
    GM_LOAD_SRC(fs, cur); GM_ADOPT(cs, fs);
    bool has_next = ((long)G + c) < (long)nwg;
    if (has_next) { p.unit(xcd_remap(G + c, nwg), nxt); GM_LOAD_SRC(ns, nxt); } else { nxt = cur; ns = fs; }
    Acc acc;
#pragma unroll
    for (int a = 0; a < 2; ++a)
#pragma unroll
        for (int b = 0; b < 2; ++b)
#pragma unroll
            for (int m = 0; m < 4; ++m)
#pragma unroll
                for (int n = 0; n < 2; ++n) acc[a][b][m][n] = (f32x4){0.f, 0.f, 0.f, 0.f};
    bf16x8 At[4][2], B0[2][2], B1[2][2];
    GM_STAGE_B(GM_SB(0, 0), cs.b); GM_STAGE_B(GM_SB(0, 1), cs.b + hstepB); GM_STAGE_A(GM_SA(0, 0), cs, 0, 0); GM_STAGE_A(GM_SA(0, 1), cs, 1, 0);
    if (wr == 1) GM_BAR;
    GM_WAIT_V(2); GM_BAR;
    GM_STAGE_B(GM_SB(1, 0), cs.b + 128); GM_STAGE_A(GM_SA(1, 0), cs, 0, 128); GM_STAGE_B(GM_SB(1, 1), cs.b + hstepB + 128);
    GM_WAIT_V(6); GM_BAR;
    for (;;) {
#pragma clang loop unroll(disable)
        for (int t = 0; t < nt; t += 2) {
            const bool last = (t == nt - 2);
            GM_LDB(B0, 0, 0); GM_LDB(B1, 0, 1); GM_SCHED; GM_LDA(At, 0, 0); GM_STAGE_A(GM_SA(1, 1), cs, 1, (size_t)(t + 1) * 128);
            GM_WAIT_V(8); GM_WAIT_L(0); GM_BAR; GM_MMA(0, 0, At, B0); GM_MMA(0, 1, At, B1); GM_BAR; GM_SCHED;
            size_t kb;
            if (last) {
                if constexpr (P::GATHER) { asm volatile("" : "+v"(ns.ga[0][0]), "+v"(ns.ga[0][1]), "+v"(ns.ga[1][0]), "+v"(ns.ga[1][1])); }
                GM_ADOPT(cs, ns); kb = 0; } else kb = (size_t)(t + 2) * 128;
            GM_LDA(At, 0, 1); GM_STAGE_B(GM_SB(0, 0), cs.b + kb); GM_STAGE_B(GM_SB(0, 1), cs.b + hstepB + kb); GM_STAGE_A(GM_SA(0, 0), cs, 0, kb);
            GM_WAIT_V(8); GM_WAIT_L(0); GM_BAR; GM_MMA(1, 0, At, B0); GM_MMA(1, 1, At, B1); GM_BAR; GM_SCHED;
            GM_LDB(B0, 1, 0); GM_LDB(B1, 1, 1); GM_SCHED; GM_LDA(At, 1, 0); GM_STAGE_A(GM_SA(0, 1), cs, 1, kb);
            GM_WAIT_V(8); GM_WAIT_L(0); GM_BAR; GM_MMA(0, 0, At, B0); GM_MMA(0, 1, At, B1); GM_BAR; GM_SCHED;
            GM_LDA(At, 1, 1); GM_STAGE_B(GM_SB(1, 0), cs.b + kb + 128); GM_STAGE_B(GM_SB(1, 1), cs.b + hstepB + kb + 128); GM_STAGE_A(GM_SA(1, 0), cs, 0, kb + 128);
            GM_WAIT_V(8); GM_WAIT_L(0); GM_BAR; GM_MMA(1, 0, At, B0); GM_MMA(1, 1, At, B1); GM_BAR; GM_SCHED;
        }
        bool has_nx2 = false;
        if (has_next) { const long L2 = (long)(ui + 2) * G + c; has_nx2 = L2 < (long)nwg; if (has_nx2) { p.unit(xcd_remap((int)L2, nwg), nx2); GM_LOAD_SRC(ns, nx2); } }
        if constexpr (is_f8<P>::value) asm volatile("s_nop 7\n\ts_nop 7\n\ts_nop 7" ::: "memory");
        if (wr == 0) GM_BAR;
        { int t2 = threadIdx.x; asm volatile("" : "+v"(t2));
          const int w2 = __builtin_amdgcn_readfirstlane(t2 >> 6), l2 = t2 & 63; p.epi(acc, cur, w2 >> 2, w2 & 3, l2 & 15, l2 >> 4); }
        if (!has_next) break;
#pragma unroll
        for (int a = 0; a < 2; ++a)
#pragma unroll
            for (int b = 0; b < 2; ++b)
#pragma unroll
                for (int m = 0; m < 4; ++m)
#pragma unroll
                    for (int n = 0; n < 2; ++n) acc[a][b][m][n] = (f32x4){0.f, 0.f, 0.f, 0.f};
        cur = nxt; nxt = nx2; has_next = has_nx2; ++ui;
        if (wr == 1) GM_BAR;
    }
    GM_WAIT_V(0);
    GM_BAR;
#undef GM_GLDS
#undef GM_SA
#undef GM_SB
#undef GM_STAGE_A
#undef GM_STAGE_B
#undef GM_LDA
#undef GM_LDB
#undef GM_MMA
#undef GM_CAT8
#undef GM_WAIT_V
#undef GM_WAIT_L
#undef GM_BAR
#undef GM_SCHED
#undef GM_LOAD_SRC
}
}

namespace gm {
constexpr int ES = 4608;
__device__ __forceinline__ size_t kv_row0(int pm) { return pm < 128 ? (size_t)(pm >> 3) * KVL + CTXL + (size_t)(pm & 7) * 256 : (size_t)(pm - 128) * KVL; }
__device__ __forceinline__ u32x4 pack8(const f32x4 a, const f32x4 b) { u32x4 w; w.x = cvt_pk_bf16(a[0], a[1]); w.y = cvt_pk_bf16(a[2], a[3]); w.z = cvt_pk_bf16(b[0], b[1]); w.w = cvt_pk_bf16(b[2], b[3]); return w; }
#define GM_NOGATHER static constexpr bool AZERO = false; __device__ __forceinline__ const char* zero_base() const { return nullptr; } __device__ __forceinline__ const char* araw() const { return nullptr; } __device__ __forceinline__ const int* gidx(const Unit&) const { return nullptr; }
#define GM_DEV __device__ __forceinline__

struct P_QKV0 {
    static constexpr bool PERM = false, GATHER = false;
    const char* A; const char* B; bf16_t* q; bf16_t* k; bf16_t* v; const float* ropeC; const float* ropeS;
    GM_DEV int K() const { return 1024; } GM_DEV unsigned lda() const { return 2048; } GM_DEV unsigned ldb() const { return 2048; }
    GM_DEV int nunits() const { return 144 * 12; }
    GM_DEV void unit(int w, Unit& u) const { u.z = 0; tile_of(w, 144, 12, u.pm, u.pn); }
    GM_DEV const char* abase(const Unit& u) const { return A + (size_t)u.pm * 256 * 2048; }
    GM_DEV const char* bbase(const Unit& u) const { return B + (size_t)u.pn * 256 * 2048; }
    GM_NOGATHER
    GM_DEV void rope_store(Acc& acc, bf16_t* dst, const Unit& u, bool is_ctx, int wr, int wc, int fr, int fq) const {
        constexpr size_t rstride = 128, cstride = (size_t)KVL * 128;
        const int par = wc & 1;
#pragma unroll
        for (int ai = 0; ai < 2; ++ai)
#pragma unroll
            for (int m = 0; m < 4; ++m) { const int rl = ai * 128 + wr * 64 + m * 16 + fr;
                f32x4 c4 = (f32x4){1.f, 1.f, 1.f, 1.f}, s4 = (f32x4){0.f, 0.f, 0.f, 0.f};
                if (!is_ctx) { const int t = (u.pm & 7) * 256 + rl, pos = par ? (t & 63) : (t >> 6); c4 = *(const f32x4*)(ropeC + pos * 16 + 4 * fq); s4 = *(const f32x4*)(ropeS + pos * 16 + 4 * fq); }
#pragma unroll
                for (int bj = 0; bj < 2; ++bj) { const f32x4 x1 = acc[ai][bj][m][0], x2 = acc[ai][bj][m][1];
                    *(u32x4*)(dst + (size_t)rl * rstride + (size_t)bj * cstride) = pack8(x1 * c4 - x2 * s4, x1 * s4 + x2 * c4); }
                __builtin_amdgcn_sched_barrier(0); }
    }
    GM_DEV void epi(Acc& acc, const Unit& u, int wr, int wc, int fr, int fq) const {
        const int sect = u.pn >> 2, colt = (u.pn & 3) * 256; const bool is_ctx = u.pm >= 128;
        const int b = u.pm < 128 ? (u.pm >> 3) : (u.pm - 128); const size_t key0 = u.pm < 128 ? (size_t)CTXL + (size_t)(u.pm & 7) * 256 : 0;
        if (sect < 2) {
            bf16_t* d0 = q + (size_t)sect * (size_t)(k - q) + (((size_t)b * 8 + (colt >> 7)) * KVL + key0) * 128;
            rope_store(acc, d0 + wc * 32 + 8 * fq, u, is_ctx, wr, wc, fr, fq);
        } else {
            bf16_t* dst = v + (((size_t)b * 8 + (colt >> 7)) * KVL + key0) * 128 + wc * 32 + 4 * fq;
#pragma unroll
            for (int ai = 0; ai < 2; ++ai)
#pragma unroll
                for (int m = 0; m < 4; ++m) { const int rl = ai * 128 + wr * 64 + m * 16 + fr;
#pragma unroll
                    for (int bj = 0; bj < 2; ++bj)
#pragma unroll
                        for (int n = 0; n < 2; ++n) { const f32x4 x = acc[ai][bj][m][n]; u32x2 w; w.x = cvt_pk_bf16(x[0], x[1]); w.y = cvt_pk_bf16(x[2], x[3]);
                            *(u32x2*)(dst + (size_t)bj * KVL * 128 + (size_t)rl * 128 + 16 * n) = w; } }
        }
    }
};
struct P_QKV2 {
    static constexpr bool PERM = true, GATHER = false;
    const char* A; const char* B; bf16_t* q; bf16_t* k; bf16_t* v;
    GM_DEV int K() const { return 1024; } GM_DEV unsigned lda() const { return 2048; } GM_DEV unsigned ldb() const { return 2048; }
    GM_DEV int nunits() const { return 144 * 12; }
    GM_DEV void unit(int w, Unit& u) const { u.z = 0; tile_of(w, 144, 12, u.pm, u.pn); }
    GM_DEV const char* abase(const Unit& u) const { return A + (size_t)u.pm * 256 * 2048; }
    GM_DEV const char* bbase(const Unit& u) const { return B + (size_t)u.pn * 256 * 2048; }
    GM_NOGATHER
    GM_DEV void epi(Acc& acc, const Unit& u, int wr, int wc, int fr, int fq) const {
        const int sect = u.pn >> 2, colt = (u.pn & 3) * 256; const bool is_ctx = u.pm >= 128;
        if (sect == 0 && is_ctx) return;
        bf16_t* dst = sect == 0 ? q + (size_t)u.pm * 256 * 1024 : (sect == 1 ? k : v) + kv_row0(u.pm) * 1024;
#pragma unroll
        for (int ai = 0; ai < 2; ++ai)
#pragma unroll
            for (int m = 0; m < 4; ++m) { const int rl = ai * 128 + wr * 64 + m * 16 + fr;
#pragma unroll
                for (int bj = 0; bj < 2; ++bj) *(u32x4*)(dst + (size_t)rl * 1024 + colt + bj * 128 + wc * 32 + 8 * fq) = pack8(acc[ai][bj][m][0], acc[ai][bj][m][1]); }
    }
};
struct P_OUT {
    static constexpr bool PERM = true, GATHER = false;
    const char* A; const char* B; unsigned lda_; int K_, nM;
    bf16_t* xb_; bf16_t* cb_; const float* gate;
    GM_DEV int K() const { return K_; } GM_DEV unsigned lda() const { return lda_; } GM_DEV unsigned ldb() const { return (unsigned)K_ * 2u; }
    GM_DEV int nunits() const { return nM * 4; }
    GM_DEV void unit(int w, Unit& u) const { u.z = 0; tile_of(w, nM, 4, u.pm, u.pn); }
    GM_DEV const char* abase(const Unit& u) const { return A + (size_t)u.pm * 256 * lda_; }
    GM_DEV const char* bbase(const Unit& u) const { return B + (size_t)u.pn * 256 * (size_t)K_ * 2; }
    GM_NOGATHER
    GM_DEV void epi(Acc& acc, const Unit& u, int wr, int wc, int fr, int fq) const {
        const bool is_ctx = u.pm >= 128;
        const size_t t0 = is_ctx ? (size_t)(u.pm - 128) * 256 * 1024 : (size_t)u.pm * 256 * 1024;
        bf16_t* xs = (is_ctx ? cb_ : xb_) + t0;
        const int col0 = u.pn * 256 + wc * 32 + 8 * fq;
        const float* g = gate + (size_t)(is_ctx ? 16 : (u.pm >> 3)) * MODW + col0;
        f32x4 gv[2][2];
#pragma unroll
        for (int bj = 0; bj < 2; ++bj)
#pragma unroll
            for (int n = 0; n < 2; ++n) gv[bj][n] = *(const f32x4*)(g + bj * 128 + 4 * n);
        u32x4 xh[2][2];
#define PO_LOAD(slot, off_) do { _Pragma("unroll") for (int bj = 0; bj < 2; ++bj) xh[slot][bj] = *(const u32x4*)(xs + (off_) + bj * 128); } while (0)
        PO_LOAD(0, (size_t)(wr * 64 + fr) * 1024 + col0);
#pragma unroll
        for (int q = 0; q < 8; ++q) { const int ai = q >> 2, m = q & 3; const size_t off = (size_t)(ai * 128 + wr * 64 + m * 16 + fr) * 1024 + col0;
            if (q + 1 < 8) { const size_t off2 = (size_t)(((q + 1) >> 2) * 128 + wr * 64 + ((q + 1) & 3) * 16 + fr) * 1024 + col0; PO_LOAD((q + 1) & 1, off2); }
#pragma unroll
            for (int bj = 0; bj < 2; ++bj) { const u32x4 w = xh[q & 1][bj];
                const f32x4 x0 = (f32x4){bf_lo(w.x), bf_hi(w.x), bf_lo(w.y), bf_hi(w.y)}, x1 = (f32x4){bf_lo(w.z), bf_hi(w.z), bf_lo(w.w), bf_hi(w.w)};
                *(u32x4*)(xs + off + bj * 128) = pack8(x0 + gv[bj][0] * acc[ai][bj][m][0], x1 + gv[bj][1] * acc[ai][bj][m][1]); } }
#undef PO_LOAD
    }
};
struct P_GU {
    static constexpr bool PERM = true, GATHER = true, AZERO = false, F8 = true;
    GM_DEV const char* zero_base() const { return nullptr; }
    const char* hx; const char* W; unsigned char* hid; const int* slot_row; int nM;
    GM_DEV int K() const { return 512; } GM_DEV unsigned lda() const { return 1024; } GM_DEV unsigned ldb() const { return 1024; }
    GM_DEV int nunits() const { return NE * nM * 8; }
    GM_DEV void unit(int w, Unit& u) const { const int per = nM * 8; u.z = w / per; tile_of(w - u.z * per, nM, 8, u.pm, u.pn); }
    GM_DEV const char* abase(const Unit&) const { return hx; }
    GM_DEV const char* bbase(const Unit& u) const { return W + ((size_t)u.z * 2048 + (size_t)u.pn * 256) * 1024; }
    GM_DEV const char* araw() const { return hx; }
    GM_DEV const int* gidx(const Unit& u) const { return slot_row + u.z * ES + u.pm * 256; }
    GM_DEV void epi(Acc& acc, const Unit& u, int wr, int wc, int fr, int fq) const {
        unsigned char* dst = hid + ((size_t)u.z * ES + (size_t)u.pm * 256) * 1024 + u.pn * 128 + wc * 32 + 8 * fq;
        constexpr float ds = 1.0f / (F8_SX * F8_SW), c1 = -1.4426950408889634f * ds, kk = 1.0f / (F8_SH * ds * ds);
#pragma unroll
        for (int ai = 0; ai < 2; ++ai)
#pragma unroll
            for (int m = 0; m < 4; ++m) { const int rl = ai * 128 + wr * 64 + m * 16 + fr; f32x4 h[2];
#pragma unroll
                for (int n = 0; n < 2; ++n) { const f32x4 ag = acc[ai][0][m][n], au = acc[ai][1][m][n]; const f32x4 t = ag * c1; f32x4 e;
#pragma unroll
                    for (int j = 0; j < 4; ++j) e[j] = __builtin_amdgcn_exp2f(t[j]);
                    const f32x4 d = __builtin_elementwise_fma(e, (f32x4){kk, kk, kk, kk}, (f32x4){kk, kk, kk, kk}); f32x4 r;
#pragma unroll
                    for (int j = 0; j < 4; ++j) r[j] = __builtin_amdgcn_rcpf(d[j]);
                    h[n] = (ag * au) * r; }
                u32x2 w; w.x = pk4_fp8(h[0][0], h[0][1], h[0][2], h[0][3]); w.y = pk4_fp8(h[1][0], h[1][1], h[1][2], h[1][3]);
                *(u32x2*)(dst + (size_t)rl * 1024) = w; }
    }
};
struct P_DOWN {
    static constexpr bool PERM = true, GATHER = false, F8 = true;
    const char* hid; const char* W; bf16_t* ys; const float* slot_aff; int nM;
    GM_DEV int K() const { return 512; } GM_DEV unsigned lda() const { return 1024; } GM_DEV unsigned ldb() const { return 1024; }
    GM_DEV int nunits() const { return NE * nM * 4; }
    GM_DEV void unit(int w, Unit& u) const { const int per = nM * 4; u.z = w / per; tile_of(w - u.z * per, nM, 4, u.pm, u.pn); }
    GM_DEV const char* abase(const Unit& u) const { return hid + ((size_t)u.z * ES + (size_t)u.pm * 256) * 1024; }
    GM_DEV const char* bbase(const Unit& u) const { return W + ((size_t)u.z * 1024 + (size_t)u.pn * 256) * 1024; }
    GM_NOGATHER
    GM_DEV void epi(Acc& acc, const Unit& u, int wr, int wc, int fr, int fq) const {
        const size_t r0 = (size_t)u.z * ES + (size_t)u.pm * 256;
        unsigned char* dst8 = (unsigned char*)ys + r0 * 1024 + u.pn * 256 + wc * 32 + 8 * fq;
        float af[2][4];
#pragma unroll
        for (int ai = 0; ai < 2; ++ai)
#pragma unroll
            for (int m = 0; m < 4; ++m) af[ai][m] = slot_aff[r0 + ai * 128 + wr * 64 + m * 16 + fr];
#pragma unroll
        for (int ai = 0; ai < 2; ++ai)
#pragma unroll
            for (int m = 0; m < 4; ++m) { const int rl = ai * 128 + wr * 64 + m * 16 + fr; const float a = af[ai][m];
#pragma unroll
                for (int bj = 0; bj < 2; ++bj) { const f32x4 y0 = acc[ai][bj][m][0] * (a * (32.0f / (F8_SH * F8_SW))), y1 = acc[ai][bj][m][1] * (a * (32.0f / (F8_SH * F8_SW)));
                    int w0 = 0, w1 = 0;
                    w0 = __builtin_amdgcn_cvt_pk_fp8_f32(__builtin_amdgcn_fmed3f(y0[0], -440.f, 440.f), __builtin_amdgcn_fmed3f(y0[1], -440.f, 440.f), w0, false);
                    w0 = __builtin_amdgcn_cvt_pk_fp8_f32(__builtin_amdgcn_fmed3f(y0[2], -440.f, 440.f), __builtin_amdgcn_fmed3f(y0[3], -440.f, 440.f), w0, true);
                    w1 = __builtin_amdgcn_cvt_pk_fp8_f32(__builtin_amdgcn_fmed3f(y1[0], -440.f, 440.f), __builtin_amdgcn_fmed3f(y1[1], -440.f, 440.f), w1, false);
                    w1 = __builtin_amdgcn_cvt_pk_fp8_f32(__builtin_amdgcn_fmed3f(y1[2], -440.f, 440.f), __builtin_amdgcn_fmed3f(y1[3], -440.f, 440.f), w1, true);
                    u32x2 w; w.x = (unsigned)w0; w.y = (unsigned)w1; *(u32x2*)(dst8 + (size_t)rl * 1024 + bj * 128) = w; } }
    }
};
struct P_GMU {
    static constexpr bool PERM = true, GATHER = false;
    const char* hx; const char* W; bf16_t* u_out;
    GM_DEV int K() const { return 1024; } GM_DEV unsigned lda() const { return 2048; } GM_DEV unsigned ldb() const { return 2048; }
    GM_DEV int nunits() const { return 1152; }
    GM_DEV void unit(int w, Unit& u) const { u.z = 0; tile_of(w, 144, 8, u.pm, u.pn); }
    GM_DEV const char* abase(const Unit& u) const { return hx + (size_t)u.pm * 256 * 2048; }
    GM_DEV const char* bbase(const Unit& u) const { return W + (size_t)u.pn * 256 * 2048; }
    GM_NOGATHER
    GM_DEV void epi(Acc& acc, const Unit& u, int wr, int wc, int fr, int fq) const {
        bf16_t* dst = u_out + (size_t)u.pm * 256 * 2048 + u.pn * 256 + wc * 32 + 8 * fq;
#pragma unroll
        for (int ai = 0; ai < 2; ++ai)
#pragma unroll
            for (int m = 0; m < 4; ++m) { const int rl = ai * 128 + wr * 64 + m * 16 + fr;
#pragma unroll
                for (int bj = 0; bj < 2; ++bj) { const f32x4 g0 = gelu_tanh4(acc[ai][bj][m][0]), g1 = gelu_tanh4(acc[ai][bj][m][1]);
                    *(u32x4*)(dst + (size_t)rl * 2048 + bj * 128) = pack8(g0, g1); }
                __builtin_amdgcn_sched_barrier(0); }
    }
};
struct P_GMV {
    static constexpr bool PERM = true, GATHER = false;
    const char* hx; const char* W; bf16_t* vT; float* sumsq;
    GM_DEV int K() const { return 1024; } GM_DEV unsigned lda() const { return 2048; } GM_DEV unsigned ldb() const { return 2048; }
    GM_DEV int nunits() const { return 1152; }
    GM_DEV void unit(int w, Unit& u) const { u.z = 0; tile_of(w, 8, 144, u.pm, u.pn); }
    GM_DEV const char* abase(const Unit& u) const { return W + (size_t)(2048 + u.pm * 256) * 2048; }
    GM_DEV const char* bbase(const Unit& u) const { return hx + (size_t)u.pn * 256 * 2048; }
    GM_NOGATHER
    GM_DEV void epi(Acc& acc, const Unit& u, int wr, int wc, int fr, int fq) const {
        const bool is_ctx = u.pn >= 128; const int b = is_ctx ? u.pn - 128 : (u.pn >> 3);
        const int tok0 = is_ctx ? 0 : CTXL + (u.pn & 7) * 256, grow0 = is_ctx ? NLAT + b * CTXL : b * SEQ + (u.pn & 7) * 256;
        bf16_t* dst = vT + ((size_t)b * 2048 + (size_t)u.pm * 256) * KVL + tok0 + wc * 32 + 8 * fq;
#pragma unroll
        for (int bj = 0; bj < 2; ++bj) {
            f32x4 s0 = (f32x4){0.f, 0.f, 0.f, 0.f}, s1 = (f32x4){0.f, 0.f, 0.f, 0.f};
#pragma unroll
            for (int ai = 0; ai < 2; ++ai)
#pragma unroll
                for (int m = 0; m < 4; ++m) { const int rl = ai * 128 + wr * 64 + m * 16 + fr; const f32x4 g0 = gelu_tanh4(acc[ai][bj][m][0]), g1 = gelu_tanh4(acc[ai][bj][m][1]);
                    *(u32x4*)(dst + (size_t)rl * KVL + bj * 128) = pack8(g0, g1); s0 += g0 * g0; s1 += g1 * g1;
                    __builtin_amdgcn_sched_barrier(0); }
#pragma unroll
            for (int j = 0; j < 4; ++j) { float a = s0[j], c = s1[j];
                a += __shfl_xor(a, 1); a += __shfl_xor(a, 2); a += __shfl_xor(a, 4); a += __shfl_xor(a, 8);
                c += __shfl_xor(c, 1); c += __shfl_xor(c, 2); c += __shfl_xor(c, 4); c += __shfl_xor(c, 8);
                if (fr == 0) { float* pp = sumsq + (size_t)(grow0 + bj * 128 + wc * 32 + 8 * fq + j) * 16 + u.pm * 2 + wr; pp[0] = a; pp[64] = c; } }
        }
    }
};
struct P_SPAT {
    static constexpr bool PERM = true, GATHER = false, AZERO = true;
    const char* App; const char* vT; bf16_t* u_io; const float* v_g; const float* b_s; const char* zeros;
    GM_DEV const char* zero_base() const { return zeros; } GM_DEV const char* araw() const { return nullptr; } GM_DEV const int* gidx(const Unit&) const { return nullptr; }
    GM_DEV int K() const { return 256; } GM_DEV unsigned lda() const { return 256; } GM_DEV unsigned ldb() const { return KVL * 2; }
    GM_DEV int nunits() const { return NB * 9 * 8; }
    GM_DEV void unit(int w, Unit& u) const { u.z = w; u.pm = 0; u.pn = 0; }
    GM_DEV const char* abase(const Unit& u) const { return App + (size_t)u.z * 65536; }
    GM_DEV const char* bbase(const Unit& u) const { const int g = u.z & 7, bc = u.z >> 3, b = bc / 9, cp = bc - b * 9; return vT + (((size_t)b * 2048 + (size_t)g * 256) * KVL + (size_t)cp * 256) * 2; }
    GM_DEV void epi(Acc& acc, const Unit& u, int wr, int wc, int fr, int fq) const {
        const int g = u.z & 7, bc = u.z >> 3, b = bc / 9, cp = bc - b * 9;
        const size_t trow0 = cp == 0 ? (size_t)NLAT + (size_t)b * CTXL : (size_t)b * SEQ + (size_t)(cp - 1) * 256;
        const int ch0 = g * 256 + wc * 32 + 8 * fq;
        f32x4 vg[2][2];
#pragma unroll
        for (int bj = 0; bj < 2; ++bj)
#pragma unroll
            for (int n = 0; n < 2; ++n) vg[bj][n] = *(const f32x4*)(v_g + ch0 + bj * 128 + 4 * n);
        float bsv[8];
#pragma unroll
        for (int q = 0; q < 8; ++q) bsv[q] = b_s[g * 128 + (((q >> 2) * 128 + wr * 64 + (q & 3) * 16 + fr) & 127)];
        u32x4 ub[2][2];
#pragma unroll
        for (int bj = 0; bj < 2; ++bj) ub[0][bj] = *(const u32x4*)(u_io + (trow0 + wr * 64 + fr) * 2048 + ch0 + bj * 128);
#pragma unroll
        for (int q = 0; q < 8; ++q) { const int ai = q >> 2, m = q & 3, rl = ai * 128 + wr * 64 + m * 16 + fr; const float bs = bsv[q];
            bf16_t* up = u_io + (trow0 + rl) * 2048 + ch0;
            if (q + 1 < 8) { const int rl2 = ((q + 1) >> 2) * 128 + wr * 64 + ((q + 1) & 3) * 16 + fr;
#pragma unroll
                for (int bj = 0; bj < 2; ++bj) ub[(q + 1) & 1][bj] = *(const u32x4*)(u_io + (trow0 + rl2) * 2048 + ch0 + bj * 128); }
#pragma unroll
            for (int bj = 0; bj < 2; ++bj) { const u32x4 uw = ub[q & 1][bj];
                const f32x4 u0 = (f32x4){bf_lo(uw.x), bf_hi(uw.x), bf_lo(uw.y), bf_hi(uw.y)}, u1 = (f32x4){bf_lo(uw.z), bf_hi(uw.z), bf_lo(uw.w), bf_hi(uw.w)};
                *(u32x4*)(up + bj * 128) = pack8(u0 * (acc[ai][bj][m][0] * vg[bj][0] + bs), u1 * (acc[ai][bj][m][1] * vg[bj][1] + bs)); } }
    }
};
constexpr int PQ_LD = 2176;
struct P_CDFT {
    static constexpr bool PERM = true, GATHER = false;
    const char* CS; const char* hx; bf16_t* PQt;
    GM_DEV int K() const { return 256; } GM_DEV unsigned lda() const { return 512; } GM_DEV unsigned ldb() const { return 2048; }
    GM_DEV int nunits() const { return 4 * NB * 9; }
    GM_DEV void unit(int w, Unit& u) const { u.z = w / (NB * 9); const int r = w - u.z * (NB * 9); u.pn = r; const int tt = r % 9; u.pm = (tt >= 4 && tt < 8) ? 1 : 0; }
    GM_DEV const char* abase(const Unit& u) const { return CS + (size_t)u.pm * 256 * 512; }
    GM_DEV const char* bbase(const Unit& u) const { return hx + (size_t)u.pn * 256 * 2048 + (size_t)u.z * 512; }
    GM_NOGATHER
    GM_DEV void epi(Acc& acc, const Unit& u, int wr, int wc, int fr, int fq) const {
        const int b = u.pn / 9, tt = u.pn - b * 9;
        bf16_t* dst = PQt + ((size_t)b * 1024 + (size_t)u.z * 256) * PQ_LD + tt * 256 + wc * 32 + 8 * fq;
#pragma unroll
        for (int ai = 0; ai < 2; ++ai)
#pragma unroll
            for (int m = 0; m < 4; ++m) { const int rl = ai * 128 + wr * 64 + m * 16 + fr;
#pragma unroll
                for (int bj = 0; bj < 2; ++bj) { if (tt == 8 && bj == 1) continue;
                    *(u32x4*)(dst + (size_t)rl * PQ_LD + bj * 128) = pack8(acc[ai][bj][m][0] * 0.0625f, acc[ai][bj][m][1] * 0.0625f); } }
    }
};
struct P_PDFT {
    static constexpr bool PERM = true, GATHER = false;
    const char* DP; const char* PQt; bf16_t* f;
    GM_DEV int K() const { return PQ_LD; } GM_DEV unsigned lda() const { return PQ_LD * 2; } GM_DEV unsigned ldb() const { return PQ_LD * 2; }
    GM_DEV int nunits() const { return 512; }
    GM_DEV void unit(int w, Unit& u) const { u.z = w >> 5; tile_of(w & 31, 8, 4, u.pm, u.pn); }
    GM_DEV const char* abase(const Unit& u) const { return DP + (size_t)u.pm * 256 * (PQ_LD * 2); }
    GM_DEV const char* bbase(const Unit& u) const { return PQt + ((size_t)u.z * 1024 + (size_t)u.pn * 256) * (PQ_LD * 2); }
    GM_NOGATHER
    GM_DEV void epi(Acc& acc, const Unit& u, int wr, int wc, int fr, int fq) const {
        bf16_t* dst = f + ((size_t)u.z * 2048 + (size_t)u.pm * 256) * 1024 + u.pn * 256 + wc * 32 + 8 * fq; const float sc = 0.022097086912079608f;
#pragma unroll
        for (int ai = 0; ai < 2; ++ai)
#pragma unroll
            for (int m = 0; m < 4; ++m) { const int rl = ai * 128 + wr * 64 + m * 16 + fr;
#pragma unroll
                for (int bj = 0; bj < 2; ++bj) *(u32x4*)(dst + (size_t)rl * 1024 + bj * 128) = pack8(acc[ai][bj][m][0] * sc, acc[ai][bj][m][1] * sc); }
    }
};
}

namespace at {
constexpr float SCALE = 0.125f;
constexpr float THR = 8.f;
#define AT_SBAR() __builtin_amdgcn_sched_barrier(0)
#define AT_KSWZ(row, colB) ((row) * 256 + ((colB) ^ (((row) & 7) << 4)))
#define AT_KSWZ64(row, colB) ((row) * 128 + ((colB) ^ ((((row) >> 1) & 7) << 4)))
__device__ __forceinline__ int crow(int r, int hi) { return (r & 3) + 8 * (r >> 2) + 4 * hi; }
__device__ __forceinline__ void partialSM(f32x16& p0, f32x16& p1, float& m_reg, float& mn, float& alpha) {
    constexpr float C = SCALE * 1.4426950408889634f;
    float pmax = p0[0];
#pragma unroll
    for (int r = 1; r < 16; ++r) pmax = fmaxf(pmax, p0[r]);
#pragma unroll
    for (int r = 0; r < 16; ++r) pmax = fmaxf(pmax, p1[r]);
    { auto rr = __builtin_amdgcn_permlane32_swap(__float_as_uint(pmax), __float_as_uint(pmax), false, false);
      pmax = fmaxf(__uint_as_float(rr[0]), __uint_as_float(rr[1])); }
    if (__builtin_expect(__all(pmax - m_reg <= THR / SCALE), 1)) { mn = m_reg; alpha = 1.f; }
    else { mn = fmaxf(m_reg, pmax); alpha = __builtin_amdgcn_exp2f((m_reg - mn) * C); m_reg = mn; }
    const float mnC = -mn * C;
#pragma unroll
    for (int r = 0; r < 16; ++r) p0[r] = fmaf(p0[r], C, mnC);
#pragma unroll
    for (int r = 0; r < 16; ++r) p1[r] = fmaf(p1[r], C, mnC);
#pragma unroll
    for (int r = 0; r < 16; ++r) p0[r] = __builtin_amdgcn_exp2f(p0[r]);
}
#define AT_PK4(P, BASE, OUT) do { unsigned a0 = cvt_pk_bf16(P[BASE + 0], P[BASE + 1]), a1 = cvt_pk_bf16(P[BASE + 2], P[BASE + 3]);   \
    unsigned b0 = cvt_pk_bf16(P[BASE + 4], P[BASE + 5]), b1 = cvt_pk_bf16(P[BASE + 6], P[BASE + 7]);                              \
    auto r0 = __builtin_amdgcn_permlane32_swap(a0, b0, false, false); auto r1 = __builtin_amdgcn_permlane32_swap(a1, b1, false, false); \
    u32x4 w = {r0[0], r1[0], r0[1], r1[1]}; OUT = *reinterpret_cast<bf16x8*>(&w); } while (0)
__device__ __forceinline__ void finishSM(f32x16& p0, f32x16& p1, float alpha, float& l_reg, bf16x8& pa0, bf16x8& pa1, bf16x8& pa2, bf16x8& pa3) {
#pragma unroll
    for (int r = 0; r < 16; ++r) p1[r] = __builtin_amdgcn_exp2f(p1[r]);
    float ps = 0;
#pragma unroll
    for (int r = 0; r < 16; ++r) ps += p0[r];
#pragma unroll
    for (int r = 0; r < 16; ++r) ps += p1[r];
    { auto rr = __builtin_amdgcn_permlane32_swap(__float_as_uint(ps), __float_as_uint(ps), false, false);
      ps = __uint_as_float(rr[0]) + __uint_as_float(rr[1]); }
    l_reg = l_reg * alpha + ps;
    AT_PK4(p0, 0, pa0); AT_PK4(p0, 8, pa1); AT_PK4(p1, 0, pa2); AT_PK4(p1, 8, pa3);
}
__device__ __forceinline__ void qkt64(f32x16& p0, f32x16& p1, const LAS char* Ks, const bf16x8* qr, int r32, int hi, int cb0) {
    p0 = f32x16{}; p1 = f32x16{};
    bf16x8 k0[4], k1[4];
#pragma unroll
    for (int d0 = 0; d0 < 4; ++d0) { const int cb = cb0 + (d0 * 16 + hi * 8) * 2;
        k0[d0] = *reinterpret_cast<const LAS bf16x8*>(Ks + AT_KSWZ(r32, cb)); k1[d0] = *reinterpret_cast<const LAS bf16x8*>(Ks + AT_KSWZ(32 + r32, cb)); }
    __builtin_amdgcn_sched_barrier(0);
#pragma unroll
    for (int d0 = 0; d0 < 4; ++d0) { p0 = __builtin_amdgcn_mfma_f32_32x32x16_bf16(k0[d0], qr[d0], p0, 0, 0, 0); p1 = __builtin_amdgcn_mfma_f32_32x32x16_bf16(k1[d0], qr[d0], p1, 0, 0, 0); }
}
template <int NCB> __device__ __forceinline__ int v_st(int k, int c) { const int kk = (k & ~0xC) | ((k & 4) << 1) | ((k & 8) >> 1); return ((kk >> 3) * NCB + (c >> 5)) * 512 + ((kk & 7) * 32 + (c & 31)) * 2; }
__device__ __forceinline__ int v_rd_base(int lane) { return ((lane & 3) << 3) | (((lane >> 2) & 3) << 6) | (((lane >> 4) & 1) << 5) | (((lane >> 5) & 1) << 8); }
template <int NCB> constexpr int v_rd_off(int d0, int ks, int half) { return d0 * 512 + ks * (NCB * 1024) + half * (NCB * 512); }
template <int OFF> __device__ __forceinline__ s16x4 tr_read(int vb) {
    return __builtin_amdgcn_ds_read_tr16_b64_v4i16((LAS s16x4*)(uintptr_t)(unsigned)(vb + OFF));
}
template <int NCB, int D0> __device__ __forceinline__ void pv_one(f32x16& od, int vb, bf16x8 pa0, bf16x8 pa1, bf16x8 pa2, bf16x8 pa3) {
    const s16x4 l0 = tr_read<v_rd_off<NCB>(D0, 0, 0)>(vb), h0 = tr_read<v_rd_off<NCB>(D0, 0, 1)>(vb), l1 = tr_read<v_rd_off<NCB>(D0, 1, 0)>(vb), h1 = tr_read<v_rd_off<NCB>(D0, 1, 1)>(vb);
    const s16x4 l2 = tr_read<v_rd_off<NCB>(D0, 2, 0)>(vb), h2 = tr_read<v_rd_off<NCB>(D0, 2, 1)>(vb), l3 = tr_read<v_rd_off<NCB>(D0, 3, 0)>(vb), h3 = tr_read<v_rd_off<NCB>(D0, 3, 1)>(vb);
#define AT_PK(L, H) (bf16x8){L[0], L[1], L[2], L[3], H[0], H[1], H[2], H[3]}
    od = __builtin_amdgcn_mfma_f32_32x32x16_bf16(pa0, AT_PK(l0, h0), od, 0, 0, 0);
    od = __builtin_amdgcn_mfma_f32_32x32x16_bf16(pa1, AT_PK(l1, h1), od, 0, 0, 0);
    od = __builtin_amdgcn_mfma_f32_32x32x16_bf16(pa2, AT_PK(l2, h2), od, 0, 0, 0);
    od = __builtin_amdgcn_mfma_f32_32x32x16_bf16(pa3, AT_PK(l3, h3), od, 0, 0, 0);
#undef AT_PK
}

template <int NCB, int D0>
__device__ __forceinline__ void pv_pair(f32x16& o0, f32x16& o1, int vb, bf16x8 pa0, bf16x8 pa1, bf16x8 pa2, bf16x8 pa3) {
    s16x4 l[2][4], h[2][4];
    l[0][0] = tr_read<v_rd_off<NCB>(D0, 0, 0)>(vb); h[0][0] = tr_read<v_rd_off<NCB>(D0, 0, 1)>(vb); l[0][1] = tr_read<v_rd_off<NCB>(D0, 1, 0)>(vb); h[0][1] = tr_read<v_rd_off<NCB>(D0, 1, 1)>(vb);
    l[0][2] = tr_read<v_rd_off<NCB>(D0, 2, 0)>(vb); h[0][2] = tr_read<v_rd_off<NCB>(D0, 2, 1)>(vb); l[0][3] = tr_read<v_rd_off<NCB>(D0, 3, 0)>(vb); h[0][3] = tr_read<v_rd_off<NCB>(D0, 3, 1)>(vb);
    l[1][0] = tr_read<v_rd_off<NCB>(D0 + 1, 0, 0)>(vb); h[1][0] = tr_read<v_rd_off<NCB>(D0 + 1, 0, 1)>(vb); l[1][1] = tr_read<v_rd_off<NCB>(D0 + 1, 1, 0)>(vb); h[1][1] = tr_read<v_rd_off<NCB>(D0 + 1, 1, 1)>(vb);
    l[1][2] = tr_read<v_rd_off<NCB>(D0 + 1, 2, 0)>(vb); h[1][2] = tr_read<v_rd_off<NCB>(D0 + 1, 2, 1)>(vb); l[1][3] = tr_read<v_rd_off<NCB>(D0 + 1, 3, 0)>(vb); h[1][3] = tr_read<v_rd_off<NCB>(D0 + 1, 3, 1)>(vb);
    __builtin_amdgcn_sched_barrier(0);
#define AT_PK(L, H) (bf16x8){L[0], L[1], L[2], L[3], H[0], H[1], H[2], H[3]}
    o0 = __builtin_amdgcn_mfma_f32_32x32x16_bf16(pa0, AT_PK(l[0][0], h[0][0]), o0, 0, 0, 0); o1 = __builtin_amdgcn_mfma_f32_32x32x16_bf16(pa0, AT_PK(l[1][0], h[1][0]), o1, 0, 0, 0);
    o0 = __builtin_amdgcn_mfma_f32_32x32x16_bf16(pa1, AT_PK(l[0][1], h[0][1]), o0, 0, 0, 0); o1 = __builtin_amdgcn_mfma_f32_32x32x16_bf16(pa1, AT_PK(l[1][1], h[1][1]), o1, 0, 0, 0);
    o0 = __builtin_amdgcn_mfma_f32_32x32x16_bf16(pa2, AT_PK(l[0][2], h[0][2]), o0, 0, 0, 0); o1 = __builtin_amdgcn_mfma_f32_32x32x16_bf16(pa2, AT_PK(l[1][2], h[1][2]), o1, 0, 0, 0);
    o0 = __builtin_amdgcn_mfma_f32_32x32x16_bf16(pa3, AT_PK(l[0][3], h[0][3]), o0, 0, 0, 0); o1 = __builtin_amdgcn_mfma_f32_32x32x16_bf16(pa3, AT_PK(l[1][3], h[1][3]), o1, 0, 0, 0);
#undef AT_PK
    __builtin_amdgcn_sched_barrier(0);
}
__device__ __forceinline__ void pv_batch2(f32x16& o0, f32x16& o1, int vb, bf16x8 pa0, bf16x8 pa1, bf16x8 pa2, bf16x8 pa3) { pv_pair<2, 0>(o0, o1, vb, pa0, pa1, pa2, pa3); }

constexpr int DA_LDS_V = 0, DA_LDS_K = 32768, DA_LDS_WS = 69632, DA_XPITCH = 132;
template <int VARIANT = 0>
__device__ __forceinline__ void diff_attn_unit(const bf16_t* __restrict__ Qb, const bf16_t* __restrict__ Kh, const bf16_t* __restrict__ Vh, bf16_t* __restrict__ Ob,
                                               int seq, float lam, float oscale, const float* __restrict__ subg, LAS char* lds) {
    constexpr int LDK = 128, SHM_V = 16384, SHM_K = 16384, KVBLK = 64;
    constexpr float C = SCALE * 1.4426950408889634f;
    int tid = threadIdx.x; asm volatile("" : "+v"(tid));
    const int wid = __builtin_amdgcn_readfirstlane(tid >> 6), lane = tid & 63, r32 = lane & 31, hi = lane >> 5, jh = wid >> 2, wq = wid & 3;
    LAS char* V_lds = lds + DA_LDS_V; LAS char* K_lds = lds + DA_LDS_K;
    LAS float* ws = (LAS float*)(lds + DA_LDS_WS) + wid * 64; LAS float* li_l = ws; LAS float* al_l = ws + 32;
    float m_reg = -1e30f, l_reg = 0.f, alpha = 1.f; f32x16 o[4] = {}; bf16x8 qr[4];
    const bf16_t* Qw = Qb + (size_t)(wq * 32 + r32) * 128 + jh * 64 + hi * 8;
#pragma unroll
    for (int d0 = 0; d0 < 4; ++d0) qr[d0] = *reinterpret_cast<const bf16x8*>(Qw + d0 * 16);
    const int cb0 = jh * 128;
    const int sr = tid >> 4, sc = (tid & 15) * 8, vst0 = v_st<4>(sr, sc), vst1 = v_st<4>(32 + sr, sc), kst0 = AT_KSWZ(sr, sc * 2), kst1 = AT_KSWZ(32 + sr, sc * 2);
    const int vb0 = (int)(uintptr_t)V_lds + v_rd_base(lane);
    const int NT = seq / KVBLK;
    bf16x8 ek0[2], ek1[2], ev0[2], ev1[2];
#define DA_ELOAD(s, ev) do { const int kt_ = (ev) + 1; \
        if (kt_ < NT) { ek0[s] = *reinterpret_cast<const bf16x8*>(&Kh[(size_t)(kt_ * KVBLK + sr) * LDK + sc]); ek1[s] = *reinterpret_cast<const bf16x8*>(&Kh[(size_t)(kt_ * KVBLK + 32 + sr) * LDK + sc]); } \
        ev0[s] = *reinterpret_cast<const bf16x8*>(&Vh[(size_t)((ev) * KVBLK + sr) * LDK + sc]); ev1[s] = *reinterpret_cast<const bf16x8*>(&Vh[(size_t)((ev) * KVBLK + 32 + sr) * LDK + sc]); } while (0)
#define DA_EWRITE(s, ev) do { const int kt_ = (ev) + 1; \
        if (kt_ < NT) { *(LAS bf16x8*)(K_lds + (kt_ & 1) * SHM_K + kst0) = ek0[s]; *(LAS bf16x8*)(K_lds + (kt_ & 1) * SHM_K + kst1) = ek1[s]; } \
        *(LAS bf16x8*)(V_lds + ((ev) & 1) * SHM_V + vst0) = ev0[s]; *(LAS bf16x8*)(V_lds + ((ev) & 1) * SHM_V + vst1) = ev1[s]; } while (0)
#define DA_CONSUME(s) asm volatile("" :: "v"(ek0[s]), "v"(ek1[s]), "v"(ev0[s]), "v"(ev1[s]))
#define DA_STAGE(i) do { if ((i) & 1) { if (VARIANT == 4) DA_CONSUME(1); else DA_EWRITE(1, i); if ((i) + 2 < NT) DA_ELOAD(1, (i) + 2); } else { if (VARIANT == 4) DA_CONSUME(0); else DA_EWRITE(0, i); if ((i) + 2 < NT) DA_ELOAD(0, (i) + 2); } } while (0)
#define DA_RESC(a) do { if (__any((a) < 1.f)) { if (hi == 0) al_l[r32] = (a); asm volatile("s_waitcnt lgkmcnt(0)" ::: "memory"); \
    _Pragma("unroll") for (int d = 0; d < 4; ++d) _Pragma("unroll") for (int r = 0; r < 16; ++r) o[d][r] *= al_l[crow(r, hi)]; } } while (0)
#define DA_PV(vb) do { pv_pair<4, 0>(o[0], o[1], vb, pa0, pa1, pa2, pa3); pv_pair<4, 2>(o[2], o[3], vb, pa0, pa1, pa2, pa3); } while (0)
    f32x16 p0, p1; bf16x8 pa0, pa1, pa2, pa3;
    { const bf16x8 a0 = *reinterpret_cast<const bf16x8*>(&Kh[(size_t)sr * LDK + sc]), a1 = *reinterpret_cast<const bf16x8*>(&Kh[(size_t)(32 + sr) * LDK + sc]);
      *(LAS bf16x8*)(K_lds + kst0) = a0; *(LAS bf16x8*)(K_lds + kst1) = a1; }
    DA_ELOAD(0, 0); if (1 < NT) DA_ELOAD(1, 1);
    __syncthreads();
    if (jh == 1) __syncthreads();
    for (int i = 0; i < NT; ++i) {
        if (VARIANT != 1) { if (jh == 1) DA_STAGE(i); }
        if (i > 0 && VARIANT != 3) { DA_RESC(alpha); const int vb = vb0 + ((i - 1) & 1) * SHM_V; DA_PV(vb); }
        qkt64(p0, p1, K_lds + (i & 1) * SHM_K, qr, r32, hi, cb0);
        __syncthreads();
        if (VARIANT != 1) { if (jh == 0) DA_STAGE(i); }
        { float pmax = p0[0];
#pragma unroll
          for (int r = 1; r < 16; ++r) pmax = fmaxf(pmax, p0[r]);
#pragma unroll
          for (int r = 0; r < 16; ++r) pmax = fmaxf(pmax, p1[r]);
          { auto rr = __builtin_amdgcn_permlane32_swap(__float_as_uint(pmax), __float_as_uint(pmax), false, false); pmax = fmaxf(__uint_as_float(rr[0]), __uint_as_float(rr[1])); }
          float mn;
          if (__builtin_expect(__all(pmax - m_reg <= THR / SCALE), 1)) { mn = m_reg; alpha = 1.f; }
          else { mn = fmaxf(m_reg, pmax); alpha = __builtin_amdgcn_exp2f((m_reg - mn) * C); m_reg = mn; }
          const float mnC = -mn * C; float ps = 0.f;
#pragma unroll
          for (int r = 0; r < 16; ++r) { if (VARIANT == 2) { p0[r] = fmaf(p0[r], C, mnC); p1[r] = fmaf(p1[r], C, mnC); } else { p0[r] = __builtin_amdgcn_exp2f(fmaf(p0[r], C, mnC)); p1[r] = __builtin_amdgcn_exp2f(fmaf(p1[r], C, mnC)); } }
#pragma unroll
          for (int r = 0; r < 16; ++r) ps += p0[r] + p1[r];
          { auto rr = __builtin_amdgcn_permlane32_swap(__float_as_uint(ps), __float_as_uint(ps), false, false); ps = __uint_as_float(rr[0]) + __uint_as_float(rr[1]); }
          l_reg = l_reg * alpha + ps;
          AT_PK4(p0, 0, pa0); AT_PK4(p0, 8, pa1); AT_PK4(p1, 0, pa2); AT_PK4(p1, 8, pa3); }
        __syncthreads();
    }
    { DA_RESC(alpha); const int vb = vb0 + ((NT - 1) & 1) * SHM_V; DA_PV(vb); }
    if (jh == 0) __syncthreads();
    if (hi == 0) li_l[r32] = l_reg; asm volatile("s_waitcnt lgkmcnt(0)" ::: "memory");
    float rli[16];
#pragma unroll
    for (int r = 0; r < 16; ++r) rli[r] = __builtin_amdgcn_rcpf(li_l[crow(r, hi)]);
    __syncthreads();
    LAS float* X = (LAS float*)lds;
    if (jh == 1) {
#pragma unroll
        for (int r = 0; r < 16; ++r)
#pragma unroll
            for (int d0 = 0; d0 < 4; ++d0) X[(wq * 32 + crow(r, hi)) * DA_XPITCH + d0 * 32 + r32] = o[d0][r] * rli[r];
    }
    __syncthreads();
    if (jh == 0) {
#pragma unroll
        for (int r = 0; r < 16; ++r)
#pragma unroll
            for (int d0 = 0; d0 < 4; ++d0) { const int ix = (wq * 32 + crow(r, hi)) * DA_XPITCH + d0 * 32 + r32; X[ix] = o[d0][r] * rli[r] - lam * X[ix]; }
    }
    __syncthreads();
    { const int row = tid >> 2, qd = tid & 3; const LAS f32x4* xr = (const LAS f32x4*)(X + row * DA_XPITCH + qd * 32);
      f32x4 v[8]; float ss = 0.f;
#pragma unroll
      for (int i = 0; i < 8; ++i) { v[i] = xr[i]; ss += (v[i][0] * v[i][0] + v[i][1] * v[i][1]) + (v[i][2] * v[i][2] + v[i][3] * v[i][3]); }
      ss += __shfl_xor(ss, 1); ss += __shfl_xor(ss, 2);
      const float rs = __builtin_amdgcn_rsqf(ss * (1.f / 128.f) + EPS) * oscale;
      const f32x4* gp = (const f32x4*)(subg + qd * 32); f32x4 gq[8];
#pragma unroll
      for (int i = 0; i < 8; ++i) gq[i] = gp[i];
      bf16_t* op = Ob + (size_t)row * 1024 + qd * 32;
#pragma unroll
      for (int i = 0; i < 4; ++i) { const f32x4 a = v[2 * i] * rs * gq[2 * i], b = v[2 * i + 1] * rs * gq[2 * i + 1]; *(u32x4*)(op + 8 * i) = gm::pack8(a, b); } }
    __syncthreads();
#undef DA_ELOAD
#undef DA_EWRITE
#undef DA_STAGE
#undef DA_RESC
#undef DA_PV
}

constexpr int DD_LDS_K = 0, DD_LDS_V = 65536, DD_LDS_WS = 131072 + 256;
__device__ __forceinline__ void diff_attn_unit_dma(const bf16_t* __restrict__ Qb, const bf16_t* __restrict__ Kh, const bf16_t* __restrict__ Vh, bf16_t* __restrict__ Ob,
                                                   int seq, float lam, float oscale, const float* __restrict__ subg, LAS char* lds) {
    constexpr int LDK = 128, SLOT = 16384, KVBLK = 64;
    constexpr float C = SCALE * 1.4426950408889634f;
    int tid = threadIdx.x; asm volatile("" : "+v"(tid));
    const int wid = __builtin_amdgcn_readfirstlane(tid >> 6), lane = tid & 63, r32 = lane & 31, hi = lane >> 5, jh = wid >> 2, wq = wid & 3;
    LAS char* K_lds = lds + DD_LDS_K; LAS char* V_lds = lds + DD_LDS_V;
    LAS float* ws = (LAS float*)(lds + DD_LDS_WS) + wid * 64; LAS float* li_l = ws; LAS float* al_l = ws + 32;
    float m_reg = -1e30f, l_reg = 0.f, alpha = 1.f; f32x16 o[4] = {}; bf16x8 qr[4];
    const bf16_t* Qw = Qb + (size_t)(wq * 32 + r32) * 128 + jh * 64 + hi * 8;
#pragma unroll
    for (int d0 = 0; d0 < 4; ++d0) qr[d0] = *reinterpret_cast<const bf16x8*>(Qw + d0 * 16);
    const int cb0 = jh * 128;
    const int vb0 = (int)(uintptr_t)V_lds + v_rd_base(lane);
    const int NT = seq / KVBLK;
    unsigned koff[2], voff[2]; unsigned pbase[2];
#pragma unroll
    for (int j = 0; j < 2; ++j) { const int piece = j * 8 + wid; pbase[j] = (unsigned)piece * 1024u;
        const int krow = piece * 4 + (lane >> 4), kcolB = ((lane & 15) * 16) ^ ((krow & 7) << 4); koff[j] = (unsigned)(krow * LDK + (kcolB >> 1));
        const int sub = piece * 2 + (lane >> 5), kk = (sub >> 2) * 8 + ((lane & 31) >> 2), vk = (kk & ~0xC) | ((kk & 4) << 1) | ((kk & 8) >> 1), vc = (sub & 3) * 32 + (lane & 3) * 8; voff[j] = (unsigned)(vk * LDK + vc); }
#define DD_DMA(gp, lp) __builtin_amdgcn_global_load_lds((const unsigned*)(gp), (LAS unsigned*)(lp), 16, 0, 0)
#define DD_KTILE(t, slot) do { const bf16_t* g_ = Kh + (size_t)(t) * KVBLK * LDK; DD_DMA(g_ + koff[0], K_lds + (slot) * SLOT + pbase[0]); DD_DMA(g_ + koff[1], K_lds + (slot) * SLOT + pbase[1]); } while (0)
#define DD_VTILE(t, slot) do { const bf16_t* g_ = Vh + (size_t)(t) * KVBLK * LDK; DD_DMA(g_ + voff[0], V_lds + (slot) * SLOT + pbase[0]); DD_DMA(g_ + voff[1], V_lds + (slot) * SLOT + pbase[1]); } while (0)
#define DD_STAGE(e) do { asm volatile("s_waitcnt vmcnt(4)" ::: "memory"); const int kt_ = (e) + 3 < NT ? (e) + 3 : 0, vt_ = (e) + 2 < NT ? (e) + 2 : 0; DD_KTILE(kt_, ((e) + 3) & 3); DD_VTILE(vt_, ((e) + 2) & 3); } while (0)
#define DD_BAR() do { asm volatile("s_waitcnt lgkmcnt(0)" ::: "memory"); __builtin_amdgcn_s_barrier(); asm volatile("" ::: "memory"); } while (0)
#define DD_RESC(a) do { if (__any((a) < 1.f)) { if (hi == 0) al_l[r32] = (a); asm volatile("s_waitcnt lgkmcnt(0)" ::: "memory"); \
    _Pragma("unroll") for (int d = 0; d < 4; ++d) _Pragma("unroll") for (int r = 0; r < 16; ++r) o[d][r] *= al_l[crow(r, hi)]; } } while (0)
#define DD_PV(vb) do { pv_pair<4, 0>(o[0], o[1], vb, pa0, pa1, pa2, pa3); pv_pair<4, 2>(o[2], o[3], vb, pa0, pa1, pa2, pa3); } while (0)
    f32x16 p0, p1; bf16x8 pa0, pa1, pa2, pa3;
    DD_KTILE(0, 0); DD_KTILE(1, 1); DD_KTILE(2, 2); DD_VTILE(0, 0); DD_VTILE(1, 1);
    asm volatile("s_waitcnt vmcnt(0)" ::: "memory");
    asm volatile("" : "+v"(qr[0]), "+v"(qr[1]), "+v"(qr[2]), "+v"(qr[3]));
    DD_BAR();
    if (jh == 1) DD_BAR();
    for (int i = 0; i < NT; ++i) {
        if (jh == 1) DD_STAGE(i);
        if (i > 0) { DD_RESC(alpha); const int vb = vb0 + ((i - 1) & 3) * SLOT; DD_PV(vb); }
        qkt64(p0, p1, K_lds + (i & 3) * SLOT, qr, r32, hi, cb0);
        DD_BAR();
        if (jh == 0) DD_STAGE(i);
        { float pmax = p0[0];
#pragma unroll
          for (int r = 1; r < 16; ++r) pmax = fmaxf(pmax, p0[r]);
#pragma unroll
          for (int r = 0; r < 16; ++r) pmax = fmaxf(pmax, p1[r]);
          { auto rr = __builtin_amdgcn_permlane32_swap(__float_as_uint(pmax), __float_as_uint(pmax), false, false); pmax = fmaxf(__uint_as_float(rr[0]), __uint_as_float(rr[1])); }
          float mn;
          if (__builtin_expect(__all(pmax - m_reg <= THR / SCALE), 1)) { mn = m_reg; alpha = 1.f; }
          else { mn = fmaxf(m_reg, pmax); alpha = __builtin_amdgcn_exp2f((m_reg - mn) * C); m_reg = mn; }
          const float mnC = -mn * C; float ps = 0.f;
#pragma unroll
          for (int r = 0; r < 16; ++r) { p0[r] = __builtin_amdgcn_exp2f(fmaf(p0[r], C, mnC)); p1[r] = __builtin_amdgcn_exp2f(fmaf(p1[r], C, mnC)); }
#pragma unroll
          for (int r = 0; r < 16; ++r) ps += p0[r] + p1[r];
          { auto rr = __builtin_amdgcn_permlane32_swap(__float_as_uint(ps), __float_as_uint(ps), false, false); ps = __uint_as_float(rr[0]) + __uint_as_float(rr[1]); }
          l_reg = l_reg * alpha + ps;
          AT_PK4(p0, 0, pa0); AT_PK4(p0, 8, pa1); AT_PK4(p1, 0, pa2); AT_PK4(p1, 8, pa3); }
        DD_BAR();
    }
    { DD_RESC(alpha); const int vb = vb0 + ((NT - 1) & 3) * SLOT; DD_PV(vb); }
    asm volatile("s_waitcnt vmcnt(0)" ::: "memory");
    if (jh == 0) DD_BAR();
    if (hi == 0) li_l[r32] = l_reg; asm volatile("s_waitcnt lgkmcnt(0)" ::: "memory");
    float rli[16];
#pragma unroll
    for (int r = 0; r < 16; ++r) rli[r] = __builtin_amdgcn_rcpf(li_l[crow(r, hi)]);
    DD_BAR();
    LAS float* X = (LAS float*)lds;
    if (jh == 1) {
#pragma unroll
        for (int r = 0; r < 16; ++r)
#pragma unroll
            for (int d0 = 0; d0 < 4; ++d0) X[(wq * 32 + crow(r, hi)) * DA_XPITCH + d0 * 32 + r32] = o[d0][r] * rli[r];
    }
    DD_BAR();
    if (jh == 0) {
#pragma unroll
        for (int r = 0; r < 16; ++r)
#pragma unroll
            for (int d0 = 0; d0 < 4; ++d0) { const int ix = (wq * 32 + crow(r, hi)) * DA_XPITCH + d0 * 32 + r32; X[ix] = o[d0][r] * rli[r] - lam * X[ix]; }
    }
    DD_BAR();
    { const int row = tid >> 2, qd = tid & 3; const LAS f32x4* xr = (const LAS f32x4*)(X + row * DA_XPITCH + qd * 32);
      f32x4 v[8]; float ss = 0.f;
#pragma unroll
      for (int i = 0; i < 8; ++i) { v[i] = xr[i]; ss += (v[i][0] * v[i][0] + v[i][1] * v[i][1]) + (v[i][2] * v[i][2] + v[i][3] * v[i][3]); }
      ss += __shfl_xor(ss, 1); ss += __shfl_xor(ss, 2);
      const float rs = __builtin_amdgcn_rsqf(ss * (1.f / 128.f) + EPS) * oscale;
      const f32x4* gp = (const f32x4*)(subg + qd * 32); f32x4 gq[8];
#pragma unroll
      for (int i = 0; i < 8; ++i) gq[i] = gp[i];
      bf16_t* op = Ob + (size_t)row * 1024 + qd * 32;
#pragma unroll
      for (int i = 0; i < 4; ++i) { const f32x4 a = v[2 * i] * rs * gq[2 * i], b = v[2 * i + 1] * rs * gq[2 * i + 1]; *(u32x4*)(op + 8 * i) = gm::pack8(a, b); } }
    asm volatile("s_waitcnt vmcnt(0)" ::: "memory");
    DD_BAR();
#undef DD_DMA
#undef DD_KTILE
#undef DD_VTILE
#undef DD_STAGE
#undef DD_BAR
#undef DD_RESC
#undef DD_PV
}


template <int NCB, int D0, int KM>
__device__ __forceinline__ void pv_pair_km(f32x16& o0, f32x16& o1, int vb, bf16x8 pa0, bf16x8 pa1, bf16x8 pa2, bf16x8 pa3) {
    s16x4 l[2][4], h[2][4];
    if (KM & 1) { l[0][0] = tr_read<v_rd_off<NCB>(D0, 0, 0)>(vb); h[0][0] = tr_read<v_rd_off<NCB>(D0, 0, 1)>(vb); l[1][0] = tr_read<v_rd_off<NCB>(D0 + 1, 0, 0)>(vb); h[1][0] = tr_read<v_rd_off<NCB>(D0 + 1, 0, 1)>(vb); }
    if (KM & 2) { l[0][1] = tr_read<v_rd_off<NCB>(D0, 1, 0)>(vb); h[0][1] = tr_read<v_rd_off<NCB>(D0, 1, 1)>(vb); l[1][1] = tr_read<v_rd_off<NCB>(D0 + 1, 1, 0)>(vb); h[1][1] = tr_read<v_rd_off<NCB>(D0 + 1, 1, 1)>(vb); }
    if (KM & 4) { l[0][2] = tr_read<v_rd_off<NCB>(D0, 2, 0)>(vb); h[0][2] = tr_read<v_rd_off<NCB>(D0, 2, 1)>(vb); l[1][2] = tr_read<v_rd_off<NCB>(D0 + 1, 2, 0)>(vb); h[1][2] = tr_read<v_rd_off<NCB>(D0 + 1, 2, 1)>(vb); }
    if (KM & 8) { l[0][3] = tr_read<v_rd_off<NCB>(D0, 3, 0)>(vb); h[0][3] = tr_read<v_rd_off<NCB>(D0, 3, 1)>(vb); l[1][3] = tr_read<v_rd_off<NCB>(D0 + 1, 3, 0)>(vb); h[1][3] = tr_read<v_rd_off<NCB>(D0 + 1, 3, 1)>(vb); }
    __builtin_amdgcn_sched_barrier(0);
#define AT_PK(L, H) (bf16x8){L[0], L[1], L[2], L[3], H[0], H[1], H[2], H[3]}
    if (KM & 1) { o0 = __builtin_amdgcn_mfma_f32_32x32x16_bf16(pa0, AT_PK(l[0][0], h[0][0]), o0, 0, 0, 0); o1 = __builtin_amdgcn_mfma_f32_32x32x16_bf16(pa0, AT_PK(l[1][0], h[1][0]), o1, 0, 0, 0); }
    if (KM & 2) { o0 = __builtin_amdgcn_mfma_f32_32x32x16_bf16(pa1, AT_PK(l[0][1], h[0][1]), o0, 0, 0, 0); o1 = __builtin_amdgcn_mfma_f32_32x32x16_bf16(pa1, AT_PK(l[1][1], h[1][1]), o1, 0, 0, 0); }
    if (KM & 4) { o0 = __builtin_amdgcn_mfma_f32_32x32x16_bf16(pa2, AT_PK(l[0][2], h[0][2]), o0, 0, 0, 0); o1 = __builtin_amdgcn_mfma_f32_32x32x16_bf16(pa2, AT_PK(l[1][2], h[1][2]), o1, 0, 0, 0); }
    if (KM & 8) { o0 = __builtin_amdgcn_mfma_f32_32x32x16_bf16(pa3, AT_PK(l[0][3], h[0][3]), o0, 0, 0, 0); o1 = __builtin_amdgcn_mfma_f32_32x32x16_bf16(pa3, AT_PK(l[1][3], h[1][3]), o1, 0, 0, 0); }
#undef AT_PK
    __builtin_amdgcn_sched_barrier(0);
}
template <int MODE>
__device__ __forceinline__ void na_softmax_pv(f32x16& p0, f32x16& p1, f32x16 (&o)[2], float& m_reg, float& l_reg, const LAS float* rb, int hi, int r32, int wc0, LAS float* al_l, int vb) {
    constexpr float SC2 = SCALE * 1.4426950408889634f;
    constexpr int A0 = MODE == 2 ? 12 : 0, B1 = MODE == 1 ? 4 : 16;
    if (MODE != 0) { float bb0[16], bb1[16];
#pragma unroll
        for (int r = A0; r < 16; ++r) bb0[r] = rb[crow(r, hi)];
#pragma unroll
        for (int r = 0; r < B1; ++r) bb1[r] = rb[crow(r, hi) + 32];
        __builtin_amdgcn_sched_barrier(0);
#pragma unroll
        for (int r = A0; r < 16; ++r) { const int kc = crow(r, hi); p0[r] = (kc >= wc0 && kc < wc0 + 16) ? fmaf(p0[r], SC2, bb0[r]) : -1e30f; }
#pragma unroll
        for (int r = 0; r < B1; ++r) { const int kc = crow(r, hi) + 32; p1[r] = (kc >= wc0 && kc < wc0 + 16) ? fmaf(p1[r], SC2, bb1[r]) : -1e30f; } }
    float pmax = p0[A0];
#pragma unroll
    for (int r = A0 + 1; r < 16; ++r) pmax = fmaxf(pmax, p0[r]);
#pragma unroll
    for (int r = 0; r < B1; ++r) pmax = fmaxf(pmax, p1[r]);
    { auto rr = __builtin_amdgcn_permlane32_swap(__float_as_uint(pmax), __float_as_uint(pmax), false, false); pmax = fmaxf(__uint_as_float(rr[0]), __uint_as_float(rr[1])); }
    if (MODE == 0) pmax *= SC2;
    float mn = m_reg, alpha = 1.f;
    if (!__all(pmax - m_reg <= THR * 1.4426950408889634f)) { mn = fmaxf(m_reg, pmax); alpha = __builtin_amdgcn_exp2f(m_reg - mn); m_reg = mn; }
    float ps = 0.f;
#pragma unroll
    for (int r = 0; r < 16; ++r) { if (r >= A0) { p0[r] = MODE == 0 ? __builtin_amdgcn_exp2f(fmaf(p0[r], SC2, -mn)) : __builtin_amdgcn_exp2f(p0[r] - mn); ps += p0[r]; } else p0[r] = 0.f; }
#pragma unroll
    for (int r = 0; r < 16; ++r) { if (r < B1) { p1[r] = MODE == 0 ? __builtin_amdgcn_exp2f(fmaf(p1[r], SC2, -mn)) : __builtin_amdgcn_exp2f(p1[r] - mn); ps += p1[r]; } else p1[r] = 0.f; }
    { auto rr = __builtin_amdgcn_permlane32_swap(__float_as_uint(ps), __float_as_uint(ps), false, false); ps = __uint_as_float(rr[0]) + __uint_as_float(rr[1]); }
    l_reg = l_reg * alpha + ps;
    if (__any(alpha < 1.f)) { if (hi == 0) al_l[r32] = alpha; asm volatile("s_waitcnt lgkmcnt(0)" ::: "memory");
#pragma unroll
        for (int d = 0; d < 2; ++d)
#pragma unroll
            for (int r = 0; r < 16; ++r) o[d][r] *= al_l[crow(r, hi)]; }
    bf16x8 pa0 = {}, pa1, pa2, pa3 = {};
    if (MODE != 2) AT_PK4(p0, 0, pa0);
    AT_PK4(p0, 8, pa1); AT_PK4(p1, 0, pa2);
    if (MODE != 1) AT_PK4(p1, 8, pa3);
    pv_pair_km<2, 0, (MODE == 0 ? 15 : (MODE == 1 ? 7 : 14))>(o[0], o[1], vb, pa0, pa1, pa2, pa3);
}
constexpr int NA_LDS_K = 0, NA_LDS_V = 24576, NA_LDS_RPB = 49152, NA_LDS_WS = 53248, NA_LDS_KB = 57344, NA_LDS_VB = 81920;
__device__ __forceinline__ void natten_unit(const bf16_t* __restrict__ qbuf, const bf16_t* __restrict__ kbuf, const bf16_t* __restrict__ vbuf, bf16_t* __restrict__ obuf,
                                            const float* __restrict__ rpb, int b, int h, int R4, LAS char* lds) {
    constexpr float L2E = 1.4426950408889634f, SC2 = SCALE * L2E;
    int tid = threadIdx.x; asm volatile("" : "+v"(tid));
    const int wid = __builtin_amdgcn_readfirstlane(tid >> 6), lane = tid & 63, r32 = lane & 31, hi = lane >> 5;
    const int qrow = R4 * 4 + (wid >> 1), qc0 = (wid & 1) * 32, qc = qc0 + r32;
    const int r0q = min(max(qrow - 4, 0), 24), wc0 = min(max(qc - 8, 0), 48);
    const int lo = min(max(R4 * 4 - 4, 0), 24), hir = min(max(R4 * 4 - 1, 0), 24) + 7, nb = hir - lo + 1 - 8;
    constexpr int nloc = 8, T = 12;
    const int rowi = wid >> 1;
    LAS char* K_lds = lds + NA_LDS_K; LAS char* V_lds = lds + NA_LDS_V; LAS float* rp = (LAS float*)(lds + NA_LDS_RPB);
    LAS float* ws = (LAS float*)(lds + NA_LDS_WS) + wid * 64; LAS float* li_l = ws; LAS float* al_l = ws + 32;
    for (int i = tid; i < 465; i += NTHREADS) rp[i] = rpb[h * 465 + i] * L2E;
    const size_t qtok = (size_t)b * SEQ + qrow * 64 + qc;
    bf16x8 qr[4];
#pragma unroll
    for (int d0 = 0; d0 < 4; ++d0) qr[d0] = *reinterpret_cast<const bf16x8*>(qbuf + qtok * 1024 + h * 64 + d0 * 16 + hi * 8);
    const bf16_t* Kb = kbuf + (size_t)b * KVL * 1024 + h * 64; const bf16_t* Vb = vbuf + (size_t)b * KVL * 1024 + h * 64;
    const int srow = tid >> 3, sch = tid & 7;
    const int kst = AT_KSWZ64(srow, sch * 16), vst = v_st<2>(srow, sch * 8);
    const int vb0 = (int)(uintptr_t)V_lds + v_rd_base(lane);
    float m_reg = -1e30f, l_reg = 0.f; f32x16 o[2] = {};
    const bool weven = (wid & 1) == 0;
    bf16x8 kreg[3], vreg[3];
#define NA_KROW(ti) ((ti) < nloc ? CTXL + (lo + (ti)) * 64 : ((ti) - nloc) * 64)
#define NA_LOAD(s, ti) do { if ((ti) < T) { const int kr0_ = NA_KROW(ti); kreg[s] = *reinterpret_cast<const bf16x8*>(Kb + (size_t)(kr0_ + srow) * 1024 + sch * 8); vreg[s] = *reinterpret_cast<const bf16x8*>(Vb + (size_t)(kr0_ + srow) * 1024 + sch * 8); } } while (0)
#define NA_WRITE(s) do { *(LAS bf16x8*)(K_lds + (s) * 8192 + kst) = kreg[s]; *(LAS bf16x8*)(V_lds + (s) * 8192 + vst) = vreg[s]; } while (0)
    NA_LOAD(0, 0); NA_LOAD(1, 1); NA_LOAD(2, 2);
    if (nb) { bf16x8 kb2[3], vb2[3];
#pragma unroll
        for (int j = 0; j < 3; ++j) { const int kr0_ = CTXL + (lo + 8 + j) * 64; kb2[j] = *reinterpret_cast<const bf16x8*>(Kb + (size_t)(kr0_ + srow) * 1024 + sch * 8); vb2[j] = *reinterpret_cast<const bf16x8*>(Vb + (size_t)(kr0_ + srow) * 1024 + sch * 8); }
#pragma unroll
        for (int j = 0; j < 3; ++j) { *(LAS bf16x8*)(lds + NA_LDS_KB + j * 8192 + kst) = kb2[j]; *(LAS bf16x8*)(lds + NA_LDS_VB + j * 8192 + vst) = vb2[j]; } }
    NA_WRITE(0); NA_LOAD(0, 3);
    __syncthreads();
#define NA_STEP(ti, S0, S1) do { \
        const bool local = (ti) < nloc; \
        const bool useb = local && nb != 0 && (ti) < rowi;                    \
        const int kr = useb ? lo + 8 + (ti) : lo + (ti); \
        const bool active = !local || (kr >= r0q && kr < r0q + 8); \
        if (active) { \
            f32x16 p0 = {}, p1 = {}; \
            const LAS char* Ks = useb ? lds + NA_LDS_KB + (ti) * 8192 : K_lds + (S0) * 8192; \
              \
            { bf16x8 kf0[4], kf1[4]; \
              _Pragma("unroll") for (int d0 = 0; d0 < 4; ++d0) { const int cb = (d0 * 16 + hi * 8) * 2; \
                kf0[d0] = *reinterpret_cast<const LAS bf16x8*>(Ks + AT_KSWZ64(r32, cb)); kf1[d0] = *reinterpret_cast<const LAS bf16x8*>(Ks + AT_KSWZ64(32 + r32, cb)); } \
              __builtin_amdgcn_sched_barrier(0); \
              _Pragma("unroll") for (int d0 = 0; d0 < 4; ++d0) { \
                p0 = __builtin_amdgcn_mfma_f32_32x32x16_bf16(kf0[d0], qr[d0], p0, 0, 0, 0); \
                p1 = __builtin_amdgcn_mfma_f32_32x32x16_bf16(kf1[d0], qr[d0], p1, 0, 0, 0); } } \
            const int vb = useb ? vb0 + (NA_LDS_VB - NA_LDS_V) + (ti) * 8192 : vb0 + (S0) * 8192; \
            if (local) { const LAS float* rb = rp + (kr - qrow + 7) * 31 + 15 - qc; \
                if (weven) na_softmax_pv<1>(p0, p1, o, m_reg, l_reg, rb, hi, r32, wc0, al_l, vb); else na_softmax_pv<2>(p0, p1, o, m_reg, l_reg, rb, hi, r32, wc0, al_l, vb); } \
            else na_softmax_pv<0>(p0, p1, o, m_reg, l_reg, rp, hi, r32, wc0, al_l, vb); \
        } \
        if ((ti) + 1 < T) { NA_WRITE(S1); NA_LOAD(S1, (ti) + 4); } \
        __syncthreads(); } while (0)
    for (int t3 = 0; t3 < T; t3 += 3) { NA_STEP(t3, 0, 1); NA_STEP(t3 + 1, 1, 2); NA_STEP(t3 + 2, 2, 0); }
    if (hi == 0) li_l[r32] = l_reg; asm volatile("s_waitcnt lgkmcnt(0)" ::: "memory");
    LAS bf16_t* ost = (LAS bf16_t*)(lds + NA_LDS_K) + wid * (32 * 72);
#pragma unroll
    for (int r = 0; r < 16; ++r) { const int orow = crow(r, hi); const float rl = __builtin_amdgcn_rcpf(li_l[orow]);
#pragma unroll
        for (int d0 = 0; d0 < 2; ++d0) { const unsigned w = cvt_pk_bf16(o[d0][r] * rl, 0.f); ost[orow * 72 + d0 * 32 + r32] = (bf16_t)(w & 0xffffu); } }
    asm volatile("s_waitcnt lgkmcnt(0)" ::: "memory");
    { bf16_t* op = obuf + ((size_t)b * SEQ + qrow * 64 + qc0) * 1024 + h * 64;
#pragma unroll
      for (int t = 0; t < 4; ++t) { const int ch = lane + 64 * t, orow = ch >> 3, c8 = (ch & 7) * 8;
          *(u32x4*)(op + (size_t)orow * 1024 + c8) = *(const LAS u32x4*)(ost + orow * 72 + c8); } }
    __syncthreads();
#undef NA_KROW
#undef NA_LOAD
#undef NA_WRITE
#undef NA_STEP
}
}

struct Params { const float* in[29]; float* out; unsigned char* ws; int ph_lo, ph_hi, li, pad; };
enum { I_X = 0, I_C, I_CTX, I_CCTX, I_ADAW, I_ADAB, I_MNG, I_MOEG, I_ROUTER, I_WGATE, I_WUP, I_WDOWN, I_DAWIN, I_LQ1, I_LK1, I_LQ2, I_LK2, I_SUBLN, I_DAWOUT,
       I_GMWIN, I_GMVG, I_GMWS, I_GMBS, I_GMWOUT, I_NAWIN, I_NARPB, I_NAWOUT, I_FNWOUT, I_FINALG };
struct Frame {
    LAS unsigned char* lds; const float* in[29]; unsigned char* ws; float* out;
    int tid, lane, wave, G, bid;
    template <class T> __device__ __forceinline__ T* W(size_t off) const { return (T*)(ws + off); }
};

struct TItem { const float* src; bf16_t* dst; int ldw, K, f8; };
__device__ __forceinline__ void titem_load(const TItem& t, int lane, float (&r)[32]) {
#pragma unroll
    for (int i = 0; i < 32; ++i) r[i] = t.src[(size_t)(2 * i + (lane >> 5)) * t.ldw + (lane & 31)];
}
__device__ __forceinline__ void titem_finish(const TItem& t, int lane, const float (&r)[32], LAS float* scr) {
#pragma unroll
    for (int i = 0; i < 32; ++i) scr[(2 * i + (lane >> 5)) * 33 + (lane & 31)] = r[i];
    LDS_WAIT(); asm volatile("" ::: "memory");
    if (t.f8) { const int c4 = lane & 3; unsigned char* d8 = (unsigned char*)t.dst;
#pragma unroll
        for (int j = 0; j < 2; ++j) { const int n = (lane >> 2) + 16 * j; const LAS float* s = scr + (16 * c4) * 33 + n; u32x4 o;
            o.x = gm::pk4_fp8(s[0 * 33] * gm::F8_SW, s[1 * 33] * gm::F8_SW, s[2 * 33] * gm::F8_SW, s[3 * 33] * gm::F8_SW); o.y = gm::pk4_fp8(s[4 * 33] * gm::F8_SW, s[5 * 33] * gm::F8_SW, s[6 * 33] * gm::F8_SW, s[7 * 33] * gm::F8_SW);
            o.z = gm::pk4_fp8(s[8 * 33] * gm::F8_SW, s[9 * 33] * gm::F8_SW, s[10 * 33] * gm::F8_SW, s[11 * 33] * gm::F8_SW); o.w = gm::pk4_fp8(s[12 * 33] * gm::F8_SW, s[13 * 33] * gm::F8_SW, s[14 * 33] * gm::F8_SW, s[15 * 33] * gm::F8_SW);
            *(u32x4*)(d8 + (size_t)n * t.K + 16 * c4) = o; }
        LDS_WAIT(); asm volatile("" ::: "memory"); return; }
    const int c = lane & 7;
#pragma unroll
    for (int j = 0; j < 4; ++j) { const int n = (lane >> 3) + 8 * j; const LAS float* s = scr + (8 * c) * 33 + n;
        u32x4 o; o.x = cvt_pk_bf16(s[0 * 33], s[1 * 33]); o.y = cvt_pk_bf16(s[2 * 33], s[3 * 33]); o.z = cvt_pk_bf16(s[4 * 33], s[5 * 33]); o.w = cvt_pk_bf16(s[6 * 33], s[7 * 33]);
        *(u32x4*)(t.dst + (size_t)n * t.K + 8 * c) = o; }
    LDS_WAIT(); asm volatile("" ::: "memory");
}
__device__ __forceinline__ TItem titem_make(const float* W, int ldw, int K, bf16_t* WT, int k0, int n0, int drow0) { TItem t; t.src = W + (size_t)k0 * ldw + n0; t.dst = WT + (size_t)drow0 * K + k0; t.ldw = ldw; t.K = K; t.f8 = 0; return t; }
__device__ __forceinline__ TItem titem_make8(const float* W, int ldw, int K, unsigned char* WT, int k0, int n0, int drow0) { TItem t; t.src = W + (size_t)k0 * ldw + n0; t.dst = (bf16_t*)(WT + (size_t)drow0 * K + k0); t.ldw = ldw; t.K = K; t.f8 = 1; return t; }
__device__ __forceinline__ TItem titem_plain(const float* W, int K, int N, bf16_t* WT, int item) { const int nblk = N / 32, kb = item / nblk, nb = item - kb * nblk; return titem_make(W, N, K, WT, 64 * kb, 32 * nb, 32 * nb); }
__device__ __forceinline__ TItem titem_moe(const Frame& F, int layer, int item) {
    const int kind = item / 8192, r = item - kind * 8192, e = r >> 9, it = r & 511, kb = it >> 5, nb = it & 31;
    const size_t eoff = ((size_t)layer * NE + e) * (size_t)(D * D);
    if (kind < 2) { const float* W = (kind == 0 ? F.in[I_WGATE] : F.in[I_WUP]) + eoff; unsigned char* WT = F.W<unsigned char>(WGU_OF(layer)) + (size_t)e * 2048 * 1024;
        const int n0 = 32 * nb; return titem_make8(W, D, D, WT, 64 * kb, n0, 256 * (n0 >> 7) + 128 * kind + (n0 & 127)); }
    const float* W = F.in[I_WDOWN] + eoff; unsigned char* WT = F.W<unsigned char>(WD_OF(layer)) + (size_t)e * 1024 * 1024; return titem_make8(W, D, D, WT, 64 * kb, 32 * nb, 32 * nb);
}
constexpr int MIX_J0 = 16 * 96, MIX_J1 = 16 * 32, MIX_J2 = 16 * 128, MIX_J3 = 32 * 32, MIX_J4 = 16 * 96, MIX_J5 = 16 * 32, MIX_J6 = 16 * 32, MIX_NJ = MIX_J0 + MIX_J1 + MIX_J2 + MIX_J3 + MIX_J4 + MIX_J5 + MIX_J6;
__device__ __forceinline__ TItem titem_mixer(const Frame& F, int it) { int r = it;
    if (r < MIX_J0) return titem_plain(F.in[I_DAWIN], 1024, 3072, F.W<bf16_t>(WS_WQKV0), r); r -= MIX_J0;
    if (r < MIX_J1) return titem_plain(F.in[I_DAWOUT], 1024, 1024, F.W<bf16_t>(WS_WO0), r); r -= MIX_J1;
    if (r < MIX_J2) return titem_plain(F.in[I_GMWIN], 1024, 4096, F.W<bf16_t>(WS_WGIN), r); r -= MIX_J2;
    if (r < MIX_J3) return titem_plain(F.in[I_GMWOUT], 2048, 1024, F.W<bf16_t>(WS_WGOUT), r); r -= MIX_J3;
    if (r < MIX_J4) return titem_plain(F.in[I_NAWIN], 1024, 3072, F.W<bf16_t>(WS_WQKV2), r); r -= MIX_J4;
    if (r < MIX_J5) return titem_plain(F.in[I_NAWOUT], 1024, 1024, F.W<bf16_t>(WS_WO2), r); r -= MIX_J5;
    return titem_plain(F.in[I_FNWOUT], 1024, 1024, F.W<bf16_t>(WS_WFO), r);
}
__device__ __forceinline__ void weights_range(const Frame& F, int layer, int n_mix, int i0, int i1, int gw, int nw) {
    LAS float* scr = (LAS float*)F.lds + F.wave * 2112;
    int it = i0 + gw; if (it >= i1) return;
    TItem cur = it < n_mix ? titem_mixer(F, it) : titem_moe(F, layer, it - n_mix); float ra[32], rb[32];
    titem_load(cur, F.lane, ra);
    for (;;) { const int nx = it + nw; const bool more = nx < i1; TItem nxt = cur;
        if (more) { nxt = nx < n_mix ? titem_mixer(F, nx) : titem_moe(F, layer, nx - n_mix); titem_load(nxt, F.lane, rb); }
        titem_finish(cur, F.lane, ra, scr);
        if (!more) break;
#pragma unroll
        for (int i = 0; i < 32; ++i) ra[i] = rb[i];
        cur = nxt; it = nx; }
}
__device__ __forceinline__ void moe_weights_phase(const Frame& F, int layer, int i0 = 0) { weights_range(F, layer, 0, i0, 24576, F.bid * NWAVES + F.wave, F.G * NWAVES); __syncthreads(); }
__device__ __forceinline__ void moe_weights_tail(const Frame& F, int layer, int i0, int per, int rank) {
    if (rank < 0) return;
    const int b0 = i0 + rank * per; weights_range(F, layer, 0, b0, b0 + per < 24576 ? b0 + per : 24576, F.wave, NWAVES); __syncthreads();
}
__device__ __forceinline__ void p0_prologue(const Frame& F, bool tails) {
    weights_range(F, 0, MIX_NJ, 0, tails ? MIX_NJ : MIX_NJ + 24576, F.bid * NWAVES + F.wave, F.G * NWAVES);
    const int gt = F.bid * NTHREADS + F.tid, NGT = F.G * NTHREADS;
    for (int i = gt; i < 1024; i += NGT) { const int pos = i >> 4, f = i & 15; const float inv = powf(10000.f, -(float)f / 16.f), ang = (float)pos * inv;
        F.W<float>(WS_ROPE)[i] = cosf(ang); F.W<float>(WS_ROPE + 4096)[i] = sinf(ang); }
    for (int i = gt; i < 512 * 256 / 8; i += NGT) { const int m = i >> 5, j0 = (i & 31) * 8; const int mm = m & 255; float v[8];
#pragma unroll
        for (int t = 0; t < 8; ++t) { const float x = (float)((mm * (j0 + t)) & 255) * (1.f / 128.f); v[t] = m < 256 ? cospif(x) : sinpif(x); }
        u32x4 w; w.x = cvt_pk_bf16(v[0], v[1]); w.y = cvt_pk_bf16(v[2], v[3]); w.z = cvt_pk_bf16(v[4], v[5]); w.w = cvt_pk_bf16(v[6], v[7]);
        *(u32x4*)(F.W<bf16_t>(WS_CS) + (size_t)i * 8) = w; }
    for (int i = gt; i < 2048 * 272; i += NGT) { const int k = i / 272, n0 = (i - k * 272) * 8; float v[8];
#pragma unroll
        for (int t = 0; t < 8; ++t) { const int np = n0 + t; const float x = (float)((k * (np & 1023)) & 2047) * (1.f / 1024.f);
            v[t] = np < 1024 ? cospif(x) : (np < 2048 ? -sinpif(x) : (np == 2048 ? ((k & 1) ? -1.f : 1.f) : 0.f)); }
        u32x4 w; w.x = cvt_pk_bf16(v[0], v[1]); w.y = cvt_pk_bf16(v[2], v[3]); w.z = cvt_pk_bf16(v[4], v[5]); w.w = cvt_pk_bf16(v[6], v[7]);
        *(u32x4*)(F.W<bf16_t>(WS_DP) + (size_t)i * 8) = w; }
    LAS float* sc = (LAS float*)F.lds;
    LAS float* part = (LAS float*)(F.lds + 73728);
    __syncthreads();
    { float cx[34];
#pragma unroll
      for (int q = 0; q < 34; ++q) { const int i = F.tid + NTHREADS * q, r = i >> 10, k = i & 1023; cx[q] = r < 16 ? F.in[I_C][r * 1024 + k] : F.in[I_CCTX][k]; }
#pragma unroll
      for (int q = 0; q < 34; ++q) sc[F.tid + NTHREADS * q] = cx[q] / (1.f + expf(-cx[q])); }
    __syncthreads();
    for (int item = F.bid; item < 4 * 192; item += F.G) { const int l = item / 192, c0 = (item - l * 192) * 32, cs = F.tid & 31, ks = F.tid >> 5;
        const float* wp = F.in[I_ADAW] + ((size_t)l * 1024 + (size_t)ks * 64) * MODW + c0 + cs;
        float a[17];
#pragma unroll
        for (int r = 0; r < 17; ++r) a[r] = 0.f;
        for (int k0 = 0; k0 < 64; k0 += 32) { float w[32];
#pragma unroll
            for (int kk = 0; kk < 32; ++kk) w[kk] = wp[(size_t)(k0 + kk) * MODW];
#pragma unroll
            for (int kk = 0; kk < 32; ++kk) {
#pragma unroll
                for (int r = 0; r < 17; ++r) a[r] = fmaf(sc[r * 1024 + ks * 64 + k0 + kk], w[kk], a[r]);
                __builtin_amdgcn_sched_barrier(0); } }
#pragma unroll
        for (int r = 0; r < 17; ++r) part[(ks * 17 + r) * 32 + cs] = a[r];
        __syncthreads();
        for (int i = F.tid; i < 17 * 32; i += NTHREADS) { const int r = i >> 5, cc = i & 31; float s = F.in[I_ADAB][l * MODW + c0 + cc];
#pragma unroll
            for (int q = 0; q < 16; ++q) s += part[(q * 17 + r) * 32 + cc];
            F.W<float>(WS_MOD)[((size_t)l * MODR + r) * MODW + c0 + cc] = s; }
        __syncthreads(); }
}

template <int CTRL> __device__ __forceinline__ float dpp_f(float x) { return __uint_as_float((unsigned)__builtin_amdgcn_mov_dpp((int)__float_as_uint(x), CTRL, 0xf, 0xf, true)); }
constexpr int DPP_X1 = 0xB1, DPP_X2 = 0x4E, DPP_ROR4 = 0x124, DPP_ROR8 = 0x128, DPP_ROR12 = 0x12C;
__device__ __forceinline__ float swap16_sum(float a, float b) { auto rr = __builtin_amdgcn_permlane16_swap(__float_as_uint(a), __float_as_uint(b), false, false); return __uint_as_float(rr[0]) + __uint_as_float(rr[1]); }
__device__ __forceinline__ float swap32_sum(float a, float b) { auto rr = __builtin_amdgcn_permlane32_swap(__float_as_uint(a), __float_as_uint(b), false, false); return __uint_as_float(rr[0]) + __uint_as_float(rr[1]); }
__device__ __forceinline__ float swap16_max(float a) { auto rr = __builtin_amdgcn_permlane16_swap(__float_as_uint(a), __float_as_uint(a), false, false); return fmaxf(__uint_as_float(rr[0]), __uint_as_float(rr[1])); }
__device__ __forceinline__ float swap32_max(float a) { auto rr = __builtin_amdgcn_permlane32_swap(__float_as_uint(a), __float_as_uint(a), false, false); return fmaxf(__uint_as_float(rr[0]), __uint_as_float(rr[1])); }
__device__ __forceinline__ float wave_sum64(float x) {
    x += dpp_f<DPP_ROR8>(x); x += dpp_f<DPP_ROR4>(x); x += dpp_f<DPP_X2>(x); x += dpp_f<DPP_X1>(x); x = swap16_sum(x, x); return swap32_sum(x, x);
}
template <int O> __device__ __forceinline__ float lane_xor(float x, int lane, bool x4a) {
    if (O == 1) return dpp_f<DPP_X1>(x);
    if (O == 2) return dpp_f<DPP_X2>(x);
    if (O == 4) { const float a = dpp_f<DPP_ROR4>(x), b = dpp_f<DPP_ROR12>(x); return x4a ? a : b; }
    if (O == 8) return dpp_f<DPP_ROR8>(x);
    if (O == 16) { auto rr = __builtin_amdgcn_permlane16_swap(__float_as_uint(x), __float_as_uint(x), false, false); return __uint_as_float((lane & 16) ? rr[0] : rr[1]); }
    auto rr = __builtin_amdgcn_permlane32_swap(__float_as_uint(x), __float_as_uint(x), false, false); return __uint_as_float((lane & 32) ? rr[0] : rr[1]);
}
struct NormArgs {
    const float* xsrc; float* xdst; const float* csrc; float* cdst;
    int do_lat, do_ctx, xbf, xcopy;
    const float* gain; const float* shift; const float* scale;
    bf16_t* hx;
    const bf16_t* ys; const int* tokslot; const int* tokslotc; const float* g2;
    int ctx_comb;
    const float* wrouter; float* aff;
    float* out;
};
constexpr int WRT_PITCH = 1028;
constexpr size_t WS_ZROW = WS_CTL + 768 * 1024;
struct NormVec { f32x4 g[4], sh[4], g2[4]; int mr; };
template <bool COMBINE, bool FINAL, bool ROUTER = false>
__device__ __forceinline__ void normvec_load(const NormArgs& A, int mr, int lane, NormVec& nv) {
    nv.mr = mr;
#pragma unroll
    for (int j = 0; j < 4; ++j) { nv.g[j] = ((const f32x4*)A.gain)[lane + 64 * j];
        if (!FINAL) { nv.sh[j] = ((const f32x4*)(A.shift + (size_t)mr * MODW))[lane + 64 * j]; const f32x4 sc = ((const f32x4*)(A.scale + (size_t)mr * MODW))[lane + 64 * j];
            nv.g[j] = nv.g[j] * (sc + 1.0f);
            if (ROUTER) { nv.g[j] = nv.g[j] * gm::F8_SX; nv.sh[j] = nv.sh[j] * gm::F8_SX; } }
        if (COMBINE) nv.g2[j] = ((const f32x4*)(A.g2 + (size_t)mr * MODW))[lane + 64 * j]; }
}
template <int R>
__device__ __forceinline__ void norm_load(const NormArgs& A, int row0, int rstep, int lane, f32x4 (&v)[R][4]) {
#pragma unroll
    for (int r = 0; r < R; ++r) { const int row = row0 + r * rstep;
        if (A.xbf) { const bf16_t* src = row >= NLAT ? (const bf16_t*)A.csrc + (size_t)(row - NLAT) * D : (const bf16_t*)A.xsrc + (size_t)row * D;
#pragma unroll
            for (int j = 0; j < 4; ++j) { const u32x2 w = ((const u32x2*)src)[lane + 64 * j]; v[r][j] = (f32x4){bf_lo(w.x), bf_hi(w.x), bf_lo(w.y), bf_hi(w.y)}; } }
        else { const float* src = row >= NLAT ? A.csrc + (size_t)(row - NLAT) * D : A.xsrc + (size_t)row * D;
#pragma unroll
            for (int j = 0; j < 4; ++j) v[r][j] = ((const f32x4*)src)[lane + 64 * j]; } }
}
template <bool COMBINE, bool ROUTER, bool FINAL, int R>
__device__ __forceinline__ void norm_rows(const NormArgs& A, const NormVec& nv, int row0, int rstep, int lane, const LAS float* wrT, const bf16_t* zrow, f32x4 (&v)[R][4], int hxfold = -1) {
    int row[R], b[R], mr[R]; bool ic[R];
#pragma unroll
    for (int r = 0; r < R; ++r) { row[r] = row0 + r * rstep; ic[r] = row[r] >= NLAT; b[r] = ic[r] ? (row[r] - NLAT) >> 8 : row[r] >> 11; mr[r] = ic[r] ? 16 : b[r]; }
    if (!COMBINE && !FINAL && A.xcopy) {
#pragma unroll
        for (int r = 0; r < R; ++r) { bf16_t* dst = ic[r] ? (bf16_t*)A.cdst + (size_t)(row[r] - NLAT) * D : (bf16_t*)A.xdst + (size_t)row[r] * D;
#pragma unroll
            for (int j = 0; j < 4; ++j) { u32x2 w; w.x = cvt_pk_bf16(v[r][j][0], v[r][j][1]); w.y = cvt_pk_bf16(v[r][j][2], v[r][j][3]); ((u32x2*)dst)[lane + 64 * j] = w; } } }
    if (COMBINE) {
        int myslot[R]; unsigned msk[R]; int tmax = 0;
#pragma unroll
        for (int r = 0; r < R; ++r) { myslot[r] = -1;
            if (lane < 16 && (!ic[r] || A.ctx_comb)) myslot[r] = ic[r] ? A.tokslotc[(b[r] * 16 + lane) * CTXL + ((row[r] - NLAT) & 255)] : A.tokslot[(b[r] * 16 + lane) * SEQ + (row[r] & 2047)]; }
#pragma unroll
        for (int r = 0; r < R; ++r) { msk[r] = (unsigned)__ballot(myslot[r] >= 0) & 0xffffu; const int c = __builtin_popcount(msk[r]); tmax = c > tmax ? c : tmax; }
        f32x4 a[R][4];
#pragma unroll
        for (int r = 0; r < R; ++r)
#pragma unroll
            for (int j = 0; j < 4; ++j) a[r][j] = (f32x4){0.f, 0.f, 0.f, 0.f};
        for (int t = 0; t < tmax; ++t) {
            unsigned w[R][4];
#pragma unroll
            for (int r = 0; r < R; ++r) { const unsigned m = msk[r]; const bool ok = m != 0u; const int e = ok ? __builtin_ctz(m) : 0; msk[r] = m & (m - 1u);
                const int sl = __builtin_amdgcn_readlane(myslot[r], e);
                const unsigned char* yr = ok ? (const unsigned char*)A.ys + ((size_t)e * gm::ES + (ic[r] ? 4096 + b[r] * CAPC : b[r] * CAP) + sl) * D : (const unsigned char*)zrow;
#pragma unroll
                for (int j = 0; j < 4; ++j) w[r][j] = ((const unsigned*)yr)[lane + 64 * j]; }
#pragma unroll
            for (int r = 0; r < R; ++r)
#pragma unroll
                for (int j = 0; j < 4; ++j) { const f32x2 lo = __builtin_amdgcn_cvt_pk_f32_fp8((int)w[r][j], false), hi2 = __builtin_amdgcn_cvt_pk_f32_fp8((int)w[r][j], true);
                    a[r][j] += (f32x4){lo[0], lo[1], hi2[0], hi2[1]}; }
        }
#pragma unroll
        for (int r = 0; r < R; ++r) { if (ic[r] && !A.ctx_comb) continue;
#pragma unroll
            for (int j = 0; j < 4; ++j) v[r][j] += nv.g2[j] * (a[r][j] * 0.03125f);
            if (!FINAL) { bf16_t* dst = ic[r] ? (bf16_t*)A.cdst + (size_t)(row[r] - NLAT) * D : (bf16_t*)A.xdst + (size_t)row[r] * D;
#pragma unroll
                for (int j = 0; j < 4; ++j) { u32x2 w; w.x = cvt_pk_bf16(v[r][j][0], v[r][j][1]); w.y = cvt_pk_bf16(v[r][j][2], v[r][j][3]); ((u32x2*)dst)[lane + 64 * j] = w; } } }
    }
    float ss[R];
#pragma unroll
    for (int r = 0; r < R; ++r) { ss[r] = 0.f;
#pragma unroll
        for (int j = 0; j < 4; ++j) ss[r] += (v[r][j][0] * v[r][j][0] + v[r][j][1] * v[r][j][1]) + (v[r][j][2] * v[r][j][2] + v[r][j][3] * v[r][j][3]); }
#pragma unroll
    for (int r = 0; r < R; ++r) ss[r] = wave_sum64(ss[r]);
    if (FINAL) {
#pragma unroll
        for (int r = 0; r < R; ++r) { const float rstd = __builtin_amdgcn_rsqf(ss[r] * (1.f / D) + EPS);
#pragma unroll
            for (int j = 0; j < 4; ++j) ((f32x4*)(A.out + (size_t)row[r] * D))[lane + 64 * j] = v[r][j] * rstd * nv.g[j]; }
        return;
    }
#pragma unroll
    for (int r = 0; r < R; ++r) { const float rstd = __builtin_amdgcn_rsqf(ss[r] * (1.f / D) + EPS);
#pragma unroll
        for (int j = 0; j < 4; ++j) { v[r][j] = v[r][j] * rstd * nv.g[j] + nv.sh[j];
            if (ROUTER) ((unsigned*)((unsigned char*)A.hx + (size_t)row[r] * D))[lane + 64 * j] = gm::pk4_fp8(v[r][j][0], v[r][j][1], v[r][j][2], v[r][j][3]);
            else if (hxfold < 0) { u32x2 w; w.x = cvt_pk_bf16(v[r][j][0], v[r][j][1]); w.y = cvt_pk_bf16(v[r][j][2], v[r][j][3]); ((u32x2*)(A.hx + (size_t)row[r] * D))[lane + 64 * j] = w; } } }
    if (hxfold >= 0) {
#pragma unroll
        for (int j = 0; j < 4; ++j) { const f32x4 a = R == 2 ? v[0][j] + v[R - 1][j] : v[0][j];
            u32x2 w; w.x = cvt_pk_bf16(a[0], a[1]); w.y = cvt_pk_bf16(a[2], a[3]); ((u32x2*)(A.hx + (size_t)hxfold * D))[lane + 64 * j] = w;
            if (R == 2) { const f32x4 d = v[0][j] - v[1][j]; u32x2 w2; w2.x = cvt_pk_bf16(d[0], d[1]); w2.y = cvt_pk_bf16(d[2], d[3]); ((u32x2*)(A.hx + (size_t)(hxfold + 1024) * D))[lane + 64 * j] = w2; } } }
    if (ROUTER) {
        float t1[R]; float lgs[R][16];
        f32x4 wb[2][4];
#define RT_LOAD(buf, e) do { _Pragma("unroll") for (int j = 0; j < 4; ++j) wb[buf][j] = *(const LAS f32x4*)(wrT + (e) * WRT_PITCH + 4 * lane + 256 * j); } while (0)
        RT_LOAD(0, 0);
#pragma unroll
        for (int e = 0; e < 16; ++e) {
            if (e + 1 < 16) RT_LOAD((e + 1) & 1, e + 1);
            __builtin_amdgcn_sched_barrier(0);
            f32x2 s_[R];
#pragma unroll
            for (int r = 0; r < R; ++r) s_[r] = (f32x2){0.f, 0.f};
#pragma unroll
            for (int j = 0; j < 4; ++j) { const f32x4 w = wb[e & 1][j]; const f32x2 wlo = (f32x2){w[0], w[1]}, whi = (f32x2){w[2], w[3]};
#pragma unroll
                for (int r = 0; r < R; ++r) { s_[r] = __builtin_elementwise_fma((f32x2){v[r][j][0], v[r][j][1]}, wlo, s_[r]); s_[r] = __builtin_elementwise_fma((f32x2){v[r][j][2], v[r][j][3]}, whi, s_[r]); } }
#pragma unroll
            for (int r = 0; r < R; ++r) lgs[r][e] = s_[r][0] + s_[r][1];
            __builtin_amdgcn_sched_barrier(0);
        }
#undef RT_LOAD
        const bool x4a = __builtin_amdgcn_mov_dpp(lane, DPP_ROR4, 0xf, 0xf, true) == (lane ^ 4);
#pragma unroll
        for (int r = 0; r < R; ++r) {
            float lg[16];
#pragma unroll
            for (int e = 0; e < 16; ++e) lg[e] = lgs[r][e];
            float t8[8], t4[4], t2[2];
#pragma unroll
            for (int k = 0; k < 8; ++k) t8[k] = swap32_sum(lg[k], lg[k + 8]);
#pragma unroll
            for (int k = 0; k < 4; ++k) t4[k] = swap16_sum(t8[k], t8[k + 4]);
            { const bool up = (lane & 8) != 0;
#pragma unroll
              for (int k = 0; k < 2; ++k) { const float keep = up ? t4[k + 2] : t4[k], send = up ? t4[k] : t4[k + 2]; t2[k] = keep + lane_xor<8>(send, lane, x4a); } }
            { const bool up = (lane & 4) != 0; const float keep = up ? t2[1] : t2[0], send = up ? t2[0] : t2[1]; t1[r] = keep + lane_xor<4>(send, lane, x4a); }
        }
#pragma unroll
        for (int r = 0; r < R; ++r) { t1[r] += lane_xor<2>(t1[r], lane, x4a); }
#pragma unroll
        for (int r = 0; r < R; ++r) { t1[r] += lane_xor<1>(t1[r], lane, x4a); }
        float mx[R], ex[R], sm[R];
#pragma unroll
        for (int r = 0; r < R; ++r) { float m = t1[r]; m = fmaxf(m, dpp_f<DPP_ROR8>(m)); m = fmaxf(m, dpp_f<DPP_ROR4>(m)); m = swap16_max(m); mx[r] = swap32_max(m); }
#pragma unroll
        for (int r = 0; r < R; ++r) { ex[r] = __builtin_amdgcn_exp2f((t1[r] - mx[r]) * 1.4426950408889634f); sm[r] = ex[r]; }
#pragma unroll
        for (int r = 0; r < R; ++r) { float q = sm[r]; q += dpp_f<DPP_ROR8>(q); q += dpp_f<DPP_ROR4>(q); q = swap16_sum(q, q); sm[r] = swap32_sum(q, q); }
#pragma unroll
        for (int r = 0; r < R; ++r) if ((lane & 3) == 0) A.aff[(size_t)row[r] * 16 + (lane >> 2)] = ex[r] * __builtin_amdgcn_rcpf(sm[r]);
    }
}
template <bool COMBINE, bool ROUTER, bool FINAL>
__device__ __forceinline__ void norm_phase(const Frame& F, const NormArgs& A) {
    constexpr int R = 2;
    LAS float* wrT = (LAS float*)F.lds;
    if (ROUTER) {
        float tmp[32];
#pragma unroll
        for (int k = 0; k < 32; ++k) tmp[k] = A.wrouter[F.tid + NTHREADS * k];
#pragma unroll
        for (int k = 0; k < 32; ++k) { const int i = F.tid + NTHREADS * k; wrT[(i & 15) * WRT_PITCH + (i >> 4)] = tmp[k] * (1.0f / gm::F8_SX); }
        __syncthreads(); }
    const bf16_t* zrow = (const bf16_t*)(F.ws + WS_ZROW);
    const int gw = F.bid * NWAVES + F.wave, NGW = F.G * NWAVES;
    NormVec nv; nv.mr = -1;
    for (int part = 0; part < 2; ++part) {
        if (part == 0 ? !A.do_lat : !A.do_ctx) continue;
        const int base = part == 0 ? 0 : NLAT, n = part == 0 ? NLAT : NCTX, rpw = (n + NGW - 1) / NGW;
        int row = base + gw * rpw; const int rend = (row + rpw < base + n) ? row + rpw : base + n;
        f32x4 va[R][4], vb[R][4];
        const auto same = [&](int r) { return r + 1 < rend && (part == 1 ? ((r - NLAT) >> 8) == ((r + 1 - NLAT) >> 8) : (r >> 11) == ((r + 1) >> 11)); };
        if (row < rend && same(row)) norm_load<R>(A, row, 1, F.lane, va);
        while (row < rend) {
            const int mr = part == 1 ? 16 : (row >> 11);
            if (mr != nv.mr) normvec_load<COMBINE, FINAL, ROUTER>(A, mr, F.lane, nv);
            if (same(row)) { const int nx = row + R; const bool more = nx < rend && same(nx);
                if (more) norm_load<R>(A, nx, 1, F.lane, vb);
                norm_rows<COMBINE, ROUTER, FINAL, R>(A, nv, row, 1, F.lane, wrT, zrow, va);
                if (more) {
#pragma unroll
                    for (int r = 0; r < R; ++r)
#pragma unroll
                        for (int j = 0; j < 4; ++j) va[r][j] = vb[r][j]; }
                else if (nx < rend && !more) {   }
                row = nx; }
            else { f32x4 v1[1][4]; norm_load<1>(A, row, 1, F.lane, v1); norm_rows<COMBINE, ROUTER, FINAL, 1>(A, nv, row, 1, F.lane, wrT, zrow, v1); row += 1;
                if (row < rend && same(row)) norm_load<R>(A, row, 1, F.lane, va); }
        }
    }
    __syncthreads();
}

constexpr int HF_ROWS = 2304;
template <bool COMBINE>
__device__ __forceinline__ void norm_fold_phase(const Frame& F, const NormArgs& A) {
    const bf16_t* zrow = (const bf16_t*)(F.ws + WS_ZROW);
    const int gw = F.bid * NWAVES + F.wave, NGW = F.G * NWAVES;
    constexpr int NPAIR = NB * 1023;
    NormVec nv; nv.mr = -1;
    { const int ipw = (NPAIR + NGW - 1) / NGW; int it = gw * ipw; const int iend = (it + ipw < NPAIR) ? it + ipw : NPAIR; f32x4 va[2][4], vb[2][4];
      if (it < iend) { const int b = it / 1023, n = 1 + it - b * 1023; norm_load<2>(A, b * SEQ + n, SEQ - 2 * n, F.lane, va); }
      for (; it < iend; ++it) { const int b = it / 1023, n = 1 + it - b * 1023; const int nx = it + 1; const bool more = nx < iend;
          if (b != nv.mr) normvec_load<COMBINE, false>(A, b, F.lane, nv);
          if (more) { const int b2 = nx / 1023, n2 = 1 + nx - b2 * 1023; norm_load<2>(A, b2 * SEQ + n2, SEQ - 2 * n2, F.lane, vb); }
          norm_rows<COMBINE, false, false, 2>(A, nv, b * SEQ + n, SEQ - 2 * n, F.lane, nullptr, zrow, va, b * HF_ROWS + n);
          if (more) {
#pragma unroll
              for (int r = 0; r < 2; ++r)
#pragma unroll
                  for (int j = 0; j < 4; ++j) va[r][j] = vb[r][j]; } } }
    for (int it = gw; it < 2 * NB; it += NGW) { const int b = it >> 1, hi = it & 1; f32x4 v1[1][4];
        if (b != nv.mr) normvec_load<COMBINE, false>(A, b, F.lane, nv);
        norm_load<1>(A, b * SEQ + hi * 1024, 0, F.lane, v1); norm_rows<COMBINE, false, false, 1>(A, nv, b * SEQ + hi * 1024, 0, F.lane, nullptr, zrow, v1, b * HF_ROWS + hi * 2048); }
    for (int it = gw; it < NB * 256; it += NGW) { const int b = it >> 8, q = it & 255; const int r = q == 0 ? 1024 : 2048 + q;
        u32x2 z; z.x = 0u; z.y = 0u;
#pragma unroll
        for (int j = 0; j < 4; ++j) ((u32x2*)(A.hx + ((size_t)b * HF_ROWS + r) * D))[F.lane + 64 * j] = z; }
    __syncthreads();
}

template <int NV, int NTOK, int CAPN>
__device__ __forceinline__ void select_unit(const Frame& F, const float* aff_base  , int* tokslot_out  , int* slot_row_out, float* slot_aff_out, int row_base) {
    LAS int* cnt = (LAS int*)F.lds;
    LAS int* tg = cnt + 64; LAS int* te = tg + NV * 8;
    unsigned v[NV]; bool ok[NV];
#pragma unroll
    for (int k = 0; k < NV; ++k) { const int n = F.tid + NTHREADS * k; ok[k] = n < NTOK; v[k] = ok[k] ? __float_as_uint(aff_base[(size_t)n * 16]) : 0u; }
    unsigned T = 0u;
    for (int bit = 29; bit >= 0; --bit) { const unsigned cand = T | (1u << bit); int cw = 0;
#pragma unroll
        for (int k = 0; k < NV; ++k) cw += __builtin_popcountll(__ballot(ok[k] && v[k] >= cand));
        LAS int* cb = cnt + (bit & 1) * 8;
        if (F.lane == 0) cb[F.wave] = cw;
        __syncthreads();
        int tot = 0;
#pragma unroll
        for (int w = 0; w < 8; ++w) tot += cb[w];
        if (tot >= CAPN) T = cand; }
    int pg[NV], pe[NV]; bool isg[NV], ise[NV];
#pragma unroll
    for (int k = 0; k < NV; ++k) { isg[k] = ok[k] && v[k] > T; ise[k] = ok[k] && v[k] == T;
        const unsigned long long mg = __ballot(isg[k]), me = __ballot(ise[k]); const unsigned long long below = (1ull << F.lane) - 1ull;
        pg[k] = __builtin_popcountll(mg & below); pe[k] = __builtin_popcountll(me & below);
        if (F.lane == 0) { tg[k * 8 + F.wave] = __builtin_popcountll(mg); te[k * 8 + F.wave] = __builtin_popcountll(me); } }
    __syncthreads();
    LAS int* xg = te + NV * 8; LAS int* xe = xg + NV * 8 + 1;
    if (F.tid == 0) { int ag = 0, ae = 0; for (int i = 0; i < NV * 8; ++i) { xg[i] = ag; xe[i] = ae; ag += tg[i]; ae += te[i]; } xg[NV * 8] = ag; }
    __syncthreads();
    const int totg = xg[NV * 8];
#pragma unroll
    for (int k = 0; k < NV; ++k) { const int og = xg[k * 8 + F.wave], oe = xe[k * 8 + F.wave];
        const int n = F.tid + NTHREADS * k;
        if (ok[k]) { int slot = -1;
            if (isg[k]) slot = og + pg[k];
            else if (ise[k]) { const int rk = oe + pe[k]; if (totg + rk < CAPN) slot = totg + rk; }
            tokslot_out[n] = slot;
            if (slot >= 0) { slot_row_out[slot] = row_base + n; slot_aff_out[slot] = __uint_as_float(v[k]); } } }
    __syncthreads();
}
__device__ __forceinline__ void topk_phase(const Frame& F, bool do_ctx) {
    const float* aff = F.W<float>(WS_AFF); int* slot_row = F.W<int>(WS_SLOTROW); float* slot_aff = F.W<float>(WS_SLOTAFF); int* tokslot = F.W<int>(WS_TOKSLOT); int* tokslotc = F.W<int>(WS_TOKSLOTC);
    const int nunits = do_ctx ? 512 : 256;
    for (int u = F.bid; u < nunits; u += F.G) {
        if (u < 256) { const int b = u >> 4, e = u & 15;
            select_unit<4, SEQ, CAP>(F, aff + (size_t)b * SEQ * 16 + e, tokslot + (b * 16 + e) * SEQ, slot_row + e * gm::ES + b * CAP, slot_aff + e * gm::ES + b * CAP, b * SEQ); }
        else { const int b = (u - 256) >> 4, e = u & 15;
            select_unit<1, CTXL, CAPC>(F, aff + ((size_t)NLAT + (size_t)b * CTXL) * 16 + e, tokslotc + (b * 16 + e) * CTXL, slot_row + e * gm::ES + 4096 + b * CAPC, slot_aff + e * gm::ES + 4096 + b * CAPC, NLAT + b * CTXL); }
    }
}

__device__ __forceinline__ void gm_prep_phase(const Frame& F) {
    const float* ws_ = F.in[I_GMWS]; const float* sumsq = F.W<float>(WS_SUMSQ); bf16_t* App = F.W<bf16_t>(RA_APP);
    LAS float* rs = (LAS float*)F.lds;
    for (int item = F.bid; item < NB * 9 * 2; item += F.G) { const int gq = item & 1, bc = item >> 1, b = bc / 9, cp = bc - b * 9;
        const size_t trow0 = cp == 0 ? (size_t)NLAT + (size_t)b * CTXL : (size_t)b * SEQ + (size_t)(cp - 1) * 256;
        if (F.tid < 256) { const f32x4* pa = (const f32x4*)(sumsq + (trow0 + F.tid) * 16); const f32x4 a0 = pa[0], a1 = pa[1], a2 = pa[2], a3 = pa[3];
            const float sm = (((a0[0] + a0[1]) + (a0[2] + a0[3])) + ((a1[0] + a1[1]) + (a1[2] + a1[3]))) + (((a2[0] + a2[1]) + (a2[2] + a2[3])) + ((a3[0] + a3[1]) + (a3[2] + a3[3])));
            rs[F.tid] = __builtin_amdgcn_rsqf(sm * (1.f / 2048.f) + EPS); }
        __syncthreads();
        constexpr int U = 4;
        for (int i0 = F.tid; i0 < 4 * 4096; i0 += U * NTHREADS) {
            f32x4 w0[U], w1[U];
#pragma unroll
            for (int q = 0; q < U; ++q) { const int i = i0 + q * NTHREADS; const int g = gq * 4 + (i >> 12), r = (i >> 4) & 255, k0 = (i & 15) * 8;
                const float* wp = ws_ + ((size_t)g * 128 + (r & 127)) * 128 + k0; w0[q] = *(const f32x4*)wp; w1[q] = *(const f32x4*)(wp + 4); }
#pragma unroll
            for (int q = 0; q < U; ++q) { const int i = i0 + q * NTHREADS; const int g = gq * 4 + (i >> 12), r = (i >> 4) & 255, k0 = (i & 15) * 8, tk = (r >> 7) * 128 + k0;
                const f32x4 r0 = *(const LAS f32x4*)(rs + tk), r1 = *(const LAS f32x4*)(rs + tk + 4);
                *(u32x4*)(App + ((size_t)(bc * 8 + g) * 4096 + (i & 4095)) * 8) = gm::pack8(w0[q] * r0, w1[q] * r1); }
        }
        __syncthreads();
    }
}

enum { PH_PRO = 0,
       PH_L0_N1, PH_L0_QKV, PH_L0_ATT, PH_L0_OUT, PH_L0_N2, PH_L0_TOPK, PH_L0_GU, PH_L0_DOWN,
       PH_L1_N1, PH_L1_GMIN, PH_L1_PREP, PH_L1_SPAT, PH_L1_OUT, PH_L1_N2, PH_L1_TOPK, PH_L1_GU, PH_L1_DOWN,
       PH_L2_N1, PH_L2_QKV, PH_L2_ATT, PH_L2_OUT, PH_L2_N2, PH_L2_TOPK, PH_L2_GU, PH_L2_DOWN,
       PH_L3_N1, PH_L3_CDFT, PH_L3_PDFT, PH_L3_OUT, PH_L3_N2, PH_L3_TOPK, PH_L3_GU, PH_L3_DOWN,
       PH_FINAL, NPHASES };

__device__ __forceinline__ const float* modp(const Frame& F, int layer, int j) { return F.W<float>(WS_MOD) + (size_t)layer * MODR * MODW + (size_t)j * D; }

template <bool COMBINE>
__device__ __forceinline__ void norm1_phase(const Frame& F, int layer, bool do_ctx, bool ctx_comb) {
    NormArgs A{};
    A.xsrc = COMBINE ? F.W<float>(WS_X) : F.in[I_X]; A.xdst = F.W<float>(WS_X); A.csrc = COMBINE ? F.W<float>(WS_CTX) : F.in[I_CTX]; A.cdst = F.W<float>(WS_CTX);
    A.do_lat = 1; A.do_ctx = do_ctx ? 1 : 0; A.xbf = COMBINE ? 1 : 0; A.xcopy = COMBINE ? 0 : 1;
    A.gain = F.in[I_MNG] + layer * D; A.shift = modp(F, layer, 0); A.scale = modp(F, layer, 1); A.hx = F.W<bf16_t>(WS_HX);
    A.ys = F.W<bf16_t>(RA_YS); A.tokslot = F.W<int>(WS_TOKSLOT); A.tokslotc = F.W<int>(WS_TOKSLOTC); A.g2 = modp(F, layer > 0 ? layer - 1 : 0, 5); A.ctx_comb = ctx_comb ? 1 : 0;
    norm_phase<COMBINE, false, false>(F, A);
}
__device__ __forceinline__ void norm2_phase(const Frame& F, int layer, bool do_ctx) {
    NormArgs A{};
    A.xsrc = F.W<float>(WS_X); A.csrc = F.W<float>(WS_CTX); A.do_lat = 1; A.do_ctx = do_ctx ? 1 : 0; A.xbf = 1;
    A.gain = F.in[I_MOEG] + layer * D; A.shift = modp(F, layer, 3); A.scale = modp(F, layer, 4); A.hx = F.W<bf16_t>(WS_HX);
    A.wrouter = F.in[I_ROUTER] + (size_t)layer * D * NE; A.aff = F.W<float>(WS_AFF);
    norm_phase<false, true, false>(F, A);
}
__device__ __forceinline__ void out_phase(const Frame& F, int layer, const char* A, unsigned lda, int K, size_t wofs, int nM) {
    gm::P_OUT p; p.A = A; p.B = (const char*)(F.ws + wofs); p.lda_ = lda; p.K_ = K; p.nM = nM;
    p.xb_ = F.W<bf16_t>(WS_X); p.cb_ = F.W<bf16_t>(WS_CTX); p.gate = modp(F, layer, 2);
    gm::gemm_phase(F.lds, p);
}
__device__ __forceinline__ void gu_phase(const Frame& F, int layer, bool with_ctx) {
    gm::P_GU p; p.hx = (const char*)(F.ws + WS_HX); p.W = (const char*)(F.ws + WGU_OF(layer)); p.hid = F.W<unsigned char>(RA_HID); p.slot_row = F.W<int>(WS_SLOTROW); p.nM = with_ctx ? 18 : 16;
    gm::gemm_phase(F.lds, p);
}
__device__ __forceinline__ void down_phase(const Frame& F, int layer, bool with_ctx) {
    gm::P_DOWN p; p.hid = (const char*)(F.ws + RA_HID); p.W = (const char*)(F.ws + WD_OF(layer)); p.ys = F.W<bf16_t>(RA_YS); p.slot_aff = F.W<float>(WS_SLOTAFF); p.nM = with_ctx ? 18 : 16;
    gm::gemm_phase(F.lds, p);
}

__global__ void __launch_bounds__(NTHREADS, 2) fwd(Params P) {
    extern __shared__ __attribute__((aligned(16))) unsigned char lds_raw[];
    Frame F;
    F.lds = (LAS unsigned char*)lds_raw; F.ws = P.ws; F.out = P.out;
#pragma unroll
    for (int i = 0; i < 29; ++i) F.in[i] = P.in[i];
    F.tid = threadIdx.x; F.lane = F.tid & 63; F.wave = __builtin_amdgcn_readfirstlane(F.tid >> 6); F.G = gridDim.x; F.bid = blockIdx.x;
    volatile LAS unsigned* MISC = (volatile LAS unsigned*)(F.lds + LDS_MISC);
    if (F.tid < 64) MISC[F.tid] = 0u;
    __syncthreads();
    const int lo = P.ph_lo, hi = P.ph_hi;
    const bool tails = (gridDim.x == 256);
    XcdBarrier bar = xcd_barrier_post((unsigned*)(F.ws + WS_CTL) + 1024 + (size_t)P.li * XCD_BAR_WORDS, MISC);
#ifdef MK_ONLY_PHASE
#define IN(k) ((k) == MK_ONLY_PHASE && lo <= (k) && (k) < hi)
#else
#define IN(k) (lo <= (k) && (k) < hi)
#endif
#define SEAM(k) do { if (IN(k) && IN((k) + 1)) xcd_barrier(bar); } while (0)
#define REFRESH() do { int tz_ = threadIdx.x; asm volatile("" : "+v"(tz_)); F.tid = tz_; F.lane = tz_ & 63; F.wave = __builtin_amdgcn_readfirstlane(tz_ >> 6); } while (0)

    if (IN(PH_PRO)) { REFRESH(); p0_prologue(F, tails); } SEAM(PH_PRO);

    if (IN(PH_L0_N1)) { REFRESH(); norm1_phase<false>(F, 0, true, false); } SEAM(PH_L0_N1);
    if (IN(PH_L0_QKV)) { REFRESH();
        gm::P_QKV0 p; p.A = (const char*)(F.ws + WS_HX); p.B = (const char*)(F.ws + WS_WQKV0); p.q = F.W<bf16_t>(RB_Q); p.k = F.W<bf16_t>(RB_K); p.v = F.W<bf16_t>(RB_V);
        p.ropeC = F.W<float>(WS_ROPE); p.ropeS = F.W<float>(WS_ROPE + 4096);
        gm::gemm_phase(F.lds, p);
        if (tails) moe_weights_tail(F, 1, 0, 48, F.bid - 192);
    } SEAM(PH_L0_QKV);
    if (IN(PH_L0_ATT)) { REFRESH();
        float lam;
        { const float a = F.in[I_LQ1][F.lane] * F.in[I_LK1][F.lane], b = F.in[I_LQ2][F.lane] * F.in[I_LK2][F.lane]; lam = expf(wave_sum(a)) - expf(wave_sum(b)) + 0.2f; }
        const bf16_t* q = F.W<bf16_t>(RB_Q); const bf16_t* k = F.W<bf16_t>(RB_K); const bf16_t* v = F.W<bf16_t>(RB_V); bf16_t* o = F.W<bf16_t>(RB_O);
        if (tails && ((F.bid >> 3) & 3) == 0) { const int rank = (F.bid >> 5) * 8 + (F.bid & 7);
            weights_range(F, 0, 0, rank * 384, rank * 384 + 384, F.wave, NWAVES);
            weights_range(F, 1, 0, 18432 + rank * 96, 18432 + rank * 96 + 96, F.wave, NWAVES);
            weights_range(F, 3, 0, 3072 + rank * 336, 3072 + rank * 336 + 336, F.wave, NWAVES);
            __syncthreads(); }
        { unsigned* qcnt = (unsigned*)(F.ws + WS_CTL) + 160000; volatile LAS unsigned* qslot = (volatile LAS unsigned*)(F.lds + LDS_MISC) + 8;
          const int myx = (int)(xb_xcc_id() & 7u);
          for (int s8 = 0; s8 < 8; ++s8) { const int x = (myx + s8) & 7;
            for (;;) {
                if (F.tid == 0) *qslot = __hip_atomic_fetch_add(qcnt + x * 64, 1u, __ATOMIC_RELAXED, __HIP_MEMORY_SCOPE_AGENT);
                __syncthreads();
                const int kq = (int)*qslot;
                if (kq >= 288) { __syncthreads(); break; }
                if (kq < 256) { const int bh = x + 8 * (kq >> 4), qb = kq & 15, b = bh >> 3, h = bh & 7; const size_t row0 = (size_t)b * SEQ + qb * 128;
                    at::diff_attn_unit_dma(q + (((size_t)b * 8 + h) * KVL + CTXL + qb * 128) * 128, k + ((size_t)b * 8 + h) * KVL * 128, v + ((size_t)b * 8 + h) * KVL * 128, o + row0 * D + h * 128, KVL, lam, 0.8f, F.in[I_SUBLN], (LAS char*)F.lds); }
                else { const int kk = kq - 256, bh = x + 8 * (kk >> 1), qb = kk & 1, b = bh >> 3, h = bh & 7; const size_t row0 = (size_t)NLAT + (size_t)b * CTXL + qb * 128;
                    at::diff_attn_unit_dma(q + (((size_t)b * 8 + h) * KVL + qb * 128) * 128, k + ((size_t)b * 8 + h) * KVL * 128, v + ((size_t)b * 8 + h) * KVL * 128, o + row0 * D + h * 128, CTXL, lam, 0.8f, F.in[I_SUBLN], (LAS char*)F.lds); }
            } } }
#ifdef MK_PROBE_ATT
        { bf16_t* od = F.W<bf16_t>(RA_HID);
          for (int u = F.bid; u < 2048 + 256; u += F.G) {
            if (u < 2048) { const int b = u >> 7, h = (u >> 4) & 7, qb = u & 15; const size_t row0 = (size_t)b * SEQ + qb * 128;
                at::diff_attn_unit<MK_PROBE_ATT>(q + (((size_t)b * 8 + h) * KVL + CTXL + qb * 128) * 128, k + ((size_t)b * 8 + h) * KVL * 128, v + ((size_t)b * 8 + h) * KVL * 128, od + row0 * D + h * 128, KVL, lam, 0.8f, F.in[I_SUBLN], (LAS char*)F.lds); }
            else { const int uu = u - 2048, b = uu >> 4, h = (uu >> 1) & 7, qb = uu & 1; const size_t row0 = (size_t)NLAT + (size_t)b * CTXL + qb * 128;
                at::diff_attn_unit<MK_PROBE_ATT>(q + (((size_t)b * 8 + h) * KVL + qb * 128) * 128, k + ((size_t)b * 8 + h) * KVL * 128, v + ((size_t)b * 8 + h) * KVL * 128, od + row0 * D + h * 128, CTXL, lam, 0.8f, F.in[I_SUBLN], (LAS char*)F.lds); }
          } }
#endif
    } SEAM(PH_L0_ATT);
    if (IN(PH_L0_OUT)) { REFRESH(); out_phase(F, 0, (const char*)(F.ws + RB_O), 2048, 1024, WS_WO0, 144); if (tails) moe_weights_tail(F, 1, 3072, 48, F.bid - 64); } SEAM(PH_L0_OUT);
    if (IN(PH_L0_N2)) { REFRESH(); norm2_phase(F, 0, true); } SEAM(PH_L0_N2);
    if (IN(PH_L0_TOPK)) { REFRESH(); topk_phase(F, true); } SEAM(PH_L0_TOPK);
    if (IN(PH_L0_GU)) { REFRESH(); gu_phase(F, 0, true); } SEAM(PH_L0_GU);
    if (IN(PH_L0_DOWN)) { REFRESH(); down_phase(F, 0, true); if (tails) moe_weights_tail(F, 1, 12288, 48, F.bid - 128); } SEAM(PH_L0_DOWN);

    if (IN(PH_L1_N1)) { REFRESH();
        norm1_phase<true>(F, 1, true, true);
        if (!tails) moe_weights_phase(F, 1, 0);
    } SEAM(PH_L1_N1);
    if (IN(PH_L1_GMIN)) { REFRESH();
        { gm::P_GMU p; p.hx = (const char*)(F.ws + WS_HX); p.W = (const char*)(F.ws + WS_WGIN); p.u_out = F.W<bf16_t>(RB_U); gm::gemm_phase(F.lds, p); }
        { gm::P_GMV p; p.hx = (const char*)(F.ws + WS_HX); p.W = (const char*)(F.ws + WS_WGIN); p.vT = F.W<bf16_t>(RB_VT); p.sumsq = F.W<float>(WS_SUMSQ); gm::gemm_phase(F.lds, p, F.G - 1 - F.bid); }
    } SEAM(PH_L1_GMIN);
    if (IN(PH_L1_PREP)) { REFRESH(); gm_prep_phase(F); } SEAM(PH_L1_PREP);
    if (IN(PH_L1_SPAT)) { REFRESH();
        gm::P_SPAT p; p.App = (const char*)(F.ws + RA_APP); p.vT = (const char*)(F.ws + RB_VT); p.u_io = F.W<bf16_t>(RB_U); p.v_g = F.in[I_GMVG]; p.b_s = F.in[I_GMBS]; p.zeros = (const char*)(F.ws + WS_CTL + 800 * 1024);
        gm::gemm_phase(F.lds, p);
    } SEAM(PH_L1_SPAT);
    if (IN(PH_L1_OUT)) { REFRESH(); out_phase(F, 1, (const char*)(F.ws + RB_U), 4096, 2048, WS_WGOUT, 144); if (tails) moe_weights_tail(F, 2, 0, 96, F.bid - 64); } SEAM(PH_L1_OUT);
    if (IN(PH_L1_N2)) { REFRESH(); norm2_phase(F, 1, true); } SEAM(PH_L1_N2);
    if (IN(PH_L1_TOPK)) { REFRESH(); topk_phase(F, true); } SEAM(PH_L1_TOPK);
    if (IN(PH_L1_GU)) { REFRESH(); gu_phase(F, 1, true); } SEAM(PH_L1_GU);
    if (IN(PH_L1_DOWN)) { REFRESH(); down_phase(F, 1, true); if (tails) moe_weights_tail(F, 2, 18432, 48, F.bid - 128); } SEAM(PH_L1_DOWN);

    if (IN(PH_L2_N1)) { REFRESH(); norm1_phase<true>(F, 2, true, true); if (!tails) moe_weights_phase(F, 2); } SEAM(PH_L2_N1);
    if (IN(PH_L2_QKV)) { REFRESH();
        gm::P_QKV2 p; p.A = (const char*)(F.ws + WS_HX); p.B = (const char*)(F.ws + WS_WQKV2); p.q = F.W<bf16_t>(RB_Q); p.k = F.W<bf16_t>(RB_K); p.v = F.W<bf16_t>(RB_V);
        gm::gemm_phase(F.lds, p);
        if (tails) moe_weights_tail(F, 3, 0, 48, F.bid - 192);
    } SEAM(PH_L2_QKV);
    if (IN(PH_L2_ATT)) { REFRESH();
        for (int u = F.bid; u < 2048; u += F.G) { const int b = u >> 7, h = (u >> 3) & 15, R4 = u & 7;
            at::natten_unit(F.W<bf16_t>(RB_Q), F.W<bf16_t>(RB_K), F.W<bf16_t>(RB_V), F.W<bf16_t>(RB_O), F.in[I_NARPB], b, h, R4, (LAS char*)F.lds); }
    } SEAM(PH_L2_ATT);
    if (IN(PH_L2_OUT)) { REFRESH(); out_phase(F, 2, (const char*)(F.ws + RB_O), 2048, 1024, WS_WO2, 128); } SEAM(PH_L2_OUT);
    if (IN(PH_L2_N2)) { REFRESH(); norm2_phase(F, 2, false); } SEAM(PH_L2_N2);
    if (IN(PH_L2_TOPK)) { REFRESH(); topk_phase(F, false); } SEAM(PH_L2_TOPK);
    if (IN(PH_L2_GU)) { REFRESH(); gu_phase(F, 2, false); } SEAM(PH_L2_GU);
    if (IN(PH_L2_DOWN)) { REFRESH(); down_phase(F, 2, false); } SEAM(PH_L2_DOWN);

    if (IN(PH_L3_N1)) { REFRESH();
        NormArgs A{};
        A.xsrc = F.W<float>(WS_X); A.xdst = F.W<float>(WS_X); A.csrc = F.W<float>(WS_CTX); A.cdst = F.W<float>(WS_CTX); A.do_lat = 1; A.do_ctx = 0; A.xbf = 1;
        A.gain = F.in[I_MNG] + 3 * D; A.shift = modp(F, 3, 0); A.scale = modp(F, 3, 1); A.hx = F.W<bf16_t>(WS_HX);
        A.ys = F.W<bf16_t>(RA_YS); A.tokslot = F.W<int>(WS_TOKSLOT); A.tokslotc = F.W<int>(WS_TOKSLOTC); A.g2 = modp(F, 2, 5); A.ctx_comb = 0;
        norm_fold_phase<true>(F, A);
        if (!tails) moe_weights_phase(F, 3, 0); } SEAM(PH_L3_N1);
    if (IN(PH_L3_CDFT)) { REFRESH();
        gm::P_CDFT p; p.CS = (const char*)(F.ws + WS_CS); p.hx = (const char*)(F.ws + WS_HX); p.PQt = F.W<bf16_t>(RB_PQ);
        gm::gemm_phase(F.lds, p);
    } SEAM(PH_L3_CDFT);
    if (IN(PH_L3_PDFT)) { REFRESH();
        gm::P_PDFT p; p.DP = (const char*)(F.ws + WS_DP); p.PQt = (const char*)(F.ws + RB_PQ); p.f = F.W<bf16_t>(RB_F);
        gm::gemm_phase(F.lds, p);
    } SEAM(PH_L3_PDFT);
    if (IN(PH_L3_OUT)) { REFRESH(); out_phase(F, 3, (const char*)(F.ws + RB_F), 2048, 1024, WS_WFO, 128); } SEAM(PH_L3_OUT);
    if (IN(PH_L3_N2)) { REFRESH(); norm2_phase(F, 3, false); } SEAM(PH_L3_N2);
    if (IN(PH_L3_TOPK)) { REFRESH(); topk_phase(F, false); } SEAM(PH_L3_TOPK);
    if (IN(PH_L3_GU)) { REFRESH(); gu_phase(F, 3, false); } SEAM(PH_L3_GU);
    if (IN(PH_L3_DOWN)) { REFRESH(); down_phase(F, 3, false); } SEAM(PH_L3_DOWN);

    if (IN(PH_FINAL)) { REFRESH();
        NormArgs A{};
        A.xsrc = F.W<float>(WS_X); A.do_lat = 1; A.do_ctx = 0; A.xbf = 1; A.gain = F.in[I_FINALG];
        A.ys = F.W<bf16_t>(RA_YS); A.tokslot = F.W<int>(WS_TOKSLOT); A.tokslotc = F.W<int>(WS_TOKSLOTC); A.g2 = modp(F, 3, 5); A.out = F.out;
        norm_phase<true, false, true>(F, A);
    }
#undef IN
#undef SEAM
}

extern "C" void kernel_launch(void* const* d_in, const int* in_sizes, int n_in, void* d_out, int out_size, void* d_ws, size_t ws_size, hipStream_t stream) {
    static int grid = 0;
    if (grid == 0) {
        if (n_in != 29 || in_sizes[0] != NLAT * D || out_size != NLAT * D || ws_size < WS_END) {
            fprintf(stderr, "kernel_launch: shape mismatch: n_in %d in0 %d out %d ws %zu (need >= %zu)\n", n_in, n_in > 0 ? in_sizes[0] : -1, out_size, ws_size, (size_t)WS_END); grid = -1; return; }
        int dev = 0, cus = 0, per_cu = 0;
        if (hipGetDevice(&dev) != hipSuccess || hipDeviceGetAttribute(&cus, hipDeviceAttributeMultiprocessorCount, dev) != hipSuccess) { grid = -1; return; }
        if (hipFuncSetAttribute((const void*)fwd, hipFuncAttributeMaxDynamicSharedMemorySize, LDS_BYTES) != hipSuccess) { fprintf(stderr, "kernel_launch: hipFuncSetAttribute failed\n"); grid = -1; return; }
        if (hipOccupancyMaxActiveBlocksPerMultiprocessor(&per_cu, (const void*)fwd, NTHREADS, LDS_BYTES) != hipSuccess || per_cu < 1) { fprintf(stderr, "kernel_launch: occupancy query says %d\n", per_cu); (void)hipGetLastError(); per_cu = 1; }
        grid = cus;
    }
    if (grid < 0) return;
    (void)hipMemsetAsync((char*)d_ws + WS_CTL, 0, CTL_BYTES, stream);
    Params p{};
    for (int i = 0; i < 29; ++i) p.in[i] = (const float*)d_in[i];
    p.out = (float*)d_out; p.ws = (unsigned char*)d_ws;
#ifndef MK_RANGES
#define MK_RANGES 0, NPHASES
#endif
    static const int ranges[] = { MK_RANGES };
    for (unsigned r = 0; r + 1 < sizeof(ranges) / sizeof(ranges[0]); r += 2) { p.ph_lo = ranges[r]; p.ph_hi = ranges[r + 1]; p.li = (int)(r / 2); hipLaunchKernelGGL(fwd, dim3(grid), dim3(NTHREADS), LDS_BYTES, stream, p); }
    const hipError_t le = hipPeekAtLastError();
    if (le != hipSuccess) fprintf(stderr, "kernel_launch: launch failed: %s\n", hipGetErrorName(le));
}
```
